# Optimizing an MI355X kernel written in HIP

```python
import math
import jax, jax.numpy as jnp
from jax import lax
import numpy as np

D_MODEL = 2048
BATCH = 2
SEQ = 16384
DEPTH = 2

MEM_LEN = 256
BLOCK = 128
EPS = 1e-6
NEG = -1e30

MLA_HEADS = 8
MLA_Q_RANK = 768
MLA_KV_RANK = 512
MLA_NOPE = 128
MLA_ROPE = 64
MLA_V = 128
ROPE_THETA = 10000.0

SWA_HEADS = 16
SWA_KV_HEADS = 2
SWA_GROUP = SWA_HEADS // SWA_KV_HEADS
SWA_HEAD_DIM = 64
WINDOW = 128

REL_BUCKETS = 32
REL_MAX_DIST = 128

FOX_HEADS = 16
FOX_HEAD_DIM = 128
FOX_WIDTH = FOX_HEADS * FOX_HEAD_DIM

X_HEADS = 4
X_HEAD_DIM = 128
X_WIDTH = X_HEADS * X_HEAD_DIM

D_FF = 7168
N_EXPERTS = 8
TOP_K = 2

N_EVEN = (DEPTH + 1) // 2
N_ODD = DEPTH // 2

EVEN_SPLITS = (
    MLA_Q_RANK,
    MLA_Q_RANK + MLA_KV_RANK,
    MLA_Q_RANK + MLA_KV_RANK + MLA_ROPE,
    MLA_Q_RANK + MLA_KV_RANK + MLA_ROPE + SWA_HEADS * SWA_HEAD_DIM,
    MLA_Q_RANK + MLA_KV_RANK + MLA_ROPE + (SWA_HEADS + SWA_KV_HEADS) * SWA_HEAD_DIM,
)
EVEN_IN = MLA_Q_RANK + MLA_KV_RANK + MLA_ROPE + (SWA_HEADS + 2 * SWA_KV_HEADS) * SWA_HEAD_DIM
EVEN_OUT = MLA_HEADS * MLA_V + SWA_HEADS * SWA_HEAD_DIM
ODD_SPLITS = (FOX_WIDTH, 2 * FOX_WIDTH, 3 * FOX_WIDTH)
ODD_IN = 3 * FOX_WIDTH + FOX_HEADS

kernel_name = "hybrid_mla_swa_fox_moe_trunk"


def rmsnorm(x, g):
    xf = x.astype(jnp.float32)
    y = xf * lax.rsqrt(jnp.mean(xf * xf, axis=-1, keepdims=True) + EPS)
    return (y * g.astype(jnp.float32)).astype(x.dtype)


def rope(x, positions):
    half = x.shape[-1] // 2
    inv = ROPE_THETA ** (-jnp.arange(half, dtype=jnp.float32) / half)
    ang = positions.astype(jnp.float32)[..., None] * inv
    ang = ang.reshape(ang.shape[:2] + (1,) * (x.ndim - 3) + (half,))
    cos, sin = jnp.cos(ang), jnp.sin(ang)
    xf = x.astype(jnp.float32)
    x1, x2 = xf[..., :half], xf[..., half:]
    return jnp.concatenate([x1 * cos - x2 * sin, x2 * cos + x1 * sin], axis=-1).astype(x.dtype)


def t5_bucket(dist):
    max_exact = REL_BUCKETS // 2
    large = max_exact + (jnp.log(jnp.maximum(dist, 1).astype(jnp.float32) / max_exact)
                         / math.log(REL_MAX_DIST / max_exact) * (REL_BUCKETS - max_exact)).astype(jnp.int32)
    large = jnp.minimum(large, REL_BUCKETS - 1)
    return jnp.where(dist < max_exact, dist, large)


def causal_block_attention(q, k, v, scale, decay=None):
    B, S, H, _ = q.shape
    Dv = v.shape[-1]
    nb = S // BLOCK
    kpos = jnp.arange(S)
    if decay is not None:
        dk = jnp.swapaxes(decay, 1, 2)

    def step(n):
        start = n * BLOCK
        qblk = lax.dynamic_slice_in_dim(q, start, BLOCK, axis=1)
        s = jnp.einsum('bqhd,bshd->bhqs', qblk, k).astype(jnp.float32) * scale
        if decay is not None:
            dq = lax.dynamic_slice_in_dim(decay, start, BLOCK, axis=1)
            s = s + jnp.swapaxes(dq, 1, 2)[..., None] - dk[:, :, None, :]
        qpos = start + jnp.arange(BLOCK)
        s = jnp.where(kpos[None, :] <= qpos[:, None], s, NEG)
        p = jax.nn.softmax(s, axis=-1).astype(v.dtype)
        return jnp.einsum('bhqs,bshd->bqhd', p, v)

    out = lax.map(step, jnp.arange(nb))
    return jnp.moveaxis(out, 0, 1).reshape(B, S, H * Dv)


def sliding_window_attention(q, k, v, sinks, rel_bias):
    B, S = q.shape[:2]
    nb = S // BLOCK
    qb = q.reshape(B, nb, BLOCK, SWA_KV_HEADS, SWA_GROUP, SWA_HEAD_DIM)

    def band(a):
        a = a.reshape(B, nb, BLOCK, SWA_KV_HEADS, SWA_HEAD_DIM)
        prev = jnp.pad(a, ((0, 0), (1, 0), (0, 0), (0, 0), (0, 0)))[:, :-1]
        return jnp.concatenate([prev, a], axis=2)

    kb, vb = band(k), band(v)
    s = jnp.einsum('bnqkgd,bnskd->bnkgqs', qb, kb).astype(jnp.float32) * (SWA_HEAD_DIM ** -0.5)
    i = jnp.arange(BLOCK)[:, None]
    j = jnp.arange(2 * BLOCK)[None, :]
    rel = BLOCK + i - j
    bias = rel_bias[t5_bucket(jnp.maximum(rel, 0))].astype(jnp.float32)
    bias = jnp.transpose(bias, (2, 0, 1)).reshape(SWA_KV_HEADS, SWA_GROUP, BLOCK, 2 * BLOCK)
    s_abs = (jnp.arange(nb)[:, None, None] - 1) * BLOCK + j
    valid = (rel >= 0) & (rel < WINDOW) & (s_abs >= 0)
    s = jnp.where(valid[None, :, None, None], s + bias, NEG)
    sink = jnp.broadcast_to(sinks.astype(jnp.float32).reshape(1, 1, SWA_KV_HEADS, SWA_GROUP, 1, 1),
                            s.shape[:-1] + (1,))
    p = jax.nn.softmax(jnp.concatenate([s, sink], axis=-1), axis=-1)[..., :-1].astype(v.dtype)
    o = jnp.einsum('bnkgqs,bnskd->bnqkgd', p, vb)
    return o.reshape(B, S, SWA_HEADS * SWA_HEAD_DIM)


def even_mixer(h, positions, rel_bias, w_in, q_norm, w_uq, kv_norm, w_ukv, sinks, w_o):
    B, S, _ = h.shape
    z = h @ w_in
    c_q, c_kv, k_rope, q_s, k_s, v_s = jnp.split(z, EVEN_SPLITS, axis=-1)
    q = (rmsnorm(c_q, q_norm) @ w_uq).reshape(B, S, MLA_HEADS, MLA_NOPE + MLA_ROPE)
    q = jnp.concatenate([q[..., :MLA_NOPE], rope(q[..., MLA_NOPE:], positions)], axis=-1)
    kv = (rmsnorm(c_kv, kv_norm) @ w_ukv).reshape(B, S, MLA_HEADS, MLA_NOPE + MLA_V)
    k_pe = jnp.broadcast_to(rope(k_rope, positions)[:, :, None, :], (B, S, MLA_HEADS, MLA_ROPE))
    k = jnp.concatenate([kv[..., :MLA_NOPE], k_pe], axis=-1)
    o_mla = causal_block_attention(q, k, kv[..., MLA_NOPE:], (MLA_NOPE + MLA_ROPE) ** -0.5)
    o_swa = sliding_window_attention(
        q_s.reshape(B, S, SWA_HEADS, SWA_HEAD_DIM),
        k_s.reshape(B, S, SWA_KV_HEADS, SWA_HEAD_DIM),
        v_s.reshape(B, S, SWA_KV_HEADS, SWA_HEAD_DIM),
        sinks, rel_bias)
    return jnp.concatenate([o_mla, o_swa], axis=-1) @ w_o


def odd_mixer(h, w_in, b_f, w_o):
    B, S, _ = h.shape
    z = h @ w_in
    q, k, v, f_logit = jnp.split(z, ODD_SPLITS, axis=-1)
    log_f = jax.nn.log_sigmoid(f_logit.astype(jnp.float32) + b_f.astype(jnp.float32))
    decay = jnp.cumsum(log_f, axis=1)
    shp = (B, S, FOX_HEADS, FOX_HEAD_DIM)
    o = causal_block_attention(q.reshape(shp), k.reshape(shp), v.reshape(shp),
                               FOX_HEAD_DIM ** -0.5, decay)
    return o @ w_o


def cross_attention(h, mem_n, w_q, w_k, w_v, w_o):
    B, S, _ = h.shape
    M = mem_n.shape[1]
    q = (h @ w_q).reshape(B, S, X_HEADS, X_HEAD_DIM)
    k = (mem_n @ w_k).reshape(B, M, X_HEADS, X_HEAD_DIM)
    v = (mem_n @ w_v).reshape(B, M, X_HEADS, X_HEAD_DIM)
    s = jnp.einsum('bqhd,bmhd->bhqm', q, k).astype(jnp.float32) * (X_HEAD_DIM ** -0.5)
    p = jax.nn.softmax(s, axis=-1).astype(v.dtype)
    return jnp.einsum('bhqm,bmhd->bqhd', p, v).reshape(B, S, X_WIDTH) @ w_o


def swiglu(h, w_gate, w_up, w_down):
    return (jax.nn.silu(h @ w_gate) * (h @ w_up)) @ w_down


def moe_swiglu(h, w_router, b_router, w_gate, w_up, w_down):
    logits = (h @ w_router).astype(jnp.float32) + b_router.astype(jnp.float32)
    top_vals, top_idx = lax.top_k(logits, TOP_K)
    gates = jax.nn.softmax(top_vals, axis=-1)
    combine = jnp.sum(jax.nn.one_hot(top_idx, N_EXPERTS, dtype=jnp.float32) * gates[..., None], axis=-2)
    out = jnp.zeros_like(h)
    for e in range(N_EXPERTS):
        out = out + swiglu(h, w_gate[e], w_up[e], w_down[e]) * combine[..., e:e + 1].astype(h.dtype)
    return out


def setup_inputs(seed: int = 0) -> dict:
    key = jax.random.key(seed)
    ks = iter(jax.random.split(key, 64))
    f32 = jnp.float32

    def w(shape, fan_in):
        return jax.random.normal(next(ks), shape, f32) * (fan_in ** -0.5)

    def gain(shape):
        return 1.0 + 0.05 * jax.random.normal(next(ks), shape, f32)

    x = jax.random.normal(next(ks), (BATCH, SEQ, D_MODEL), f32)
    mem = jax.random.normal(next(ks), (BATCH, MEM_LEN, D_MODEL), f32)
    offset = jax.random.randint(next(ks), (BATCH, 1), 0, 4096, dtype=jnp.int32)
    positions = offset + jnp.arange(SEQ, dtype=jnp.int32)[None, :]
    return {
        "x": x,
        "mem": mem,
        "positions": positions,
        "rel_bias": 0.5 * jax.random.normal(next(ks), (REL_BUCKETS, SWA_HEADS), f32),
        "norm_mix": gain((DEPTH, D_MODEL)),
        "norm_cross": gain((DEPTH, D_MODEL)),
        "norm_mem": gain((DEPTH, D_MODEL)),
        "norm_ffn": gain((DEPTH, D_MODEL)),
        "x_wq": w((DEPTH, D_MODEL, X_WIDTH), D_MODEL),
        "x_wk": w((DEPTH, D_MODEL, X_WIDTH), D_MODEL),
        "x_wv": w((DEPTH, D_MODEL, X_WIDTH), D_MODEL),
        "x_wo": w((DEPTH, X_WIDTH, D_MODEL), X_WIDTH),
        "ev_w_in": w((N_EVEN, D_MODEL, EVEN_IN), D_MODEL),
        "ev_mla_q_norm": gain((N_EVEN, MLA_Q_RANK)),
        "ev_mla_w_uq": w((N_EVEN, MLA_Q_RANK, MLA_HEADS * (MLA_NOPE + MLA_ROPE)), MLA_Q_RANK),
        "ev_mla_kv_norm": gain((N_EVEN, MLA_KV_RANK)),
        "ev_mla_w_ukv": w((N_EVEN, MLA_KV_RANK, MLA_HEADS * (MLA_NOPE + MLA_V)), MLA_KV_RANK),
        "ev_swa_sinks": jax.random.normal(next(ks), (N_EVEN, SWA_HEADS), f32),
        "ev_w_o": w((N_EVEN, EVEN_OUT, D_MODEL), EVEN_OUT),
        "ev_ffn_w_gate": w((N_EVEN, D_MODEL, D_FF), D_MODEL),
        "ev_ffn_w_up": w((N_EVEN, D_MODEL, D_FF), D_MODEL),
        "ev_ffn_w_down": w((N_EVEN, D_FF, D_MODEL), D_FF),
        "od_w_in": w((N_ODD, D_MODEL, ODD_IN), D_MODEL),
        "od_fox_b_f": jax.random.uniform(next(ks), (N_ODD, FOX_HEADS), f32, 1.0, 6.0),
        "od_w_o": w((N_ODD, FOX_WIDTH, D_MODEL), FOX_WIDTH),
        "od_router_w": w((N_ODD, D_MODEL, N_EXPERTS), D_MODEL),
        "od_router_b": 0.01 * jax.random.normal(next(ks), (N_ODD, N_EXPERTS), f32),
        "od_moe_w_gate": w((N_ODD, N_EXPERTS, D_MODEL, D_FF), D_MODEL),
        "od_moe_w_up": w((N_ODD, N_EXPERTS, D_MODEL, D_FF), D_MODEL),
        "od_moe_w_down": w((N_ODD, N_EXPERTS, D_FF, D_MODEL), D_FF),
        "final_norm": gain((D_MODEL,)),
    }


def reference(x, mem, positions, rel_bias, norm_mix, norm_cross, norm_mem, norm_ffn,
              x_wq, x_wk, x_wv, x_wo,
              ev_w_in, ev_mla_q_norm, ev_mla_w_uq, ev_mla_kv_norm, ev_mla_w_ukv,
              ev_swa_sinks, ev_w_o, ev_ffn_w_gate, ev_ffn_w_up, ev_ffn_w_down,
              od_w_in, od_fox_b_f, od_w_o, od_router_w, od_router_b,
              od_moe_w_gate, od_moe_w_up, od_moe_w_down, final_norm):
    for layer in range(DEPTH):
        i = layer // 2
        h = rmsnorm(x, norm_mix[layer])
        if layer % 2 == 0:
            x = x + even_mixer(h, positions, rel_bias, ev_w_in[i], ev_mla_q_norm[i], ev_mla_w_uq[i],
                               ev_mla_kv_norm[i], ev_mla_w_ukv[i], ev_swa_sinks[i], ev_w_o[i])
        else:
            x = x + odd_mixer(h, od_w_in[i], od_fox_b_f[i], od_w_o[i])
        x = x + cross_attention(rmsnorm(x, norm_cross[layer]), rmsnorm(mem, norm_mem[layer]),
                                x_wq[layer], x_wk[layer], x_wv[layer], x_wo[layer])
        h = rmsnorm(x, norm_ffn[layer])
        if layer % 2 == 0:
            x = x + swiglu(h, ev_ffn_w_gate[i], ev_ffn_w_up[i], ev_ffn_w_down[i])
        else:
            x = x + moe_swiglu(h, od_router_w[i], od_router_b[i],
                               od_moe_w_gate[i], od_moe_w_up[i], od_moe_w_down[i])
    return rmsnorm(x, final_norm)
```

```cpp
#include <hip/hip_runtime.h>
#include <hip/hip_bf16.h>
#include <cstdio>
#include <cstdint>
#include <cmath>

#ifndef MK_ONE_LAUNCH
#define MK_ONE_LAUNCH 1
#endif

#define GAS __attribute__((address_space(1)))
#define LAS __attribute__((address_space(3)))
typedef unsigned short bf16_t;
typedef short bf16x8 __attribute__((ext_vector_type(8)));
typedef short s16x4 __attribute__((ext_vector_type(4)));
typedef float f32x2 __attribute__((ext_vector_type(2)));
typedef float f32x4 __attribute__((ext_vector_type(4)));
typedef float f32x16 __attribute__((ext_vector_type(16)));
typedef unsigned u32x2 __attribute__((ext_vector_type(2)));
typedef unsigned u32x4 __attribute__((ext_vector_type(4)));
typedef int i32x4 __attribute__((ext_vector_type(4)));
typedef long i64x2 __attribute__((ext_vector_type(2)));

constexpr int BATCH = 2, SEQ = 16384, DM = 2048, M = BATCH * SEQ, MEMLEN = 256, MROWS = BATCH * MEMLEN;
constexpr int EVEN_IN = 2624, Z0_LD = 2816, ODD_IN = 6160, Z1_LD = 6144, IN1_PAD = 6400;
constexpr int DFF = 7168, NEXP = 8;
constexpr int HLD = DFF + 64;
constexpr int QM_LD = 1536, KM_LD = 1536, VM_LD = 1024;
constexpr float LOG2E = 1.4426950408889634f;
constexpr float C2_MLA = LOG2E * 0.07216878364870323f;
constexpr float C2_SWA = LOG2E * 0.125f;
constexpr float C2_128 = LOG2E * 0.08838834764831845f;
constexpr float EPS = 1e-6f;
constexpr int CHUNK_ROWS = 8192, CHUNK_TILES = 32, MOE_MAX_TILES = 264, MOE_MAX_ROWS = MOE_MAX_TILES * 256, MOE_CHUNKS = 9;

enum { I_X = 0, I_MEM, I_POS, I_RELB, I_NMIX, I_NCROSS, I_NMEM, I_NFFN, I_XWQ, I_XWK, I_XWV, I_XWO, I_EVWIN, I_QNORM, I_WUQ, I_KVNORM, I_WUKV, I_SINKS, I_EVWO,
       I_FG, I_FU, I_FD, I_ODWIN, I_BF, I_ODWO, I_RW, I_RB, I_MG, I_MU, I_MD, I_FNORM, N_IN };

constexpr size_t al256(size_t x) { return (x + 255) & ~(size_t)255; }
constexpr size_t WS_CTL = 0, CTL_BYTES = 1u << 20;
constexpr size_t E_IN0 = (size_t)Z0_LD * DM, E_UQ = (size_t)1536 * 768, E_UKV = (size_t)2048 * 512, E_SQ = (size_t)DM * DM, E_XQ = (size_t)512 * DM, E_XKV = (size_t)2048 * DM,
                 E_XO = (size_t)DM * 512, E_GU = (size_t)2 * DFF * DM, E_D = (size_t)DM * DFF, E_IN1 = (size_t)IN1_PAD * DM;
constexpr size_t WS_WIN0 = WS_CTL + CTL_BYTES;
constexpr size_t WS_WUQ = WS_WIN0 + 2 * E_IN0;
constexpr size_t WS_WUKV = WS_WUQ + 2 * E_UQ;
constexpr size_t WS_WO0 = WS_WUKV + 2 * E_UKV;
constexpr size_t WS_WXQ = WS_WO0 + 2 * E_SQ;
constexpr size_t WS_WXKV = WS_WXQ + 2 * 2 * E_XQ;
constexpr size_t WS_WXO = WS_WXKV + 2 * E_XKV;
constexpr size_t WS_WGU0 = WS_WXO + 2 * 2 * E_XO;
constexpr size_t WS_WD0 = WS_WGU0 + 2 * E_GU;
constexpr size_t WS_WIN1 = WS_WD0 + 2 * E_D;
constexpr size_t WS_WO1 = WS_WIN1 + 2 * E_IN1;
constexpr size_t WS_WGU1 = WS_WO1 + 2 * E_SQ;
constexpr size_t WS_WD1 = WS_WGU1 + 2 * 8 * E_GU;
constexpr size_t WS_XB = WS_WD1 + 2 * 8 * E_D;
constexpr size_t WS_SSQ = WS_XB + (size_t)M * DM * 2;
constexpr size_t WS_ROPE = WS_SSQ + (size_t)M * 32 * 4;
constexpr size_t WS_MEMN = WS_ROPE + (size_t)M * 64 * 4;
constexpr size_t WS_SSQM = WS_MEMN + (size_t)MROWS * DM * 2;
constexpr size_t WS_MEMKV = WS_SSQM + (size_t)MROWS * 32 * 4;
constexpr size_t WS_SSQQ = WS_MEMKV + (size_t)MROWS * 2048 * 2;
constexpr size_t WS_SSQKV = WS_SSQQ + (size_t)M * 12 * 4;
constexpr size_t WS_QX = WS_SSQKV + (size_t)M * 8 * 4;
constexpr size_t WS_OX = WS_QX + (size_t)M * 512 * 2;
constexpr size_t WS_FL = WS_OX + (size_t)M * 512 * 2;
constexpr size_t WS_DEC = WS_FL + (size_t)M * 16 * 4;
constexpr size_t WS_TOPE = WS_DEC + (size_t)M * 16 * 4;
constexpr size_t WS_TOPS = WS_TOPE + (size_t)M * 2 * 4;
constexpr size_t WS_TOPG = WS_TOPS + (size_t)M * 2 * 4;
constexpr size_t WS_RSTDF = WS_TOPG + (size_t)M * 2 * 4;
constexpr size_t WS_TOKPOS = WS_RSTDF + (size_t)M * 4;
constexpr size_t WS_ROWIDX = WS_TOKPOS + (size_t)M * 2 * 4;
constexpr size_t WS_GATEP = WS_ROWIDX + (size_t)MOE_MAX_ROWS * 4;
constexpr size_t WS_RSTDP = WS_GATEP + (size_t)MOE_MAX_ROWS * 4;
constexpr size_t WS_BIAST = WS_RSTDP + (size_t)MOE_MAX_ROWS * 4;
constexpr size_t WS_ARENA = al256(WS_BIAST + 16 * 128 * 4);
constexpr size_t AR_Z0 = 0;
constexpr size_t AR_QM = AR_Z0 + (size_t)M * Z0_LD * 2;
constexpr size_t AR_KM = AR_QM + (size_t)M * QM_LD * 2;
constexpr size_t AR_VM = AR_KM + (size_t)M * KM_LD * 2;
constexpr size_t AR_O0 = AR_VM + (size_t)M * VM_LD * 2;
constexpr size_t AR_END0 = AR_O0 + (size_t)M * DM * 2;
constexpr size_t AR_HID = 0;
constexpr size_t HID_BYTES = (size_t)CHUNK_ROWS * DFF * 2;
constexpr size_t AR_Y = AR_HID + 2 * HID_BYTES;
constexpr size_t AR_END2 = AR_Y + (size_t)MOE_MAX_ROWS * DM * 2;
constexpr size_t AR_Z1 = 0;
constexpr size_t AR_O1 = AR_Z1 + (size_t)M * Z1_LD * 2;
constexpr size_t AR_END1 = AR_O1 + (size_t)M * DM * 2;
constexpr size_t AR_SIZE = AR_END0 > AR_END1 ? (AR_END0 > AR_END2 ? AR_END0 : AR_END2) : (AR_END1 > AR_END2 ? AR_END1 : AR_END2);
constexpr size_t WS_END = WS_ARENA + AR_SIZE;

constexpr int CW_BAR = 4096;
constexpr int CW_CNT = 16384;
constexpr int CW_KMAX = 20480;
constexpr int CW_Q18 = 24576;
constexpr int CW_AMAX15 = 32768;
constexpr int CW_AMAX0 = 40960;
constexpr int CW_AMAXW = 131072;
static_assert((CW_AMAXW + 9 * 14336) * 4 <= (int)CTL_BYTES, "CTL map");

constexpr int RING_BYTES = 131072;
constexpr int MISC_OFF = RING_BYTES + 320;
constexpr int LDS_BYTES = 147456;
constexpr int NWAVES = 8;
#ifndef WGM_GU
#define WGM_GU 4
#endif
#ifndef WGM_K2048
#define WGM_K2048 4
#endif
#ifndef WGM_DOWN
#define WGM_DOWN 8
#endif

#define LDS_WAIT() asm volatile("s_waitcnt lgkmcnt(0)" ::: "memory")
#define VM_WAIT() asm volatile("s_waitcnt vmcnt(0)" ::: "memory")
#define RLX_AGENT __ATOMIC_RELAXED, __HIP_MEMORY_SCOPE_AGENT
__device__ __forceinline__ unsigned cvt_pk_bf16(float lo, float hi) { unsigned r; asm volatile("v_cvt_pk_bf16_f32 %0, %1, %2" : "=v"(r) : "v"(lo), "v"(hi)); return r; }
typedef _Float16 h16x2 __attribute__((ext_vector_type(2)));
typedef _Float16 h16x8 __attribute__((ext_vector_type(8)));
__device__ __forceinline__ unsigned pk_f16(float lo, float hi) { const h16x2 v = {(_Float16)lo, (_Float16)hi}; return __builtin_bit_cast(unsigned, v); }
__device__ __forceinline__ f32x2 unpk_f16(unsigned u) { const h16x2 v = __builtin_bit_cast(h16x2, u); return (f32x2){(float)v.x, (float)v.y}; }
__device__ __forceinline__ f32x4 unpk_f16x4(u32x2 u) { const f32x2 a = unpk_f16(u.x), b = unpk_f16(u.y); return (f32x4){a.x, a.y, b.x, b.y}; }
__device__ __forceinline__ u32x2 pack8_fp8(f32x4 a, f32x4 b) {
    int lo = 0, hi = 0;
    lo = __builtin_amdgcn_cvt_pk_fp8_f32(a[0], a[1], lo, false); lo = __builtin_amdgcn_cvt_pk_fp8_f32(a[2], a[3], lo, true);
    hi = __builtin_amdgcn_cvt_pk_fp8_f32(b[0], b[1], hi, false); hi = __builtin_amdgcn_cvt_pk_fp8_f32(b[2], b[3], hi, true);
    return (u32x2){(unsigned)lo, (unsigned)hi};
}
__device__ __forceinline__ float bf2f(unsigned short b) { return __uint_as_float((unsigned)b << 16); }
__device__ __forceinline__ float wave_sum(float v) {
#pragma unroll
    for (int o = 1; o < 64; o <<= 1) v += __shfl_xor(v, o);
    return v;
}

#define XB_TMO      128
#define XB_XCNT(j)  (256  + 64 * (j))
#define XB_XSUB(j)  (1280 + 64 * (j))
#define XB_XGEN(j)  (2304 + 64 * (j))
#define XB_TOP      3328
#define XB_TOPGEN   3392
#define XCD_BAR_WORDS 3456
#define XB_SPIN_CAP (1u << 18)
__device__ __forceinline__ unsigned xb_ld(unsigned* p)              { return __hip_atomic_load(p, __ATOMIC_RELAXED, __HIP_MEMORY_SCOPE_AGENT); }
__device__ __forceinline__ unsigned xb_add(unsigned* p, unsigned v) { return __hip_atomic_fetch_add(p, v, __ATOMIC_RELAXED, __HIP_MEMORY_SCOPE_AGENT); }
__device__ __forceinline__ unsigned xb_xcc_id() { return (unsigned)__builtin_amdgcn_s_getreg((3 << 11) | 20) & 0xFu; }
#define XB_SPIN(cond, bar) do { unsigned _sp = 0; while (cond) { __builtin_amdgcn_s_sleep(1); \
    if ((++_sp & 255u) == 0u) { if (xb_ld(&(bar)[XB_TMO])) break; if (_sp > XB_SPIN_CAP) { atomicAdd(&(bar)[XB_TMO], 1u); break; } } } } while (0)
struct XcdBarrier { unsigned* bar; unsigned x; volatile LAS unsigned* st; };
__device__ __forceinline__ XcdBarrier xcd_barrier_post(unsigned* bar, volatile LAS unsigned* st) {
    XcdBarrier b; b.bar = bar; b.x = xb_xcc_id(); b.st = st;
    if (threadIdx.x == 0) (void)xb_add(&bar[XB_XCNT(b.x)], 1u);
    return b;
}
__device__ __forceinline__ void xcd_barrier_complete(unsigned* bar, unsigned x, unsigned& nloc, unsigned& nx) {
    const unsigned G = gridDim.x * gridDim.y * gridDim.z;
    unsigned sum, cnt, mine, sp = 0u;
    for (;;) {
        sum = 0u; cnt = 0u; mine = 0u;
#pragma unroll
        for (unsigned j = 0; j < 16; ++j) { const unsigned c = xb_ld(&bar[XB_XCNT(j)]); sum += c; cnt += (c > 0u) ? 1u : 0u; mine = (j == x) ? c : mine; }
        if (sum == G) break;
        __builtin_amdgcn_s_sleep(1);
        if ((++sp & 255u) == 0u) { if (xb_ld(&bar[XB_TMO])) break; if (sp > XB_SPIN_CAP) { atomicAdd(&bar[XB_TMO], 1u); break; } }
    }
    nloc = mine > 0u ? mine : 1u; nx = cnt > 0u ? cnt : 1u;
}
__device__ __forceinline__ void xcd_barrier(const XcdBarrier& b) {
    asm volatile("s_waitcnt vmcnt(0)" ::: "memory");
    __syncthreads();
    if (threadIdx.x == 0) {
        unsigned* bar = b.bar;
        __builtin_amdgcn_s_waitcnt(0);
        unsigned nloc = b.st[0], nx = b.st[1];
        if (nloc == 0u) { xcd_barrier_complete(bar, b.x, nloc, nx); b.st[0] = nloc; b.st[1] = nx; }
        const unsigned old = xb_add(&bar[XB_XSUB(b.x)], 1u);
        const unsigned gen = old / nloc;
        if (old + 1u == (gen + 1u) * nloc) {
            __builtin_amdgcn_fence(__ATOMIC_RELEASE, "agent");
            asm volatile("s_waitcnt vmcnt(0)" ::: "memory");
            const unsigned og = xb_add(&bar[XB_TOP], 1u);
            const unsigned tg = og / nx;
            if (og + 1u == (tg + 1u) * nx) xb_add(&bar[XB_TOPGEN], 1u);
            else XB_SPIN(xb_ld(&bar[XB_TOPGEN]) == tg, bar);
            __builtin_amdgcn_fence(__ATOMIC_ACQUIRE, "agent");
            xb_add(&bar[XB_XGEN(b.x)], 1u);
            asm volatile("s_waitcnt vmcnt(0)" ::: "memory");
        } else {
            XB_SPIN(xb_ld(&bar[XB_XGEN(b.x)]) == gen, bar);
            __builtin_amdgcn_fence(__ATOMIC_ACQUIRE, "agent");
            asm volatile("s_waitcnt vmcnt(0)" ::: "memory");
        }
    }
    __syncthreads();
}

namespace pg8 {
constexpr int BM = 256, BK = 64, HALF = 128, HTB = HALF * BK * 2, STAGE_BYTES = 8 * HTB, NXCD = 8, WGM = 8;
__host__ __device__ __forceinline__ int lds_byte(int r, int c) { const int st = (r >> 4) * 2 + (c >> 5), rr = r & 15, cc = c & 31, ob = rr * 64 + cc * 2; return st * 1024 + (ob ^ (((ob >> 9) & 1) << 5)); }
__host__ __device__ __forceinline__ void stage_rc(int b, int& R, int& C) { const int st = b / 1024, sb = b % 1024, swz = sb ^ (((sb >> 9) & 1) << 5); R = (st >> 1) * 16 + swz / 64; C = (st & 1) * 32 + (swz % 64) / 2; }
__host__ __device__ __forceinline__ int perm32(int rho) { const int n = rho >> 4, i = rho & 15; return 8 * (i >> 2) + 4 * n + (i & 3); }
struct Unit { int pm, pn; };
struct StaticOrder {
    int nM, nN, nwg, G, c, pm0, nd, qd, wgm;
    __device__ __forceinline__ void init(int nM_, int nN_, int G_, int c_, int pm0_, int wgm_ = WGM) { nM = nM_; nN = nN_; nwg = nM * nN; G = G_; c = c_; pm0 = pm0_; nd = 0; qd = 0; wgm = wgm_; }
    __device__ __forceinline__ void quota(int nd_) { nd = nd_ < G ? nd_ : 0; if (nd_ >= G) return; const int q = (nwg + 5 * nd + G - 1) / G; qd = q > 5 ? q - 5 : 0; }
    __device__ __forceinline__ bool next(int i, Unit& u) const {
        long L;
        if (nd == 0) L = (long)i * G + c;
        else if (c < nd) { if (i >= qd) return false; L = (long)i * G + c; }
        else L = i < qd ? (long)i * G + c : (long)qd * G + (long)(i - qd) * (G - nd) + (c - nd);
        if (L >= nwg) return false;
        int wgid = (int)L; { const int q = nwg / NXCD, r = nwg % NXCD, xcd = wgid % NXCD, off = wgid / NXCD; wgid = (xcd < r ? xcd * (q + 1) : r * (q + 1) + (xcd - r) * q) + off; }
        const int nig = wgm * nN, gid = wgid / nig, fm = gid * wgm, gsz = (nM - fm) < wgm ? (nM - fm) : wgm;
        u.pm = pm0 + fm + ((wgid % nig) % gsz); u.pn = (wgid % nig) / gsz; return true;
    }
};
struct PolPlain {
    const char* A; unsigned lda2; const char* B; unsigned ldb2; int K;
    __device__ __forceinline__ size_t kstepA() const { return 128; }
    __device__ __forceinline__ size_t kstepB() const { return 128; }
    __device__ __forceinline__ unsigned a_off(const Unit& u, int h, int R, int C) const { return (unsigned)(u.pm * BM + h * HALF + R) * lda2 + (unsigned)C * 2u; }
    __device__ __forceinline__ const char* b_ptr(const Unit& u) const { return B + (size_t)u.pn * BM * ldb2; }
};
struct PolMoeUp {
    const char* A; unsigned lda2; const char* B; unsigned ldb2; int K; const int* rowidx; const LAS int* tile_e; size_t estride;
    __device__ __forceinline__ size_t kstepA() const { return 128; }
    __device__ __forceinline__ size_t kstepB() const { return 128; }
    __device__ __forceinline__ unsigned a_off(const Unit& u, int h, int R, int C) const { return (unsigned)rowidx[u.pm * BM + h * HALF + R] * lda2 + (unsigned)C * 2u; }
    __device__ __forceinline__ const char* b_ptr(const Unit& u) const { return B + (size_t)tile_e[u.pm] * estride + (size_t)u.pn * BM * ldb2; }
};
struct PolMoeDown {
    const char* A; unsigned lda2; const char* B; unsigned ldb2; int K; int pmc0; const LAS int* tile_e; size_t estride;
    __device__ __forceinline__ size_t kstepA() const { return (size_t)CHUNK_ROWS * 128; }
    __device__ __forceinline__ size_t kstepB() const { return (size_t)DM * 128; }
    __device__ __forceinline__ unsigned a_off(const Unit& u, int h, int R, int C) const { return (unsigned)((u.pm - pmc0) * BM + h * HALF + R) * 128u + (unsigned)C * 2u; }
    __device__ __forceinline__ const char* b_ptr(const Unit& u) const { return B + (size_t)tile_e[u.pm] * estride + (size_t)u.pn * BM * 128; }
};
struct PolChunkA {
    const char* A; unsigned lda2; const char* B; unsigned ldb2; int K; int pmc0;
    __device__ __forceinline__ size_t kstepA() const { return (size_t)CHUNK_ROWS * 128; }
    __device__ __forceinline__ size_t kstepB() const { return (size_t)DM * 128; }
    __device__ __forceinline__ unsigned a_off(const Unit& u, int h, int R, int C) const { return (unsigned)((u.pm - pmc0) * BM + h * HALF + R) * 128u + (unsigned)C * 2u; }
    __device__ __forceinline__ const char* b_ptr(const Unit& u) const { return B + (size_t)u.pn * BM * 128; }
};

template <int I8> struct AccT { typedef f32x4 type; };
template <> struct AccT<1> { typedef i32x4 type; };
template <class Epi, class Pol, int I8 = 0>
__device__ __forceinline__ void gemm_phase(LAS unsigned char* lds, const Pol& P, const StaticOrder& S, const Epi& E) {
    typedef typename AccT<I8>::type acc_t;
    int tid_ = threadIdx.x; asm volatile("" : "+v"(tid_));
    const int tid = tid_, wid = __builtin_amdgcn_readfirstlane(tid >> 6), lane = tid & 63, wr = wid >> 2, wc = wid & 3, fr = lane & 15, fq = lane >> 4;
    const int K = P.K, nt = K / BK;
    int sR[2], sC[2]; unsigned voffB[2];
#pragma unroll
    for (int i = 0; i < 2; ++i) { int R, C; stage_rc(tid * 16 + i * 8192, R, C); sR[i] = R; sC[i] = C; const int Rb = (R & ~31) + perm32(R & 31); voffB[i] = (unsigned)Rb * P.ldb2 + (unsigned)C * 2u; }
    const size_t kstepA = P.kstepA(), kstepB = P.kstepB();
    const size_t hstepB = (size_t)HALF * P.ldb2;
    const unsigned ldsw = (unsigned)wid * 1024u;
    const int aoff = lds_byte(wr * 64 + fr, fq * 8), boff = lds_byte(wc * 32 + fr, fq * 8);
#define PG8_SA(b, h) (((b) * 2 + (h)) * HTB)
#define PG8_SB(b, h) ((4 + (b) * 2 + (h)) * HTB)
#define PG8_STAGE(bufoff, gbase, voff) do { _Pragma("unroll") for (int _i = 0; _i < 2; ++_i) \
        __builtin_amdgcn_global_load_lds((const unsigned*)((const char*)(gbase) + (voff)[_i]), (LAS unsigned*)(lds + (bufoff) + ldsw + _i * 8192), 16, 0, 0); } while (0)
#define PG8_LDA(dst, b, h) do { _Pragma("unroll") for (int m = 0; m < 4; ++m) _Pragma("unroll") for (int k = 0; k < 2; ++k) dst[m][k] = *(const LAS bf16x8*)(lds + PG8_SA(b, h) + aoff + m * 2048 + k * 1024); } while (0)
#define PG8_LDB(dst, b, h) do { _Pragma("unroll") for (int n = 0; n < 2; ++n) _Pragma("unroll") for (int k = 0; k < 2; ++k) dst[n][k] = *(const LAS bf16x8*)(lds + PG8_SB(b, h) + boff + n * 2048 + k * 1024); } while (0)
#define PG8_MMA(ai, bj, At, Bt) do { __builtin_amdgcn_s_setprio(1); _Pragma("unroll") for (int m = 0; m < 4; ++m) _Pragma("unroll") for (int n = 0; n < 2; ++n) _Pragma("unroll") for (int k = 0; k < 2; ++k) \
        { if constexpr (I8 == 1) acc[ai][bj][m][n] = __builtin_amdgcn_mfma_i32_16x16x64_i8(__builtin_bit_cast(i32x4, Bt[n][k]), __builtin_bit_cast(i32x4, At[m][k]), acc[ai][bj][m][n], 0, 0, 0); \
          else if constexpr (I8 == 4) { const i64x2 b_ = __builtin_bit_cast(i64x2, Bt[n][k]), a_ = __builtin_bit_cast(i64x2, At[m][k]); \
              acc[ai][bj][m][n] = __builtin_amdgcn_mfma_f32_16x16x32_fp8_fp8(b_[0], a_[0], acc[ai][bj][m][n], 0, 0, 0); acc[ai][bj][m][n] = __builtin_amdgcn_mfma_f32_16x16x32_fp8_fp8(b_[1], a_[1], acc[ai][bj][m][n], 0, 0, 0); } \
          else if constexpr (I8 == 3) acc[ai][bj][m][n] = __builtin_amdgcn_mfma_f32_16x16x32_f16(__builtin_bit_cast(h16x8, Bt[n][k]), __builtin_bit_cast(h16x8, At[m][k]), acc[ai][bj][m][n], 0, 0, 0); \
          else acc[ai][bj][m][n] = __builtin_amdgcn_mfma_f32_16x16x32_bf16(Bt[n][k], At[m][k], acc[ai][bj][m][n], 0, 0, 0); } __builtin_amdgcn_s_setprio(0); } while (0)
#define PG8_WAIT_V(n) asm volatile("s_waitcnt vmcnt(" #n ")" ::: "memory")
#define PG8_WAIT_L(n) asm volatile("s_waitcnt lgkmcnt(" #n ")" ::: "memory")
#define PG8_BAR __builtin_amdgcn_s_barrier()
#define PG8_SCHED __builtin_amdgcn_sched_barrier(0)
    Unit cur, nxt; int ui = 0;
    if (!S.next(0, cur)) return;
    LAS unsigned char* sl_ = lds + RING_BYTES + 4096;
#define PG8_SCALES(u_, slot) do { if constexpr (Epi::LDS_SCALES) { \
        if (wid == 0) __builtin_amdgcn_global_load_lds((const unsigned*)(E.row_src(u_)) + lane * 4, (LAS unsigned*)(sl_ + (slot) * 2048), 16, 0, 0); \
        else if (wid == 1) __builtin_amdgcn_global_load_lds((const unsigned*)(E.col_src(u_)) + lane * 4, (LAS unsigned*)(sl_ + (slot) * 2048 + 1024), 16, 0, 0); } } while (0)
    PG8_SCALES(cur, 0);
    acc_t acc[2][2][4][2];
#pragma unroll
    for (int a = 0; a < 2; ++a)
#pragma unroll
        for (int b = 0; b < 2; ++b)
#pragma unroll
            for (int m = 0; m < 4; ++m)
#pragma unroll
                for (int n = 0; n < 2; ++n) acc[a][b][m][n] = acc_t{};
    bf16x8 At[4][2], B0[2][2], B1[2][2];
    unsigned vC0[2], vC1[2], vN0[2], vN1[2];
#pragma unroll
    for (int i = 0; i < 2; ++i) { vC0[i] = P.a_off(cur, 0, sR[i], sC[i]); vC1[i] = P.a_off(cur, 1, sR[i], sC[i]); }
    const char* Ab = P.A; const char* cB = P.b_ptr(cur);
    PG8_STAGE(PG8_SB(0, 0), cB, voffB); PG8_STAGE(PG8_SB(0, 1), cB + hstepB, voffB); PG8_STAGE(PG8_SA(0, 0), Ab, vC0); PG8_STAGE(PG8_SA(0, 1), Ab, vC1);
    if (wr == 1) PG8_BAR;
    PG8_WAIT_V(2); PG8_BAR;
    PG8_STAGE(PG8_SB(1, 0), cB + kstepB, voffB); PG8_STAGE(PG8_SA(1, 0), Ab + kstepA, vC0); PG8_STAGE(PG8_SB(1, 1), cB + hstepB + kstepB, voffB);
    PG8_WAIT_V(6); PG8_BAR;
    for (;;) {
        const bool has_next = S.next(ui + 1, nxt);
        const char* nB = cB;
#pragma unroll
        for (int i = 0; i < 2; ++i) { vN0[i] = vC0[i]; vN1[i] = vC1[i]; }
        if (has_next) { nB = P.b_ptr(nxt);
#pragma unroll
            for (int i = 0; i < 2; ++i) { vN0[i] = P.a_off(nxt, 0, sR[i], sC[i]); vN1[i] = P.a_off(nxt, 1, sR[i], sC[i]); } }
        int tsc_ = 4; asm volatile("" : "+s"(tsc_));
#pragma unroll 1
        for (int t = 0; t < nt; t += 2) {
            const bool last = (t == nt - 2);
            if (t == tsc_ && has_next) PG8_SCALES(nxt, (ui + 1) & 1);
            const char* a1 = Ab + (size_t)(t + 1) * kstepA;
            const char* a2 = last ? Ab : Ab + (size_t)(t + 2) * kstepA; const char* b2 = last ? nB : cB + (size_t)(t + 2) * kstepB;
            const char* a3 = a2 + kstepA; const char* b3 = b2 + kstepB;
            unsigned v20[2], v21[2];
#pragma unroll
            for (int i = 0; i < 2; ++i) { v20[i] = last ? vN0[i] : vC0[i]; v21[i] = last ? vN1[i] : vC1[i]; }
            PG8_LDB(B0, 0, 0); PG8_LDB(B1, 0, 1); PG8_SCHED; PG8_LDA(At, 0, 0); PG8_STAGE(PG8_SA(1, 1), a1, vC1);
            PG8_WAIT_V(8); PG8_WAIT_L(0); PG8_BAR; PG8_MMA(0, 0, At, B0); PG8_MMA(0, 1, At, B1); PG8_BAR; PG8_SCHED;
            PG8_LDA(At, 0, 1); PG8_STAGE(PG8_SB(0, 0), b2, voffB); PG8_STAGE(PG8_SB(0, 1), b2 + hstepB, voffB); PG8_STAGE(PG8_SA(0, 0), a2, v20);
            PG8_WAIT_V(8); PG8_WAIT_L(0); PG8_BAR; PG8_MMA(1, 0, At, B0); PG8_MMA(1, 1, At, B1); PG8_BAR; PG8_SCHED;
            PG8_LDB(B0, 1, 0); PG8_LDB(B1, 1, 1); PG8_SCHED; PG8_LDA(At, 1, 0); PG8_STAGE(PG8_SA(0, 1), a2, v21);
            PG8_WAIT_V(8); PG8_WAIT_L(0); PG8_BAR; PG8_MMA(0, 0, At, B0); PG8_MMA(0, 1, At, B1); PG8_BAR; PG8_SCHED;
            PG8_LDA(At, 1, 1); PG8_STAGE(PG8_SB(1, 0), b3, voffB); PG8_STAGE(PG8_SB(1, 1), b3 + hstepB, voffB); PG8_STAGE(PG8_SA(1, 0), a3, v20);
            PG8_WAIT_V(8); PG8_WAIT_L(0); PG8_BAR; PG8_MMA(1, 0, At, B0); PG8_MMA(1, 1, At, B1); PG8_BAR; PG8_SCHED;
        }
        if (wr == 0) PG8_BAR;
        E(acc, cur, wr, wc, fr, fq, (const LAS unsigned char*)(sl_ + (ui & 1) * 2048));
        if (!has_next) break;
#pragma unroll
        for (int a = 0; a < 2; ++a)
#pragma unroll
            for (int b = 0; b < 2; ++b)
#pragma unroll
                for (int m = 0; m < 4; ++m)
#pragma unroll
                    for (int n = 0; n < 2; ++n) acc[a][b][m][n] = acc_t{};
        cur = nxt; cB = nB; ++ui;
#pragma unroll
        for (int i = 0; i < 2; ++i) { vC0[i] = vN0[i]; vC1[i] = vN1[i]; }
        if (wr == 1) PG8_BAR;
    }
    PG8_WAIT_V(0);
    PG8_BAR;
#undef PG8_SA
#undef PG8_SB
#undef PG8_STAGE
#undef PG8_SCALES
#undef PG8_LDA
#undef PG8_LDB
#undef PG8_MMA
#undef PG8_WAIT_V
#undef PG8_WAIT_L
#undef PG8_BAR
#undef PG8_SCHED
}

__device__ __forceinline__ float row_rstd(const float* ssq, int row, int nparts, float inv_n) {
    const f32x4* p = (const f32x4*)(ssq + (size_t)row * nparts); f32x4 s = p[0];
    for (int i = 1; i < nparts / 4; ++i) s += p[i];
    return __builtin_amdgcn_rsqf(((s[0] + s[1]) + (s[2] + s[3])) * inv_n + EPS);
}
template <int NP>
__device__ __forceinline__ void wave_row_rstd(const float* ssq, float inv_n, int rowbase, int wr, int wid, int fr, LAS float* xl, float (&rs)[8]) {
    const int lane = threadIdx.x & 63; LAS float* wl = xl + wid * 128;
    f32x4 sa = (f32x4){0.f, 0.f, 0.f, 0.f}, sb = sa;
    const f32x4* pa = (const f32x4*)(ssq + (size_t)(rowbase + wr * 64 + lane) * NP); const f32x4* pb = (const f32x4*)(ssq + (size_t)(rowbase + HALF + wr * 64 + lane) * NP);
#pragma unroll
    for (int i = 0; i < NP / 4; ++i) { sa += pa[i]; sb += pb[i]; }
    wl[lane] = __builtin_amdgcn_rsqf(((sa[0] + sa[1]) + (sa[2] + sa[3])) * inv_n + EPS);
    wl[64 + lane] = __builtin_amdgcn_rsqf(((sb[0] + sb[1]) + (sb[2] + sb[3])) * inv_n + EPS);
    asm volatile("s_waitcnt lgkmcnt(0)" ::: "memory");
#pragma unroll
    for (int ai = 0; ai < 2; ++ai)
#pragma unroll
        for (int m = 0; m < 4; ++m) rs[ai * 4 + m] = wl[ai * 64 + 16 * m + fr];
    asm volatile("s_waitcnt lgkmcnt(0)" ::: "memory");
}
__device__ __forceinline__ void rope8(f32x4& v0, f32x4& v1, const float* tab  ) {
    const f32x4 t0 = *(const f32x4*)tab, t1 = *(const f32x4*)(tab + 4);
    f32x4 a = v0, b = v1;
    v0[0] = a[0] * t0[0] - a[1] * t0[1]; v0[1] = a[1] * t0[0] + a[0] * t0[1]; v0[2] = a[2] * t0[2] - a[3] * t0[3]; v0[3] = a[3] * t0[2] + a[2] * t0[3];
    v1[0] = b[0] * t1[0] - b[1] * t1[1]; v1[1] = b[1] * t1[0] + b[0] * t1[1]; v1[2] = b[2] * t1[2] - b[3] * t1[3]; v1[3] = b[3] * t1[2] + b[2] * t1[3];
}
__device__ __forceinline__ u32x4 pack8(f32x4 v0, f32x4 v1) { u32x4 w; w.x = cvt_pk_bf16(v0[0], v0[1]); w.y = cvt_pk_bf16(v0[2], v0[3]); w.z = cvt_pk_bf16(v1[0], v1[1]); w.w = cvt_pk_bf16(v1[2], v1[3]); return w; }
__device__ __forceinline__ float sq8(f32x4 v0, f32x4 v1) { return (v0[0] * v0[0] + v0[1] * v0[1]) + (v0[2] * v0[2] + v0[3] * v0[3]) + (v1[0] * v1[0] + v1[1] * v1[1]) + (v1[2] * v1[2] + v1[3] * v1[3]); }

__device__ __forceinline__ f32x4 acc_f(const f32x4& a) { return a; }
__device__ __forceinline__ f32x4 acc_f(const i32x4& a) { return __builtin_convertvector(a, f32x4); }
template <int MODE, int NP> struct EpiStore {
    bf16_t* O; int ldc; const float* ssq; LAS float* xl; float inv_n;
    const float* rope; float* ssq_q; float* ssq_kv;
    bf16_t* O2; const bf16_t* Zsrc; float* Flog;
    const float* rowf; const unsigned* cmax;
    static constexpr bool LDS_SCALES = (MODE == 1 || MODE == 4);
    __device__ __forceinline__ const float* row_src(const Unit& u) const { return rowf + u.pm * BM; }
    __device__ __forceinline__ const unsigned* col_src(const Unit& u) const { return cmax + u.pn * BM; }
    template <class ACC>
    __device__ __forceinline__ void operator()(const ACC (&acc)[2][2][4][2], const Unit& u, int wr, int wc, int fr, int fq, const LAS unsigned char* lsc) const {
        const int row0 = u.pm * BM + wr * 64 + fr;
        float rs8[8];
        const LAS unsigned* cp = (const LAS unsigned*)(lsc + 1024) + wc * 32 + 8 * fq; const LAS float* rp = (const LAS float*)lsc + wr * 64 + fr;
        if (!LDS_SCALES) wave_row_rstd<NP>(ssq, inv_n, u.pm * BM, wr, wr * 4 + wc, fr, xl, rs8);
#pragma unroll
        for (int ai = 0; ai < 2; ++ai)
#pragma unroll
            for (int m = 0; m < 4; ++m) {
                const int row = row0 + ai * HALF + m * 16;
                const float rs = LDS_SCALES ? rp[ai * HALF + m * 16] * (1.f / 127.f) : rs8[ai * 4 + m];
                float sq = 0.f;
#pragma unroll
                for (int bj = 0; bj < 2; ++bj) {
                    const int col = u.pn * BM + bj * HALF + wc * 32 + 8 * fq;
                    f32x4 v0 = acc_f(acc[ai][bj][m][0]) * rs, v1 = acc_f(acc[ai][bj][m][1]) * rs;
                    if (LDS_SCALES) { const u32x4 c0 = *(const LAS u32x4*)(cp + bj * HALF), c1 = *(const LAS u32x4*)(cp + bj * HALF + 4);
                        v0 *= (f32x4){__uint_as_float(c0.x), __uint_as_float(c0.y), __uint_as_float(c0.z), __uint_as_float(c0.w)};
                        v1 *= (f32x4){__uint_as_float(c1.x), __uint_as_float(c1.y), __uint_as_float(c1.z), __uint_as_float(c1.w)}; }
                    if (MODE == 1) { if (col >= 1280 && col < 1344) rope8(v0, v1, rope + (size_t)row * 64 + (col - 1280)); sq += sq8(v0, v1); }
                    if (MODE == 2) { const int w = col % 192; if (w >= 128) rope8(v0, v1, rope + (size_t)row * 64 + (w - 128)); }
                    if (MODE == 3) {
                        if (bj == 0) *(u32x4*)(O + (size_t)row * KM_LD + u.pn * 192 + wc * 32 + 8 * fq) = pack8(v0, v1);
                        else *(u32x4*)(O2 + (size_t)row * VM_LD + u.pn * 128 + wc * 32 + 8 * fq) = pack8(v0, v1);
                    } else if (MODE == 4) {
                        if (u.pn < 24) *(u32x4*)(O + (size_t)row * ldc + col) = pack8(v0, v1);
                        else if (bj == 0 && wc == 0 && fq < 2) { *(f32x4*)(Flog + (size_t)row * 16 + 8 * fq) = v0; *(f32x4*)(Flog + (size_t)row * 16 + 8 * fq + 4) = v1; }
                    } else *(u32x4*)(O + (size_t)row * ldc + col) = pack8(v0, v1);
                }
                if (MODE == 1 && u.pn < 5) {
                    sq += __shfl_xor(sq, 16); sq += __shfl_xor(sq, 32);
                    if (fq == 0) { if (u.pn < 3) ssq_q[(size_t)row * 12 + u.pn * 4 + wc] = sq; else ssq_kv[(size_t)row * 8 + (u.pn - 3) * 4 + wc] = sq; }
                }
                asm volatile("" ::: "memory");
            }
        if (MODE == 3) {
            const int tid = (wr * 4 + wc) * 64 + fq * 16 + fr;
#pragma unroll
            for (int i = 0; i < 4; ++i) { const int idx = tid + 512 * i, r = idx >> 3, c = idx & 7; const size_t row = (size_t)u.pm * BM + r;
                *(u32x4*)(O + row * KM_LD + u.pn * 192 + 128 + c * 8) = *(const u32x4*)(Zsrc + row * Z0_LD + 1280 + c * 8); }
        }
    }
};
template <bool BF32> struct EpiRes {
    const void* base; unsigned short* out; float* ssq; float sc = 1.f;
    static constexpr bool LDS_SCALES = false;
    __device__ __forceinline__ void operator()(const f32x4 (&acc)[2][2][4][2], const Unit& u, int wr, int wc, int fr, int fq, const LAS unsigned char*) const {
        const int row0 = u.pm * BM + wr * 64 + fr; const int colb = u.pn * BM + wc * 32 + 8 * fq;
        f32x4 bA[2][2], bB[2][2];
#define ER_LOAD(dst, i) do { const size_t off_ = (size_t)(row0 + ((i) >> 2) * HALF + ((i) & 3) * 16) * DM + colb; \
        _Pragma("unroll") for (int bj = 0; bj < 2; ++bj) { \
            if constexpr (BF32) { dst[bj][0] = *(const f32x4*)((const float*)base + off_ + bj * HALF); dst[bj][1] = *(const f32x4*)((const float*)base + off_ + bj * HALF + 4); } \
            else { const u32x4 h_ = *(const u32x4*)((const unsigned short*)base + off_ + bj * HALF); dst[bj][0] = unpk_f16x4((u32x2){h_.x, h_.y}); dst[bj][1] = unpk_f16x4((u32x2){h_.z, h_.w}); } } } while (0)
#define ER_DO(src, i) do { const int ai = (i) >> 2, m = (i) & 3; const int row = row0 + ai * HALF + m * 16; float sq = 0.f; \
        _Pragma("unroll") for (int bj = 0; bj < 2; ++bj) { const size_t off = (size_t)row * DM + colb + bj * HALF; \
            const f32x4 v0 = acc[ai][bj][m][0] * sc + src[bj][0], v1 = acc[ai][bj][m][1] * sc + src[bj][1]; \
            u32x4 w_; w_.x = pk_f16(v0[0], v0[1]); w_.y = pk_f16(v0[2], v0[3]); w_.z = pk_f16(v1[0], v1[1]); w_.w = pk_f16(v1[2], v1[3]); \
            *(u32x4*)(out + off) = w_; sq += sq8(v0, v1); } \
        if (ssq) { sq += __shfl_xor(sq, 16); sq += __shfl_xor(sq, 32); if (fq == 0) ssq[(size_t)row * 32 + u.pn * 4 + wc] = sq; } } while (0)
        ER_LOAD(bA, 0); asm volatile("" ::: "memory");
#pragma unroll
        for (int i = 0; i < 8; i += 2) {
            ER_LOAD(bB, i + 1); asm volatile("" ::: "memory");
            ER_DO(bA, i); asm volatile("" ::: "memory");
            if (i + 2 < 8) { ER_LOAD(bA, i + 2); asm volatile("" ::: "memory"); }
            ER_DO(bB, i + 1); asm volatile("" ::: "memory");
        }
#undef ER_LOAD
#undef ER_DO
    }
};
template <int RS> struct EpiSwiGLU {
    bf16_t* H; int row_base; const float* ssq; const float* rsp; const unsigned* cmax; const LAS int* tile_e; int f8 = 0;
    static constexpr bool LDS_SCALES = (RS == 2);
    __device__ __forceinline__ const float* row_src(const Unit& u) const { return rsp + u.pm * BM; }
    __device__ __forceinline__ const unsigned* col_src(const Unit& u) const { return cmax + (size_t)(tile_e ? tile_e[u.pm] : 0) * (2 * DFF) + u.pn * BM; }
    template <class ACC>
    __device__ __forceinline__ void operator()(const ACC (&acc)[2][2][4][2], const Unit& u, int wr, int wc, int fr, int fq, const LAS unsigned char* lsc) const {
        const int row0 = u.pm * BM + wr * 64 + fr;
        f32x4 sg[2], su[2];
        if (RS == 2) { const LAS unsigned* cp = (const LAS unsigned*)(lsc + 1024) + wc * 32 + 8 * fq;
#pragma unroll
            for (int n = 0; n < 2; ++n) { const u32x4 a = *(const LAS u32x4*)(cp + 4 * n), b = *(const LAS u32x4*)(cp + HALF + 4 * n);
#pragma unroll
                for (int j = 0; j < 4; ++j) { sg[n][j] = __uint_as_float(a[j]) * (1.f / 127.f); su[n][j] = __uint_as_float(b[j]) * (1.f / 127.f); } } }
        float rs8[8];
#pragma unroll
        for (int i = 0; i < 8; ++i) { const int row = row0 + (i >> 2) * HALF + (i & 3) * 16;
            if (RS == 2) rs8[i] = ((const LAS float*)lsc)[wr * 64 + fr + (i >> 2) * HALF + (i & 3) * 16]; else rs8[i] = RS == 0 ? row_rstd(ssq, row, 32, 1.f / DM) : rsp[row]; }
#pragma unroll
        for (int ai = 0; ai < 2; ++ai)
#pragma unroll
            for (int m = 0; m < 4; ++m) {
                const int row = row0 + ai * HALF + m * 16;
                const float rs = rs8[ai * 4 + m];
                f32x4 o[2];
#pragma unroll
                for (int n = 0; n < 2; ++n) { f32x4 g = acc_f(acc[ai][0][m][n]) * rs, up = acc_f(acc[ai][1][m][n]) * rs;
                    if (RS == 2) { g *= sg[n]; up *= su[n]; }
#pragma unroll
                    for (int j = 0; j < 4; ++j) o[n][j] = g[j] * __builtin_amdgcn_rcpf(1.f + __builtin_amdgcn_exp2f(-LOG2E * g[j])) * up[j]; }
                if (RS == 2 && f8) {
                    _Pragma("unroll") for (int n = 0; n < 2; ++n) _Pragma("unroll") for (int j = 0; j < 4; ++j) o[n][j] = __builtin_amdgcn_fmed3f(o[n][j], -448.f, 448.f);
                    *(u32x2*)((unsigned char*)H + ((size_t)u.pn * CHUNK_ROWS + (row - row_base)) * 128 + wc * 32 + 8 * fq) = pack8_fp8(o[0], o[1]);
                } else
                *(u32x4*)(H + ((size_t)(u.pn * 2 + (wc >> 1)) * CHUNK_ROWS + (row - row_base)) * 64 + (wc & 1) * 32 + 8 * fq) = pack8(o[0], o[1]);
                asm volatile("" ::: "memory");
            }
    }
};
struct EpiMoeDown {
    bf16_t* Y; const float* gate;
    static constexpr bool LDS_SCALES = false;
    __device__ __forceinline__ void operator()(const f32x4 (&acc)[2][2][4][2], const Unit& u, int wr, int wc, int fr, int fq, const LAS unsigned char*) const {
        const int row0 = u.pm * BM + wr * 64 + fr;
        float g8[8];
#pragma unroll
        for (int i = 0; i < 8; ++i) g8[i] = gate[row0 + (i >> 2) * HALF + (i & 3) * 16] * (1.f / 64.f);
#pragma unroll
        for (int ai = 0; ai < 2; ++ai)
#pragma unroll
            for (int m = 0; m < 4; ++m) {
                const int row = row0 + ai * HALF + m * 16; const float g = g8[ai * 4 + m];
#pragma unroll
                for (int bj = 0; bj < 2; ++bj) *(u32x4*)(Y + (size_t)row * DM + u.pn * BM + bj * HALF + wc * 32 + 8 * fq) = pack8(acc[ai][bj][m][0] * g, acc[ai][bj][m][1] * g);
                asm volatile("" ::: "memory");
            }
    }
};
}

namespace fa {
#define SBAR() __builtin_amdgcn_sched_barrier(0)
template <int NDV> __device__ __forceinline__ int v_st(int k, int c) { const int kk = (k & ~0xC) | ((k & 4) << 1) | ((k & 8) >> 1); return ((kk >> 3) * NDV + (c >> 5)) * 512 + ((kk & 7) * 32 + (c & 31)) * 2; }
__device__ __forceinline__ int v_rd_base(int lane) { return ((lane & 3) << 3) | (((lane >> 2) & 3) << 6) | (((lane >> 4) & 1) << 5) | (((lane >> 5) & 1) << 8); }
__device__ __forceinline__ int crow(int r, int hi) { return (r & 3) + 8 * (r >> 2) + 4 * hi; }
__device__ __forceinline__ void mask_tile(f32x16& p0, f32x16& p1, int dq, unsigned W) {
    const float NEG = -__builtin_inff();
#pragma unroll
    for (int r = 0; r < 16; ++r) {
        const int c = (r & 3) + 8 * (r >> 2);
        if ((unsigned)(dq - c) >= W) p0[r] = NEG;
        if ((unsigned)(dq - c - 32) >= W) p1[r] = NEG;
    }
}
struct AttnArgs {
    const bf16_t* Q; int ldq; const bf16_t* K; int ldk; const bf16_t* V; int ldv; bf16_t* O; int ldo;
    int q0, j_lo, j_hi, W;
    const float* dec;
    float sinkl; const float* biasT;
    const float* sinks;
    float kmax;
};
template <int DK, int DV, int MODE>
__device__ __forceinline__ void attn_unit(const AttnArgs& a, LAS char* lds) {
    constexpr int KROWB = DK * 2 + 16  , SHM_K = 64 * KROWB, SHM_V = 64 * DV * 2, NDK = DK / 16, NDV = DV / 32, KCH = DK / 8, VCH = DV / 8, KPT = KCH * 64 / 512, VPT = VCH * 64 / 512;
    constexpr int RB = NDV * 512;
    constexpr float THR = 8.f;
    int tid_ = threadIdx.x; asm volatile("" : "+v"(tid_));
    const int tid = tid_, wid = __builtin_amdgcn_readfirstlane(tid >> 6), lane = tid & 63, r32 = lane & 31, hi = lane >> 5;
    LAS char* V_lds = lds; LAS char* K_lds = lds + 2 * SHM_V;
    LAS float* dec_l = (LAS float*)(K_lds + 2 * SHM_K);
    LAS float* ws = dec_l + 128 + wid * 64;
    LAS float* bias_l = dec_l + 128 + 512 + ((MODE == 2) ? wid * 128 : 0);
    const int NT = a.j_hi - a.j_lo;
    const int qlo = (MODE == 2) ? a.q0 : a.q0 + wid * 32, qpos = qlo + r32;
    const int hoff = (MODE == 2) ? wid * 64 : 0;
    static_assert(KPT == KCH / 8 && VPT == VCH / 8, "staging map");
    const int srow_ = tid >> 3, scg_ = tid & 7;
    const int kws0 = srow_ * KROWB + scg_ * 16, vws0 = v_st<NDV>(srow_, scg_ * 8);
    const unsigned ksrc0 = (unsigned)(srow_ * a.ldk + scg_ * 8) * 2u, vsrc0 = (unsigned)(srow_ * a.ldv + scg_ * 8) * 2u;
    bf16x8 qr[NDK];
#pragma unroll
    for (int d0 = 0; d0 < NDK; ++d0) qr[d0] = *(const bf16x8*)(a.Q + (size_t)qpos * a.ldq + hoff + d0 * 16 + hi * 8);
    __builtin_amdgcn_s_waitcnt(0x0F70);
    float m_reg = -1e30f, l_reg = 0.f;
    if (MODE == 2) { m_reg = a.sinks[wid] * LOG2E; l_reg = 1.f; }
    f32x16 o[NDV];
#pragma unroll
    for (int d = 0; d < NDV; ++d) o[d] = f32x16{};
    float clq = 0.f; if (MODE == 1) clq = a.dec[(size_t)qpos * 16];
    if (MODE == 2) { (dec_l + 128 + 512)[tid] = a.biasT[tid]; (dec_l + 128 + 512)[tid + 512] = a.biasT[tid + 512]; }
    const int vb0 = (int)(uintptr_t)V_lds + v_rd_base(lane);
    const int kq = r32 * KROWB;
    bf16x8 sk[2][KPT], sv[2][VPT]; float sdec[2] = {0.f, 0.f};
    if (wid >= 4) __builtin_amdgcn_s_setprio(1);
#define FA_LOADT(j, S_) do { const size_t kb_ = (size_t)(j) * 64; const char* kt_ = (const char*)(a.K + kb_ * a.ldk); const char* vt_ = (const char*)(a.V + kb_ * a.ldv); \
        _Pragma("unroll") for (int i = 0; i < KPT; ++i) sk[S_][i] = *(const bf16x8*)(kt_ + ksrc0 + i * 128); \
        _Pragma("unroll") for (int i = 0; i < VPT; ++i) sv[S_][i] = *(const bf16x8*)(vt_ + vsrc0 + i * 128); \
        if (MODE == 1) { if (tid < 64) sdec[S_] = a.dec[(kb_ + tid) * 16]; } } while (0)
#define FA_WRITET(bf, S_) do { \
        _Pragma("unroll") for (int i = 0; i < KPT; ++i) *(LAS bf16x8*)(K_lds + (bf) * SHM_K + kws0 + i * 128) = sk[S_][i]; \
        _Pragma("unroll") for (int i = 0; i < VPT; ++i) *(LAS bf16x8*)(V_lds + (bf) * SHM_V + vws0 + i * 1024) = sv[S_][i]; \
        if (MODE == 1) { if (tid < 64) dec_l[(bf) * 64 + tid] = sdec[S_]; } } while (0)
#define FA_TR(dst, off) asm volatile("ds_read_b64_tr_b16 %0, %1 offset:%2" : "=&v"(dst) : "v"(vb0), "i"(off) : "memory")
#define FA_VRD(S, BUF, d0) do { constexpr int b_ = (BUF) * SHM_V + (d0) * 512; \
        FA_TR(S##l[0], b_); FA_TR(S##h[0], b_ + RB); FA_TR(S##l[1], b_ + 2 * RB); FA_TR(S##h[1], b_ + 3 * RB); FA_TR(S##l[2], b_ + 4 * RB); FA_TR(S##h[2], b_ + 5 * RB); FA_TR(S##l[3], b_ + 6 * RB); FA_TR(S##h[3], b_ + 7 * RB); } while (0)
#define FA_VMM(S, d0) do { \
        o[d0] = __builtin_amdgcn_mfma_f32_32x32x16_bf16(pa0, (bf16x8){S##l[0][0], S##l[0][1], S##l[0][2], S##l[0][3], S##h[0][0], S##h[0][1], S##h[0][2], S##h[0][3]}, o[d0], 0, 0, 0); \
        o[d0] = __builtin_amdgcn_mfma_f32_32x32x16_bf16(pa1, (bf16x8){S##l[1][0], S##l[1][1], S##l[1][2], S##l[1][3], S##h[1][0], S##h[1][1], S##h[1][2], S##h[1][3]}, o[d0], 0, 0, 0); \
        o[d0] = __builtin_amdgcn_mfma_f32_32x32x16_bf16(pa2, (bf16x8){S##l[2][0], S##l[2][1], S##l[2][2], S##l[2][3], S##h[2][0], S##h[2][1], S##h[2][2], S##h[2][3]}, o[d0], 0, 0, 0); \
        o[d0] = __builtin_amdgcn_mfma_f32_32x32x16_bf16(pa3, (bf16x8){S##l[3][0], S##l[3][1], S##l[3][2], S##l[3][3], S##h[3][0], S##h[3][1], S##h[3][2], S##h[3][3]}, o[d0], 0, 0, 0); } while (0)
#define FA_LW(n) do { asm volatile("s_waitcnt lgkmcnt(" #n ")" ::: "memory"); SBAR(); } while (0)
#define FA_PVALL(BUF) do { s16x4 Al[4], Ah[4], Bl[4], Bh[4]; \
        FA_VRD(A, BUF, 0); FA_VRD(B, BUF, 1); FA_LW(8); FA_VMM(A, 0); \
        if constexpr (NDV == 4) { FA_VRD(A, BUF, 2); FA_LW(8); FA_VMM(B, 1); FA_VRD(B, BUF, 3); FA_LW(8); FA_VMM(A, 2); FA_LW(0); FA_VMM(B, 3); } \
        else { FA_LW(0); FA_VMM(B, 1); } } while (0)
#define FA_PK4(P, B_, OUT) do { unsigned a0 = cvt_pk_bf16(P[B_ + 0], P[B_ + 1]), a1 = cvt_pk_bf16(P[B_ + 2], P[B_ + 3]); \
        unsigned b0 = cvt_pk_bf16(P[B_ + 4], P[B_ + 5]), b1 = cvt_pk_bf16(P[B_ + 6], P[B_ + 7]); \
        auto r0 = __builtin_amdgcn_permlane32_swap(a0, b0, false, false); auto r1 = __builtin_amdgcn_permlane32_swap(a1, b1, false, false); \
        u32x4 w = {r0[0], r1[0], r0[1], r1[1]}; OUT = *reinterpret_cast<bf16x8*>(&w); } while (0)
#define FA_COMPUTE(BUF, kb) do { \
            f32x16 p0, p1; \
            if (MODE == 1) { _Pragma("unroll") for (int r = 0; r < 16; ++r) { p0[r] = clq - dec_l[(BUF) * 64 + crow(r, hi)]; p1[r] = clq - dec_l[(BUF) * 64 + 32 + crow(r, hi)]; } } \
            else { p0 = f32x16{}; p1 = f32x16{}; } \
            { const LAS char* kbp[4];     \
              kbp[0] = K_lds + (BUF) * SHM_K + kq + hi * 16; \
              bf16x8 ka0 = *(const LAS bf16x8*)kbp[0], ka1 = *(const LAS bf16x8*)(kbp[0] + 32 * KROWB), kb0, kb1; SBAR(); \
              _Pragma("unroll") for (int d0 = 0; d0 < NDK; d0 += 2) { \
                  { const LAS char* ap = kbp[0] + (d0 + 1) * 32; kb0 = *(const LAS bf16x8*)ap; kb1 = *(const LAS bf16x8*)(ap + 32 * KROWB); } SBAR(); \
                  p0 = __builtin_amdgcn_mfma_f32_32x32x16_bf16(ka0, qr[d0], p0, 0, 0, 0); p1 = __builtin_amdgcn_mfma_f32_32x32x16_bf16(ka1, qr[d0], p1, 0, 0, 0); SBAR(); \
                  if (d0 + 2 < NDK) { const LAS char* ap = kbp[0] + (d0 + 2) * 32; ka0 = *(const LAS bf16x8*)ap; ka1 = *(const LAS bf16x8*)(ap + 32 * KROWB); } SBAR(); \
                  p0 = __builtin_amdgcn_mfma_f32_32x32x16_bf16(kb0, qr[d0 + 1], p0, 0, 0, 0); p1 = __builtin_amdgcn_mfma_f32_32x32x16_bf16(kb1, qr[d0 + 1], p1, 0, 0, 0); SBAR(); } } \
            if (MODE == 2) { const int dq0 = qpos - (kb) - 4 * hi; \
                _Pragma("unroll") for (int r = 0; r < 16; ++r) { const int c = (r & 3) + 8 * (r >> 2); int i0 = dq0 - c, i1 = dq0 - c - 32; \
                    i0 = i0 < 0 ? 0 : (i0 > 127 ? 127 : i0); i1 = i1 < 0 ? 0 : (i1 > 127 ? 127 : i1); p0[r] += bias_l[i0]; p1[r] += bias_l[i1]; } } \
            if (MODE != 3) { if ((kb) + 63 > qlo || (kb) <= qlo + 31 - a.W) mask_tile(p0, p1, qpos - (kb) - 4 * hi, (unsigned)a.W); } \
            float pmax = p0[0]; \
            _Pragma("unroll") for (int r = 1; r < 16; ++r) pmax = fmaxf(pmax, p0[r]); \
            _Pragma("unroll") for (int r = 0; r < 16; ++r) pmax = fmaxf(pmax, p1[r]); \
            { auto rr = __builtin_amdgcn_permlane32_swap(__float_as_uint(pmax), __float_as_uint(pmax), false, false); pmax = fmaxf(__uint_as_float(rr[0]), __uint_as_float(rr[1])); } \
            float mn, alpha; \
            if (__builtin_expect(__all((pmax - m_reg) <= THR), 1)) { mn = m_reg; alpha = 1.f; } \
            else { mn = fmaxf(m_reg, pmax); alpha = __builtin_amdgcn_exp2f(m_reg - mn); m_reg = mn; } \
            _Pragma("unroll") for (int r = 0; r < 16; ++r) { p0[r] = __builtin_amdgcn_exp2f(p0[r] - mn); p1[r] = __builtin_amdgcn_exp2f(p1[r] - mn); } \
            float ps = 0.f; \
            _Pragma("unroll") for (int r = 0; r < 16; ++r) ps += p0[r]; \
            _Pragma("unroll") for (int r = 0; r < 16; ++r) ps += p1[r]; \
            { auto rr = __builtin_amdgcn_permlane32_swap(__float_as_uint(ps), __float_as_uint(ps), false, false); ps = __uint_as_float(rr[0]) + __uint_as_float(rr[1]); } \
            l_reg = l_reg * alpha + ps; \
            if (__any(alpha < 1.f)) { if (hi == 0) ws[32 + r32] = alpha; asm volatile("s_waitcnt lgkmcnt(0)" ::: "memory"); \
                _Pragma("unroll") for (int d_ = 0; d_ < NDV; ++d_) _Pragma("unroll") for (int r = 0; r < 16; ++r) o[d_][r] *= ws[32 + crow(r, hi)]; } \
            bf16x8 pa0, pa1, pa2, pa3; \
            FA_PK4(p0, 0, pa0); FA_PK4(p0, 8, pa1); FA_PK4(p1, 0, pa2); FA_PK4(p1, 8, pa3); SBAR(); \
            FA_PVALL(BUF); \
        } while (0)
    if constexpr (MODE != 1) {
#define FA_TILE(t, BUF) do { \
        const int kb = (a.j_lo + (t)) * 64; \
        bool act = true; if (MODE != 3) act = (kb <= qlo + 31) && (kb + 63 >= qlo - a.W + 1); \
        if ((t) + 2 < NT) FA_LOADT(a.j_lo + (t) + 2, BUF);              \
        if (act) FA_COMPUTE(BUF, kb); \
        if ((t) + 1 < NT) FA_WRITET((BUF) ^ 1, (BUF) ^ 1);              \
        __syncthreads(); } while (0)
        FA_LOADT(a.j_lo, 0); FA_WRITET(0, 0); if (NT > 1) FA_LOADT(a.j_lo + 1, 1); __syncthreads();
        for (int t = 0; t < NT; t += 2) {
            FA_TILE(t, 0);
            if (t + 1 < NT) FA_TILE(t + 1, 1);
        }
#undef FA_TILE
    } else {
        constexpr float TEXIT = 28.f;
        float qn2 = 0.f;
#pragma unroll
        for (int d0 = 0; d0 < NDK; ++d0)
#pragma unroll
            for (int e = 0; e < 8; ++e) { const float f = bf2f((unsigned short)qr[d0][e]); qn2 += f * f; }
        { auto rr = __builtin_amdgcn_permlane32_swap(__float_as_uint(qn2), __float_as_uint(qn2), false, false); qn2 = __uint_as_float(rr[0]) + __uint_as_float(rr[1]); }
#pragma unroll
        for (int o_ = 1; o_ < 32; o_ <<= 1) qn2 = fmaxf(qn2, __shfl_xor(qn2, o_));
        const float ubase = sqrtf(qn2) * a.kmax * 1.0001f + __shfl(clq, 0);
        LAS int* flags = (LAS int*)(dec_l + 128 + 512 + 128);
        bool wdone = false, stop = false;
#define FA_TILE_R(t, BUF) do { \
        const int kb = (a.j_lo + (t)) * 64; const bool more = (t) > 0; \
        const bool act = !wdone && (kb <= qlo + 31); \
        if ((t) > 1) FA_LOADT(a.j_lo + (t) - 2, BUF); \
        if (act) { FA_COMPUTE(BUF, kb); \
            float mm = m_reg; \
            _Pragma("unroll") for (int o_ = 1; o_ < 32; o_ <<= 1) mm = fminf(mm, __shfl_xor(mm, o_)); \
            wdone = __builtin_amdgcn_readfirstlane((int)((ubase - dec_l[(BUF) * 64]) < (mm - TEXIT))) != 0; } \
        if (more) FA_WRITET((BUF) ^ 1, (BUF) ^ 1); \
        if (lane == 0) flags[(BUF) * 8 + wid] = wdone ? 1 : 0; \
        __syncthreads(); \
        { int all_ = 1; _Pragma("unroll") for (int w_ = 0; w_ < 8; ++w_) all_ &= flags[(BUF) * 8 + w_]; stop = !more || (all_ != 0); } } while (0)
        FA_LOADT(a.j_lo + NT - 1, 0); FA_WRITET(0, 0); if (NT > 1) FA_LOADT(a.j_lo + NT - 2, 1); __syncthreads();
        for (int t = NT - 1;;) {
            FA_TILE_R(t, 0); if (stop) break; --t;
            FA_TILE_R(t, 1); if (stop) break; --t;
        }
#undef FA_TILE_R
    }
    __builtin_amdgcn_s_setprio(0);
    if (hi == 0) ws[r32] = l_reg; asm volatile("s_waitcnt lgkmcnt(0)" ::: "memory");
    float rli[16];
#pragma unroll
    for (int r = 0; r < 16; ++r) rli[r] = __builtin_amdgcn_rcpf(ws[crow(r, hi)]);
    bf16_t* Ow = a.O + (size_t)qlo * a.ldo + hoff;
#pragma unroll
    for (int r = 0; r < 16; ++r) { const int orow = crow(r, hi);
#pragma unroll
        for (int d0 = 0; d0 < NDV; ++d0) { const float v = o[d0][r] * rli[r]; const float vn = __shfl_xor(v, 1);
            if ((r32 & 1) == 0) *(unsigned*)(Ow + (size_t)orow * a.ldo + d0 * 32 + r32) = cvt_pk_bf16(v, vn); } }
    __syncthreads();
#undef FA_LOADT
#undef FA_WRITET
#undef FA_TR
#undef FA_VRD
#undef FA_VMM
#undef FA_LW
#undef FA_PVALL
#undef FA_PK4
#undef FA_COMPUTE
}
#undef SBAR
}

struct Args { const void* in[N_IN]; float* out; unsigned char* ws; int ph_lo, ph_hi; };

__device__ const float ROPE_INV[32] = {
    1.000000000e+00f, 7.498942614e-01f, 5.623413324e-01f, 4.216965139e-01f, 3.162277639e-01f, 2.371373773e-01f, 1.778279394e-01f, 1.333521307e-01f,
    1.000000015e-01f, 7.498941571e-02f, 5.623413250e-02f, 4.216965288e-02f, 3.162277490e-02f, 2.371373773e-02f, 1.778279431e-02f, 1.333521493e-02f,
    9.999999776e-03f, 7.498941850e-03f, 5.623413250e-03f, 4.216964822e-03f, 3.162277630e-03f, 2.371373586e-03f, 1.778279431e-03f, 1.333521446e-03f,
    1.000000047e-03f, 7.498942432e-04f, 5.623413017e-04f, 4.216965172e-04f, 3.162277571e-04f, 2.371373703e-04f, 1.778279402e-04f, 1.333521504e-04f };
__device__ const unsigned char T5_BUCKET[128] = {
    0, 1, 2, 3, 4, 5, 6, 7, 8, 9, 10, 11, 12, 13, 14, 15, 16, 16, 16, 17, 17, 18, 18, 18, 19, 19, 19, 20, 20, 20, 20, 21, 21, 21, 21, 22, 22, 22, 22, 22, 23, 23, 23, 23, 23, 23, 24, 24, 24, 24, 24, 24,
    25, 25, 25, 25, 25, 25, 25, 26, 26, 26, 26, 26, 26, 26, 26, 27, 27, 27, 27, 27, 27, 27, 27, 27, 27, 28, 28, 28, 28, 28, 28, 28, 28, 28, 28, 29, 29, 29, 29, 29, 29, 29, 29, 29, 29, 29, 29,
    30, 30, 30, 30, 30, 30, 30, 30, 30, 30, 30, 30, 30, 30, 31, 31, 31, 31, 31, 31, 31, 31, 31, 31, 31, 31, 31, 31, 31 };

struct CvtJob { const float* src; int K, Nsrc, Npad; const float* gain; bf16_t* dst; int ldd; int mode; int row_off; int kblk;   unsigned* amax;   int f8;   int f16;   };
__device__ __forceinline__ int cvt_row(int mode, int n) {
    if (mode == 1) { if (n >= 1280 && n < 1344) { const int j = n - 1280; return 1280 + 2 * (j & 31) + (j >> 5); } return n; }
    if (mode == 2) { const int h = n / 192, w = n - h * 192; if (w >= 128) { const int j = w - 128; return h * 192 + 128 + 2 * (j & 31) + (j >> 5); } return n; }
    if (mode == 4) return (n >> 7) * 256 + (n & 127);
    if (mode == 5) return (n >> 7) * 256 + 128 + (n & 127);
    return n;
}
__device__ __forceinline__ float cvt_cs(int mode, int n) {
    if (mode == 1) return (n >= 1344 && n < 2368) ? C2_SWA : 1.f;
    if (mode == 2) return C2_MLA;
    if (mode == 3) return C2_128;
    if (mode == 6) return n < 2048 ? C2_128 : 1.f;
    return 1.f;
}
constexpr int N_CVT_JOBS = 17 + 24;
__device__ __forceinline__ CvtJob get_job(const Args& a, int j) {
    unsigned char* ws = a.ws; CvtJob jb; jb.gain = nullptr; jb.mode = 0; jb.row_off = 0; jb.amax = nullptr; jb.kblk = 0; jb.f16 = 0; jb.f8 = 0;
    const float* nmix = (const float*)a.in[I_NMIX]; const float* ncross = (const float*)a.in[I_NCROSS]; const float* nmem = (const float*)a.in[I_NMEM]; const float* nffn = (const float*)a.in[I_NFFN];
    if (j >= 17) { const int t = (j - 17) >> 3, e = (j - 17) & 7;
        if (t == 0) { jb.src = (const float*)a.in[I_MG] + (size_t)e * DM * DFF; jb.K = DM; jb.Nsrc = jb.Npad = DFF; jb.gain = nffn + DM; jb.dst = (bf16_t*)(ws + WS_WGU1 + (size_t)e * E_GU); jb.ldd = DM; jb.mode = 4; jb.amax = (unsigned*)(ws + WS_CTL) + CW_AMAXW + e * 2 * DFF; }
        else if (t == 1) { jb.src = (const float*)a.in[I_MU] + (size_t)e * DM * DFF; jb.K = DM; jb.Nsrc = jb.Npad = DFF; jb.gain = nffn + DM; jb.dst = (bf16_t*)(ws + WS_WGU1 + (size_t)e * E_GU); jb.ldd = DM; jb.mode = 5; jb.amax = (unsigned*)(ws + WS_CTL) + CW_AMAXW + e * 2 * DFF; }
        else { jb.src = (const float*)a.in[I_MD] + (size_t)e * DFF * DM; jb.K = DFF; jb.Nsrc = jb.Npad = DM; jb.dst = (bf16_t*)(ws + WS_WD1 + (size_t)e * E_D)  ; jb.ldd = DFF; jb.kblk = 1; jb.f8 = 1; }
        return jb; }
    switch (j) {
    case 0: jb.src = (const float*)a.in[I_EVWIN]; jb.K = DM; jb.Nsrc = EVEN_IN; jb.Npad = Z0_LD; jb.gain = nmix; jb.dst = (bf16_t*)(ws + WS_WIN0)  ; jb.ldd = DM; jb.mode = 1; jb.amax = (unsigned*)(ws + WS_CTL) + CW_AMAX0; break;
    case 1: jb.src = (const float*)a.in[I_WUQ]; jb.K = 768; jb.Nsrc = jb.Npad = 1536; jb.gain = (const float*)a.in[I_QNORM]; jb.dst = (bf16_t*)(ws + WS_WUQ); jb.ldd = 768; jb.mode = 2; break;
    case 2: jb.src = (const float*)a.in[I_WUKV]; jb.K = 512; jb.Nsrc = jb.Npad = 2048; jb.gain = (const float*)a.in[I_KVNORM]; jb.dst = (bf16_t*)(ws + WS_WUKV); jb.ldd = 512; break;
    case 3: jb.src = (const float*)a.in[I_EVWO]; jb.K = DM; jb.Nsrc = jb.Npad = DM; jb.dst = (bf16_t*)(ws + WS_WO0); jb.ldd = DM; break;
    case 4: case 5: { const int l = j - 4; jb.src = (const float*)a.in[I_XWQ] + (size_t)l * DM * 512; jb.K = DM; jb.Nsrc = jb.Npad = 512; jb.gain = ncross + l * DM; jb.dst = (bf16_t*)(ws + WS_WXQ) + (size_t)l * E_XQ; jb.ldd = DM; jb.mode = 3; jb.f16 = 1; break; }
    case 6: case 7: { const int l = j - 6; jb.src = (const float*)a.in[I_XWK] + (size_t)l * DM * 512; jb.K = DM; jb.Nsrc = jb.Npad = 512; jb.gain = nmem + l * DM; jb.dst = (bf16_t*)(ws + WS_WXKV); jb.ldd = DM; jb.row_off = l * 1024; break; }
    case 8: case 9: { const int l = j - 8; jb.src = (const float*)a.in[I_XWV] + (size_t)l * DM * 512; jb.K = DM; jb.Nsrc = jb.Npad = 512; jb.gain = nmem + l * DM; jb.dst = (bf16_t*)(ws + WS_WXKV); jb.ldd = DM; jb.row_off = l * 1024 + 512; break; }
    case 10: case 11: { const int l = j - 10; jb.src = (const float*)a.in[I_XWO] + (size_t)l * 512 * DM; jb.K = 512; jb.Nsrc = jb.Npad = DM; jb.dst = (bf16_t*)(ws + WS_WXO) + (size_t)l * E_XO; jb.ldd = 512; break; }
    case 12: jb.src = (const float*)a.in[I_FG]; jb.K = DM; jb.Nsrc = jb.Npad = DFF; jb.gain = nffn; jb.dst = (bf16_t*)(ws + WS_WGU0); jb.ldd = DM; jb.mode = 4; jb.amax = (unsigned*)(ws + WS_CTL) + CW_AMAXW + 8 * 2 * DFF; break;
    case 13: jb.src = (const float*)a.in[I_FU]; jb.K = DM; jb.Nsrc = jb.Npad = DFF; jb.gain = nffn; jb.dst = (bf16_t*)(ws + WS_WGU0); jb.ldd = DM; jb.mode = 5; jb.amax = (unsigned*)(ws + WS_CTL) + CW_AMAXW + 8 * 2 * DFF; break;
    case 14: jb.src = (const float*)a.in[I_FD]; jb.K = DFF; jb.Nsrc = jb.Npad = DM; jb.dst = (bf16_t*)(ws + WS_WD0); jb.ldd = DFF; jb.kblk = 1; break;
    case 15: jb.src = (const float*)a.in[I_ODWIN]; jb.K = DM; jb.Nsrc = ODD_IN; jb.Npad = IN1_PAD; jb.gain = nmix + DM; jb.dst = (bf16_t*)(ws + WS_WIN1)  ; jb.ldd = DM; jb.mode = 6; jb.amax = (unsigned*)(ws + WS_CTL) + CW_AMAX15; break;
    default: jb.src = (const float*)a.in[I_ODWO]; jb.K = DM; jb.Nsrc = jb.Npad = DM; jb.dst = (bf16_t*)(ws + WS_WO1); jb.ldd = DM; break;
    }
    return jb;
}
__device__ __forceinline__ int cvt_find(const LAS int* cum, int it, int& j) { while (it >= cum[j + 1]) ++j; return it - cum[j]; }
__device__ __forceinline__ void cvt_load(const CvtJob& jb, int item, int lane, float (&v)[32]) {
    const int nblk = jb.Npad / 32, kb = item / nblk, nb = item % nblk, k0 = 64 * kb, n0 = 32 * nb;
    const int nn = n0 + (lane & 31); const bool ok = nn < jb.Nsrc;
    const float* p = jb.src + (size_t)(k0 + (lane >> 5)) * jb.Nsrc + nn; const size_t st = (size_t)2 * jb.Nsrc;
#pragma unroll
    for (int i = 0; i < 32; ++i) v[i] = ok ? __builtin_nontemporal_load(p + i * st) : 0.f;
}
__device__ __forceinline__ void cvt_store(const CvtJob& jb, LAS float* scr, int item, int lane, const float (&v)[32]) {
    const int nblk = jb.Npad / 32, kb = item / nblk, nb = item % nblk, k0 = 64 * kb, n0 = 32 * nb;
    const float cs = cvt_cs(jb.mode, n0 + (lane & 31));
    const int c = lane & 7;
    f32x4 g0 = (f32x4){1.f, 1.f, 1.f, 1.f}, g1 = g0;
    if (jb.gain) { g0 = *(const f32x4*)(jb.gain + k0 + 8 * c); g1 = *(const f32x4*)(jb.gain + k0 + 8 * c + 4); }
#pragma unroll
    for (int i = 0; i < 32; ++i) scr[(2 * i + (lane >> 5)) * 33 + (lane & 31)] = v[i] * cs;
    LDS_WAIT(); asm volatile("" ::: "memory");
#pragma unroll
    for (int j = 0; j < 4; ++j) { const int n = (lane >> 3) + 8 * j; const LAS float* s = scr + (8 * c) * 33 + n;
        u32x4 o;
        if (jb.f16) { o.x = pk_f16(s[0 * 33] * g0[0], s[1 * 33] * g0[1]); o.y = pk_f16(s[2 * 33] * g0[2], s[3 * 33] * g0[3]); o.z = pk_f16(s[4 * 33] * g1[0], s[5 * 33] * g1[1]); o.w = pk_f16(s[6 * 33] * g1[2], s[7 * 33] * g1[3]); }
        else { o.x = cvt_pk_bf16(s[0 * 33] * g0[0], s[1 * 33] * g0[1]); o.y = cvt_pk_bf16(s[2 * 33] * g0[2], s[3 * 33] * g0[3]); o.z = cvt_pk_bf16(s[4 * 33] * g1[0], s[5 * 33] * g1[1]); o.w = cvt_pk_bf16(s[6 * 33] * g1[2], s[7 * 33] * g1[3]); }
        const int drow = jb.row_off + cvt_row(jb.mode, n0 + n);
        if (jb.f8) {
            const f32x4 a_ = (f32x4){s[0 * 33] * g0[0], s[1 * 33] * g0[1], s[2 * 33] * g0[2], s[3 * 33] * g0[3]} * 64.f, b_ = (f32x4){s[4 * 33] * g1[0], s[5 * 33] * g1[1], s[6 * 33] * g1[2], s[7 * 33] * g1[3]} * 64.f;
            *(u32x2*)((unsigned char*)jb.dst + ((size_t)(k0 >> 7) * jb.Npad + drow) * 128 + (k0 & 64) + 8 * c) = pack8_fp8(a_, b_);
        } else { bf16_t* dp = jb.kblk ? jb.dst + ((size_t)(k0 >> 6) * jb.Npad + drow) * 64 + 8 * c : jb.dst + (size_t)drow * jb.ldd + k0 + 8 * c; *(u32x4*)dp = o; } }
    LDS_WAIT(); asm volatile("" ::: "memory");
}
__device__ __forceinline__ void cvt_amax(const CvtJob& jb, int item, int lane, const float (&v)[32]) {
    const int nblk = jb.Npad / 32, kb = item / nblk, nb = item % nblk, k0 = 64 * kb, n0 = 32 * nb;
    const int nn = n0 + (lane & 31); float mx = 0.f;
#pragma unroll
    for (int i = 0; i < 32; ++i) mx = fmaxf(mx, fabsf(v[i] * jb.gain[k0 + 2 * i + (lane >> 5)]));
    mx = fmaxf(mx, __shfl_xor(mx, 32)) * cvt_cs(jb.mode, nn);
    if (lane < 32 && nn < jb.Nsrc) atomicMax(jb.amax + jb.row_off + cvt_row(jb.mode, nn), __float_as_uint(mx));
}
__device__ __forceinline__ float cvt_amax_item(const CvtJob& jb, int item, int lane, const float (&v)[32]) {
    const int nblk = jb.Npad / 32, kb = item / nblk, nb = item % nblk, k0 = 64 * kb, n0 = 32 * nb;
    float mx = 0.f;
#pragma unroll
    for (int i = 0; i < 32; ++i) mx = fmaxf(mx, fabsf(v[i] * jb.gain[k0 + 2 * i + (lane >> 5)]));
    return fmaxf(mx, __shfl_xor(mx, 32)) * cvt_cs(jb.mode, n0 + (lane & 31));
}
__device__ __forceinline__ void cvt_store_q8(const CvtJob& jb, LAS float* scr, int item, int lane, const float (&v)[32], const LAS float* cam = nullptr) {
    const int nblk = jb.Npad / 32, kb = item / nblk, nb = item % nblk, k0 = 64 * kb, n0 = 32 * nb;
    const int c = lane & 7;
    const f32x4 g0 = *(const f32x4*)(jb.gain + k0 + 8 * c), g1 = *(const f32x4*)(jb.gain + k0 + 8 * c + 4);
#pragma unroll
    for (int i = 0; i < 32; ++i) scr[(2 * i + (lane >> 5)) * 33 + (lane & 31)] = v[i];
    LDS_WAIT(); asm volatile("" ::: "memory");
#pragma unroll
    for (int j = 0; j < 4; ++j) { const int n = (lane >> 3) + 8 * j; const LAS float* s = scr + (8 * c) * 33 + n;
        const int row = jb.row_off + cvt_row(jb.mode, n0 + n);
        const float am = cam ? cam[n] : __uint_as_float(__hip_atomic_load(jb.amax + row, RLX_AGENT)); const float inv = am > 0.f ? cvt_cs(jb.mode, n0 + n) * 127.f / am : 0.f;
        int q[8];
#pragma unroll
        for (int i = 0; i < 4; ++i) { q[i] = (int)__builtin_rintf(s[i * 33] * g0[i] * inv); q[4 + i] = (int)__builtin_rintf(s[(4 + i) * 33] * g1[i] * inv); }
#pragma unroll
        for (int i = 0; i < 8; ++i) q[i] = q[i] > 127 ? 127 : (q[i] < -127 ? -127 : q[i]);
        u32x2 o; o.x = (unsigned)(q[0] & 255) | ((unsigned)(q[1] & 255) << 8) | ((unsigned)(q[2] & 255) << 16) | ((unsigned)(q[3] & 255) << 24);
        o.y = (unsigned)(q[4] & 255) | ((unsigned)(q[5] & 255) << 8) | ((unsigned)(q[6] & 255) << 16) | ((unsigned)(q[7] & 255) << 24);
        *(u32x2*)((unsigned char*)jb.dst + (size_t)row * jb.ldd + k0 + 8 * c) = o; }
    LDS_WAIT(); asm volatile("" ::: "memory");
}
__device__ __forceinline__ void row_to_bf16_ssq(const float* xrow, bf16_t* orow, float* ssqrow, int lane) {
    const f32x4* xr = (const f32x4*)xrow + lane; f32x4 v[8]; float s = 0.f;
#pragma unroll
    for (int j = 0; j < 8; ++j) { v[j] = xr[64 * j]; s += (v[j][0] * v[j][0] + v[j][1] * v[j][1]) + (v[j][2] * v[j][2] + v[j][3] * v[j][3]); }
    s = wave_sum(s);
    u32x2* o8 = (u32x2*)orow + lane;
#pragma unroll
    for (int j = 0; j < 8; ++j) { u32x2 w; w.x = cvt_pk_bf16(v[j][0], v[j][1]); w.y = cvt_pk_bf16(v[j][2], v[j][3]); o8[64 * j] = w; }
    if (lane < 32) ssqrow[lane] = lane == 0 ? s : 0.f;
}

__global__ void __launch_bounds__(NWAVES * 64, 2) trunk_fwd(Args args) {
    extern __shared__ __attribute__((aligned(16))) unsigned char lds_raw[];
    LAS unsigned char* lds = (LAS unsigned char*)lds_raw;
    volatile LAS unsigned* MISC = (volatile LAS unsigned*)(lds + MISC_OFF);
    const int tid = threadIdx.x, lane = tid & 63, wave = __builtin_amdgcn_readfirstlane(tid >> 6);
    const int G = gridDim.x; const int bx = blockIdx.x; const int vcu = (G % 8 == 0) ? (bx % 8) * (G / 8) + bx / 8 : bx;
    const int gw = vcu * NWAVES + wave, NGW = G * NWAVES;
    unsigned* ctl = (unsigned*)(args.ws + WS_CTL);
    const int lo = args.ph_lo, hi = args.ph_hi;
    const bool fused = (hi - lo) > 1;
    for (int u = tid; u < (LDS_BYTES - RING_BYTES) / 4; u += NWAVES * 64) ((LAS unsigned*)(lds + RING_BYTES))[u] = 0u;
    __syncthreads();
    XcdBarrier bar; bar.bar = ctl + CW_BAR; bar.x = 0; bar.st = nullptr;
    if (fused) bar = xcd_barrier_post(ctl + CW_BAR, MISC + 8);
#ifndef PH_MASK
#define PH_MASK 0xFFFFFFFFFFFFFFFFull
#endif
#define IN(k) ((((unsigned long long)PH_MASK >> (k)) & 1ull) && lo <= (k) && (k) < hi)
#define GRID_BAR(k) do { if (fused && IN((k) + 1)) xcd_barrier(bar); } while (0)
#ifndef DUP_MASK
#define DUP_MASK 0ull
#endif
#ifndef DUP_SUB
#define DUP_SUB 0
#endif
#define NREP(k) ((((unsigned long long)DUP_MASK >> (k)) & 1ull) ? 2 : 1)
#define PHASE(k) for (int rep_ = 0; rep_ < NREP(k) && IN(k); ++rep_)

#define WSL() GAS unsigned char* wsg_ = (GAS unsigned char*)args.ws; asm volatile("" : "+s"(wsg_)); unsigned char* ws = (unsigned char*)wsg_
#define XB ((bf16_t*)(ws + WS_XB))
#define SSQ ((float*)(ws + WS_SSQ))
#define ROPE ((float*)(ws + WS_ROPE))
#define MEMN ((bf16_t*)(ws + WS_MEMN))
#define SSQM ((float*)(ws + WS_SSQM))
#define MEMKV ((bf16_t*)(ws + WS_MEMKV))
#define SSQQ ((float*)(ws + WS_SSQQ))
#define SSQKV ((float*)(ws + WS_SSQKV))
#define QX ((bf16_t*)(ws + WS_QX))
#define OX ((bf16_t*)(ws + WS_OX))
#define FL ((float*)(ws + WS_FL))
#define DEC ((float*)(ws + WS_DEC))
#define TOPE ((int*)(ws + WS_TOPE))
#define TOPS ((int*)(ws + WS_TOPS))
#define TOPG ((float*)(ws + WS_TOPG))
#define RSTDF ((float*)(ws + WS_RSTDF))
#define TOKPOS ((int*)(ws + WS_TOKPOS))
#define ROWIDX ((int*)(ws + WS_ROWIDX))
#define GATEP ((float*)(ws + WS_GATEP))
#define RSTDP ((float*)(ws + WS_RSTDP))
#define BIAST ((float*)(ws + WS_BIAST))
#define Z0 ((bf16_t*)(ws + WS_ARENA + AR_Z0))
#define QM ((bf16_t*)(ws + WS_ARENA + AR_QM))
#define KM ((bf16_t*)(ws + WS_ARENA + AR_KM))
#define VM ((bf16_t*)(ws + WS_ARENA + AR_VM))
#define O0 ((bf16_t*)(ws + WS_ARENA + AR_O0))
#define HIDB(i) ((bf16_t*)(ws + WS_ARENA + AR_HID + (size_t)((i) & 1) * HID_BYTES))
#define YB ((bf16_t*)(ws + WS_ARENA + AR_Y))
#define Z1 ((bf16_t*)(ws + WS_ARENA + AR_Z1))
#define O1 ((bf16_t*)(ws + WS_ARENA + AR_O1))
#define XQ ((unsigned char*)(ws + WS_QX))
#define XH ((unsigned short*)(ws + WS_XB))
#define XIN ((const float*)args.in[I_X])

    PHASE(0) {
        WSL();
        LAS float* scr = (LAS float*)(lds + wave * 16384);
        LAS int* cum = (LAS int*)(lds + RING_BYTES + 4096);
        if (tid < N_CVT_JOBS) { const CvtJob jb = get_job(args, tid); cum[64 + tid] = jb.amax ? 0   : (jb.K / 64) * (jb.Npad / 32); }
        __syncthreads();
        if (tid == 0) { int run = 0; for (int j = 0; j < N_CVT_JOBS; ++j) { cum[j] = run; run += cum[64 + j]; } cum[N_CVT_JOBS] = run; cum[N_CVT_JOBS + 1] = 0x7fffffff; }
        __syncthreads();
        {
            const int total = cum[N_CVT_JOBS];
            float va[32], vb[32]; int jL = 0, jP = 0;
            if (gw < total) { const int li = cvt_find(cum, gw, jL); cvt_load(get_job(args, jL), li, lane, va); }
#pragma unroll 1
            for (int it = gw; it < total; it += 2 * NGW) {
                const int it2 = it + NGW, it3 = it + 2 * NGW;
                if (it2 < total) { const int li = cvt_find(cum, it2, jL); cvt_load(get_job(args, jL), li, lane, vb); }
                { const int li = cvt_find(cum, it, jP); const CvtJob jb = get_job(args, jP); cvt_store(jb, scr, li, lane, va); }
                if (it2 < total) {
                    if (it3 < total) { const int li = cvt_find(cum, it3, jL); cvt_load(get_job(args, jL), li, lane, va); }
                    const int li = cvt_find(cum, it2, jP); const CvtJob jb = get_job(args, jP); cvt_store(jb, scr, li, lane, vb);
                }
            }
        }
        for (int m = gw; m < M; m += NGW) {
            const f32x4* xr = (const f32x4*)(XIN + (size_t)m * DM) + lane; f32x4 v[8]; float ss = 0.f, amx = 0.f;
#pragma unroll
            for (int j = 0; j < 8; ++j) { v[j] = xr[64 * j]; ss += (v[j][0] * v[j][0] + v[j][1] * v[j][1]) + (v[j][2] * v[j][2] + v[j][3] * v[j][3]);
                amx = fmaxf(amx, fmaxf(fmaxf(fabsf(v[j][0]), fabsf(v[j][1])), fmaxf(fabsf(v[j][2]), fabsf(v[j][3])))); }
            ss = wave_sum(ss);
#pragma unroll
            for (int o_ = 1; o_ < 64; o_ <<= 1) amx = fmaxf(amx, __shfl_xor(amx, o_));
            const float inv = amx > 0.f ? 127.f / amx : 0.f; unsigned* xq = (unsigned*)((unsigned char*)XB + (size_t)m * DM) + lane;
#pragma unroll
            for (int j = 0; j < 8; ++j) { const int q0 = (int)__builtin_rintf(v[j][0] * inv), q1 = (int)__builtin_rintf(v[j][1] * inv), q2 = (int)__builtin_rintf(v[j][2] * inv), q3 = (int)__builtin_rintf(v[j][3] * inv);
                xq[64 * j] = (unsigned)(q0 & 255) | ((unsigned)(q1 & 255) << 8) | ((unsigned)(q2 & 255) << 16) | ((unsigned)(q3 & 255) << 24); }
            if (lane == 0) RSTDF[m] = __builtin_amdgcn_rsqf(ss * (1.f / DM) + EPS) * amx * (1.f / 127.f);
        }
        for (int m = gw; m < MROWS; m += NGW) row_to_bf16_ssq((const float*)args.in[I_MEM] + (size_t)m * DM, MEMN + (size_t)m * DM, SSQM + (size_t)m * 32, lane);
        const int* pos = (const int*)args.in[I_POS];
        int gt0_ = tid; asm volatile("" : "+v"(gt0_)); gt0_ += bx * 512;
        for (int e = gt0_; e < M * 32; e += G * 512) {
            const int row = e >> 5, i = e & 31;
            const float ang = (float)pos[row] * ROPE_INV[i];
            const double rev = (double)ang * 0.15915494309189535; const float fr = (float)(rev - __builtin_rint(rev));
            ROPE[(size_t)e * 2] = __builtin_amdgcn_cosf(fr); ROPE[(size_t)e * 2 + 1] = __builtin_amdgcn_sinf(fr);
        }
        const float* relb = (const float*)args.in[I_RELB];
        for (int e = gt0_; e < 16 * 128; e += G * 512) { const int h = e >> 7, d = e & 127; BIAST[e] = relb[(int)T5_BUCKET[d] * 16 + h] * LOG2E; }
        if (fused && IN(1) && !IN(44)) xcd_barrier(bar);
        __syncthreads();
    }

    PHASE(44) {
        LAS float* scr = (LAS float*)(lds + wave * 16384);
        LAS float* cam = (LAS float*)(lds + RING_BYTES + 4096);
        constexpr int NBJ = DFF / 32, NB15 = IN1_PAD / 32, NB0 = Z0_LD / 32, NB = 18 * NBJ + NB15 + NB0;
#define Q8DEC(cb_, j_, nb_) const int j_ = (cb_) >= 18 * NBJ + NB15 ? 0 : ((cb_) >= 18 * NBJ ? 15 : ((cb_) / NBJ < 2 ? 12 + (cb_) / NBJ : 15 + (cb_) / NBJ)); \
        const int nb_ = (cb_) >= 18 * NBJ + NB15 ? (cb_) - 18 * NBJ - NB15 : ((cb_) >= 18 * NBJ ? (cb_) - 18 * NBJ : (cb_) % NBJ)
        float v0[32], v1[32], v2[32], v3[32];
        if (bx < NB) { Q8DEC(bx, j, nb); const CvtJob jb = get_job(args, j); const int nblk = jb.Npad / 32;
            cvt_load(jb, (4 * wave + 0) * nblk + nb, lane, v0); cvt_load(jb, (4 * wave + 1) * nblk + nb, lane, v1);
            cvt_load(jb, (4 * wave + 2) * nblk + nb, lane, v2); cvt_load(jb, (4 * wave + 3) * nblk + nb, lane, v3); }
#pragma unroll 1
        for (int cb = bx; cb < NB; cb += G) {
            Q8DEC(cb, j, nb); const CvtJob jb = get_job(args, j); const int nblk = jb.Npad / 32;
            const int cn = cb + G; const bool more = cn < NB; Q8DEC(more ? cn : cb, jn, nbn); const CvtJob jbn = get_job(args, jn); const int nblkn = jbn.Npad / 32;
            float mx = fmaxf(fmaxf(cvt_amax_item(jb, (4 * wave + 0) * nblk + nb, lane, v0), cvt_amax_item(jb, (4 * wave + 1) * nblk + nb, lane, v1)),
                             fmaxf(cvt_amax_item(jb, (4 * wave + 2) * nblk + nb, lane, v2), cvt_amax_item(jb, (4 * wave + 3) * nblk + nb, lane, v3)));
            __syncthreads();
            if (lane < 32) cam[wave * 32 + lane] = mx;
            __syncthreads();
            if (lane < 32) { float m = cam[lane];
#pragma unroll
                for (int w = 1; w < 8; ++w) m = fmaxf(m, cam[w * 32 + lane]);
                cam[256 + wave * 32 + lane] = m;
                const int nn = 32 * nb + lane; if (wave == 0 && nn < jb.Nsrc) jb.amax[jb.row_off + cvt_row(jb.mode, nn)] = __float_as_uint(m); }
            LDS_WAIT(); asm volatile("" ::: "memory");
            const LAS float* camw = cam + 256 + wave * 32;
            cvt_store_q8(jb, scr, (4 * wave + 0) * nblk + nb, lane, v0, camw); if (more) cvt_load(jbn, (4 * wave + 0) * nblkn + nbn, lane, v0);
            cvt_store_q8(jb, scr, (4 * wave + 1) * nblk + nb, lane, v1, camw); if (more) cvt_load(jbn, (4 * wave + 1) * nblkn + nbn, lane, v1);
            cvt_store_q8(jb, scr, (4 * wave + 2) * nblk + nb, lane, v2, camw); if (more) cvt_load(jbn, (4 * wave + 2) * nblkn + nbn, lane, v2);
            cvt_store_q8(jb, scr, (4 * wave + 3) * nblk + nb, lane, v3, camw); if (more) cvt_load(jbn, (4 * wave + 3) * nblkn + nbn, lane, v3);
        }
#undef Q8DEC
        GRID_BAR(0);
    }

    PHASE(1) {
        WSL();
        { pg8::PolPlain P{(const char*)XB  , DM, (const char*)(ws + WS_WIN0)  , DM, DM / 2};
          pg8::StaticOrder S; S.init(M / 256, Z0_LD / 256, G, bx, 0, WGM_K2048);
          pg8::EpiStore<1, 32> E{Z0, Z0_LD, nullptr, (LAS float*)(lds + RING_BYTES + 12288), 1.f / DM, ROPE, SSQQ, SSQKV, nullptr, nullptr, nullptr, RSTDF, ctl + CW_AMAX0};
          pg8::gemm_phase<pg8::EpiStore<1, 32>, pg8::PolPlain, 1>(lds, P, S, E); }
        { pg8::PolPlain P{(const char*)MEMN, DM * 2, (const char*)(ws + WS_WXKV), DM * 2, DM};
          pg8::StaticOrder S; S.init(MROWS / 256, 2048 / 256, G, (G - 1) - bx, 0);
          pg8::EpiStore<0, 32> E{MEMKV, 2048, SSQM, (LAS float*)(lds + RING_BYTES + 12288), 1.f / DM, nullptr, nullptr, nullptr, nullptr, nullptr, nullptr};
          pg8::gemm_phase(lds, P, S, E); }
        GRID_BAR(1);
    }
    PHASE(2) {
        WSL();
        { pg8::PolPlain P{(const char*)Z0, Z0_LD * 2, (const char*)(ws + WS_WUQ), 768 * 2, 768};
          pg8::StaticOrder S; S.init(M / 256, 1536 / 256, G, bx, 0);
          pg8::EpiStore<2, 12> E{QM, QM_LD, SSQQ, (LAS float*)(lds + RING_BYTES + 12288), 1.f / 768.f, ROPE, nullptr, nullptr, nullptr, nullptr, nullptr};
          pg8::gemm_phase(lds, P, S, E); }
        { pg8::PolPlain P{(const char*)(Z0 + 768), Z0_LD * 2, (const char*)(ws + WS_WUKV), 512 * 2, 512};
          pg8::StaticOrder S; S.init(M / 256, 2048 / 256, G, bx, 0);
          pg8::EpiStore<3, 8> E{KM, KM_LD, SSQKV, (LAS float*)(lds + RING_BYTES + 12288), 1.f / 512.f, nullptr, nullptr, nullptr, VM, Z0, nullptr};
          pg8::gemm_phase(lds, P, S, E); }
        GRID_BAR(2);
    }
    PHASE(3) {
        WSL();
#pragma unroll 1
        for (int r3_ = 0; r3_ < (DUP_SUB == 1 ? 2 : 1); ++r3_)
#pragma unroll 1
        for (int it = vcu; it < BATCH * 8 * 32; it += G) {
            const int bh = it >> 5, x = it & 31, b = bh >> 3, h = bh & 7;
#pragma unroll 1
            for (int pass = 0; pass < 2; ++pass) { const int qb = pass ? x : 63 - x;
                fa::AttnArgs a; a.Q = QM + (size_t)b * SEQ * QM_LD + h * 192; a.ldq = QM_LD; a.K = KM + (size_t)b * SEQ * KM_LD + h * 192; a.ldk = KM_LD;
                a.V = VM + (size_t)b * SEQ * VM_LD + h * 128; a.ldv = VM_LD; a.O = O0 + (size_t)b * SEQ * DM + h * 128; a.ldo = DM;
                a.q0 = qb * 256; a.j_lo = 0; a.j_hi = qb * 4 + 4; a.W = 0x3fffffff; a.dec = nullptr; a.sinkl = 0.f; a.sinks = nullptr; a.biasT = nullptr; a.kmax = 0.f;
                fa::attn_unit<192, 128, 0>(a, (LAS char*)lds); } }
        const float* sinks = (const float*)args.in[I_SINKS];
#pragma unroll 1
        for (int r3_ = 0; r3_ < (DUP_SUB == 2 ? 2 : 1); ++r3_)
#pragma unroll 1
        for (int it = vcu; it < BATCH * 2 * (SEQ / 32); it += G) {
            const int bk = it >> 9, qb = it & 511, b = bk >> 1, kvh = bk & 1, q0 = qb * 32;
            fa::AttnArgs a; const bf16_t* zb = Z0 + (size_t)b * SEQ * Z0_LD;
            a.Q = zb + 1344 + kvh * 512; a.ldq = Z0_LD; a.K = zb + 2368 + kvh * 64; a.ldk = Z0_LD; a.V = zb + 2496 + kvh * 64; a.ldv = Z0_LD;
            a.O = O0 + (size_t)b * SEQ * DM + 1024 + kvh * 512; a.ldo = DM;
            a.q0 = q0; a.j_lo = q0 - 127 < 0 ? 0 : (q0 - 127) >> 6; a.j_hi = ((q0 + 31) >> 6) + 1; a.W = 128; a.dec = nullptr; a.sinkl = 0.f; a.sinks = sinks + kvh * 8;
            a.biasT = BIAST + kvh * 8 * 128; a.kmax = 0.f;
            fa::attn_unit<64, 64, 2>(a, (LAS char*)lds); }
        GRID_BAR(3);
    }
    PHASE(4) {
        WSL();
        pg8::PolPlain P{(const char*)O0, DM * 2, (const char*)(ws + WS_WO0), DM * 2, DM};
        pg8::StaticOrder S; S.init(M / 256, DM / 256, G, bx, 0, WGM_K2048);
        pg8::EpiRes<true> E{XIN, XH, SSQ};
        pg8::gemm_phase(lds, P, S, E);
        GRID_BAR(4);
    }
#define CROSS_PHASES(l, s0) \
    PHASE(s0) { WSL(); \
        pg8::PolPlain P{(const char*)XH  , DM * 2, (const char*)(ws + WS_WXQ + (size_t)(l) * E_XQ * 2)  , DM * 2, DM}; \
        pg8::StaticOrder S; S.init(M / 256, 512 / 256, G, bx, 0, WGM_K2048); \
        pg8::EpiStore<0, 32> E{QX, 512, SSQ, (LAS float*)(lds + RING_BYTES + 12288), 1.f / DM, nullptr, nullptr, nullptr, nullptr, nullptr, nullptr}; \
        pg8::gemm_phase<pg8::EpiStore<0, 32>, pg8::PolPlain, 3>(lds, P, S, E); \
        GRID_BAR(s0); } \
    PHASE((s0) + 1) { WSL(); \
        _Pragma("unroll 1") for (int it = vcu; it < BATCH * 4 * 64; it += G) { \
            const int bh = it >> 6, qb = it & 63, b = bh >> 2, h = bh & 3; \
            fa::AttnArgs a; a.Q = QX + (size_t)b * SEQ * 512 + h * 128; a.ldq = 512; a.K = MEMKV + (size_t)b * MEMLEN * 2048 + (l) * 1024 + h * 128; a.ldk = 2048; \
            a.V = a.K + 512; a.ldv = 2048; a.O = OX + (size_t)b * SEQ * 512 + h * 128; a.ldo = 512; \
            a.q0 = qb * 256; a.j_lo = 0; a.j_hi = 4; a.W = 0x3fffffff; a.dec = nullptr; a.sinkl = 0.f; a.sinks = nullptr; a.biasT = nullptr; a.kmax = 0.f; \
            fa::attn_unit<128, 128, 3>(a, (LAS char*)lds); } \
        GRID_BAR((s0) + 1); } \
    PHASE((s0) + 2) { WSL(); \
        pg8::PolPlain P{(const char*)OX, 512 * 2, (const char*)(ws + WS_WXO + (size_t)(l) * E_XO * 2), 512 * 2, 512}; \
        pg8::StaticOrder S; S.init(M / 256, DM / 256, G, bx, 0); \
        pg8::EpiRes<false> E{XH, XH, nullptr};           \
        pg8::gemm_phase(lds, P, S, E); \
        GRID_BAR((s0) + 2); }
    CROSS_PHASES(0, 5)
    PHASE(45) {
        WSL();
#pragma unroll 1
        for (int m = gw; m < M; m += NGW) {
            const u32x2* xr = (const u32x2*)(XH + (size_t)m * DM) + lane; f32x4 v[8]; float ss = 0.f, amx = 0.f;
#pragma unroll
            for (int j = 0; j < 8; ++j) { v[j] = unpk_f16x4(xr[64 * j]); ss += (v[j][0] * v[j][0] + v[j][1] * v[j][1]) + (v[j][2] * v[j][2] + v[j][3] * v[j][3]);
                amx = fmaxf(amx, fmaxf(fmaxf(fabsf(v[j][0]), fabsf(v[j][1])), fmaxf(fabsf(v[j][2]), fabsf(v[j][3])))); }
            ss = wave_sum(ss);
#pragma unroll
            for (int o_ = 1; o_ < 64; o_ <<= 1) amx = fmaxf(amx, __shfl_xor(amx, o_));
            const float inv = amx > 0.f ? 127.f / amx : 0.f; unsigned* xq = (unsigned*)(XQ + (size_t)m * DM) + lane;
#pragma unroll
            for (int j = 0; j < 8; ++j) { const int q0 = (int)__builtin_rintf(v[j][0] * inv), q1 = (int)__builtin_rintf(v[j][1] * inv), q2 = (int)__builtin_rintf(v[j][2] * inv), q3 = (int)__builtin_rintf(v[j][3] * inv);
                xq[64 * j] = (unsigned)(q0 & 255) | ((unsigned)(q1 & 255) << 8) | ((unsigned)(q2 & 255) << 16) | ((unsigned)(q3 & 255) << 24); }
            if (lane == 0) RSTDF[m] = __builtin_amdgcn_rsqf(ss * (1.f / DM) + EPS) * amx * (1.f / 127.f);
        }
        GRID_BAR(7);
    }
#pragma unroll 1
    for (int p = 0; p < 5; ++p) {
        PHASE(8 + p) {
            if (p >= 1) {
                WSL();
                const int c = p - 1;
                pg8::PolChunkA P{(const char*)HIDB(c), 128, (const char*)(ws + WS_WD0), 128, DFF, c * CHUNK_TILES};
                pg8::StaticOrder S; S.init(CHUNK_TILES, DM / 256, G, bx, c * CHUNK_TILES, WGM_DOWN);
                pg8::EpiRes<false> E{XH, XH, SSQ};
                pg8::gemm_phase(lds, P, S, E);
            }
            int pg = p; asm volatile("" : "+s"(pg));
            if (pg <= 3) {
                WSL();
                pg8::PolPlain P{(const char*)XQ, DM, (const char*)(ws + WS_WGU0)  , DM, DM / 2};
                pg8::StaticOrder S; S.init(CHUNK_TILES, 2 * DFF / 256, G, bx, pg * CHUNK_TILES, WGM_GU);
                pg8::EpiSwiGLU<2> E{HIDB(pg), pg * CHUNK_ROWS, nullptr, RSTDF, ctl + CW_AMAXW + 8 * 2 * DFF, nullptr};
                pg8::gemm_phase<pg8::EpiSwiGLU<2>, pg8::PolPlain, 1>(lds, P, S, E);
            }
            GRID_BAR(8 + p);
        }
    }
    PHASE(46) {
        WSL();
#pragma unroll 1
        for (int m = gw; m < M; m += NGW) {
            const u32x2* xr = (const u32x2*)(XH + (size_t)m * DM) + lane; f32x4 v[8]; float ss = 0.f, amx = 0.f;
#pragma unroll
            for (int j = 0; j < 8; ++j) { v[j] = unpk_f16x4(xr[64 * j]); ss += (v[j][0] * v[j][0] + v[j][1] * v[j][1]) + (v[j][2] * v[j][2] + v[j][3] * v[j][3]);
                amx = fmaxf(amx, fmaxf(fmaxf(fabsf(v[j][0]), fabsf(v[j][1])), fmaxf(fabsf(v[j][2]), fabsf(v[j][3])))); }
            ss = wave_sum(ss);
#pragma unroll
            for (int o_ = 1; o_ < 64; o_ <<= 1) amx = fmaxf(amx, __shfl_xor(amx, o_));
            const float inv = amx > 0.f ? 127.f / amx : 0.f; unsigned* xq = (unsigned*)(XQ + (size_t)m * DM) + lane;
#pragma unroll
            for (int j = 0; j < 8; ++j) { const int q0 = (int)__builtin_rintf(v[j][0] * inv), q1 = (int)__builtin_rintf(v[j][1] * inv), q2 = (int)__builtin_rintf(v[j][2] * inv), q3 = (int)__builtin_rintf(v[j][3] * inv);
                xq[64 * j] = (unsigned)(q0 & 255) | ((unsigned)(q1 & 255) << 8) | ((unsigned)(q2 & 255) << 16) | ((unsigned)(q3 & 255) << 24); }
            if (lane == 0) RSTDF[m] = __builtin_amdgcn_rsqf(ss * (1.f / DM) + EPS) * amx * (1.f / 127.f);
        }
        GRID_BAR(15);
    }
    PHASE(16) {
        WSL();
        pg8::PolPlain P{(const char*)XQ  , DM, (const char*)(ws + WS_WIN1)  , DM, DM / 2};
        pg8::StaticOrder S; S.init(M / 256, IN1_PAD / 256, G, bx, 0, WGM_K2048);
        pg8::EpiStore<4, 32> E{Z1, Z1_LD, nullptr, (LAS float*)(lds + RING_BYTES + 12288), 1.f / DM, nullptr, nullptr, nullptr, nullptr, nullptr, FL, RSTDF, ctl + CW_AMAX15};
        pg8::gemm_phase<pg8::EpiStore<4, 32>, pg8::PolPlain, 1>(lds, P, S, E);
        GRID_BAR(16);
    }
    PHASE(17) {
        WSL();
#pragma unroll 1
        for (int b = 0; b < BATCH; ++b) {
            float kmx = 0.f;
#pragma unroll 1
            for (int r = gw; r < SEQ; r += NGW) {
                const u32x4* kp = (const u32x4*)(Z1 + ((size_t)b * SEQ + r) * Z1_LD + 2048 + lane * 32); float ss = 0.f;
#pragma unroll
                for (int q = 0; q < 4; ++q) { const u32x4 w = kp[q];
#pragma unroll
                    for (int e = 0; e < 4; ++e) { const float lo_ = __uint_as_float(w[e] << 16), hi_ = __uint_as_float(w[e] & 0xffff0000u); ss += lo_ * lo_ + hi_ * hi_; } }
                ss += __shfl_xor(ss, 1); ss += __shfl_xor(ss, 2);
                kmx = fmaxf(kmx, ss);
            }
            if ((lane & 3) == 0) atomicMax(ctl + CW_KMAX + 64 * (b * 16 + (lane >> 2)), __float_as_uint(kmx));
        }
        const float* bfv = (const float*)args.in[I_BF];
        LAS double* wtot = (LAS double*)lds;
#pragma unroll 1
        for (int bh = bx; bh < BATCH * 16; bh += G) {
            const int b = bh >> 4, h = bh & 15; const float bias = bfv[h];
            const size_t base = ((size_t)b * SEQ + (size_t)tid * 32) * 16 + h;
            float lf[32]; double run = 0.0;
#pragma unroll
            for (int i = 0; i < 32; ++i) { const float xv = FL[base + (size_t)i * 16] + bias; lf[i] = fminf(xv, 0.f) - log1pf(expf(-fabsf(xv))); }
#pragma unroll
            for (int i = 0; i < 32; ++i) run += (double)lf[i];
            double incl = run;
#pragma unroll
            for (int o = 1; o < 64; o <<= 1) { const double t = __shfl_up(incl, o); if (lane >= o) incl += t; }
            if (lane == 63) wtot[wave] = incl;
            __syncthreads();
            double off = incl - run;
            for (int w = 0; w < wave; ++w) off += wtot[w];
            double cacc = off;
#pragma unroll
            for (int i = 0; i < 32; ++i) { cacc += (double)lf[i]; DEC[base + (size_t)i * 16] = (float)(cacc * 1.4426950408889634); }
            __syncthreads();
        }
        GRID_BAR(17);
    }
    PHASE(18) {
        WSL();
        LAS int* qslot = (LAS int*)(lds + RING_BYTES + 8192);
#pragma unroll 1
        for (;;) {
            if (tid == 0) qslot[0] = (int)__hip_atomic_fetch_add(ctl + CW_Q18, 1u, RLX_AGENT);
            __syncthreads();
            const int u = qslot[0];
            __syncthreads();
            if (u >= BATCH * 16 * 64) break;
            const int qb = 63 - (u >> 5), bh = u & 31, b = bh >> 4, h = bh & 15;
            fa::AttnArgs a; const bf16_t* zb = Z1 + (size_t)b * SEQ * Z1_LD;
            a.Q = zb + h * 128; a.ldq = Z1_LD; a.K = zb + 2048 + h * 128; a.ldk = Z1_LD; a.V = zb + 4096 + h * 128; a.ldv = Z1_LD;
            a.O = O1 + (size_t)b * SEQ * DM + h * 128; a.ldo = DM;
            a.q0 = qb * 256; a.j_lo = 0; a.j_hi = qb * 4 + 4; a.W = 0x3fffffff; a.dec = DEC + (size_t)b * SEQ * 16 + h; a.sinkl = 0.f; a.sinks = nullptr; a.biasT = nullptr;
            a.kmax = sqrtf(__uint_as_float(__hip_atomic_load(ctl + CW_KMAX + 64 * bh, RLX_AGENT)));
            fa::attn_unit<128, 128, 1>(a, (LAS char*)lds);
        }
        GRID_BAR(18);
    }
    PHASE(19) {
        WSL();
        pg8::PolPlain P{(const char*)O1, DM * 2, (const char*)(ws + WS_WO1), DM * 2, DM};
        pg8::StaticOrder S; S.init(M / 256, DM / 256, G, bx, 0, WGM_K2048);
        pg8::EpiRes<false> E{XH, XH, SSQ};
        pg8::gemm_phase(lds, P, S, E);
        GRID_BAR(19);
    }
    CROSS_PHASES(1, 20)
    PHASE(23) {
        WSL();
        LAS float* WrT = (LAS float*)lds;
        const float* rw = (const float*)args.in[I_RW]; const float* gn = (const float*)args.in[I_NFFN] + DM; const float* rb = (const float*)args.in[I_RB];
        for (int i = tid; i < 8 * DM; i += 512) { const int e = i >> 11, k = i & 2047; WrT[i] = rw[k * 8 + e] * gn[k]; }
        __syncthreads();
#pragma unroll 1
        for (int g16 = gw; g16 < M / 16; g16 += NGW) {
            int e1 = 0, e2 = 0; float g1 = 0.f, g2 = 0.f, rstd = 0.f;
#pragma unroll 1
            for (int i = 0; i < 16; ++i) {
                const int row = g16 * 16 + i;
                const u32x2* xr = (const u32x2*)(XH + (size_t)row * DM) + lane;
                float pe[8], ss = 0.f, amx = 0.f;
#pragma unroll
                for (int e = 0; e < 8; ++e) pe[e] = 0.f;
#pragma unroll 2
                for (int j = 0; j < 8; ++j) { const f32x4 v = unpk_f16x4(xr[64 * j]); ss += (v[0] * v[0] + v[1] * v[1]) + (v[2] * v[2] + v[3] * v[3]);
                    amx = fmaxf(amx, fmaxf(fmaxf(fabsf(v[0]), fabsf(v[1])), fmaxf(fabsf(v[2]), fabsf(v[3]))));
#pragma unroll
                    for (int e = 0; e < 8; ++e) { const f32x4 w = *(const LAS f32x4*)(WrT + e * DM + 256 * j + lane * 4); pe[e] += (v[0] * w[0] + v[1] * w[1]) + (v[2] * w[2] + v[3] * w[3]); } }
                ss = wave_sum(ss);
#pragma unroll
                for (int e = 0; e < 8; ++e) pe[e] = wave_sum(pe[e]);
                const float rs = __builtin_amdgcn_rsqf(ss * (1.f / DM) + EPS);
#pragma unroll
                for (int o_ = 1; o_ < 64; o_ <<= 1) amx = fmaxf(amx, __shfl_xor(amx, o_));
                { const float inv = amx > 0.f ? 127.f / amx : 0.f; unsigned* xq = (unsigned*)(XQ + (size_t)row * DM) + lane;
#pragma unroll 2
                  for (int j = 0; j < 8; ++j) { const f32x4 v = unpk_f16x4(xr[64 * j]);
                      const int q0 = (int)__builtin_rintf(v[0] * inv), q1 = (int)__builtin_rintf(v[1] * inv), q2 = (int)__builtin_rintf(v[2] * inv), q3 = (int)__builtin_rintf(v[3] * inv);
                      xq[64 * j] = (unsigned)(q0 & 255) | ((unsigned)(q1 & 255) << 8) | ((unsigned)(q2 & 255) << 16) | ((unsigned)(q3 & 255) << 24); } }
                const float rowf = rs * amx * (1.f / 127.f);
                float lg[8];
#pragma unroll
                for (int e = 0; e < 8; ++e) lg[e] = pe[e] * rs + rb[e];
                int b1 = 0; float v1 = lg[0];
#pragma unroll
                for (int e = 1; e < 8; ++e) if (lg[e] > v1) { v1 = lg[e]; b1 = e; }
                int b2 = -1; float v2 = -__builtin_inff();
#pragma unroll
                for (int e = 0; e < 8; ++e) if (e != b1 && lg[e] > v2) { v2 = lg[e]; b2 = e; }
                const float ex = __expf(v2 - v1); const float gg2 = ex / (1.f + ex), gg1 = 1.f / (1.f + ex);
                if (lane == i) { e1 = b1; e2 = b2; g1 = gg1; g2 = gg2; rstd = rowf; }
            }
            int s1 = 0, s2 = 0;
#pragma unroll
            for (int e = 0; e < 8; ++e) {
                const unsigned long long m1 = __ballot(lane < 16 && e1 == e), m2 = __ballot(lane < 16 && e2 == e);
                const int c1 = __popcll(m1), c2 = __popcll(m2);
                int basev = 0;
                if (lane == 0 && c1 + c2 > 0) basev = (int)__hip_atomic_fetch_add(ctl + CW_CNT + 64 * e, (unsigned)(c1 + c2), RLX_AGENT);
                basev = __shfl(basev, 0);
                const unsigned long long lt = (1ull << lane) - 1ull;
                if (lane < 16 && e1 == e) s1 = basev + __popcll(m1 & lt);
                if (lane < 16 && e2 == e) s2 = basev + c1 + __popcll(m2 & lt);
            }
            if (lane < 16) { const int row = g16 * 16 + lane; TOPE[row * 2] = e1; TOPE[row * 2 + 1] = e2; TOPS[row * 2] = s1; TOPS[row * 2 + 1] = s2;
                TOPG[row * 2] = g1; TOPG[row * 2 + 1] = g2; RSTDF[row] = rstd; }
        }
        GRID_BAR(23);
    }
    if (hi > 24) {
#define EOFF() int eoff[9]; eoff[0] = 0; _Pragma("unroll") for (int e = 0; e < 8; ++e) { const int c_ = (int)__hip_atomic_load(ctl + CW_CNT + 64 * e, RLX_AGENT); eoff[e + 1] = eoff[e] + ((c_ + 255) & ~255); }
        PHASE(24) {
            WSL();
            EOFF();
            int ecnt[8];
#pragma unroll
            for (int e = 0; e < 8; ++e) ecnt[e] = (int)__hip_atomic_load(ctl + CW_CNT + 64 * e, RLX_AGENT);
            int gt1_ = tid; asm volatile("" : "+v"(gt1_)); gt1_ += bx * 512;
            for (int i = gt1_; i < M * 2; i += G * 512) {
                const int e = TOPE[i], sl = TOPS[i]; int off = 0;
#pragma unroll
                for (int q = 0; q < 8; ++q) if (q == e) off = eoff[q];
                const int pos = off + sl; ROWIDX[pos] = i >> 1; GATEP[pos] = TOPG[i]; RSTDP[pos] = RSTDF[i >> 1]; TOKPOS[i] = pos;
            }
            for (int i = gt1_; i < 8 * 256; i += G * 512) {
                const int e = i >> 8, j = i & 255; int off = 0, cnt = 0, nxt = 0;
#pragma unroll
                for (int q = 0; q < 8; ++q) if (q == e) { off = eoff[q]; cnt = ecnt[q]; nxt = eoff[q + 1]; }
                const int pos = off + cnt + j;
                if (pos < nxt) { ROWIDX[pos] = 0; GATEP[pos] = 0.f; RSTDP[pos] = 0.f; }
            }
            GRID_BAR(24);
        }
        LAS int* TILE_E = (LAS int*)(lds + RING_BYTES + 1024);
        if (hi > 25) {
            EOFF();
            for (int t = tid; t < MOE_MAX_TILES; t += 512) { int e = 0;
#pragma unroll
                for (int q = 1; q < 8; ++q) if (t * 256 >= eoff[q]) e = q;
                TILE_E[t] = e; }
            if (tid == 0) TILE_E[MOE_MAX_TILES] = eoff[8] >> 8;
            __syncthreads();
        }
#pragma unroll 1
        for (int p = 0; p <= MOE_CHUNKS; ++p) {
            PHASE(25 + p) {
                int ndown = 0;
                { WSL();
                const int ntiles = TILE_E[MOE_MAX_TILES], nch = (ntiles + CHUNK_TILES - 1) / CHUNK_TILES, t0 = ntiles - CHUNK_TILES * (nch - 1);
                if (p >= 1 && p - 1 < nch) {
                    const int c = p - 1, ft = c == 0 ? 0 : t0 + (c - 1) * CHUNK_TILES, nt_ = c == 0 ? t0 : CHUNK_TILES;
                    pg8::PolMoeDown P{(const char*)HIDB(c)  , 128, (const char*)(ws + WS_WD1)  , 128, DFF / 2, ft, TILE_E, E_D};
                    pg8::StaticOrder S; S.init(nt_, DM / 256, G, bx, ft, WGM_DOWN);
                    pg8::EpiMoeDown E{YB, GATEP};
                    pg8::gemm_phase<pg8::EpiMoeDown, pg8::PolMoeDown, 4>(lds, P, S, E);
                    ndown = nt_ * (DM / 256);
                } }
                int pg = p; asm volatile("" : "+s"(pg), "+s"(ndown));
                { WSL();
                const int ntiles = TILE_E[MOE_MAX_TILES], nch = (ntiles + CHUNK_TILES - 1) / CHUNK_TILES, t0 = ntiles - CHUNK_TILES * (nch - 1);
                if (pg < nch) {
                    const int ft = pg == 0 ? 0 : t0 + (pg - 1) * CHUNK_TILES, nt_ = pg == 0 ? t0 : CHUNK_TILES;
                    pg8::PolMoeUp P{(const char*)XQ  , DM, (const char*)(ws + WS_WGU1)  , DM, DM / 2, ROWIDX, TILE_E, E_GU};
                    pg8::StaticOrder S; S.init(nt_, 2 * DFF / 256, G, bx, ft, WGM_GU); S.quota(ndown);
                    pg8::EpiSwiGLU<2> E{HIDB(pg), ft * 256, nullptr, RSTDP, ctl + CW_AMAXW, TILE_E, 1};
                    pg8::gemm_phase<pg8::EpiSwiGLU<2>, pg8::PolMoeUp, 1>(lds, P, S, E);
                } }
                GRID_BAR(25 + p);
            }
        }
    }
    PHASE(43) {
        WSL();
        const float* fn = (const float*)args.in[I_FNORM];
#pragma unroll 1
        for (int m = gw; m < M; m += NGW) {
            const int p0 = TOKPOS[m * 2], p1 = TOKPOS[m * 2 + 1];
            const u32x2* xr = (const u32x2*)(XH + (size_t)m * DM) + lane; f32x4* orow = (f32x4*)(args.out + (size_t)m * DM) + lane;
            const u32x2* y0 = (const u32x2*)(YB + (size_t)p0 * DM) + lane; const u32x2* y1 = (const u32x2*)(YB + (size_t)p1 * DM) + lane;
            f32x4 v[8]; float s = 0.f;
#pragma unroll
            for (int j = 0; j < 8; ++j) { v[j] = unpk_f16x4(xr[64 * j]); const u32x2 a0 = y0[64 * j], a1 = y1[64 * j];
                v[j][0] += __uint_as_float(a0.x << 16) + __uint_as_float(a1.x << 16); v[j][1] += __uint_as_float(a0.x & 0xffff0000u) + __uint_as_float(a1.x & 0xffff0000u);
                v[j][2] += __uint_as_float(a0.y << 16) + __uint_as_float(a1.y << 16); v[j][3] += __uint_as_float(a0.y & 0xffff0000u) + __uint_as_float(a1.y & 0xffff0000u);
                s += (v[j][0] * v[j][0] + v[j][1] * v[j][1]) + (v[j][2] * v[j][2] + v[j][3] * v[j][3]); }
            s = wave_sum(s); const float rs = __builtin_amdgcn_rsqf(s * (1.f / DM) + EPS);
#pragma unroll
            for (int j = 0; j < 8; ++j) { const f32x4 g = *((const f32x4*)fn + lane + 64 * j); orow[64 * j] = v[j] * rs * g; }
        }
    }
#undef IN
#undef GRID_BAR
}

constexpr int N_STEPS = 47;
extern "C" void kernel_launch(void* const* d_in, const int* in_sizes, int n_in, void* d_out, int out_size, void* d_ws, size_t ws_size, hipStream_t stream) {
    static int grid = 0;
    if (grid == 0) {
        if (n_in != N_IN || in_sizes[0] != M * DM || out_size != M * DM || ws_size < WS_END) {
            fprintf(stderr, "kernel_launch: shape / workspace mismatch (n_in %d, in0 %d, out %d, ws %zu, need %zu); nothing launched\n", n_in, n_in > 0 ? in_sizes[0] : -1, out_size, ws_size, (size_t)WS_END); grid = -1; return; }
        int dev = 0, cus = 0, per_cu = 0;
        if (hipGetDevice(&dev) != hipSuccess || hipDeviceGetAttribute(&cus, hipDeviceAttributeMultiprocessorCount, dev) != hipSuccess) { grid = -1; return; }
        if (hipFuncSetAttribute((const void*)trunk_fwd, hipFuncAttributeMaxDynamicSharedMemorySize, LDS_BYTES) != hipSuccess) { fprintf(stderr, "kernel_launch: hipFuncSetAttribute failed\n"); grid = -1; return; }
        if (hipOccupancyMaxActiveBlocksPerMultiprocessor(&per_cu, (const void*)trunk_fwd, NWAVES * 64, LDS_BYTES) != hipSuccess || per_cu < 1)
            fprintf(stderr, "kernel_launch: note: occupancy query reports %d workgroups per CU\n", per_cu);
        (void)hipGetLastError();
        grid = cus;
    }
    if (grid < 0) return;
    if (hipMemsetAsync((char*)d_ws + WS_CTL, 0, CTL_BYTES, stream) != hipSuccess) return;
    Args a{};
    for (int i = 0; i < N_IN; ++i) a.in[i] = d_in[i];
    a.out = (float*)d_out; a.ws = (unsigned char*)d_ws;
#if MK_ONE_LAUNCH
    a.ph_lo = 0; a.ph_hi = N_STEPS;
    hipLaunchKernelGGL(trunk_fwd, dim3(grid), dim3(NWAVES * 64), LDS_BYTES, stream, a);
#else
    for (int i = 0; i < N_STEPS; ++i) { const int s = i == 0 ? 0 : (i == 1 ? 44 : (i <= 8 ? i - 1 : (i == 9 ? 45 : (i <= 14 ? i - 2 : (i == 15 ? 46 : i - 3))))); a.ph_lo = s; a.ph_hi = s + 1; hipLaunchKernelGGL(trunk_fwd, dim3(grid), dim3(NWAVES * 64), LDS_BYTES, stream, a); }
#endif
}
```

```cpp
#include <hip/hip_runtime.h>
#include <hip/hip_bf16.h>
#include <cstdio>
#include <cstdint>
#include <cmath>

#ifndef MK_ONE_LAUNCH
#define MK_ONE_LAUNCH 1
#endif

#define GAS __attribute__((address_space(1)))
#define LAS __attribute__((address_space(3)))
typedef unsigned short bf16_t;
typedef short bf16x8 __attribute__((ext_vector_type(8)));
typedef short s16x4 __attribute__((ext_vector_type(4)));
typedef float f32x2 __attribute__((ext_vector_type(2)));
typedef float f32x4 __attribute__((ext_vector_type(4)));
typedef float f32x16 __attribute__((ext_vector_type(16)));
typedef unsigned u32x2 __attribute__((ext_vector_type(2)));
typedef unsigned u32x4 __attribute__((ext_vector_type(4)));
typedef int i32x4 __attribute__((ext_vector_type(4)));
typedef long i64x2 __attribute__((ext_vector_type(2)));

constexpr int BATCH = 2, SEQ = 16384, DM = 2048, M = BATCH * SEQ, MEMLEN = 256, MROWS = BATCH * MEMLEN;
constexpr int EVEN_IN = 2624, Z0_LD = 2816, ODD_IN = 6160, Z1_LD = 6144, IN1_PAD = 6400;
constexpr int DFF = 7168, NEXP = 8;
constexpr int HLD = DFF + 64;
constexpr int QM_LD = 1536, KM_LD = 1536, VM_LD = 1024;
constexpr float LOG2E = 1.4426950408889634f;
constexpr float C2_MLA = LOG2E * 0.07216878364870323f;
constexpr float C2_SWA = LOG2E * 0.125f;
constexpr float C2_128 = LOG2E * 0.08838834764831845f;
constexpr float EPS = 1e-6f;
constexpr int CHUNK_ROWS = 8192, CHUNK_TILES = 32, MOE_MAX_TILES = 264, MOE_MAX_ROWS = MOE_MAX_TILES * 256;
constexpr int MCH_TILES = 64, MCH_ROWS = MCH_TILES * 256, MOE_CHUNKS = (MOE_MAX_TILES + MCH_TILES - 1) / MCH_TILES;

enum { I_X = 0, I_MEM, I_POS, I_RELB, I_NMIX, I_NCROSS, I_NMEM, I_NFFN, I_XWQ, I_XWK, I_XWV, I_XWO, I_EVWIN, I_QNORM, I_WUQ, I_KVNORM, I_WUKV, I_SINKS, I_EVWO,
       I_FG, I_FU, I_FD, I_ODWIN, I_BF, I_ODWO, I_RW, I_RB, I_MG, I_MU, I_MD, I_FNORM, N_IN };

constexpr size_t al256(size_t x) { return (x + 255) & ~(size_t)255; }
constexpr size_t WS_CTL = 0, CTL_BYTES = 1u << 20;
constexpr size_t E_IN0 = (size_t)Z0_LD * DM, E_UQ = (size_t)1536 * 768, E_UKV = (size_t)2048 * 512, E_SQ = (size_t)DM * DM, E_XQ = (size_t)512 * DM, E_XKV = (size_t)2048 * DM,
                 E_XO = (size_t)DM * 512, E_GU = (size_t)2 * DFF * DM, E_D = (size_t)DM * DFF, E_IN1 = (size_t)IN1_PAD * DM;
constexpr size_t WS_WIN0 = WS_CTL + CTL_BYTES;
constexpr size_t WS_WUQ = WS_WIN0 + 2 * E_IN0;
constexpr size_t WS_WUKV = WS_WUQ + 2 * E_UQ;
constexpr size_t WS_WO0 = WS_WUKV + 2 * E_UKV;
constexpr size_t WS_WXQ = WS_WO0 + 2 * E_SQ;
constexpr size_t WS_WXKV = WS_WXQ + 2 * 2 * E_XQ;
constexpr size_t WS_WXO = WS_WXKV + 2 * E_XKV;
constexpr size_t WS_WGU0 = WS_WXO + 2 * 2 * E_XO;
constexpr size_t WS_WD0 = WS_WGU0 + 2 * E_GU;
constexpr size_t WS_WIN1 = WS_WD0 + 2 * E_D;
constexpr size_t WS_WO1 = WS_WIN1 + 2 * E_IN1;
constexpr size_t WS_WGU1 = WS_WO1 + 2 * E_SQ;
constexpr size_t WS_WD1 = WS_WGU1 + 2 * 8 * E_GU;
constexpr size_t WS_XB = WS_WD1 + 2 * 8 * E_D;
constexpr size_t WS_SSQ = WS_XB + (size_t)M * DM * 2;
constexpr size_t WS_ROPE = WS_SSQ + (size_t)M * 32 * 4;
constexpr size_t WS_MEMN = WS_ROPE + (size_t)M * 64 * 4;
constexpr size_t WS_SSQM = WS_MEMN + (size_t)MROWS * DM * 2;
constexpr size_t WS_MEMKV = WS_SSQM + (size_t)MROWS * 32 * 4;
constexpr size_t WS_SSQQ = WS_MEMKV + (size_t)MROWS * 2048 * 2;
constexpr size_t WS_SSQKV = WS_SSQQ + (size_t)M * 12 * 4;
constexpr size_t WS_QX = WS_SSQKV + (size_t)M * 8 * 4;
constexpr size_t WS_OX = WS_QX + (size_t)M * 512 * 2;
constexpr size_t WS_FL = WS_OX + (size_t)M * 512 * 2;
constexpr size_t WS_DEC = WS_FL + (size_t)M * 16 * 4;
constexpr size_t WS_TOPE = WS_DEC + (size_t)M * 16 * 4;
constexpr size_t WS_TOPS = WS_TOPE + (size_t)M * 2 * 4;
constexpr size_t WS_TOPG = WS_TOPS + (size_t)M * 2 * 4;
constexpr size_t WS_RSTDF = WS_TOPG + (size_t)M * 2 * 4;
constexpr size_t WS_TOKPOS = WS_RSTDF + (size_t)M * 4;
constexpr size_t WS_ROWIDX = WS_TOKPOS + (size_t)M * 2 * 4;
constexpr size_t WS_GATEP = WS_ROWIDX + (size_t)MOE_MAX_ROWS * 4;
constexpr size_t WS_RSTDP = WS_GATEP + (size_t)MOE_MAX_ROWS * 4;
constexpr size_t WS_BIAST = WS_RSTDP + (size_t)MOE_MAX_ROWS * 4;
constexpr size_t WS_ARENA = al256(WS_BIAST + 16 * 128 * 4);
constexpr size_t AR_Z0 = 0;
constexpr size_t AR_QM = AR_Z0 + (size_t)M * Z0_LD * 2;
constexpr size_t AR_KM = AR_QM + (size_t)M * QM_LD * 2;
constexpr size_t AR_VM = AR_KM + (size_t)M * KM_LD * 2;
constexpr size_t AR_O0 = AR_VM + (size_t)M * VM_LD * 2;
constexpr size_t AR_END0 = AR_O0 + (size_t)M * DM * 2;
constexpr size_t AR_HID = 0;
constexpr size_t HID_BYTES = (size_t)CHUNK_ROWS * DFF * 2;
constexpr size_t AR_Y = AR_HID + 2 * HID_BYTES;
constexpr size_t AR_END2 = AR_Y + (size_t)MOE_MAX_ROWS * DM * 2;
constexpr size_t AR_Z1 = 0;
constexpr size_t AR_O1 = AR_Z1 + (size_t)M * Z1_LD * 2;
constexpr size_t AR_END1 = AR_O1 + (size_t)M * DM * 2;
constexpr size_t AR_SIZE = AR_END0 > AR_END1 ? (AR_END0 > AR_END2 ? AR_END0 : AR_END2) : (AR_END1 > AR_END2 ? AR_END1 : AR_END2);
constexpr size_t WS_END = WS_ARENA + AR_SIZE;

constexpr int CW_BAR = 4096;
constexpr int CW_CNT = 16384;
constexpr int CW_KMAX = 20480;
constexpr int CW_Q18 = 24576;
constexpr int CW_AMAX15 = 32768;
constexpr int CW_AMAX0 = 40960;
constexpr int CW_AMAXW = 131072;
static_assert((CW_AMAXW + 9 * 14336) * 4 <= (int)CTL_BYTES, "CTL map");

constexpr int RING_BYTES = 131072;
constexpr int MISC_OFF = RING_BYTES + 320;
constexpr int LDS_BYTES = 147456;
constexpr int NWAVES = 8;
#ifndef WGM_GU
#define WGM_GU 4
#endif
#ifndef WGM_K2048
#define WGM_K2048 4
#endif
#ifndef WGM_DOWN
#define WGM_DOWN 8
#endif

#define LDS_WAIT() asm volatile("s_waitcnt lgkmcnt(0)" ::: "memory")
#define VM_WAIT() asm volatile("s_waitcnt vmcnt(0)" ::: "memory")
#define RLX_AGENT __ATOMIC_RELAXED, __HIP_MEMORY_SCOPE_AGENT
__device__ __forceinline__ unsigned cvt_pk_bf16(float lo, float hi) { unsigned r; asm volatile("v_cvt_pk_bf16_f32 %0, %1, %2" : "=v"(r) : "v"(lo), "v"(hi)); return r; }
typedef _Float16 h16x2 __attribute__((ext_vector_type(2)));
typedef _Float16 h16x8 __attribute__((ext_vector_type(8)));
__device__ __forceinline__ unsigned pk_f16(float lo, float hi) { const h16x2 v = {(_Float16)lo, (_Float16)hi}; return __builtin_bit_cast(unsigned, v); }
__device__ __forceinline__ f32x2 unpk_f16(unsigned u) { const h16x2 v = __builtin_bit_cast(h16x2, u); return (f32x2){(float)v.x, (float)v.y}; }
__device__ __forceinline__ f32x4 unpk_f16x4(u32x2 u) { const f32x2 a = unpk_f16(u.x), b = unpk_f16(u.y); return (f32x4){a.x, a.y, b.x, b.y}; }
__device__ __forceinline__ u32x2 pack8_fp8(f32x4 a, f32x4 b) {
    int lo = 0, hi = 0;
    lo = __builtin_amdgcn_cvt_pk_fp8_f32(a[0], a[1], lo, false); lo = __builtin_amdgcn_cvt_pk_fp8_f32(a[2], a[3], lo, true);
    hi = __builtin_amdgcn_cvt_pk_fp8_f32(b[0], b[1], hi, false); hi = __builtin_amdgcn_cvt_pk_fp8_f32(b[2], b[3], hi, true);
    return (u32x2){(unsigned)lo, (unsigned)hi};
}
__device__ __forceinline__ float bf2f(unsigned short b) { return __uint_as_float((unsigned)b << 16); }
__device__ __forceinline__ float wave_sum(float v) {
#pragma unroll
    for (int o = 1; o < 64; o <<= 1) v += __shfl_xor(v, o);
    return v;
}

#define XB_TMO      128
#define XB_XCNT(j)  (256  + 64 * (j))
#define XB_XSUB(j)  (1280 + 64 * (j))
#define XB_XGEN(j)  (2304 + 64 * (j))
#define XB_TOP      3328
#define XB_TOPGEN   3392
#define XCD_BAR_WORDS 3456
#define XB_SPIN_CAP (1u << 18)
__device__ __forceinline__ unsigned xb_ld(unsigned* p)              { return __hip_atomic_load(p, __ATOMIC_RELAXED, __HIP_MEMORY_SCOPE_AGENT); }
__device__ __forceinline__ unsigned xb_add(unsigned* p, unsigned v) { return __hip_atomic_fetch_add(p, v, __ATOMIC_RELAXED, __HIP_MEMORY_SCOPE_AGENT); }
__device__ __forceinline__ unsigned xb_xcc_id() { return (unsigned)__builtin_amdgcn_s_getreg((3 << 11) | 20) & 0xFu; }
#define XB_SPIN(cond, bar) do { unsigned _sp = 0; while (cond) { __builtin_amdgcn_s_sleep(1); \
    if ((++_sp & 255u) == 0u) { if (xb_ld(&(bar)[XB_TMO])) break; if (_sp > XB_SPIN_CAP) { atomicAdd(&(bar)[XB_TMO], 1u); break; } } } } while (0)
struct XcdBarrier { unsigned* bar; unsigned x; volatile LAS unsigned* st; };
__device__ __forceinline__ XcdBarrier xcd_barrier_post(unsigned* bar, volatile LAS unsigned* st) {
    XcdBarrier b; b.bar = bar; b.x = xb_xcc_id(); b.st = st;
    if (threadIdx.x == 0) (void)xb_add(&bar[XB_XCNT(b.x)], 1u);
    return b;
}
__device__ __forceinline__ void xcd_barrier_complete(unsigned* bar, unsigned x, unsigned& nloc, unsigned& nx) {
    const unsigned G = gridDim.x * gridDim.y * gridDim.z;
    unsigned sum, cnt, mine, sp = 0u;
    for (;;) {
        sum = 0u; cnt = 0u; mine = 0u;
#pragma unroll
        for (unsigned j = 0; j < 16; ++j) { const unsigned c = xb_ld(&bar[XB_XCNT(j)]); sum += c; cnt += (c > 0u) ? 1u : 0u; mine = (j == x) ? c : mine; }
        if (sum == G) break;
        __builtin_amdgcn_s_sleep(1);
        if ((++sp & 255u) == 0u) { if (xb_ld(&bar[XB_TMO])) break; if (sp > XB_SPIN_CAP) { atomicAdd(&bar[XB_TMO], 1u); break; } }
    }
    nloc = mine > 0u ? mine : 1u; nx = cnt > 0u ? cnt : 1u;
}
__device__ __forceinline__ void xcd_barrier(const XcdBarrier& b) {
    asm volatile("s_waitcnt vmcnt(0)" ::: "memory");
    __syncthreads();
    if (threadIdx.x == 0) {
        unsigned* bar = b.bar;
        __builtin_amdgcn_s_waitcnt(0);
        unsigned nloc = b.st[0], nx = b.st[1];
        if (nloc == 0u) { xcd_barrier_complete(bar, b.x, nloc, nx); b.st[0] = nloc; b.st[1] = nx; }
        const unsigned old = xb_add(&bar[XB_XSUB(b.x)], 1u);
        const unsigned gen = old / nloc;
        if (old + 1u == (gen + 1u) * nloc) {
            __builtin_amdgcn_fence(__ATOMIC_RELEASE, "agent");
            asm volatile("s_waitcnt vmcnt(0)" ::: "memory");
            const unsigned og = xb_add(&bar[XB_TOP], 1u);
            const unsigned tg = og / nx;
            if (og + 1u == (tg + 1u) * nx) xb_add(&bar[XB_TOPGEN], 1u);
            else XB_SPIN(xb_ld(&bar[XB_TOPGEN]) == tg, bar);
            __builtin_amdgcn_fence(__ATOMIC_ACQUIRE, "agent");
            xb_add(&bar[XB_XGEN(b.x)], 1u);
            asm volatile("s_waitcnt vmcnt(0)" ::: "memory");
        } else {
            XB_SPIN(xb_ld(&bar[XB_XGEN(b.x)]) == gen, bar);
            __builtin_amdgcn_fence(__ATOMIC_ACQUIRE, "agent");
            asm volatile("s_waitcnt vmcnt(0)" ::: "memory");
        }
    }
    __syncthreads();
}

namespace pg8 {
constexpr int BM = 256, BK = 64, HALF = 128, HTB = HALF * BK * 2, STAGE_BYTES = 8 * HTB, NXCD = 8, WGM = 8;
__host__ __device__ __forceinline__ int lds_byte(int r, int c) { const int st = (r >> 4) * 2 + (c >> 5), rr = r & 15, cc = c & 31, ob = rr * 64 + cc * 2; return st * 1024 + (ob ^ (((ob >> 9) & 1) << 5)); }
__host__ __device__ __forceinline__ void stage_rc(int b, int& R, int& C) { const int st = b / 1024, sb = b % 1024, swz = sb ^ (((sb >> 9) & 1) << 5); R = (st >> 1) * 16 + swz / 64; C = (st & 1) * 32 + (swz % 64) / 2; }
__host__ __device__ __forceinline__ int perm32(int rho) { const int n = rho >> 4, i = rho & 15; return 8 * (i >> 2) + 4 * n + (i & 3); }
struct Unit { int pm, pn; };
struct StaticOrder {
    int nM, nN, nwg, G, c, pm0, nd, qd, wgm;
    __device__ __forceinline__ void init(int nM_, int nN_, int G_, int c_, int pm0_, int wgm_ = WGM) { nM = nM_; nN = nN_; nwg = nM * nN; G = G_; c = c_; pm0 = pm0_; nd = 0; qd = 0; wgm = wgm_; }
    __device__ __forceinline__ void quota(int nd_) { nd = nd_ < G ? nd_ : 0; if (nd_ >= G) return; const int q = (nwg + 5 * nd + G - 1) / G; qd = q > 5 ? q - 5 : 0; }
    __device__ __forceinline__ bool next(int i, Unit& u) const {
        long L;
        if (nd == 0) L = (long)i * G + c;
        else if (c < nd) { if (i >= qd) return false; L = (long)i * G + c; }
        else L = i < qd ? (long)i * G + c : (long)qd * G + (long)(i - qd) * (G - nd) + (c - nd);
        if (L >= nwg) return false;
        int wgid = (int)L; { const int q = nwg / NXCD, r = nwg % NXCD, xcd = wgid % NXCD, off = wgid / NXCD; wgid = (xcd < r ? xcd * (q + 1) : r * (q + 1) + (xcd - r) * q) + off; }
        const int nig = wgm * nN, gid = wgid / nig, fm = gid * wgm, gsz = (nM - fm) < wgm ? (nM - fm) : wgm;
        u.pm = pm0 + fm + ((wgid % nig) % gsz); u.pn = (wgid % nig) / gsz; return true;
    }
};
struct PolPlain {
    const char* A; unsigned lda2; const char* B; unsigned ldb2; int K;
    __device__ __forceinline__ size_t kstepA() const { return 128; }
    __device__ __forceinline__ size_t kstepB() const { return 128; }
    __device__ __forceinline__ unsigned a_off(const Unit& u, int h, int R, int C) const { return (unsigned)(u.pm * BM + h * HALF + R) * lda2 + (unsigned)C * 2u; }
    __device__ __forceinline__ const char* b_ptr(const Unit& u) const { return B + (size_t)u.pn * BM * ldb2; }
};
struct PolMoeUp {
    const char* A; unsigned lda2; const char* B; unsigned ldb2; int K; const int* rowidx; const LAS int* tile_e; size_t estride;
    __device__ __forceinline__ size_t kstepA() const { return 128; }
    __device__ __forceinline__ size_t kstepB() const { return 128; }
    __device__ __forceinline__ unsigned a_off(const Unit& u, int h, int R, int C) const { return (unsigned)rowidx[u.pm * BM + h * HALF + R] * lda2 + (unsigned)C * 2u; }
    __device__ __forceinline__ const char* b_ptr(const Unit& u) const { return B + (size_t)tile_e[u.pm] * estride + (size_t)u.pn * BM * ldb2; }
};
struct PolMoeDown {
    const char* A; unsigned lda2; const char* B; unsigned ldb2; int K; int pmc0; const LAS int* tile_e; size_t estride;
    __device__ __forceinline__ size_t kstepA() const { return (size_t)MCH_ROWS * 128; }
    __device__ __forceinline__ size_t kstepB() const { return (size_t)DM * 128; }
    __device__ __forceinline__ unsigned a_off(const Unit& u, int h, int R, int C) const { return (unsigned)((u.pm - pmc0) * BM + h * HALF + R) * 128u + (unsigned)C * 2u; }
    __device__ __forceinline__ const char* b_ptr(const Unit& u) const { return B + (size_t)tile_e[u.pm] * estride + (size_t)u.pn * BM * 128; }
};
struct PolChunkA {
    const char* A; unsigned lda2; const char* B; unsigned ldb2; int K; int pmc0;
    __device__ __forceinline__ size_t kstepA() const { return (size_t)CHUNK_ROWS * 128; }
    __device__ __forceinline__ size_t kstepB() const { return (size_t)DM * 128; }
    __device__ __forceinline__ unsigned a_off(const Unit& u, int h, int R, int C) const { return (unsigned)((u.pm - pmc0) * BM + h * HALF + R) * 128u + (unsigned)C * 2u; }
    __device__ __forceinline__ const char* b_ptr(const Unit& u) const { return B + (size_t)u.pn * BM * 128; }
};

template <int I8> struct AccT { typedef f32x4 type; };
template <> struct AccT<1> { typedef i32x4 type; };
template <class Epi, class Pol, int I8 = 0>
__device__ __forceinline__ void gemm_phase(LAS unsigned char* lds, const Pol& P, const StaticOrder& S, const Epi& E) {
    typedef typename AccT<I8>::type acc_t;
    int tid_ = threadIdx.x; asm volatile("" : "+v"(tid_));
    const int tid = tid_, wid = __builtin_amdgcn_readfirstlane(tid >> 6), lane = tid & 63, wr = wid >> 2, wc = wid & 3, fr = lane & 15, fq = lane >> 4;
    const int K = P.K, nt = K / BK;
    int sR[2], sC[2]; unsigned voffB[2];
#pragma unroll
    for (int i = 0; i < 2; ++i) { int R, C; stage_rc(tid * 16 + i * 8192, R, C); sR[i] = R; sC[i] = C; const int Rb = (R & ~31) + perm32(R & 31); voffB[i] = (unsigned)Rb * P.ldb2 + (unsigned)C * 2u; }
    const size_t kstepA = P.kstepA(), kstepB = P.kstepB();
    const size_t hstepB = (size_t)HALF * P.ldb2;
    const unsigned ldsw = (unsigned)wid * 1024u;
    const int aoff = lds_byte(wr * 64 + fr, fq * 8), boff = lds_byte(wc * 32 + fr, fq * 8);
#define PG8_SA(b, h) (((b) * 2 + (h)) * HTB)
#define PG8_SB(b, h) ((4 + (b) * 2 + (h)) * HTB)
#define PG8_STAGE(bufoff, gbase, voff) do { _Pragma("unroll") for (int _i = 0; _i < 2; ++_i) \
        __builtin_amdgcn_global_load_lds((const unsigned*)((const char*)(gbase) + (voff)[_i]), (LAS unsigned*)(lds + (bufoff) + ldsw + _i * 8192), 16, 0, 0); } while (0)
#define PG8_LDA(dst, b, h) do { _Pragma("unroll") for (int m = 0; m < 4; ++m) _Pragma("unroll") for (int k = 0; k < 2; ++k) dst[m][k] = *(const LAS bf16x8*)(lds + PG8_SA(b, h) + aoff + m * 2048 + k * 1024); } while (0)
#define PG8_LDB(dst, b, h) do { _Pragma("unroll") for (int n = 0; n < 2; ++n) _Pragma("unroll") for (int k = 0; k < 2; ++k) dst[n][k] = *(const LAS bf16x8*)(lds + PG8_SB(b, h) + boff + n * 2048 + k * 1024); } while (0)
#define PG8_MMA(ai, bj, At, Bt) do { __builtin_amdgcn_s_setprio(1); _Pragma("unroll") for (int m = 0; m < 4; ++m) _Pragma("unroll") for (int n = 0; n < 2; ++n) _Pragma("unroll") for (int k = 0; k < 2; ++k) \
        { if constexpr (I8 == 1) acc[ai][bj][m][n] = __builtin_amdgcn_mfma_i32_16x16x64_i8(__builtin_bit_cast(i32x4, Bt[n][k]), __builtin_bit_cast(i32x4, At[m][k]), acc[ai][bj][m][n], 0, 0, 0); \
          else if constexpr (I8 == 4) { const i64x2 b_ = __builtin_bit_cast(i64x2, Bt[n][k]), a_ = __builtin_bit_cast(i64x2, At[m][k]); \
              acc[ai][bj][m][n] = __builtin_amdgcn_mfma_f32_16x16x32_fp8_fp8(b_[0], a_[0], acc[ai][bj][m][n], 0, 0, 0); acc[ai][bj][m][n] = __builtin_amdgcn_mfma_f32_16x16x32_fp8_fp8(b_[1], a_[1], acc[ai][bj][m][n], 0, 0, 0); } \
          else if constexpr (I8 == 3) acc[ai][bj][m][n] = __builtin_amdgcn_mfma_f32_16x16x32_f16(__builtin_bit_cast(h16x8, Bt[n][k]), __builtin_bit_cast(h16x8, At[m][k]), acc[ai][bj][m][n], 0, 0, 0); \
          else acc[ai][bj][m][n] = __builtin_amdgcn_mfma_f32_16x16x32_bf16(Bt[n][k], At[m][k], acc[ai][bj][m][n], 0, 0, 0); } __builtin_amdgcn_s_setprio(0); } while (0)
#define PG8_WAIT_V(n) asm volatile("s_waitcnt vmcnt(" #n ")" ::: "memory")
#define PG8_WAIT_L(n) asm volatile("s_waitcnt lgkmcnt(" #n ")" ::: "memory")
#define PG8_BAR __builtin_amdgcn_s_barrier()
#define PG8_SCHED __builtin_amdgcn_sched_barrier(0)
    Unit cur, nxt; int ui = 0;
    if (!S.next(0, cur)) return;
    LAS unsigned char* sl_ = lds + RING_BYTES + 4096;
#define PG8_SCALES(u_, slot) do { if constexpr (Epi::LDS_SCALES) { \
        if (wid == 0) __builtin_amdgcn_global_load_lds((const unsigned*)(E.row_src(u_)) + lane * 4, (LAS unsigned*)(sl_ + (slot) * 2048), 16, 0, 0); \
        else if (wid == 1) __builtin_amdgcn_global_load_lds((const unsigned*)(E.col_src(u_)) + lane * 4, (LAS unsigned*)(sl_ + (slot) * 2048 + 1024), 16, 0, 0); } } while (0)
    PG8_SCALES(cur, 0);
    acc_t acc[2][2][4][2];
#pragma unroll
    for (int a = 0; a < 2; ++a)
#pragma unroll
        for (int b = 0; b < 2; ++b)
#pragma unroll
            for (int m = 0; m < 4; ++m)
#pragma unroll
                for (int n = 0; n < 2; ++n) acc[a][b][m][n] = acc_t{};
    bf16x8 At[4][2], B0[2][2], B1[2][2];
    unsigned vC0[2], vC1[2], vN0[2], vN1[2];
#pragma unroll
    for (int i = 0; i < 2; ++i) { vC0[i] = P.a_off(cur, 0, sR[i], sC[i]); vC1[i] = P.a_off(cur, 1, sR[i], sC[i]); }
    const char* Ab = P.A; const char* cB = P.b_ptr(cur);
    PG8_STAGE(PG8_SB(0, 0), cB, voffB); PG8_STAGE(PG8_SB(0, 1), cB + hstepB, voffB); PG8_STAGE(PG8_SA(0, 0), Ab, vC0); PG8_STAGE(PG8_SA(0, 1), Ab, vC1);
    if (wr == 1) PG8_BAR;
    PG8_WAIT_V(2); PG8_BAR;
    PG8_STAGE(PG8_SB(1, 0), cB + kstepB, voffB); PG8_STAGE(PG8_SA(1, 0), Ab + kstepA, vC0); PG8_STAGE(PG8_SB(1, 1), cB + hstepB + kstepB, voffB);
    PG8_WAIT_V(6); PG8_BAR;
    for (;;) {
        const bool has_next = S.next(ui + 1, nxt);
        const char* nB = cB;
#pragma unroll
        for (int i = 0; i < 2; ++i) { vN0[i] = vC0[i]; vN1[i] = vC1[i]; }
        if (has_next) { nB = P.b_ptr(nxt);
#pragma unroll
            for (int i = 0; i < 2; ++i) { vN0[i] = P.a_off(nxt, 0, sR[i], sC[i]); vN1[i] = P.a_off(nxt, 1, sR[i], sC[i]); } }
        int tsc_ = 4; asm volatile("" : "+s"(tsc_));
#pragma unroll 1
        for (int t = 0; t < nt; t += 2) {
            const bool last = (t == nt - 2);
            if (t == tsc_ && has_next) PG8_SCALES(nxt, (ui + 1) & 1);
            const char* a1 = Ab + (size_t)(t + 1) * kstepA;
            const char* a2 = last ? Ab : Ab + (size_t)(t + 2) * kstepA; const char* b2 = last ? nB : cB + (size_t)(t + 2) * kstepB;
            const char* a3 = a2 + kstepA; const char* b3 = b2 + kstepB;
            unsigned v20[2], v21[2];
#pragma unroll
            for (int i = 0; i < 2; ++i) { v20[i] = last ? vN0[i] : vC0[i]; v21[i] = last ? vN1[i] : vC1[i]; }
            PG8_LDB(B0, 0, 0); PG8_LDB(B1, 0, 1); PG8_SCHED; PG8_LDA(At, 0, 0); PG8_STAGE(PG8_SA(1, 1), a1, vC1);
            PG8_WAIT_V(8); PG8_WAIT_L(0); PG8_BAR; PG8_MMA(0, 0, At, B0); PG8_MMA(0, 1, At, B1); PG8_BAR; PG8_SCHED;
            PG8_LDA(At, 0, 1); PG8_STAGE(PG8_SB(0, 0), b2, voffB); PG8_STAGE(PG8_SB(0, 1), b2 + hstepB, voffB); PG8_STAGE(PG8_SA(0, 0), a2, v20);
            PG8_WAIT_V(8); PG8_WAIT_L(0); PG8_BAR; PG8_MMA(1, 0, At, B0); PG8_MMA(1, 1, At, B1); PG8_BAR; PG8_SCHED;
            PG8_LDB(B0, 1, 0); PG8_LDB(B1, 1, 1); PG8_SCHED; PG8_LDA(At, 1, 0); PG8_STAGE(PG8_SA(0, 1), a2, v21);
            PG8_WAIT_V(8); PG8_WAIT_L(0); PG8_BAR; PG8_MMA(0, 0, At, B0); PG8_MMA(0, 1, At, B1); PG8_BAR; PG8_SCHED;
            PG8_LDA(At, 1, 1); PG8_STAGE(PG8_SB(1, 0), b3, voffB); PG8_STAGE(PG8_SB(1, 1), b3 + hstepB, voffB); PG8_STAGE(PG8_SA(1, 0), a3, v20);
            PG8_WAIT_V(8); PG8_WAIT_L(0); PG8_BAR; PG8_MMA(1, 0, At, B0); PG8_MMA(1, 1, At, B1); PG8_BAR; PG8_SCHED;
        }
        if (wr == 0) PG8_BAR;
        E(acc, cur, wr, wc, fr, fq, (const LAS unsigned char*)(sl_ + (ui & 1) * 2048));
        if (!has_next) break;
#pragma unroll
        for (int a = 0; a < 2; ++a)
#pragma unroll
            for (int b = 0; b < 2; ++b)
#pragma unroll
                for (int m = 0; m < 4; ++m)
#pragma unroll
                    for (int n = 0; n < 2; ++n) acc[a][b][m][n] = acc_t{};
        cur = nxt; cB = nB; ++ui;
#pragma unroll
        for (int i = 0; i < 2; ++i) { vC0[i] = vN0[i]; vC1[i] = vN1[i]; }
        if (wr == 1) PG8_BAR;
    }
    PG8_WAIT_V(0);
    PG8_BAR;
#undef PG8_SA
#undef PG8_SB
#undef PG8_STAGE
#undef PG8_SCALES
#undef PG8_LDA
#undef PG8_LDB
#undef PG8_MMA
#undef PG8_WAIT_V
#undef PG8_WAIT_L
#undef PG8_BAR
#undef PG8_SCHED
}

__device__ __forceinline__ float row_rstd(const float* ssq, int row, int nparts, float inv_n) {
    const f32x4* p = (const f32x4*)(ssq + (size_t)row * nparts); f32x4 s = p[0];
    for (int i = 1; i < nparts / 4; ++i) s += p[i];
    return __builtin_amdgcn_rsqf(((s[0] + s[1]) + (s[2] + s[3])) * inv_n + EPS);
}
template <int NP>
__device__ __forceinline__ void wave_row_rstd(const float* ssq, float inv_n, int rowbase, int wr, int wid, int fr, LAS float* xl, float (&rs)[8]) {
    const int lane = threadIdx.x & 63; LAS float* wl = xl + wid * 128;
    f32x4 sa = (f32x4){0.f, 0.f, 0.f, 0.f}, sb = sa;
    const f32x4* pa = (const f32x4*)(ssq + (size_t)(rowbase + wr * 64 + lane) * NP); const f32x4* pb = (const f32x4*)(ssq + (size_t)(rowbase + HALF + wr * 64 + lane) * NP);
#pragma unroll
    for (int i = 0; i < NP / 4; ++i) { sa += pa[i]; sb += pb[i]; }
    wl[lane] = __builtin_amdgcn_rsqf(((sa[0] + sa[1]) + (sa[2] + sa[3])) * inv_n + EPS);
    wl[64 + lane] = __builtin_amdgcn_rsqf(((sb[0] + sb[1]) + (sb[2] + sb[3])) * inv_n + EPS);
    asm volatile("s_waitcnt lgkmcnt(0)" ::: "memory");
#pragma unroll
    for (int ai = 0; ai < 2; ++ai)
#pragma unroll
        for (int m = 0; m < 4; ++m) rs[ai * 4 + m] = wl[ai * 64 + 16 * m + fr];
    asm volatile("s_waitcnt lgkmcnt(0)" ::: "memory");
}
__device__ __forceinline__ void rope8(f32x4& v0, f32x4& v1, const float* tab  ) {
    const f32x4 t0 = *(const f32x4*)tab, t1 = *(const f32x4*)(tab + 4);
    f32x4 a = v0, b = v1;
    v0[0] = a[0] * t0[0] - a[1] * t0[1]; v0[1] = a[1] * t0[0] + a[0] * t0[1]; v0[2] = a[2] * t0[2] - a[3] * t0[3]; v0[3] = a[3] * t0[2] + a[2] * t0[3];
    v1[0] = b[0] * t1[0] - b[1] * t1[1]; v1[1] = b[1] * t1[0] + b[0] * t1[1]; v1[2] = b[2] * t1[2] - b[3] * t1[3]; v1[3] = b[3] * t1[2] + b[2] * t1[3];
}
__device__ __forceinline__ u32x4 pack8(f32x4 v0, f32x4 v1) { u32x4 w; w.x = cvt_pk_bf16(v0[0], v0[1]); w.y = cvt_pk_bf16(v0[2], v0[3]); w.z = cvt_pk_bf16(v1[0], v1[1]); w.w = cvt_pk_bf16(v1[2], v1[3]); return w; }
__device__ __forceinline__ float sq8(f32x4 v0, f32x4 v1) { return (v0[0] * v0[0] + v0[1] * v0[1]) + (v0[2] * v0[2] + v0[3] * v0[3]) + (v1[0] * v1[0] + v1[1] * v1[1]) + (v1[2] * v1[2] + v1[3] * v1[3]); }

__device__ __forceinline__ f32x4 acc_f(const f32x4& a) { return a; }
__device__ __forceinline__ f32x4 acc_f(const i32x4& a) { return __builtin_convertvector(a, f32x4); }
template <int MODE, int NP> struct EpiStore {
    bf16_t* O; int ldc; const float* ssq; LAS float* xl; float inv_n;
    const float* rope; float* ssq_q; float* ssq_kv;
    bf16_t* O2; const bf16_t* Zsrc; float* Flog;
    const float* rowf; const unsigned* cmax;
    static constexpr bool LDS_SCALES = (MODE == 1 || MODE == 4);
    __device__ __forceinline__ const float* row_src(const Unit& u) const { return rowf + u.pm * BM; }
    __device__ __forceinline__ const unsigned* col_src(const Unit& u) const { return cmax + u.pn * BM; }
    template <class ACC>
    __device__ __forceinline__ void operator()(const ACC (&acc)[2][2][4][2], const Unit& u, int wr, int wc, int fr, int fq, const LAS unsigned char* lsc) const {
        const int row0 = u.pm * BM + wr * 64 + fr;
        float rs8[8];
        const LAS unsigned* cp = (const LAS unsigned*)(lsc + 1024) + wc * 32 + 8 * fq; const LAS float* rp = (const LAS float*)lsc + wr * 64 + fr;
        if (!LDS_SCALES) wave_row_rstd<NP>(ssq, inv_n, u.pm * BM, wr, wr * 4 + wc, fr, xl, rs8);
#pragma unroll
        for (int ai = 0; ai < 2; ++ai)
#pragma unroll
            for (int m = 0; m < 4; ++m) {
                const int row = row0 + ai * HALF + m * 16;
                const float rs = LDS_SCALES ? rp[ai * HALF + m * 16] * (1.f / 127.f) : rs8[ai * 4 + m];
                float sq = 0.f;
#pragma unroll
                for (int bj = 0; bj < 2; ++bj) {
                    const int col = u.pn * BM + bj * HALF + wc * 32 + 8 * fq;
                    f32x4 v0 = acc_f(acc[ai][bj][m][0]) * rs, v1 = acc_f(acc[ai][bj][m][1]) * rs;
                    if (LDS_SCALES) { const u32x4 c0 = *(const LAS u32x4*)(cp + bj * HALF), c1 = *(const LAS u32x4*)(cp + bj * HALF + 4);
                        v0 *= (f32x4){__uint_as_float(c0.x), __uint_as_float(c0.y), __uint_as_float(c0.z), __uint_as_float(c0.w)};
                        v1 *= (f32x4){__uint_as_float(c1.x), __uint_as_float(c1.y), __uint_as_float(c1.z), __uint_as_float(c1.w)}; }
                    if (MODE == 1) { if (col >= 1280 && col < 1344) rope8(v0, v1, rope + (size_t)row * 64 + (col - 1280)); sq += sq8(v0, v1); }
                    if (MODE == 2) { const int w = col % 192; if (w >= 128) rope8(v0, v1, rope + (size_t)row * 64 + (w - 128)); }
                    if (MODE == 3) {
                        if (bj == 0) *(u32x4*)(O + (size_t)row * KM_LD + u.pn * 192 + wc * 32 + 8 * fq) = pack8(v0, v1);
                        else *(u32x4*)(O2 + (size_t)row * VM_LD + u.pn * 128 + wc * 32 + 8 * fq) = pack8(v0, v1);
                    } else if (MODE == 4) {
                        if (u.pn < 24) *(u32x4*)(O + (size_t)row * ldc + col) = pack8(v0, v1);
                        else if (bj == 0 && wc == 0 && fq < 2) { *(f32x4*)(Flog + (size_t)row * 16 + 8 * fq) = v0; *(f32x4*)(Flog + (size_t)row * 16 + 8 * fq + 4) = v1; }
                    } else *(u32x4*)(O + (size_t)row * ldc + col) = pack8(v0, v1);
                }
                if (MODE == 1 && u.pn < 5) {
                    sq += __shfl_xor(sq, 16); sq += __shfl_xor(sq, 32);
                    if (fq == 0) { if (u.pn < 3) ssq_q[(size_t)row * 12 + u.pn * 4 + wc] = sq; else ssq_kv[(size_t)row * 8 + (u.pn - 3) * 4 + wc] = sq; }
                }
                asm volatile("" ::: "memory");
            }
        if (MODE == 3) {
            const int tid = (wr * 4 + wc) * 64 + fq * 16 + fr;
#pragma unroll
            for (int i = 0; i < 4; ++i) { const int idx = tid + 512 * i, r = idx >> 3, c = idx & 7; const size_t row = (size_t)u.pm * BM + r;
                *(u32x4*)(O + row * KM_LD + u.pn * 192 + 128 + c * 8) = *(const u32x4*)(Zsrc + row * Z0_LD + 1280 + c * 8); }
        }
    }
};
template <bool BF32> struct EpiRes {
    const void* base; unsigned short* out; float* ssq; float sc = 1.f;
    static constexpr bool LDS_SCALES = false;
    __device__ __forceinline__ void operator()(const f32x4 (&acc)[2][2][4][2], const Unit& u, int wr, int wc, int fr, int fq, const LAS unsigned char*) const {
        const int row0 = u.pm * BM + wr * 64 + fr; const int colb = u.pn * BM + wc * 32 + 8 * fq;
        f32x4 bA[2][2], bB[2][2];
#define ER_LOAD(dst, i) do { const size_t off_ = (size_t)(row0 + ((i) >> 2) * HALF + ((i) & 3) * 16) * DM + colb; \
        _Pragma("unroll") for (int bj = 0; bj < 2; ++bj) { \
            if constexpr (BF32) { dst[bj][0] = *(const f32x4*)((const float*)base + off_ + bj * HALF); dst[bj][1] = *(const f32x4*)((const float*)base + off_ + bj * HALF + 4); } \
            else { const u32x4 h_ = *(const u32x4*)((const unsigned short*)base + off_ + bj * HALF); dst[bj][0] = unpk_f16x4((u32x2){h_.x, h_.y}); dst[bj][1] = unpk_f16x4((u32x2){h_.z, h_.w}); } } } while (0)
#define ER_DO(src, i) do { const int ai = (i) >> 2, m = (i) & 3; const int row = row0 + ai * HALF + m * 16; float sq = 0.f; \
        _Pragma("unroll") for (int bj = 0; bj < 2; ++bj) { const size_t off = (size_t)row * DM + colb + bj * HALF; \
            const f32x4 v0 = acc[ai][bj][m][0] * sc + src[bj][0], v1 = acc[ai][bj][m][1] * sc + src[bj][1]; \
            u32x4 w_; w_.x = pk_f16(v0[0], v0[1]); w_.y = pk_f16(v0[2], v0[3]); w_.z = pk_f16(v1[0], v1[1]); w_.w = pk_f16(v1[2], v1[3]); \
            *(u32x4*)(out + off) = w_; sq += sq8(v0, v1); } \
        if (ssq) { sq += __shfl_xor(sq, 16); sq += __shfl_xor(sq, 32); if (fq == 0) ssq[(size_t)row * 32 + u.pn * 4 + wc] = sq; } } while (0)
        ER_LOAD(bA, 0); asm volatile("" ::: "memory");
#pragma unroll
        for (int i = 0; i < 8; i += 2) {
            ER_LOAD(bB, i + 1); asm volatile("" ::: "memory");
            ER_DO(bA, i); asm volatile("" ::: "memory");
            if (i + 2 < 8) { ER_LOAD(bA, i + 2); asm volatile("" ::: "memory"); }
            ER_DO(bB, i + 1); asm volatile("" ::: "memory");
        }
#undef ER_LOAD
#undef ER_DO
    }
};
template <int RS> struct EpiSwiGLU {
    bf16_t* H; int row_base; const float* ssq; const float* rsp; const unsigned* cmax; const LAS int* tile_e; int f8 = 0;
    static constexpr bool LDS_SCALES = (RS == 2);
    __device__ __forceinline__ const float* row_src(const Unit& u) const { return rsp + u.pm * BM; }
    __device__ __forceinline__ const unsigned* col_src(const Unit& u) const { return cmax + (size_t)(tile_e ? tile_e[u.pm] : 0) * (2 * DFF) + u.pn * BM; }
    template <class ACC>
    __device__ __forceinline__ void operator()(const ACC (&acc)[2][2][4][2], const Unit& u, int wr, int wc, int fr, int fq, const LAS unsigned char* lsc) const {
        const int row0 = u.pm * BM + wr * 64 + fr;
        f32x4 sg[2], su[2];
        if (RS == 2) { const LAS unsigned* cp = (const LAS unsigned*)(lsc + 1024) + wc * 32 + 8 * fq;
#pragma unroll
            for (int n = 0; n < 2; ++n) { const u32x4 a = *(const LAS u32x4*)(cp + 4 * n), b = *(const LAS u32x4*)(cp + HALF + 4 * n);
#pragma unroll
                for (int j = 0; j < 4; ++j) { sg[n][j] = __uint_as_float(a[j]) * (1.f / 127.f); su[n][j] = __uint_as_float(b[j]) * (1.f / 127.f); } } }
        float rs8[8];
#pragma unroll
        for (int i = 0; i < 8; ++i) { const int row = row0 + (i >> 2) * HALF + (i & 3) * 16;
            if (RS == 2) rs8[i] = ((const LAS float*)lsc)[wr * 64 + fr + (i >> 2) * HALF + (i & 3) * 16]; else rs8[i] = RS == 0 ? row_rstd(ssq, row, 32, 1.f / DM) : rsp[row]; }
#pragma unroll
        for (int ai = 0; ai < 2; ++ai)
#pragma unroll
            for (int m = 0; m < 4; ++m) {
                const int row = row0 + ai * HALF + m * 16;
                const float rs = rs8[ai * 4 + m];
                f32x4 o[2];
#pragma unroll
                for (int n = 0; n < 2; ++n) { f32x4 g = acc_f(acc[ai][0][m][n]) * rs, up = acc_f(acc[ai][1][m][n]) * rs;
                    if (RS == 2) { g *= sg[n]; up *= su[n]; }
#pragma unroll
                    for (int j = 0; j < 4; ++j) o[n][j] = g[j] * __builtin_amdgcn_rcpf(1.f + __builtin_amdgcn_exp2f(-LOG2E * g[j])) * up[j]; }
                if (RS == 2 && f8) {
                    _Pragma("unroll") for (int n = 0; n < 2; ++n) _Pragma("unroll") for (int j = 0; j < 4; ++j) o[n][j] = __builtin_amdgcn_fmed3f(o[n][j], -448.f, 448.f);
                    *(u32x2*)((unsigned char*)H + ((size_t)u.pn * MCH_ROWS + (row - row_base)) * 128 + wc * 32 + 8 * fq) = pack8_fp8(o[0], o[1]);
                } else
                *(u32x4*)(H + ((size_t)(u.pn * 2 + (wc >> 1)) * CHUNK_ROWS + (row - row_base)) * 64 + (wc & 1) * 32 + 8 * fq) = pack8(o[0], o[1]);
                asm volatile("" ::: "memory");
            }
    }
};
struct EpiMoeDown {
    bf16_t* Y; const float* gate;
    static constexpr bool LDS_SCALES = false;
    __device__ __forceinline__ void operator()(const f32x4 (&acc)[2][2][4][2], const Unit& u, int wr, int wc, int fr, int fq, const LAS unsigned char*) const {
        const int row0 = u.pm * BM + wr * 64 + fr;
        float g8[8];
#pragma unroll
        for (int i = 0; i < 8; ++i) g8[i] = gate[row0 + (i >> 2) * HALF + (i & 3) * 16] * (1.f / 64.f);
#pragma unroll
        for (int ai = 0; ai < 2; ++ai)
#pragma unroll
            for (int m = 0; m < 4; ++m) {
                const int row = row0 + ai * HALF + m * 16; const float g = g8[ai * 4 + m];
#pragma unroll
                for (int bj = 0; bj < 2; ++bj) *(u32x4*)(Y + (size_t)row * DM + u.pn * BM + bj * HALF + wc * 32 + 8 * fq) = pack8(acc[ai][bj][m][0] * g, acc[ai][bj][m][1] * g);
                asm volatile("" ::: "memory");
            }
    }
};
}

namespace fa {
#define SBAR() __builtin_amdgcn_sched_barrier(0)
template <int NDV> __device__ __forceinline__ int v_st(int k, int c) { const int kk = (k & ~0xC) | ((k & 4) << 1) | ((k & 8) >> 1); return ((kk >> 3) * NDV + (c >> 5)) * 512 + ((kk & 7) * 32 + (c & 31)) * 2; }
__device__ __forceinline__ int v_rd_base(int lane) { return ((lane & 3) << 3) | (((lane >> 2) & 3) << 6) | (((lane >> 4) & 1) << 5) | (((lane >> 5) & 1) << 8); }
__device__ __forceinline__ int crow(int r, int hi) { return (r & 3) + 8 * (r >> 2) + 4 * hi; }
__device__ __forceinline__ void mask_tile(f32x16& p0, f32x16& p1, int dq, unsigned W) {
    const float NEG = -__builtin_inff();
#pragma unroll
    for (int r = 0; r < 16; ++r) {
        const int c = (r & 3) + 8 * (r >> 2);
        if ((unsigned)(dq - c) >= W) p0[r] = NEG;
        if ((unsigned)(dq - c - 32) >= W) p1[r] = NEG;
    }
}
struct AttnArgs {
    const bf16_t* Q; int ldq; const bf16_t* K; int ldk; const bf16_t* V; int ldv; bf16_t* O; int ldo;
    int q0, j_lo, j_hi, W;
    const float* dec;
    float sinkl; const float* biasT;
    const float* sinks;
    float kmax;
};
template <int DK, int DV, int MODE>
__device__ __forceinline__ void attn_unit(const AttnArgs& a, LAS char* lds) {
    constexpr int KROWB = DK * 2 + 16  , SHM_K = 64 * KROWB, SHM_V = 64 * DV * 2, NDK = DK / 16, NDV = DV / 32, KCH = DK / 8, VCH = DV / 8, KPT = KCH * 64 / 512, VPT = VCH * 64 / 512;
    constexpr int RB = NDV * 512;
    constexpr float THR = 8.f;
    int tid_ = threadIdx.x; asm volatile("" : "+v"(tid_));
    const int tid = tid_, wid = __builtin_amdgcn_readfirstlane(tid >> 6), lane = tid & 63, r32 = lane & 31, hi = lane >> 5;
    LAS char* V_lds = lds; LAS char* K_lds = lds + 2 * SHM_V;
    LAS float* dec_l = (LAS float*)(K_lds + 2 * SHM_K);
    LAS float* ws = dec_l + 128 + wid * 64;
    LAS float* bias_l = dec_l + 128 + 512 + ((MODE == 2) ? wid * 128 : 0);
    const int NT = a.j_hi - a.j_lo;
    const int qlo = (MODE == 2) ? a.q0 : a.q0 + wid * 32, qpos = qlo + r32;
    const int hoff = (MODE == 2) ? wid * 64 : 0;
    static_assert(KPT == KCH / 8 && VPT == VCH / 8, "staging map");
    const int srow_ = tid >> 3, scg_ = tid & 7;
    const int kws0 = srow_ * KROWB + scg_ * 16, vws0 = v_st<NDV>(srow_, scg_ * 8);
    const unsigned ksrc0 = (unsigned)(srow_ * a.ldk + scg_ * 8) * 2u, vsrc0 = (unsigned)(srow_ * a.ldv + scg_ * 8) * 2u;
    bf16x8 qr[NDK];
#pragma unroll
    for (int d0 = 0; d0 < NDK; ++d0) qr[d0] = *(const bf16x8*)(a.Q + (size_t)qpos * a.ldq + hoff + d0 * 16 + hi * 8);
    __builtin_amdgcn_s_waitcnt(0x0F70);
    float m_reg = -1e30f, l_reg = 0.f;
    if (MODE == 2) { m_reg = a.sinks[wid] * LOG2E; l_reg = 1.f; }
    f32x16 o[NDV];
#pragma unroll
    for (int d = 0; d < NDV; ++d) o[d] = f32x16{};
    float clq = 0.f; if (MODE == 1) clq = a.dec[(size_t)qpos * 16];
    if (MODE == 2) { (dec_l + 128 + 512)[tid] = a.biasT[tid]; (dec_l + 128 + 512)[tid + 512] = a.biasT[tid + 512]; }
    const int vb0 = (int)(uintptr_t)V_lds + v_rd_base(lane);
    const int kq = r32 * KROWB;
    bf16x8 sk[2][KPT], sv[2][VPT]; float sdec[2] = {0.f, 0.f};
    if (wid >= 4) __builtin_amdgcn_s_setprio(1);
#define FA_LOADT(j, S_) do { const size_t kb_ = (size_t)(j) * 64; const char* kt_ = (const char*)(a.K + kb_ * a.ldk); const char* vt_ = (const char*)(a.V + kb_ * a.ldv); \
        _Pragma("unroll") for (int i = 0; i < KPT; ++i) sk[S_][i] = *(const bf16x8*)(kt_ + ksrc0 + i * 128); \
        _Pragma("unroll") for (int i = 0; i < VPT; ++i) sv[S_][i] = *(const bf16x8*)(vt_ + vsrc0 + i * 128); \
        if (MODE == 1) { if (tid < 64) sdec[S_] = a.dec[(kb_ + tid) * 16]; } } while (0)
#define FA_WRITET(bf, S_) do { \
        _Pragma("unroll") for (int i = 0; i < KPT; ++i) *(LAS bf16x8*)(K_lds + (bf) * SHM_K + kws0 + i * 128) = sk[S_][i]; \
        _Pragma("unroll") for (int i = 0; i < VPT; ++i) *(LAS bf16x8*)(V_lds + (bf) * SHM_V + vws0 + i * 1024) = sv[S_][i]; \
        if (MODE == 1) { if (tid < 64) dec_l[(bf) * 64 + tid] = sdec[S_]; } } while (0)
#define FA_TR(dst, off) asm volatile("ds_read_b64_tr_b16 %0, %1 offset:%2" : "=&v"(dst) : "v"(vb0), "i"(off) : "memory")
#define FA_VRD(S, BUF, d0) do { constexpr int b_ = (BUF) * SHM_V + (d0) * 512; \
        FA_TR(S##l[0], b_); FA_TR(S##h[0], b_ + RB); FA_TR(S##l[1], b_ + 2 * RB); FA_TR(S##h[1], b_ + 3 * RB); FA_TR(S##l[2], b_ + 4 * RB); FA_TR(S##h[2], b_ + 5 * RB); FA_TR(S##l[3], b_ + 6 * RB); FA_TR(S##h[3], b_ + 7 * RB); } while (0)
#define FA_VMM(S, d0) do { \
        o[d0] = __builtin_amdgcn_mfma_f32_32x32x16_bf16(pa0, (bf16x8){S##l[0][0], S##l[0][1], S##l[0][2], S##l[0][3], S##h[0][0], S##h[0][1], S##h[0][2], S##h[0][3]}, o[d0], 0, 0, 0); \
        o[d0] = __builtin_amdgcn_mfma_f32_32x32x16_bf16(pa1, (bf16x8){S##l[1][0], S##l[1][1], S##l[1][2], S##l[1][3], S##h[1][0], S##h[1][1], S##h[1][2], S##h[1][3]}, o[d0], 0, 0, 0); \
        o[d0] = __builtin_amdgcn_mfma_f32_32x32x16_bf16(pa2, (bf16x8){S##l[2][0], S##l[2][1], S##l[2][2], S##l[2][3], S##h[2][0], S##h[2][1], S##h[2][2], S##h[2][3]}, o[d0], 0, 0, 0); \
        o[d0] = __builtin_amdgcn_mfma_f32_32x32x16_bf16(pa3, (bf16x8){S##l[3][0], S##l[3][1], S##l[3][2], S##l[3][3], S##h[3][0], S##h[3][1], S##h[3][2], S##h[3][3]}, o[d0], 0, 0, 0); } while (0)
#define FA_LW(n) do { asm volatile("s_waitcnt lgkmcnt(" #n ")" ::: "memory"); SBAR(); } while (0)
#define FA_PVALL(BUF) do { s16x4 Al[4], Ah[4], Bl[4], Bh[4]; \
        FA_VRD(A, BUF, 0); FA_VRD(B, BUF, 1); FA_LW(8); FA_VMM(A, 0); \
        if constexpr (NDV == 4) { FA_VRD(A, BUF, 2); FA_LW(8); FA_VMM(B, 1); FA_VRD(B, BUF, 3); FA_LW(8); FA_VMM(A, 2); FA_LW(0); FA_VMM(B, 3); } \
        else { FA_LW(0); FA_VMM(B, 1); } } while (0)
#define FA_PK4(P, B_, OUT) do { unsigned a0 = cvt_pk_bf16(P[B_ + 0], P[B_ + 1]), a1 = cvt_pk_bf16(P[B_ + 2], P[B_ + 3]); \
        unsigned b0 = cvt_pk_bf16(P[B_ + 4], P[B_ + 5]), b1 = cvt_pk_bf16(P[B_ + 6], P[B_ + 7]); \
        auto r0 = __builtin_amdgcn_permlane32_swap(a0, b0, false, false); auto r1 = __builtin_amdgcn_permlane32_swap(a1, b1, false, false); \
        u32x4 w = {r0[0], r1[0], r0[1], r1[1]}; OUT = *reinterpret_cast<bf16x8*>(&w); } while (0)
#define FA_COMPUTE(BUF, kb) do { \
            f32x16 p0, p1; \
            if (MODE == 1) { _Pragma("unroll") for (int r = 0; r < 16; ++r) { p0[r] = clq - dec_l[(BUF) * 64 + crow(r, hi)]; p1[r] = clq - dec_l[(BUF) * 64 + 32 + crow(r, hi)]; } } \
            else { p0 = f32x16{}; p1 = f32x16{}; } \
            { const LAS char* kbp[4];     \
              kbp[0] = K_lds + (BUF) * SHM_K + kq + hi * 16; \
              bf16x8 ka0 = *(const LAS bf16x8*)kbp[0], ka1 = *(const LAS bf16x8*)(kbp[0] + 32 * KROWB), kb0, kb1; SBAR(); \
              _Pragma("unroll") for (int d0 = 0; d0 < NDK; d0 += 2) { \
                  { const LAS char* ap = kbp[0] + (d0 + 1) * 32; kb0 = *(const LAS bf16x8*)ap; kb1 = *(const LAS bf16x8*)(ap + 32 * KROWB); } SBAR(); \
                  p0 = __builtin_amdgcn_mfma_f32_32x32x16_bf16(ka0, qr[d0], p0, 0, 0, 0); p1 = __builtin_amdgcn_mfma_f32_32x32x16_bf16(ka1, qr[d0], p1, 0, 0, 0); SBAR(); \
                  if (d0 + 2 < NDK) { const LAS char* ap = kbp[0] + (d0 + 2) * 32; ka0 = *(const LAS bf16x8*)ap; ka1 = *(const LAS bf16x8*)(ap + 32 * KROWB); } SBAR(); \
                  p0 = __builtin_amdgcn_mfma_f32_32x32x16_bf16(kb0, qr[d0 + 1], p0, 0, 0, 0); p1 = __builtin_amdgcn_mfma_f32_32x32x16_bf16(kb1, qr[d0 + 1], p1, 0, 0, 0); SBAR(); } } \
            if (MODE == 2) { const int dq0 = qpos - (kb) - 4 * hi; \
                _Pragma("unroll") for (int r = 0; r < 16; ++r) { const int c = (r & 3) + 8 * (r >> 2); int i0 = dq0 - c, i1 = dq0 - c - 32; \
                    i0 = i0 < 0 ? 0 : (i0 > 127 ? 127 : i0); i1 = i1 < 0 ? 0 : (i1 > 127 ? 127 : i1); p0[r] += bias_l[i0]; p1[r] += bias_l[i1]; } } \
            if (MODE != 3) { if ((kb) + 63 > qlo || (kb) <= qlo + 31 - a.W) mask_tile(p0, p1, qpos - (kb) - 4 * hi, (unsigned)a.W); } \
            float pmax = p0[0]; \
            _Pragma("unroll") for (int r = 1; r < 16; ++r) pmax = fmaxf(pmax, p0[r]); \
            _Pragma("unroll") for (int r = 0; r < 16; ++r) pmax = fmaxf(pmax, p1[r]); \
            { auto rr = __builtin_amdgcn_permlane32_swap(__float_as_uint(pmax), __float_as_uint(pmax), false, false); pmax = fmaxf(__uint_as_float(rr[0]), __uint_as_float(rr[1])); } \
            float mn, alpha; \
            if (__builtin_expect(__all((pmax - m_reg) <= THR), 1)) { mn = m_reg; alpha = 1.f; } \
            else { mn = fmaxf(m_reg, pmax); alpha = __builtin_amdgcn_exp2f(m_reg - mn); m_reg = mn; } \
            _Pragma("unroll") for (int r = 0; r < 16; ++r) { p0[r] = __builtin_amdgcn_exp2f(p0[r] - mn); p1[r] = __builtin_amdgcn_exp2f(p1[r] - mn); } \
            float ps = 0.f; \
            _Pragma("unroll") for (int r = 0; r < 16; ++r) ps += p0[r]; \
            _Pragma("unroll") for (int r = 0; r < 16; ++r) ps += p1[r]; \
            { auto rr = __builtin_amdgcn_permlane32_swap(__float_as_uint(ps), __float_as_uint(ps), false, false); ps = __uint_as_float(rr[0]) + __uint_as_float(rr[1]); } \
            l_reg = l_reg * alpha + ps; \
            if (__any(alpha < 1.f)) { if (hi == 0) ws[32 + r32] = alpha; asm volatile("s_waitcnt lgkmcnt(0)" ::: "memory"); \
                _Pragma("unroll") for (int d_ = 0; d_ < NDV; ++d_) _Pragma("unroll") for (int r = 0; r < 16; ++r) o[d_][r] *= ws[32 + crow(r, hi)]; } \
            bf16x8 pa0, pa1, pa2, pa3; \
            FA_PK4(p0, 0, pa0); FA_PK4(p0, 8, pa1); FA_PK4(p1, 0, pa2); FA_PK4(p1, 8, pa3); SBAR(); \
            FA_PVALL(BUF); \
        } while (0)
    if constexpr (MODE != 1) {
#define FA_TILE(t, BUF) do { \
        const int kb = (a.j_lo + (t)) * 64; \
        bool act = true; if (MODE != 3) act = (kb <= qlo + 31) && (kb + 63 >= qlo - a.W + 1); \
        if ((t) + 2 < NT) FA_LOADT(a.j_lo + (t) + 2, BUF);              \
        if (act) FA_COMPUTE(BUF, kb); \
        if ((t) + 1 < NT) FA_WRITET((BUF) ^ 1, (BUF) ^ 1);              \
        __syncthreads(); } while (0)
        FA_LOADT(a.j_lo, 0); FA_WRITET(0, 0); if (NT > 1) FA_LOADT(a.j_lo + 1, 1); __syncthreads();
        for (int t = 0; t < NT; t += 2) {
            FA_TILE(t, 0);
            if (t + 1 < NT) FA_TILE(t + 1, 1);
        }
#undef FA_TILE
    } else {
        constexpr float TEXIT = 28.f;
        float qn2 = 0.f;
#pragma unroll
        for (int d0 = 0; d0 < NDK; ++d0)
#pragma unroll
            for (int e = 0; e < 8; ++e) { const float f = bf2f((unsigned short)qr[d0][e]); qn2 += f * f; }
        { auto rr = __builtin_amdgcn_permlane32_swap(__float_as_uint(qn2), __float_as_uint(qn2), false, false); qn2 = __uint_as_float(rr[0]) + __uint_as_float(rr[1]); }
#pragma unroll
        for (int o_ = 1; o_ < 32; o_ <<= 1) qn2 = fmaxf(qn2, __shfl_xor(qn2, o_));
        const float ubase = sqrtf(qn2) * a.kmax * 1.0001f + __shfl(clq, 0);
        LAS int* flags = (LAS int*)(dec_l + 128 + 512 + 128);
        bool wdone = false, stop = false;
#define FA_TILE_R(t, BUF) do { \
        const int kb = (a.j_lo + (t)) * 64; const bool more = (t) > 0; \
        const bool act = !wdone && (kb <= qlo + 31); \
        if ((t) > 1) FA_LOADT(a.j_lo + (t) - 2, BUF); \
        if (act) { FA_COMPUTE(BUF, kb); \
            float mm = m_reg; \
            _Pragma("unroll") for (int o_ = 1; o_ < 32; o_ <<= 1) mm = fminf(mm, __shfl_xor(mm, o_)); \
            wdone = __builtin_amdgcn_readfirstlane((int)((ubase - dec_l[(BUF) * 64]) < (mm - TEXIT))) != 0; } \
        if (more) FA_WRITET((BUF) ^ 1, (BUF) ^ 1); \
        if (lane == 0) flags[(BUF) * 8 + wid] = wdone ? 1 : 0; \
        __syncthreads(); \
        { int all_ = 1; _Pragma("unroll") for (int w_ = 0; w_ < 8; ++w_) all_ &= flags[(BUF) * 8 + w_]; stop = !more || (all_ != 0); } } while (0)
        FA_LOADT(a.j_lo + NT - 1, 0); FA_WRITET(0, 0); if (NT > 1) FA_LOADT(a.j_lo + NT - 2, 1); __syncthreads();
        for (int t = NT - 1;;) {
            FA_TILE_R(t, 0); if (stop) break; --t;
            FA_TILE_R(t, 1); if (stop) break; --t;
        }
#undef FA_TILE_R
    }
    __builtin_amdgcn_s_setprio(0);
    if (hi == 0) ws[r32] = l_reg; asm volatile("s_waitcnt lgkmcnt(0)" ::: "memory");
    float rli[16];
#pragma unroll
    for (int r = 0; r < 16; ++r) rli[r] = __builtin_amdgcn_rcpf(ws[crow(r, hi)]);
    bf16_t* Ow = a.O + (size_t)qlo * a.ldo + hoff;
#pragma unroll
    for (int r = 0; r < 16; ++r) { const int orow = crow(r, hi);
#pragma unroll
        for (int d0 = 0; d0 < NDV; ++d0) { const float v = o[d0][r] * rli[r]; const float vn = __shfl_xor(v, 1);
            if ((r32 & 1) == 0) *(unsigned*)(Ow + (size_t)orow * a.ldo + d0 * 32 + r32) = cvt_pk_bf16(v, vn); } }
    __syncthreads();
#undef FA_LOADT
#undef FA_WRITET
#undef FA_TR
#undef FA_VRD
#undef FA_VMM
#undef FA_LW
#undef FA_PVALL
#undef FA_PK4
#undef FA_COMPUTE
}
#undef SBAR
}

struct Args { const void* in[N_IN]; float* out; unsigned char* ws; int ph_lo, ph_hi; };

__device__ const float ROPE_INV[32] = {
    1.000000000e+00f, 7.498942614e-01f, 5.623413324e-01f, 4.216965139e-01f, 3.162277639e-01f, 2.371373773e-01f, 1.778279394e-01f, 1.333521307e-01f,
    1.000000015e-01f, 7.498941571e-02f, 5.623413250e-02f, 4.216965288e-02f, 3.162277490e-02f, 2.371373773e-02f, 1.778279431e-02f, 1.333521493e-02f,
    9.999999776e-03f, 7.498941850e-03f, 5.623413250e-03f, 4.216964822e-03f, 3.162277630e-03f, 2.371373586e-03f, 1.778279431e-03f, 1.333521446e-03f,
    1.000000047e-03f, 7.498942432e-04f, 5.623413017e-04f, 4.216965172e-04f, 3.162277571e-04f, 2.371373703e-04f, 1.778279402e-04f, 1.333521504e-04f };
__device__ const unsigned char T5_BUCKET[128] = {
    0, 1, 2, 3, 4, 5, 6, 7, 8, 9, 10, 11, 12, 13, 14, 15, 16, 16, 16, 17, 17, 18, 18, 18, 19, 19, 19, 20, 20, 20, 20, 21, 21, 21, 21, 22, 22, 22, 22, 22, 23, 23, 23, 23, 23, 23, 24, 24, 24, 24, 24, 24,
    25, 25, 25, 25, 25, 25, 25, 26, 26, 26, 26, 26, 26, 26, 26, 27, 27, 27, 27, 27, 27, 27, 27, 27, 27, 28, 28, 28, 28, 28, 28, 28, 28, 28, 28, 29, 29, 29, 29, 29, 29, 29, 29, 29, 29, 29, 29,
    30, 30, 30, 30, 30, 30, 30, 30, 30, 30, 30, 30, 30, 30, 31, 31, 31, 31, 31, 31, 31, 31, 31, 31, 31, 31, 31, 31, 31 };

struct CvtJob { const float* src; int K, Nsrc, Npad; const float* gain; bf16_t* dst; int ldd; int mode; int row_off; int kblk;   unsigned* amax;   int f8;   int f16;   };
__device__ __forceinline__ int cvt_row(int mode, int n) {
    if (mode == 1) { if (n >= 1280 && n < 1344) { const int j = n - 1280; return 1280 + 2 * (j & 31) + (j >> 5); } return n; }
    if (mode == 2) { const int h = n / 192, w = n - h * 192; if (w >= 128) { const int j = w - 128; return h * 192 + 128 + 2 * (j & 31) + (j >> 5); } return n; }
    if (mode == 4) return (n >> 7) * 256 + (n & 127);
    if (mode == 5) return (n >> 7) * 256 + 128 + (n & 127);
    return n;
}
__device__ __forceinline__ float cvt_cs(int mode, int n) {
    if (mode == 1) return (n >= 1344 && n < 2368) ? C2_SWA : 1.f;
    if (mode == 2) return C2_MLA;
    if (mode == 3) return C2_128;
    if (mode == 6) return n < 2048 ? C2_128 : 1.f;
    return 1.f;
}
constexpr int N_CVT_JOBS = 17 + 24;
__device__ __forceinline__ CvtJob get_job(const Args& a, int j) {
    unsigned char* ws = a.ws; CvtJob jb; jb.gain = nullptr; jb.mode = 0; jb.row_off = 0; jb.amax = nullptr; jb.kblk = 0; jb.f16 = 0; jb.f8 = 0;
    const float* nmix = (const float*)a.in[I_NMIX]; const float* ncross = (const float*)a.in[I_NCROSS]; const float* nmem = (const float*)a.in[I_NMEM]; const float* nffn = (const float*)a.in[I_NFFN];
    if (j >= 17) { const int t = (j - 17) >> 3, e = (j - 17) & 7;
        if (t == 0) { jb.src = (const float*)a.in[I_MG] + (size_t)e * DM * DFF; jb.K = DM; jb.Nsrc = jb.Npad = DFF; jb.gain = nffn + DM; jb.dst = (bf16_t*)(ws + WS_WGU1 + (size_t)e * E_GU); jb.ldd = DM; jb.mode = 4; jb.amax = (unsigned*)(ws + WS_CTL) + CW_AMAXW + e * 2 * DFF; }
        else if (t == 1) { jb.src = (const float*)a.in[I_MU] + (size_t)e * DM * DFF; jb.K = DM; jb.Nsrc = jb.Npad = DFF; jb.gain = nffn + DM; jb.dst = (bf16_t*)(ws + WS_WGU1 + (size_t)e * E_GU); jb.ldd = DM; jb.mode = 5; jb.amax = (unsigned*)(ws + WS_CTL) + CW_AMAXW + e * 2 * DFF; }
        else { jb.src = (const float*)a.in[I_MD] + (size_t)e * DFF * DM; jb.K = DFF; jb.Nsrc = jb.Npad = DM; jb.dst = (bf16_t*)(ws + WS_WD1 + (size_t)e * E_D)  ; jb.ldd = DFF; jb.kblk = 1; jb.f8 = 1; }
        return jb; }
    switch (j) {
    case 0: jb.src = (const float*)a.in[I_EVWIN]; jb.K = DM; jb.Nsrc = EVEN_IN; jb.Npad = Z0_LD; jb.gain = nmix; jb.dst = (bf16_t*)(ws + WS_WIN0)  ; jb.ldd = DM; jb.mode = 1; jb.amax = (unsigned*)(ws + WS_CTL) + CW_AMAX0; break;
    case 1: jb.src = (const float*)a.in[I_WUQ]; jb.K = 768; jb.Nsrc = jb.Npad = 1536; jb.gain = (const float*)a.in[I_QNORM]; jb.dst = (bf16_t*)(ws + WS_WUQ); jb.ldd = 768; jb.mode = 2; break;
    case 2: jb.src = (const float*)a.in[I_WUKV]; jb.K = 512; jb.Nsrc = jb.Npad = 2048; jb.gain = (const float*)a.in[I_KVNORM]; jb.dst = (bf16_t*)(ws + WS_WUKV); jb.ldd = 512; break;
    case 3: jb.src = (const float*)a.in[I_EVWO]; jb.K = DM; jb.Nsrc = jb.Npad = DM; jb.dst = (bf16_t*)(ws + WS_WO0); jb.ldd = DM; break;
    case 4: case 5: { const int l = j - 4; jb.src = (const float*)a.in[I_XWQ] + (size_t)l * DM * 512; jb.K = DM; jb.Nsrc = jb.Npad = 512; jb.gain = ncross + l * DM; jb.dst = (bf16_t*)(ws + WS_WXQ) + (size_t)l * E_XQ; jb.ldd = DM; jb.mode = 3; jb.f16 = 1; break; }
    case 6: case 7: { const int l = j - 6; jb.src = (const float*)a.in[I_XWK] + (size_t)l * DM * 512; jb.K = DM; jb.Nsrc = jb.Npad = 512; jb.gain = nmem + l * DM; jb.dst = (bf16_t*)(ws + WS_WXKV); jb.ldd = DM; jb.row_off = l * 1024; break; }
    case 8: case 9: { const int l = j - 8; jb.src = (const float*)a.in[I_XWV] + (size_t)l * DM * 512; jb.K = DM; jb.Nsrc = jb.Npad = 512; jb.gain = nmem + l * DM; jb.dst = (bf16_t*)(ws + WS_WXKV); jb.ldd = DM; jb.row_off = l * 1024 + 512; break; }
    case 10: case 11: { const int l = j - 10; jb.src = (const float*)a.in[I_XWO] + (size_t)l * 512 * DM; jb.K = 512; jb.Nsrc = jb.Npad = DM; jb.dst = (bf16_t*)(ws + WS_WXO) + (size_t)l * E_XO; jb.ldd = 512; break; }
    case 12: jb.src = (const float*)a.in[I_FG]; jb.K = DM; jb.Nsrc = jb.Npad = DFF; jb.gain = nffn; jb.dst = (bf16_t*)(ws + WS_WGU0); jb.ldd = DM; jb.mode = 4; jb.amax = (unsigned*)(ws + WS_CTL) + CW_AMAXW + 8 * 2 * DFF; break;
    case 13: jb.src = (const float*)a.in[I_FU]; jb.K = DM; jb.Nsrc = jb.Npad = DFF; jb.gain = nffn; jb.dst = (bf16_t*)(ws + WS_WGU0); jb.ldd = DM; jb.mode = 5; jb.amax = (unsigned*)(ws + WS_CTL) + CW_AMAXW + 8 * 2 * DFF; break;
    case 14: jb.src = (const float*)a.in[I_FD]; jb.K = DFF; jb.Nsrc = jb.Npad = DM; jb.dst = (bf16_t*)(ws + WS_WD0); jb.ldd = DFF; jb.kblk = 1; break;
    case 15: jb.src = (const float*)a.in[I_ODWIN]; jb.K = DM; jb.Nsrc = ODD_IN; jb.Npad = IN1_PAD; jb.gain = nmix + DM; jb.dst = (bf16_t*)(ws + WS_WIN1)  ; jb.ldd = DM; jb.mode = 6; jb.amax = (unsigned*)(ws + WS_CTL) + CW_AMAX15; break;
    default: jb.src = (const float*)a.in[I_ODWO]; jb.K = DM; jb.Nsrc = jb.Npad = DM; jb.dst = (bf16_t*)(ws + WS_WO1); jb.ldd = DM; break;
    }
    return jb;
}
__device__ __forceinline__ int cvt_find(const LAS int* cum, int it, int& j) { while (it >= cum[j + 1]) ++j; return it - cum[j]; }
__device__ __forceinline__ void cvt_load(const CvtJob& jb, int item, int lane, float (&v)[32]) {
    const int nblk = jb.Npad / 32, kb = item / nblk, nb = item % nblk, k0 = 64 * kb, n0 = 32 * nb;
    const int nn = n0 + (lane & 31); const bool ok = nn < jb.Nsrc;
    const float* p = jb.src + (size_t)(k0 + (lane >> 5)) * jb.Nsrc + nn; const size_t st = (size_t)2 * jb.Nsrc;
#pragma unroll
    for (int i = 0; i < 32; ++i) v[i] = ok ? __builtin_nontemporal_load(p + i * st) : 0.f;
}
__device__ __forceinline__ void cvt_store(const CvtJob& jb, LAS float* scr, int item, int lane, const float (&v)[32]) {
    const int nblk = jb.Npad / 32, kb = item / nblk, nb = item % nblk, k0 = 64 * kb, n0 = 32 * nb;
    const float cs = cvt_cs(jb.mode, n0 + (lane & 31));
    const int c = lane & 7;
    f32x4 g0 = (f32x4){1.f, 1.f, 1.f, 1.f}, g1 = g0;
    if (jb.gain) { g0 = *(const f32x4*)(jb.gain + k0 + 8 * c); g1 = *(const f32x4*)(jb.gain + k0 + 8 * c + 4); }
#pragma unroll
    for (int i = 0; i < 32; ++i) scr[(2 * i + (lane >> 5)) * 33 + (lane & 31)] = v[i] * cs;
    LDS_WAIT(); asm volatile("" ::: "memory");
#pragma unroll
    for (int j = 0; j < 4; ++j) { const int n = (lane >> 3) + 8 * j; const LAS float* s = scr + (8 * c) * 33 + n;
        u32x4 o;
        if (jb.f16) { o.x = pk_f16(s[0 * 33] * g0[0], s[1 * 33] * g0[1]); o.y = pk_f16(s[2 * 33] * g0[2], s[3 * 33] * g0[3]); o.z = pk_f16(s[4 * 33] * g1[0], s[5 * 33] * g1[1]); o.w = pk_f16(s[6 * 33] * g1[2], s[7 * 33] * g1[3]); }
        else { o.x = cvt_pk_bf16(s[0 * 33] * g0[0], s[1 * 33] * g0[1]); o.y = cvt_pk_bf16(s[2 * 33] * g0[2], s[3 * 33] * g0[3]); o.z = cvt_pk_bf16(s[4 * 33] * g1[0], s[5 * 33] * g1[1]); o.w = cvt_pk_bf16(s[6 * 33] * g1[2], s[7 * 33] * g1[3]); }
        const int drow = jb.row_off + cvt_row(jb.mode, n0 + n);
        if (jb.f8) {
            const f32x4 a_ = (f32x4){s[0 * 33] * g0[0], s[1 * 33] * g0[1], s[2 * 33] * g0[2], s[3 * 33] * g0[3]} * 64.f, b_ = (f32x4){s[4 * 33] * g1[0], s[5 * 33] * g1[1], s[6 * 33] * g1[2], s[7 * 33] * g1[3]} * 64.f;
            *(u32x2*)((unsigned char*)jb.dst + ((size_t)(k0 >> 7) * jb.Npad + drow) * 128 + (k0 & 64) + 8 * c) = pack8_fp8(a_, b_);
        } else { bf16_t* dp = jb.kblk ? jb.dst + ((size_t)(k0 >> 6) * jb.Npad + drow) * 64 + 8 * c : jb.dst + (size_t)drow * jb.ldd + k0 + 8 * c; *(u32x4*)dp = o; } }
    LDS_WAIT(); asm volatile("" ::: "memory");
}
__device__ __forceinline__ void cvt_amax(const CvtJob& jb, int item, int lane, const float (&v)[32]) {
    const int nblk = jb.Npad / 32, kb = item / nblk, nb = item % nblk, k0 = 64 * kb, n0 = 32 * nb;
    const int nn = n0 + (lane & 31); float mx = 0.f;
#pragma unroll
    for (int i = 0; i < 32; ++i) mx = fmaxf(mx, fabsf(v[i] * jb.gain[k0 + 2 * i + (lane >> 5)]));
    mx = fmaxf(mx, __shfl_xor(mx, 32)) * cvt_cs(jb.mode, nn);
    if (lane < 32 && nn < jb.Nsrc) atomicMax(jb.amax + jb.row_off + cvt_row(jb.mode, nn), __float_as_uint(mx));
}
__device__ __forceinline__ float cvt_amax_item(const CvtJob& jb, int item, int lane, const float (&v)[32]) {
    const int nblk = jb.Npad / 32, kb = item / nblk, nb = item % nblk, k0 = 64 * kb, n0 = 32 * nb;
    float mx = 0.f;
#pragma unroll
    for (int i = 0; i < 32; ++i) mx = fmaxf(mx, fabsf(v[i] * jb.gain[k0 + 2 * i + (lane >> 5)]));
    return fmaxf(mx, __shfl_xor(mx, 32)) * cvt_cs(jb.mode, n0 + (lane & 31));
}
__device__ __forceinline__ void cvt_store_q8(const CvtJob& jb, LAS float* scr, int item, int lane, const float (&v)[32], const LAS float* cam = nullptr) {
    const int nblk = jb.Npad / 32, kb = item / nblk, nb = item % nblk, k0 = 64 * kb, n0 = 32 * nb;
    const int c = lane & 7;
    const f32x4 g0 = *(const f32x4*)(jb.gain + k0 + 8 * c), g1 = *(const f32x4*)(jb.gain + k0 + 8 * c + 4);
#pragma unroll
    for (int i = 0; i < 32; ++i) scr[(2 * i + (lane >> 5)) * 33 + (lane & 31)] = v[i];
    LDS_WAIT(); asm volatile("" ::: "memory");
#pragma unroll
    for (int j = 0; j < 4; ++j) { const int n = (lane >> 3) + 8 * j; const LAS float* s = scr + (8 * c) * 33 + n;
        const int row = jb.row_off + cvt_row(jb.mode, n0 + n);
        const float am = cam ? cam[n] : __uint_as_float(__hip_atomic_load(jb.amax + row, RLX_AGENT)); const float inv = am > 0.f ? cvt_cs(jb.mode, n0 + n) * 127.f / am : 0.f;
        int q[8];
#pragma unroll
        for (int i = 0; i < 4; ++i) { q[i] = (int)__builtin_rintf(s[i * 33] * g0[i] * inv); q[4 + i] = (int)__builtin_rintf(s[(4 + i) * 33] * g1[i] * inv); }
#pragma unroll
        for (int i = 0; i < 8; ++i) q[i] = q[i] > 127 ? 127 : (q[i] < -127 ? -127 : q[i]);
        u32x2 o; o.x = (unsigned)(q[0] & 255) | ((unsigned)(q[1] & 255) << 8) | ((unsigned)(q[2] & 255) << 16) | ((unsigned)(q[3] & 255) << 24);
        o.y = (unsigned)(q[4] & 255) | ((unsigned)(q[5] & 255) << 8) | ((unsigned)(q[6] & 255) << 16) | ((unsigned)(q[7] & 255) << 24);
        *(u32x2*)((unsigned char*)jb.dst + (size_t)row * jb.ldd + k0 + 8 * c) = o; }
    LDS_WAIT(); asm volatile("" ::: "memory");
}
__device__ __forceinline__ void row_to_bf16_ssq(const float* xrow, bf16_t* orow, float* ssqrow, int lane) {
    const f32x4* xr = (const f32x4*)xrow + lane; f32x4 v[8]; float s = 0.f;
#pragma unroll
    for (int j = 0; j < 8; ++j) { v[j] = xr[64 * j]; s += (v[j][0] * v[j][0] + v[j][1] * v[j][1]) + (v[j][2] * v[j][2] + v[j][3] * v[j][3]); }
    s = wave_sum(s);
    u32x2* o8 = (u32x2*)orow + lane;
#pragma unroll
    for (int j = 0; j < 8; ++j) { u32x2 w; w.x = cvt_pk_bf16(v[j][0], v[j][1]); w.y = cvt_pk_bf16(v[j][2], v[j][3]); o8[64 * j] = w; }
    if (lane < 32) ssqrow[lane] = lane == 0 ? s : 0.f;
}

__global__ void __launch_bounds__(NWAVES * 64, 2) trunk_fwd(Args args) {
    extern __shared__ __attribute__((aligned(16))) unsigned char lds_raw[];
    LAS unsigned char* lds = (LAS unsigned char*)lds_raw;
    volatile LAS unsigned* MISC = (volatile LAS unsigned*)(lds + MISC_OFF);
    const int tid = threadIdx.x, lane = tid & 63, wave = __builtin_amdgcn_readfirstlane(tid >> 6);
    const int G = gridDim.x; const int bx = blockIdx.x; const int vcu = (G % 8 == 0) ? (bx % 8) * (G / 8) + bx / 8 : bx;
    const int gw = vcu * NWAVES + wave, NGW = G * NWAVES;
    unsigned* ctl = (unsigned*)(args.ws + WS_CTL);
    const int lo = args.ph_lo, hi = args.ph_hi;
    const bool fused = (hi - lo) > 1;
    for (int u = tid; u < (LDS_BYTES - RING_BYTES) / 4; u += NWAVES * 64) ((LAS unsigned*)(lds + RING_BYTES))[u] = 0u;
    __syncthreads();
    XcdBarrier bar; bar.bar = ctl + CW_BAR; bar.x = 0; bar.st = nullptr;
    if (fused) bar = xcd_barrier_post(ctl + CW_BAR, MISC + 8);
#ifndef PH_MASK
#define PH_MASK 0xFFFFFFFFFFFFFFFFull
#endif
#define IN(k) ((((unsigned long long)PH_MASK >> (k)) & 1ull) && lo <= (k) && (k) < hi)
#define GRID_BAR(k) do { if (fused && IN((k) + 1)) xcd_barrier(bar); } while (0)
#ifndef DUP_MASK
#define DUP_MASK 0ull
#endif
#ifndef DUP_SUB
#define DUP_SUB 0
#endif
#define NREP(k) ((((unsigned long long)DUP_MASK >> (k)) & 1ull) ? 2 : 1)
#define PHASE(k) for (int rep_ = 0; rep_ < NREP(k) && IN(k); ++rep_)

#define WSL() GAS unsigned char* wsg_ = (GAS unsigned char*)args.ws; asm volatile("" : "+s"(wsg_)); unsigned char* ws = (unsigned char*)wsg_
#define XB ((bf16_t*)(ws + WS_XB))
#define SSQ ((float*)(ws + WS_SSQ))
#define ROPE ((float*)(ws + WS_ROPE))
#define MEMN ((bf16_t*)(ws + WS_MEMN))
#define SSQM ((float*)(ws + WS_SSQM))
#define MEMKV ((bf16_t*)(ws + WS_MEMKV))
#define SSQQ ((float*)(ws + WS_SSQQ))
#define SSQKV ((float*)(ws + WS_SSQKV))
#define QX ((bf16_t*)(ws + WS_QX))
#define OX ((bf16_t*)(ws + WS_OX))
#define FL ((float*)(ws + WS_FL))
#define DEC ((float*)(ws + WS_DEC))
#define TOPE ((int*)(ws + WS_TOPE))
#define TOPS ((int*)(ws + WS_TOPS))
#define TOPG ((float*)(ws + WS_TOPG))
#define RSTDF ((float*)(ws + WS_RSTDF))
#define TOKPOS ((int*)(ws + WS_TOKPOS))
#define ROWIDX ((int*)(ws + WS_ROWIDX))
#define GATEP ((float*)(ws + WS_GATEP))
#define RSTDP ((float*)(ws + WS_RSTDP))
#define BIAST ((float*)(ws + WS_BIAST))
#define Z0 ((bf16_t*)(ws + WS_ARENA + AR_Z0))
#define QM ((bf16_t*)(ws + WS_ARENA + AR_QM))
#define KM ((bf16_t*)(ws + WS_ARENA + AR_KM))
#define VM ((bf16_t*)(ws + WS_ARENA + AR_VM))
#define O0 ((bf16_t*)(ws + WS_ARENA + AR_O0))
#define HIDB(i) ((bf16_t*)(ws + WS_ARENA + AR_HID + (size_t)((i) & 1) * HID_BYTES))
#define YB ((bf16_t*)(ws + WS_ARENA + AR_Y))
#define Z1 ((bf16_t*)(ws + WS_ARENA + AR_Z1))
#define O1 ((bf16_t*)(ws + WS_ARENA + AR_O1))
#define XQ ((unsigned char*)(ws + WS_QX))
#define XH ((unsigned short*)(ws + WS_XB))
#define XIN ((const float*)args.in[I_X])

    PHASE(0) {
        WSL();
        LAS float* scr = (LAS float*)(lds + wave * 16384);
        LAS int* cum = (LAS int*)(lds + RING_BYTES + 4096);
        if (tid < N_CVT_JOBS) { const CvtJob jb = get_job(args, tid); cum[64 + tid] = jb.amax ? 0   : (jb.K / 64) * (jb.Npad / 32); }
        __syncthreads();
        if (tid == 0) { int run = 0; for (int j = 0; j < N_CVT_JOBS; ++j) { cum[j] = run; run += cum[64 + j]; } cum[N_CVT_JOBS] = run; cum[N_CVT_JOBS + 1] = 0x7fffffff; }
        __syncthreads();
        {
            const int total = cum[N_CVT_JOBS];
            float va[32], vb[32]; int jL = 0, jP = 0;
            if (gw < total) { const int li = cvt_find(cum, gw, jL); cvt_load(get_job(args, jL), li, lane, va); }
#pragma unroll 1
            for (int it = gw; it < total; it += 2 * NGW) {
                const int it2 = it + NGW, it3 = it + 2 * NGW;
                if (it2 < total) { const int li = cvt_find(cum, it2, jL); cvt_load(get_job(args, jL), li, lane, vb); }
                { const int li = cvt_find(cum, it, jP); const CvtJob jb = get_job(args, jP); cvt_store(jb, scr, li, lane, va); }
                if (it2 < total) {
                    if (it3 < total) { const int li = cvt_find(cum, it3, jL); cvt_load(get_job(args, jL), li, lane, va); }
                    const int li = cvt_find(cum, it2, jP); const CvtJob jb = get_job(args, jP); cvt_store(jb, scr, li, lane, vb);
                }
            }
        }
        for (int m = gw; m < M; m += NGW) {
            const f32x4* xr = (const f32x4*)(XIN + (size_t)m * DM) + lane; f32x4 v[8]; float ss = 0.f, amx = 0.f;
#pragma unroll
            for (int j = 0; j < 8; ++j) { v[j] = xr[64 * j]; ss += (v[j][0] * v[j][0] + v[j][1] * v[j][1]) + (v[j][2] * v[j][2] + v[j][3] * v[j][3]);
                amx = fmaxf(amx, fmaxf(fmaxf(fabsf(v[j][0]), fabsf(v[j][1])), fmaxf(fabsf(v[j][2]), fabsf(v[j][3])))); }
            ss = wave_sum(ss);
#pragma unroll
            for (int o_ = 1; o_ < 64; o_ <<= 1) amx = fmaxf(amx, __shfl_xor(amx, o_));
            const float inv = amx > 0.f ? 127.f / amx : 0.f; unsigned* xq = (unsigned*)((unsigned char*)XB + (size_t)m * DM) + lane;
#pragma unroll
            for (int j = 0; j < 8; ++j) { const int q0 = (int)__builtin_rintf(v[j][0] * inv), q1 = (int)__builtin_rintf(v[j][1] * inv), q2 = (int)__builtin_rintf(v[j][2] * inv), q3 = (int)__builtin_rintf(v[j][3] * inv);
                xq[64 * j] = (unsigned)(q0 & 255) | ((unsigned)(q1 & 255) << 8) | ((unsigned)(q2 & 255) << 16) | ((unsigned)(q3 & 255) << 24); }
            if (lane == 0) RSTDF[m] = __builtin_amdgcn_rsqf(ss * (1.f / DM) + EPS) * amx * (1.f / 127.f);
        }
        for (int m = gw; m < MROWS; m += NGW) row_to_bf16_ssq((const float*)args.in[I_MEM] + (size_t)m * DM, MEMN + (size_t)m * DM, SSQM + (size_t)m * 32, lane);
        const int* pos = (const int*)args.in[I_POS];
        int gt0_ = tid; asm volatile("" : "+v"(gt0_)); gt0_ += bx * 512;
        for (int e = gt0_; e < M * 32; e += G * 512) {
            const int row = e >> 5, i = e & 31;
            const float ang = (float)pos[row] * ROPE_INV[i];
            const double rev = (double)ang * 0.15915494309189535; const float fr = (float)(rev - __builtin_rint(rev));
            ROPE[(size_t)e * 2] = __builtin_amdgcn_cosf(fr); ROPE[(size_t)e * 2 + 1] = __builtin_amdgcn_sinf(fr);
        }
        const float* relb = (const float*)args.in[I_RELB];
        for (int e = gt0_; e < 16 * 128; e += G * 512) { const int h = e >> 7, d = e & 127; BIAST[e] = relb[(int)T5_BUCKET[d] * 16 + h] * LOG2E; }
        if (fused && IN(1) && !IN(44)) xcd_barrier(bar);
        __syncthreads();
    }

    PHASE(44) {
        LAS float* scr = (LAS float*)(lds + wave * 16384);
        LAS float* cam = (LAS float*)(lds + RING_BYTES + 4096);
        constexpr int NBJ = DFF / 32, NB15 = IN1_PAD / 32, NB0 = Z0_LD / 32, NB = 18 * NBJ + NB15 + NB0;
#define Q8DEC(cb_, j_, nb_) const int j_ = (cb_) >= 18 * NBJ + NB15 ? 0 : ((cb_) >= 18 * NBJ ? 15 : ((cb_) / NBJ < 2 ? 12 + (cb_) / NBJ : 15 + (cb_) / NBJ)); \
        const int nb_ = (cb_) >= 18 * NBJ + NB15 ? (cb_) - 18 * NBJ - NB15 : ((cb_) >= 18 * NBJ ? (cb_) - 18 * NBJ : (cb_) % NBJ)
        float v0[32], v1[32], v2[32], v3[32];
        if (bx < NB) { Q8DEC(bx, j, nb); const CvtJob jb = get_job(args, j); const int nblk = jb.Npad / 32;
            cvt_load(jb, (4 * wave + 0) * nblk + nb, lane, v0); cvt_load(jb, (4 * wave + 1) * nblk + nb, lane, v1);
            cvt_load(jb, (4 * wave + 2) * nblk + nb, lane, v2); cvt_load(jb, (4 * wave + 3) * nblk + nb, lane, v3); }
#pragma unroll 1
        for (int cb = bx; cb < NB; cb += G) {
            Q8DEC(cb, j, nb); const CvtJob jb = get_job(args, j); const int nblk = jb.Npad / 32;
            const int cn = cb + G; const bool more = cn < NB; Q8DEC(more ? cn : cb, jn, nbn); const CvtJob jbn = get_job(args, jn); const int nblkn = jbn.Npad / 32;
            float mx = fmaxf(fmaxf(cvt_amax_item(jb, (4 * wave + 0) * nblk + nb, lane, v0), cvt_amax_item(jb, (4 * wave + 1) * nblk + nb, lane, v1)),
                             fmaxf(cvt_amax_item(jb, (4 * wave + 2) * nblk + nb, lane, v2), cvt_amax_item(jb, (4 * wave + 3) * nblk + nb, lane, v3)));
            __syncthreads();
            if (lane < 32) cam[wave * 32 + lane] = mx;
            __syncthreads();
            if (lane < 32) { float m = cam[lane];
#pragma unroll
                for (int w = 1; w < 8; ++w) m = fmaxf(m, cam[w * 32 + lane]);
                cam[256 + wave * 32 + lane] = m;
                const int nn = 32 * nb + lane; if (wave == 0 && nn < jb.Nsrc) jb.amax[jb.row_off + cvt_row(jb.mode, nn)] = __float_as_uint(m); }
            LDS_WAIT(); asm volatile("" ::: "memory");
            const LAS float* camw = cam + 256 + wave * 32;
            cvt_store_q8(jb, scr, (4 * wave + 0) * nblk + nb, lane, v0, camw); if (more) cvt_load(jbn, (4 * wave + 0) * nblkn + nbn, lane, v0);
            cvt_store_q8(jb, scr, (4 * wave + 1) * nblk + nb, lane, v1, camw); if (more) cvt_load(jbn, (4 * wave + 1) * nblkn + nbn, lane, v1);
            cvt_store_q8(jb, scr, (4 * wave + 2) * nblk + nb, lane, v2, camw); if (more) cvt_load(jbn, (4 * wave + 2) * nblkn + nbn, lane, v2);
            cvt_store_q8(jb, scr, (4 * wave + 3) * nblk + nb, lane, v3, camw); if (more) cvt_load(jbn, (4 * wave + 3) * nblkn + nbn, lane, v3);
        }
#undef Q8DEC
        GRID_BAR(0);
    }

    PHASE(1) {
        WSL();
        { pg8::PolPlain P{(const char*)XB  , DM, (const char*)(ws + WS_WIN0)  , DM, DM / 2};
          pg8::StaticOrder S; S.init(M / 256, Z0_LD / 256, G, bx, 0, WGM_K2048);
          pg8::EpiStore<1, 32> E{Z0, Z0_LD, nullptr, (LAS float*)(lds + RING_BYTES + 12288), 1.f / DM, ROPE, SSQQ, SSQKV, nullptr, nullptr, nullptr, RSTDF, ctl + CW_AMAX0};
          pg8::gemm_phase<pg8::EpiStore<1, 32>, pg8::PolPlain, 1>(lds, P, S, E); }
        { pg8::PolPlain P{(const char*)MEMN, DM * 2, (const char*)(ws + WS_WXKV), DM * 2, DM};
          pg8::StaticOrder S; S.init(MROWS / 256, 2048 / 256, G, (G - 1) - bx, 0);
          pg8::EpiStore<0, 32> E{MEMKV, 2048, SSQM, (LAS float*)(lds + RING_BYTES + 12288), 1.f / DM, nullptr, nullptr, nullptr, nullptr, nullptr, nullptr};
          pg8::gemm_phase(lds, P, S, E); }
        GRID_BAR(1);
    }
    PHASE(2) {
        WSL();
        { pg8::PolPlain P{(const char*)Z0, Z0_LD * 2, (const char*)(ws + WS_WUQ), 768 * 2, 768};
          pg8::StaticOrder S; S.init(M / 256, 1536 / 256, G, bx, 0);
          pg8::EpiStore<2, 12> E{QM, QM_LD, SSQQ, (LAS float*)(lds + RING_BYTES + 12288), 1.f / 768.f, ROPE, nullptr, nullptr, nullptr, nullptr, nullptr};
          pg8::gemm_phase(lds, P, S, E); }
        { pg8::PolPlain P{(const char*)(Z0 + 768), Z0_LD * 2, (const char*)(ws + WS_WUKV), 512 * 2, 512};
          pg8::StaticOrder S; S.init(M / 256, 2048 / 256, G, bx, 0);
          pg8::EpiStore<3, 8> E{KM, KM_LD, SSQKV, (LAS float*)(lds + RING_BYTES + 12288), 1.f / 512.f, nullptr, nullptr, nullptr, VM, Z0, nullptr};
          pg8::gemm_phase(lds, P, S, E); }
        GRID_BAR(2);
    }
    PHASE(3) {
        WSL();
#pragma unroll 1
        for (int r3_ = 0; r3_ < (DUP_SUB == 1 ? 2 : 1); ++r3_)
#pragma unroll 1
        for (int it = vcu; it < BATCH * 8 * 32; it += G) {
            const int bh = it >> 5, x = it & 31, b = bh >> 3, h = bh & 7;
#pragma unroll 1
            for (int pass = 0; pass < 2; ++pass) { const int qb = pass ? x : 63 - x;
                fa::AttnArgs a; a.Q = QM + (size_t)b * SEQ * QM_LD + h * 192; a.ldq = QM_LD; a.K = KM + (size_t)b * SEQ * KM_LD + h * 192; a.ldk = KM_LD;
                a.V = VM + (size_t)b * SEQ * VM_LD + h * 128; a.ldv = VM_LD; a.O = O0 + (size_t)b * SEQ * DM + h * 128; a.ldo = DM;
                a.q0 = qb * 256; a.j_lo = 0; a.j_hi = qb * 4 + 4; a.W = 0x3fffffff; a.dec = nullptr; a.sinkl = 0.f; a.sinks = nullptr; a.biasT = nullptr; a.kmax = 0.f;
                fa::attn_unit<192, 128, 0>(a, (LAS char*)lds); } }
        const float* sinks = (const float*)args.in[I_SINKS];
#pragma unroll 1
        for (int r3_ = 0; r3_ < (DUP_SUB == 2 ? 2 : 1); ++r3_)
#pragma unroll 1
        for (int it = vcu; it < BATCH * 2 * (SEQ / 32); it += G) {
            const int bk = it >> 9, qb = it & 511, b = bk >> 1, kvh = bk & 1, q0 = qb * 32;
            fa::AttnArgs a; const bf16_t* zb = Z0 + (size_t)b * SEQ * Z0_LD;
            a.Q = zb + 1344 + kvh * 512; a.ldq = Z0_LD; a.K = zb + 2368 + kvh * 64; a.ldk = Z0_LD; a.V = zb + 2496 + kvh * 64; a.ldv = Z0_LD;
            a.O = O0 + (size_t)b * SEQ * DM + 1024 + kvh * 512; a.ldo = DM;
            a.q0 = q0; a.j_lo = q0 - 127 < 0 ? 0 : (q0 - 127) >> 6; a.j_hi = ((q0 + 31) >> 6) + 1; a.W = 128; a.dec = nullptr; a.sinkl = 0.f; a.sinks = sinks + kvh * 8;
            a.biasT = BIAST + kvh * 8 * 128; a.kmax = 0.f;
            fa::attn_unit<64, 64, 2>(a, (LAS char*)lds); }
        GRID_BAR(3);
    }
    PHASE(4) {
        WSL();
        pg8::PolPlain P{(const char*)O0, DM * 2, (const char*)(ws + WS_WO0), DM * 2, DM};
        pg8::StaticOrder S; S.init(M / 256, DM / 256, G, bx, 0, WGM_K2048);
        pg8::EpiRes<true> E{XIN, XH, SSQ};
        pg8::gemm_phase(lds, P, S, E);
        GRID_BAR(4);
    }
#define CROSS_PHASES(l, s0) \
    PHASE(s0) { WSL(); \
        pg8::PolPlain P{(const char*)XH  , DM * 2, (const char*)(ws + WS_WXQ + (size_t)(l) * E_XQ * 2)  , DM * 2, DM}; \
        pg8::StaticOrder S; S.init(M / 256, 512 / 256, G, bx, 0, WGM_K2048); \
        pg8::EpiStore<0, 32> E{QX, 512, SSQ, (LAS float*)(lds + RING_BYTES + 12288), 1.f / DM, nullptr, nullptr, nullptr, nullptr, nullptr, nullptr}; \
        pg8::gemm_phase<pg8::EpiStore<0, 32>, pg8::PolPlain, 3>(lds, P, S, E); \
        GRID_BAR(s0); } \
    PHASE((s0) + 1) { WSL(); \
        _Pragma("unroll 1") for (int it = vcu; it < BATCH * 4 * 64; it += G) { \
            const int bh = it >> 6, qb = it & 63, b = bh >> 2, h = bh & 3; \
            fa::AttnArgs a; a.Q = QX + (size_t)b * SEQ * 512 + h * 128; a.ldq = 512; a.K = MEMKV + (size_t)b * MEMLEN * 2048 + (l) * 1024 + h * 128; a.ldk = 2048; \
            a.V = a.K + 512; a.ldv = 2048; a.O = OX + (size_t)b * SEQ * 512 + h * 128; a.ldo = 512; \
            a.q0 = qb * 256; a.j_lo = 0; a.j_hi = 4; a.W = 0x3fffffff; a.dec = nullptr; a.sinkl = 0.f; a.sinks = nullptr; a.biasT = nullptr; a.kmax = 0.f; \
            fa::attn_unit<128, 128, 3>(a, (LAS char*)lds); } \
        GRID_BAR((s0) + 1); } \
    PHASE((s0) + 2) { WSL(); \
        pg8::PolPlain P{(const char*)OX, 512 * 2, (const char*)(ws + WS_WXO + (size_t)(l) * E_XO * 2), 512 * 2, 512}; \
        pg8::StaticOrder S; S.init(M / 256, DM / 256, G, bx, 0); \
        pg8::EpiRes<false> E{XH, XH, nullptr};           \
        pg8::gemm_phase(lds, P, S, E); \
        GRID_BAR((s0) + 2); }
    CROSS_PHASES(0, 5)
    PHASE(45) {
        WSL();
#pragma unroll 1
        for (int m = gw; m < M; m += NGW) {
            const u32x2* xr = (const u32x2*)(XH + (size_t)m * DM) + lane; f32x4 v[8]; float ss = 0.f, amx = 0.f;
#pragma unroll
            for (int j = 0; j < 8; ++j) { v[j] = unpk_f16x4(xr[64 * j]); ss += (v[j][0] * v[j][0] + v[j][1] * v[j][1]) + (v[j][2] * v[j][2] + v[j][3] * v[j][3]);
                amx = fmaxf(amx, fmaxf(fmaxf(fabsf(v[j][0]), fabsf(v[j][1])), fmaxf(fabsf(v[j][2]), fabsf(v[j][3])))); }
            ss = wave_sum(ss);
#pragma unroll
            for (int o_ = 1; o_ < 64; o_ <<= 1) amx = fmaxf(amx, __shfl_xor(amx, o_));
            const float inv = amx > 0.f ? 127.f / amx : 0.f; unsigned* xq = (unsigned*)(XQ + (size_t)m * DM) + lane;
#pragma unroll
            for (int j = 0; j < 8; ++j) { const int q0 = (int)__builtin_rintf(v[j][0] * inv), q1 = (int)__builtin_rintf(v[j][1] * inv), q2 = (int)__builtin_rintf(v[j][2] * inv), q3 = (int)__builtin_rintf(v[j][3] * inv);
                xq[64 * j] = (unsigned)(q0 & 255) | ((unsigned)(q1 & 255) << 8) | ((unsigned)(q2 & 255) << 16) | ((unsigned)(q3 & 255) << 24); }
            if (lane == 0) RSTDF[m] = __builtin_amdgcn_rsqf(ss * (1.f / DM) + EPS) * amx * (1.f / 127.f);
        }
        GRID_BAR(7);
    }
#pragma unroll 1
    for (int p = 0; p < 5; ++p) {
        PHASE(8 + p) {
            if (p >= 1) {
                WSL();
                const int c = p - 1;
                pg8::PolChunkA P{(const char*)HIDB(c), 128, (const char*)(ws + WS_WD0), 128, DFF, c * CHUNK_TILES};
                pg8::StaticOrder S; S.init(CHUNK_TILES, DM / 256, G, bx, c * CHUNK_TILES, WGM_DOWN);
                pg8::EpiRes<false> E{XH, XH, SSQ};
                pg8::gemm_phase(lds, P, S, E);
            }
            int pg = p; asm volatile("" : "+s"(pg));
            if (pg <= 3) {
                WSL();
                pg8::PolPlain P{(const char*)XQ, DM, (const char*)(ws + WS_WGU0)  , DM, DM / 2};
                pg8::StaticOrder S; S.init(CHUNK_TILES, 2 * DFF / 256, G, bx, pg * CHUNK_TILES, WGM_GU);
                pg8::EpiSwiGLU<2> E{HIDB(pg), pg * CHUNK_ROWS, nullptr, RSTDF, ctl + CW_AMAXW + 8 * 2 * DFF, nullptr};
                pg8::gemm_phase<pg8::EpiSwiGLU<2>, pg8::PolPlain, 1>(lds, P, S, E);
            }
            GRID_BAR(8 + p);
        }
    }
    PHASE(46) {
        WSL();
#pragma unroll 1
        for (int m = gw; m < M; m += NGW) {
            const u32x2* xr = (const u32x2*)(XH + (size_t)m * DM) + lane; f32x4 v[8]; float ss = 0.f, amx = 0.f;
#pragma unroll
            for (int j = 0; j < 8; ++j) { v[j] = unpk_f16x4(xr[64 * j]); ss += (v[j][0] * v[j][0] + v[j][1] * v[j][1]) + (v[j][2] * v[j][2] + v[j][3] * v[j][3]);
                amx = fmaxf(amx, fmaxf(fmaxf(fabsf(v[j][0]), fabsf(v[j][1])), fmaxf(fabsf(v[j][2]), fabsf(v[j][3])))); }
            ss = wave_sum(ss);
#pragma unroll
            for (int o_ = 1; o_ < 64; o_ <<= 1) amx = fmaxf(amx, __shfl_xor(amx, o_));
            const float inv = amx > 0.f ? 127.f / amx : 0.f; unsigned* xq = (unsigned*)(XQ + (size_t)m * DM) + lane;
#pragma unroll
            for (int j = 0; j < 8; ++j) { const int q0 = (int)__builtin_rintf(v[j][0] * inv), q1 = (int)__builtin_rintf(v[j][1] * inv), q2 = (int)__builtin_rintf(v[j][2] * inv), q3 = (int)__builtin_rintf(v[j][3] * inv);
                xq[64 * j] = (unsigned)(q0 & 255) | ((unsigned)(q1 & 255) << 8) | ((unsigned)(q2 & 255) << 16) | ((unsigned)(q3 & 255) << 24); }
            if (lane == 0) RSTDF[m] = __builtin_amdgcn_rsqf(ss * (1.f / DM) + EPS) * amx * (1.f / 127.f);
        }
        GRID_BAR(15);
    }
    PHASE(16) {
        WSL();
        pg8::PolPlain P{(const char*)XQ  , DM, (const char*)(ws + WS_WIN1)  , DM, DM / 2};
        pg8::StaticOrder S; S.init(M / 256, IN1_PAD / 256, G, bx, 0, WGM_K2048);
        pg8::EpiStore<4, 32> E{Z1, Z1_LD, nullptr, (LAS float*)(lds + RING_BYTES + 12288), 1.f / DM, nullptr, nullptr, nullptr, nullptr, nullptr, FL, RSTDF, ctl + CW_AMAX15};
        pg8::gemm_phase<pg8::EpiStore<4, 32>, pg8::PolPlain, 1>(lds, P, S, E);
        GRID_BAR(16);
    }
    PHASE(17) {
        WSL();
#pragma unroll 1
        for (int b = 0; b < BATCH; ++b) {
            float kmx = 0.f;
#pragma unroll 1
            for (int r = gw; r < SEQ; r += NGW) {
                const u32x4* kp = (const u32x4*)(Z1 + ((size_t)b * SEQ + r) * Z1_LD + 2048 + lane * 32); float ss = 0.f;
#pragma unroll
                for (int q = 0; q < 4; ++q) { const u32x4 w = kp[q];
#pragma unroll
                    for (int e = 0; e < 4; ++e) { const float lo_ = __uint_as_float(w[e] << 16), hi_ = __uint_as_float(w[e] & 0xffff0000u); ss += lo_ * lo_ + hi_ * hi_; } }
                ss += __shfl_xor(ss, 1); ss += __shfl_xor(ss, 2);
                kmx = fmaxf(kmx, ss);
            }
            if ((lane & 3) == 0) atomicMax(ctl + CW_KMAX + 64 * (b * 16 + (lane >> 2)), __float_as_uint(kmx));
        }
        const float* bfv = (const float*)args.in[I_BF];
        LAS double* wtot = (LAS double*)lds;
#pragma unroll 1
        for (int bh = bx; bh < BATCH * 16; bh += G) {
            const int b = bh >> 4, h = bh & 15; const float bias = bfv[h];
            const size_t base = ((size_t)b * SEQ + (size_t)tid * 32) * 16 + h;
            float lf[32]; double run = 0.0;
#pragma unroll
            for (int i = 0; i < 32; ++i) { const float xv = FL[base + (size_t)i * 16] + bias; lf[i] = fminf(xv, 0.f) - log1pf(expf(-fabsf(xv))); }
#pragma unroll
            for (int i = 0; i < 32; ++i) run += (double)lf[i];
            double incl = run;
#pragma unroll
            for (int o = 1; o < 64; o <<= 1) { const double t = __shfl_up(incl, o); if (lane >= o) incl += t; }
            if (lane == 63) wtot[wave] = incl;
            __syncthreads();
            double off = incl - run;
            for (int w = 0; w < wave; ++w) off += wtot[w];
            double cacc = off;
#pragma unroll
            for (int i = 0; i < 32; ++i) { cacc += (double)lf[i]; DEC[base + (size_t)i * 16] = (float)(cacc * 1.4426950408889634); }
            __syncthreads();
        }
        GRID_BAR(17);
    }
    PHASE(18) {
        WSL();
        LAS int* qslot = (LAS int*)(lds + RING_BYTES + 8192);
#pragma unroll 1
        for (;;) {
            if (tid == 0) qslot[0] = (int)__hip_atomic_fetch_add(ctl + CW_Q18, 1u, RLX_AGENT);
            __syncthreads();
            const int u = qslot[0];
            __syncthreads();
            if (u >= BATCH * 16 * 64) break;
            const int qb = 63 - (u >> 5), bh = u & 31, b = bh >> 4, h = bh & 15;
            fa::AttnArgs a; const bf16_t* zb = Z1 + (size_t)b * SEQ * Z1_LD;
            a.Q = zb + h * 128; a.ldq = Z1_LD; a.K = zb + 2048 + h * 128; a.ldk = Z1_LD; a.V = zb + 4096 + h * 128; a.ldv = Z1_LD;
            a.O = O1 + (size_t)b * SEQ * DM + h * 128; a.ldo = DM;
            a.q0 = qb * 256; a.j_lo = 0; a.j_hi = qb * 4 + 4; a.W = 0x3fffffff; a.dec = DEC + (size_t)b * SEQ * 16 + h; a.sinkl = 0.f; a.sinks = nullptr; a.biasT = nullptr;
            a.kmax = sqrtf(__uint_as_float(__hip_atomic_load(ctl + CW_KMAX + 64 * bh, RLX_AGENT)));
            fa::attn_unit<128, 128, 1>(a, (LAS char*)lds);
        }
        GRID_BAR(18);
    }
    PHASE(19) {
        WSL();
        pg8::PolPlain P{(const char*)O1, DM * 2, (const char*)(ws + WS_WO1), DM * 2, DM};
        pg8::StaticOrder S; S.init(M / 256, DM / 256, G, bx, 0, WGM_K2048);
        pg8::EpiRes<false> E{XH, XH, SSQ};
        pg8::gemm_phase(lds, P, S, E);
        GRID_BAR(19);
    }
    CROSS_PHASES(1, 20)
    PHASE(23) {
        WSL();
        LAS float* WrT = (LAS float*)lds;
        const float* rw = (const float*)args.in[I_RW]; const float* gn = (const float*)args.in[I_NFFN] + DM; const float* rb = (const float*)args.in[I_RB];
        for (int i = tid; i < 8 * DM; i += 512) { const int e = i >> 11, k = i & 2047; WrT[i] = rw[k * 8 + e] * gn[k]; }
        __syncthreads();
#pragma unroll 1
        for (int g16 = gw; g16 < M / 16; g16 += NGW) {
            int e1 = 0, e2 = 0; float g1 = 0.f, g2 = 0.f, rstd = 0.f;
#pragma unroll 1
            for (int i = 0; i < 16; ++i) {
                const int row = g16 * 16 + i;
                const u32x2* xr = (const u32x2*)(XH + (size_t)row * DM) + lane;
                float pe[8], ss = 0.f, amx = 0.f;
#pragma unroll
                for (int e = 0; e < 8; ++e) pe[e] = 0.f;
#pragma unroll 2
                for (int j = 0; j < 8; ++j) { const f32x4 v = unpk_f16x4(xr[64 * j]); ss += (v[0] * v[0] + v[1] * v[1]) + (v[2] * v[2] + v[3] * v[3]);
                    amx = fmaxf(amx, fmaxf(fmaxf(fabsf(v[0]), fabsf(v[1])), fmaxf(fabsf(v[2]), fabsf(v[3]))));
#pragma unroll
                    for (int e = 0; e < 8; ++e) { const f32x4 w = *(const LAS f32x4*)(WrT + e * DM + 256 * j + lane * 4); pe[e] += (v[0] * w[0] + v[1] * w[1]) + (v[2] * w[2] + v[3] * w[3]); } }
                ss = wave_sum(ss);
#pragma unroll
                for (int e = 0; e < 8; ++e) pe[e] = wave_sum(pe[e]);
                const float rs = __builtin_amdgcn_rsqf(ss * (1.f / DM) + EPS);
#pragma unroll
                for (int o_ = 1; o_ < 64; o_ <<= 1) amx = fmaxf(amx, __shfl_xor(amx, o_));
                { const float inv = amx > 0.f ? 127.f / amx : 0.f; unsigned* xq = (unsigned*)(XQ + (size_t)row * DM) + lane;
#pragma unroll 2
                  for (int j = 0; j < 8; ++j) { const f32x4 v = unpk_f16x4(xr[64 * j]);
                      const int q0 = (int)__builtin_rintf(v[0] * inv), q1 = (int)__builtin_rintf(v[1] * inv), q2 = (int)__builtin_rintf(v[2] * inv), q3 = (int)__builtin_rintf(v[3] * inv);
                      xq[64 * j] = (unsigned)(q0 & 255) | ((unsigned)(q1 & 255) << 8) | ((unsigned)(q2 & 255) << 16) | ((unsigned)(q3 & 255) << 24); } }
                const float rowf = rs * amx * (1.f / 127.f);
                float lg[8];
#pragma unroll
                for (int e = 0; e < 8; ++e) lg[e] = pe[e] * rs + rb[e];
                int b1 = 0; float v1 = lg[0];
#pragma unroll
                for (int e = 1; e < 8; ++e) if (lg[e] > v1) { v1 = lg[e]; b1 = e; }
                int b2 = -1; float v2 = -__builtin_inff();
#pragma unroll
                for (int e = 0; e < 8; ++e) if (e != b1 && lg[e] > v2) { v2 = lg[e]; b2 = e; }
                const float ex = __expf(v2 - v1); const float gg2 = ex / (1.f + ex), gg1 = 1.f / (1.f + ex);
                if (lane == i) { e1 = b1; e2 = b2; g1 = gg1; g2 = gg2; rstd = rowf; }
            }
            int s1 = 0, s2 = 0;
#pragma unroll
            for (int e = 0; e < 8; ++e) {
                const unsigned long long m1 = __ballot(lane < 16 && e1 == e), m2 = __ballot(lane < 16 && e2 == e);
                const int c1 = __popcll(m1), c2 = __popcll(m2);
                int basev = 0;
                if (lane == 0 && c1 + c2 > 0) basev = (int)__hip_atomic_fetch_add(ctl + CW_CNT + 64 * e, (unsigned)(c1 + c2), RLX_AGENT);
                basev = __shfl(basev, 0);
                const unsigned long long lt = (1ull << lane) - 1ull;
                if (lane < 16 && e1 == e) s1 = basev + __popcll(m1 & lt);
                if (lane < 16 && e2 == e) s2 = basev + c1 + __popcll(m2 & lt);
            }
            if (lane < 16) { const int row = g16 * 16 + lane; TOPE[row * 2] = e1; TOPE[row * 2 + 1] = e2; TOPS[row * 2] = s1; TOPS[row * 2 + 1] = s2;
                TOPG[row * 2] = g1; TOPG[row * 2 + 1] = g2; RSTDF[row] = rstd; }
        }
        GRID_BAR(23);
    }
    if (hi > 24) {
#define EOFF() int eoff[9]; eoff[0] = 0; _Pragma("unroll") for (int e = 0; e < 8; ++e) { const int c_ = (int)__hip_atomic_load(ctl + CW_CNT + 64 * e, RLX_AGENT); eoff[e + 1] = eoff[e] + ((c_ + 255) & ~255); }
        PHASE(24) {
            WSL();
            EOFF();
            int ecnt[8];
#pragma unroll
            for (int e = 0; e < 8; ++e) ecnt[e] = (int)__hip_atomic_load(ctl + CW_CNT + 64 * e, RLX_AGENT);
            int gt1_ = tid; asm volatile("" : "+v"(gt1_)); gt1_ += bx * 512;
            for (int i = gt1_; i < M * 2; i += G * 512) {
                const int e = TOPE[i], sl = TOPS[i]; int off = 0;
#pragma unroll
                for (int q = 0; q < 8; ++q) if (q == e) off = eoff[q];
                const int pos = off + sl; ROWIDX[pos] = i >> 1; GATEP[pos] = TOPG[i]; RSTDP[pos] = RSTDF[i >> 1]; TOKPOS[i] = pos;
            }
            for (int i = gt1_; i < 8 * 256; i += G * 512) {
                const int e = i >> 8, j = i & 255; int off = 0, cnt = 0, nxt = 0;
#pragma unroll
                for (int q = 0; q < 8; ++q) if (q == e) { off = eoff[q]; cnt = ecnt[q]; nxt = eoff[q + 1]; }
                const int pos = off + cnt + j;
                if (pos < nxt) { ROWIDX[pos] = 0; GATEP[pos] = 0.f; RSTDP[pos] = 0.f; }
            }
            GRID_BAR(24);
        }
        LAS int* TILE_E = (LAS int*)(lds + RING_BYTES + 1024);
        if (hi > 25) {
            EOFF();
            for (int t = tid; t < MOE_MAX_TILES; t += 512) { int e = 0;
#pragma unroll
                for (int q = 1; q < 8; ++q) if (t * 256 >= eoff[q]) e = q;
                TILE_E[t] = e; }
            if (tid == 0) TILE_E[MOE_MAX_TILES] = eoff[8] >> 8;
            __syncthreads();
        }
#pragma unroll 1
        for (int p = 0; p <= MOE_CHUNKS; ++p) {
            PHASE(25 + p) {
                int ndown = 0;
                { WSL();
                const int ntiles = TILE_E[MOE_MAX_TILES], nch = (ntiles + MCH_TILES - 1) / MCH_TILES, t0 = ntiles - MCH_TILES * (nch - 1);
                if (p >= 1 && p - 1 < nch) {
                    const int c = p - 1, ft = c == 0 ? 0 : t0 + (c - 1) * MCH_TILES, nt_ = c == 0 ? t0 : MCH_TILES;
                    pg8::PolMoeDown P{(const char*)HIDB(c)  , 128, (const char*)(ws + WS_WD1)  , 128, DFF / 2, ft, TILE_E, E_D};
                    pg8::StaticOrder S; S.init(nt_, DM / 256, G, bx, ft, WGM_DOWN);
                    pg8::EpiMoeDown E{YB, GATEP};
                    pg8::gemm_phase<pg8::EpiMoeDown, pg8::PolMoeDown, 4>(lds, P, S, E);
                    ndown = nt_ * (DM / 256);
                } }
                int pg = p; asm volatile("" : "+s"(pg), "+s"(ndown));
                { WSL();
                const int ntiles = TILE_E[MOE_MAX_TILES], nch = (ntiles + MCH_TILES - 1) / MCH_TILES, t0 = ntiles - MCH_TILES * (nch - 1);
                if (pg < nch) {
                    const int ft = pg == 0 ? 0 : t0 + (pg - 1) * MCH_TILES, nt_ = pg == 0 ? t0 : MCH_TILES;
                    pg8::PolMoeUp P{(const char*)XQ  , DM, (const char*)(ws + WS_WGU1)  , DM, DM / 2, ROWIDX, TILE_E, E_GU};
                    pg8::StaticOrder S; S.init(nt_, 2 * DFF / 256, G, bx, ft, WGM_GU); S.quota(ndown);
                    pg8::EpiSwiGLU<2> E{HIDB(pg), ft * 256, nullptr, RSTDP, ctl + CW_AMAXW, TILE_E, 1};
                    pg8::gemm_phase<pg8::EpiSwiGLU<2>, pg8::PolMoeUp, 1>(lds, P, S, E);
                } }
                GRID_BAR(25 + p);
            }
        }
    }
    PHASE(43) {
        WSL();
        const float* fn = (const float*)args.in[I_FNORM];
#pragma unroll 1
        for (int m = gw; m < M; m += NGW) {
            const int p0 = TOKPOS[m * 2], p1 = TOKPOS[m * 2 + 1];
            const u32x2* xr = (const u32x2*)(XH + (size_t)m * DM) + lane; f32x4* orow = (f32x4*)(args.out + (size_t)m * DM) + lane;
            const u32x2* y0 = (const u32x2*)(YB + (size_t)p0 * DM) + lane; const u32x2* y1 = (const u32x2*)(YB + (size_t)p1 * DM) + lane;
            f32x4 v[8]; float s = 0.f;
#pragma unroll
            for (int j = 0; j < 8; ++j) { v[j] = unpk_f16x4(xr[64 * j]); const u32x2 a0 = y0[64 * j], a1 = y1[64 * j];
                v[j][0] += __uint_as_float(a0.x << 16) + __uint_as_float(a1.x << 16); v[j][1] += __uint_as_float(a0.x & 0xffff0000u) + __uint_as_float(a1.x & 0xffff0000u);
                v[j][2] += __uint_as_float(a0.y << 16) + __uint_as_float(a1.y << 16); v[j][3] += __uint_as_float(a0.y & 0xffff0000u) + __uint_as_float(a1.y & 0xffff0000u);
                s += (v[j][0] * v[j][0] + v[j][1] * v[j][1]) + (v[j][2] * v[j][2] + v[j][3] * v[j][3]); }
            s = wave_sum(s); const float rs = __builtin_amdgcn_rsqf(s * (1.f / DM) + EPS);
#pragma unroll
            for (int j = 0; j < 8; ++j) { const f32x4 g = *((const f32x4*)fn + lane + 64 * j); orow[64 * j] = v[j] * rs * g; }
        }
    }
#undef IN
#undef GRID_BAR
}

constexpr int N_STEPS = 47;
extern "C" void kernel_launch(void* const* d_in, const int* in_sizes, int n_in, void* d_out, int out_size, void* d_ws, size_t ws_size, hipStream_t stream) {
    static int grid = 0;
    if (grid == 0) {
        if (n_in != N_IN || in_sizes[0] != M * DM || out_size != M * DM || ws_size < WS_END) {
            fprintf(stderr, "kernel_launch: shape / workspace mismatch (n_in %d, in0 %d, out %d, ws %zu, need %zu); nothing launched\n", n_in, n_in > 0 ? in_sizes[0] : -1, out_size, ws_size, (size_t)WS_END); grid = -1; return; }
        int dev = 0, cus = 0, per_cu = 0;
        if (hipGetDevice(&dev) != hipSuccess || hipDeviceGetAttribute(&cus, hipDeviceAttributeMultiprocessorCount, dev) != hipSuccess) { grid = -1; return; }
        if (hipFuncSetAttribute((const void*)trunk_fwd, hipFuncAttributeMaxDynamicSharedMemorySize, LDS_BYTES) != hipSuccess) { fprintf(stderr, "kernel_launch: hipFuncSetAttribute failed\n"); grid = -1; return; }
        if (hipOccupancyMaxActiveBlocksPerMultiprocessor(&per_cu, (const void*)trunk_fwd, NWAVES * 64, LDS_BYTES) != hipSuccess || per_cu < 1)
            fprintf(stderr, "kernel_launch: note: occupancy query reports %d workgroups per CU\n", per_cu);
        (void)hipGetLastError();
        grid = cus;
    }
    if (grid < 0) return;
    if (hipMemsetAsync((char*)d_ws + WS_CTL, 0, CTL_BYTES, stream) != hipSuccess) return;
    Args a{};
    for (int i = 0; i < N_IN; ++i) a.in[i] = d_in[i];
    a.out = (float*)d_out; a.ws = (unsigned char*)d_ws;
#if MK_ONE_LAUNCH
    a.ph_lo = 0; a.ph_hi = N_STEPS;
    hipLaunchKernelGGL(trunk_fwd, dim3(grid), dim3(NWAVES * 64), LDS_BYTES, stream, a);
#else
    for (int i = 0; i < N_STEPS; ++i) { const int s = i == 0 ? 0 : (i == 1 ? 44 : (i <= 8 ? i - 1 : (i == 9 ? 45 : (i <= 14 ? i - 2 : (i == 15 ? 46 : i - 3))))); a.ph_lo = s; a.ph_hi = s + 1; hipLaunchKernelGGL(trunk_fwd, dim3(grid), dim3(NWAVES * 64), LDS_BYTES, stream, a); }
#endif
}
```

```cpp
#include <hip/hip_runtime.h>
#include <hip/hip_bf16.h>
#include <cstdio>
#include <cstdint>
#include <cmath>

#ifndef MK_ONE_LAUNCH
#define MK_ONE_LAUNCH 1
#endif

#define GAS __attribute__((address_space(1)))
#define LAS __attribute__((address_space(3)))
typedef unsigned short bf16_t;
typedef short bf16x8 __attribute__((ext_vector_type(8)));
typedef short s16x4 __attribute__((ext_vector_type(4)));
typedef float f32x2 __attribute__((ext_vector_type(2)));
typedef float f32x4 __attribute__((ext_vector_type(4)));
typedef float f32x16 __attribute__((ext_vector_type(16)));
typedef unsigned u32x2 __attribute__((ext_vector_type(2)));
typedef unsigned u32x4 __attribute__((ext_vector_type(4)));
typedef int i32x4 __attribute__((ext_vector_type(4)));
typedef long i64x2 __attribute__((ext_vector_type(2)));

constexpr int BATCH = 2, SEQ = 16384, DM = 2048, M = BATCH * SEQ, MEMLEN = 256, MROWS = BATCH * MEMLEN;
constexpr int EVEN_IN = 2624, Z0_LD = 2816, ODD_IN = 6160, Z1_LD = 6144, IN1_PAD = 6400;
constexpr int DFF = 7168, NEXP = 8;
constexpr int HLD = DFF + 64;
constexpr int QM_LD = 1536, KM_LD = 1536, VM_LD = 1024;
constexpr float LOG2E = 1.4426950408889634f;
constexpr float C2_MLA = LOG2E * 0.07216878364870323f;
constexpr float C2_SWA = LOG2E * 0.125f;
constexpr float C2_128 = LOG2E * 0.08838834764831845f;
constexpr float EPS = 1e-6f;
constexpr int CHUNK_ROWS = 8192, CHUNK_TILES = 32, MOE_MAX_TILES = 264, MOE_MAX_ROWS = MOE_MAX_TILES * 256;
constexpr int MCH_TILES = 64, MCH_ROWS = MCH_TILES * 256, MOE_CHUNKS = (MOE_MAX_TILES + MCH_TILES - 1) / MCH_TILES;

enum { I_X = 0, I_MEM, I_POS, I_RELB, I_NMIX, I_NCROSS, I_NMEM, I_NFFN, I_XWQ, I_XWK, I_XWV, I_XWO, I_EVWIN, I_QNORM, I_WUQ, I_KVNORM, I_WUKV, I_SINKS, I_EVWO,
       I_FG, I_FU, I_FD, I_ODWIN, I_BF, I_ODWO, I_RW, I_RB, I_MG, I_MU, I_MD, I_FNORM, N_IN };

constexpr size_t al256(size_t x) { return (x + 255) & ~(size_t)255; }
constexpr size_t WS_CTL = 0, CTL_BYTES = 1u << 20;
constexpr size_t E_IN0 = (size_t)Z0_LD * DM, E_UQ = (size_t)1536 * 768, E_UKV = (size_t)2048 * 512, E_SQ = (size_t)DM * DM, E_XQ = (size_t)512 * DM, E_XKV = (size_t)2048 * DM,
                 E_XO = (size_t)DM * 512, E_GU = (size_t)2 * DFF * DM, E_D = (size_t)DM * DFF, E_IN1 = (size_t)IN1_PAD * DM;
constexpr size_t WS_WIN0 = WS_CTL + CTL_BYTES;
constexpr size_t WS_WUQ = WS_WIN0 + 2 * E_IN0;
constexpr size_t WS_WUKV = WS_WUQ + 2 * E_UQ;
constexpr size_t WS_WO0 = WS_WUKV + 2 * E_UKV;
constexpr size_t WS_WXQ = WS_WO0 + 2 * E_SQ;
constexpr size_t WS_WXKV = WS_WXQ + 2 * 2 * E_XQ;
constexpr size_t WS_WXO = WS_WXKV + 2 * E_XKV;
constexpr size_t WS_WGU0 = WS_WXO + 2 * 2 * E_XO;
constexpr size_t WS_WD0 = WS_WGU0 + 2 * E_GU;
constexpr size_t WS_WIN1 = WS_WD0 + 2 * E_D;
constexpr size_t WS_WO1 = WS_WIN1 + 2 * E_IN1;
constexpr size_t WS_WGU1 = WS_WO1 + 2 * E_SQ;
constexpr size_t WS_WD1 = WS_WGU1 + 2 * 8 * E_GU;
constexpr size_t WS_XB = WS_WD1 + 2 * 8 * E_D;
constexpr size_t WS_SSQ = WS_XB + (size_t)M * DM * 2;
constexpr size_t WS_ROPE = WS_SSQ + (size_t)M * 32 * 4;
constexpr size_t WS_MEMN = WS_ROPE + (size_t)M * 64 * 4;
constexpr size_t WS_SSQM = WS_MEMN + (size_t)MROWS * DM * 2;
constexpr size_t WS_MEMKV = WS_SSQM + (size_t)MROWS * 32 * 4;
constexpr size_t WS_SSQQ = WS_MEMKV + (size_t)MROWS * 2048 * 2;
constexpr size_t WS_SSQKV = WS_SSQQ + (size_t)M * 12 * 4;
constexpr size_t WS_QX = WS_SSQKV + (size_t)M * 8 * 4;
constexpr size_t WS_OX = WS_QX + (size_t)M * 512 * 2;
constexpr size_t WS_FL = WS_OX + (size_t)M * 512 * 2;
constexpr size_t WS_DEC = WS_FL + (size_t)M * 16 * 4;
constexpr size_t WS_TOPE = WS_DEC + (size_t)M * 16 * 4;
constexpr size_t WS_TOPS = WS_TOPE + (size_t)M * 2 * 4;
constexpr size_t WS_TOPG = WS_TOPS + (size_t)M * 2 * 4;
constexpr size_t WS_RSTDF = WS_TOPG + (size_t)M * 2 * 4;
constexpr size_t WS_TOKPOS = WS_RSTDF + (size_t)M * 4;
constexpr size_t WS_ROWIDX = WS_TOKPOS + (size_t)M * 2 * 4;
constexpr size_t WS_GATEP = WS_ROWIDX + (size_t)MOE_MAX_ROWS * 4;
constexpr size_t WS_RSTDP = WS_GATEP + (size_t)MOE_MAX_ROWS * 4;
constexpr size_t WS_BIAST = WS_RSTDP + (size_t)MOE_MAX_ROWS * 4;
constexpr size_t WS_ARENA = al256(WS_BIAST + 16 * 128 * 4);
constexpr size_t AR_Z0 = 0;
constexpr size_t AR_QM = AR_Z0 + (size_t)M * Z0_LD * 2;
constexpr size_t AR_KM = AR_QM + (size_t)M * QM_LD * 2;
constexpr size_t AR_VM = AR_KM + (size_t)M * KM_LD * 2;
constexpr size_t AR_O0 = AR_VM + (size_t)M * VM_LD * 2;
constexpr size_t AR_END0 = AR_O0 + (size_t)M * DM * 2;
constexpr size_t AR_HID = 0;
constexpr size_t HID_BYTES = (size_t)CHUNK_ROWS * DFF * 2;
constexpr size_t AR_Y = AR_HID + 2 * HID_BYTES;
constexpr size_t AR_END2 = AR_Y + (size_t)MOE_MAX_ROWS * DM * 2;
constexpr size_t AR_Z1 = 0;
constexpr size_t AR_O1 = AR_Z1 + (size_t)M * Z1_LD * 2;
constexpr size_t AR_END1 = AR_O1 + (size_t)M * DM * 2;
constexpr size_t AR_SIZE = AR_END0 > AR_END1 ? (AR_END0 > AR_END2 ? AR_END0 : AR_END2) : (AR_END1 > AR_END2 ? AR_END1 : AR_END2);
constexpr size_t WS_END = WS_ARENA + AR_SIZE;

constexpr int CW_BAR = 4096;
constexpr int CW_CNT = 16384;
constexpr int CW_KMAX = 20480;
constexpr int CW_Q18 = 24576;
constexpr int CW_AMAX15 = 32768;
constexpr int CW_AMAX0 = 40960;
constexpr int CW_AMAXW = 131072;
static_assert((CW_AMAXW + 9 * 14336) * 4 <= (int)CTL_BYTES, "CTL map");

constexpr int RING_BYTES = 131072;
constexpr int MISC_OFF = RING_BYTES + 320;
constexpr int LDS_BYTES = 147456;
constexpr int NWAVES = 8;
#ifndef WGM_GU
#define WGM_GU 4
#endif
#ifndef WGM_K2048
#define WGM_K2048 4
#endif
#ifndef WGM_DOWN
#define WGM_DOWN 8
#endif

#define LDS_WAIT() asm volatile("s_waitcnt lgkmcnt(0)" ::: "memory")
#define VM_WAIT() asm volatile("s_waitcnt vmcnt(0)" ::: "memory")
#define RLX_AGENT __ATOMIC_RELAXED, __HIP_MEMORY_SCOPE_AGENT
__device__ __forceinline__ unsigned cvt_pk_bf16(float lo, float hi) { unsigned r; asm volatile("v_cvt_pk_bf16_f32 %0, %1, %2" : "=v"(r) : "v"(lo), "v"(hi)); return r; }
typedef _Float16 h16x2 __attribute__((ext_vector_type(2)));
typedef _Float16 h16x8 __attribute__((ext_vector_type(8)));
__device__ __forceinline__ unsigned pk_f16(float lo, float hi) { const h16x2 v = {(_Float16)lo, (_Float16)hi}; return __builtin_bit_cast(unsigned, v); }
__device__ __forceinline__ f32x2 unpk_f16(unsigned u) { const h16x2 v = __builtin_bit_cast(h16x2, u); return (f32x2){(float)v.x, (float)v.y}; }
__device__ __forceinline__ f32x4 unpk_f16x4(u32x2 u) { const f32x2 a = unpk_f16(u.x), b = unpk_f16(u.y); return (f32x4){a.x, a.y, b.x, b.y}; }
__device__ __forceinline__ u32x2 pack8_fp8(f32x4 a, f32x4 b) {
    int lo = 0, hi = 0;
    lo = __builtin_amdgcn_cvt_pk_fp8_f32(a[0], a[1], lo, false); lo = __builtin_amdgcn_cvt_pk_fp8_f32(a[2], a[3], lo, true);
    hi = __builtin_amdgcn_cvt_pk_fp8_f32(b[0], b[1], hi, false); hi = __builtin_amdgcn_cvt_pk_fp8_f32(b[2], b[3], hi, true);
    return (u32x2){(unsigned)lo, (unsigned)hi};
}
__device__ __forceinline__ float bf2f(unsigned short b) { return __uint_as_float((unsigned)b << 16); }
__device__ __forceinline__ float wave_sum(float v) {
#pragma unroll
    for (int o = 1; o < 64; o <<= 1) v += __shfl_xor(v, o);
    return v;
}

#define XB_TMO      128
#define XB_XCNT(j)  (256  + 64 * (j))
#define XB_XSUB(j)  (1280 + 64 * (j))
#define XB_XGEN(j)  (2304 + 64 * (j))
#define XB_TOP      3328
#define XB_TOPGEN   3392
#define XCD_BAR_WORDS 3456
#define XB_SPIN_CAP (1u << 18)
__device__ __forceinline__ unsigned xb_ld(unsigned* p)              { return __hip_atomic_load(p, __ATOMIC_RELAXED, __HIP_MEMORY_SCOPE_AGENT); }
__device__ __forceinline__ unsigned xb_add(unsigned* p, unsigned v) { return __hip_atomic_fetch_add(p, v, __ATOMIC_RELAXED, __HIP_MEMORY_SCOPE_AGENT); }
__device__ __forceinline__ unsigned xb_xcc_id() { return (unsigned)__builtin_amdgcn_s_getreg((3 << 11) | 20) & 0xFu; }
#define XB_SPIN(cond, bar) do { unsigned _sp = 0; while (cond) { __builtin_amdgcn_s_sleep(1); \
    if ((++_sp & 255u) == 0u) { if (xb_ld(&(bar)[XB_TMO])) break; if (_sp > XB_SPIN_CAP) { atomicAdd(&(bar)[XB_TMO], 1u); break; } } } } while (0)
struct XcdBarrier { unsigned* bar; unsigned x; volatile LAS unsigned* st; };
__device__ __forceinline__ XcdBarrier xcd_barrier_post(unsigned* bar, volatile LAS unsigned* st) {
    XcdBarrier b; b.bar = bar; b.x = xb_xcc_id(); b.st = st;
    if (threadIdx.x == 0) (void)xb_add(&bar[XB_XCNT(b.x)], 1u);
    return b;
}
__device__ __forceinline__ void xcd_barrier_complete(unsigned* bar, unsigned x, unsigned& nloc, unsigned& nx) {
    const unsigned G = gridDim.x * gridDim.y * gridDim.z;
    unsigned sum, cnt, mine, sp = 0u;
    for (;;) {
        sum = 0u; cnt = 0u; mine = 0u;
#pragma unroll
        for (unsigned j = 0; j < 16; ++j) { const unsigned c = xb_ld(&bar[XB_XCNT(j)]); sum += c; cnt += (c > 0u) ? 1u : 0u; mine = (j == x) ? c : mine; }
        if (sum == G) break;
        __builtin_amdgcn_s_sleep(1);
        if ((++sp & 255u) == 0u) { if (xb_ld(&bar[XB_TMO])) break; if (sp > XB_SPIN_CAP) { atomicAdd(&bar[XB_TMO], 1u); break; } }
    }
    nloc = mine > 0u ? mine : 1u; nx = cnt > 0u ? cnt : 1u;
}
__device__ __forceinline__ void xcd_barrier(const XcdBarrier& b) {
    asm volatile("s_waitcnt vmcnt(0)" ::: "memory");
    __syncthreads();
    if (threadIdx.x == 0) {
        unsigned* bar = b.bar;
        __builtin_amdgcn_s_waitcnt(0);
        unsigned nloc = b.st[0], nx = b.st[1];
        if (nloc == 0u) { xcd_barrier_complete(bar, b.x, nloc, nx); b.st[0] = nloc; b.st[1] = nx; }
        const unsigned old = xb_add(&bar[XB_XSUB(b.x)], 1u);
        const unsigned gen = old / nloc;
        if (old + 1u == (gen + 1u) * nloc) {
            __builtin_amdgcn_fence(__ATOMIC_RELEASE, "agent");
            asm volatile("s_waitcnt vmcnt(0)" ::: "memory");
            const unsigned og = xb_add(&bar[XB_TOP], 1u);
            const unsigned tg = og / nx;
            if (og + 1u == (tg + 1u) * nx) xb_add(&bar[XB_TOPGEN], 1u);
            else XB_SPIN(xb_ld(&bar[XB_TOPGEN]) == tg, bar);
            __builtin_amdgcn_fence(__ATOMIC_ACQUIRE, "agent");
            xb_add(&bar[XB_XGEN(b.x)], 1u);
            asm volatile("s_waitcnt vmcnt(0)" ::: "memory");
        } else {
            XB_SPIN(xb_ld(&bar[XB_XGEN(b.x)]) == gen, bar);
            __builtin_amdgcn_fence(__ATOMIC_ACQUIRE, "agent");
            asm volatile("s_waitcnt vmcnt(0)" ::: "memory");
        }
    }
    __syncthreads();
}

namespace pg8 {
constexpr int BM = 256, BK = 64, HALF = 128, HTB = HALF * BK * 2, STAGE_BYTES = 8 * HTB, NXCD = 8, WGM = 8;
__host__ __device__ __forceinline__ int lds_byte(int r, int c) { const int st = (r >> 4) * 2 + (c >> 5), rr = r & 15, cc = c & 31, ob = rr * 64 + cc * 2; return st * 1024 + (ob ^ (((ob >> 9) & 1) << 5)); }
__host__ __device__ __forceinline__ void stage_rc(int b, int& R, int& C) { const int st = b / 1024, sb = b % 1024, swz = sb ^ (((sb >> 9) & 1) << 5); R = (st >> 1) * 16 + swz / 64; C = (st & 1) * 32 + (swz % 64) / 2; }
__host__ __device__ __forceinline__ int perm32(int rho) { const int n = rho >> 4, i = rho & 15; return 8 * (i >> 2) + 4 * n + (i & 3); }
struct Unit { int pm, pn; };
struct StaticOrder {
    int nM, nN, nwg, G, c, pm0, nd, qd, wgm;
    __device__ __forceinline__ void init(int nM_, int nN_, int G_, int c_, int pm0_, int wgm_ = WGM) { nM = nM_; nN = nN_; nwg = nM * nN; G = G_; c = c_; pm0 = pm0_; nd = 0; qd = 0; wgm = wgm_; }
    __device__ __forceinline__ void quota(int nd_) { nd = nd_ < G ? nd_ : 0; if (nd_ >= G) return; const int q = (nwg + 5 * nd + G - 1) / G; qd = q > 5 ? q - 5 : 0; }
    __device__ __forceinline__ bool next(int i, Unit& u) const {
        long L;
        if (nd == 0) L = (long)i * G + c;
        else if (c < nd) { if (i >= qd) return false; L = (long)i * G + c; }
        else L = i < qd ? (long)i * G + c : (long)qd * G + (long)(i - qd) * (G - nd) + (c - nd);
        if (L >= nwg) return false;
        int wgid = (int)L; { const int q = nwg / NXCD, r = nwg % NXCD, xcd = wgid % NXCD, off = wgid / NXCD; wgid = (xcd < r ? xcd * (q + 1) : r * (q + 1) + (xcd - r) * q) + off; }
        const int nig = wgm * nN, gid = wgid / nig, fm = gid * wgm, gsz = (nM - fm) < wgm ? (nM - fm) : wgm;
        u.pm = pm0 + fm + ((wgid % nig) % gsz); u.pn = (wgid % nig) / gsz; return true;
    }
};
struct PolPlain {
    const char* A; unsigned lda2; const char* B; unsigned ldb2; int K;
    __device__ __forceinline__ size_t kstepA() const { return 128; }
    __device__ __forceinline__ size_t kstepB() const { return 128; }
    __device__ __forceinline__ unsigned a_off(const Unit& u, int h, int R, int C) const { return (unsigned)(u.pm * BM + h * HALF + R) * lda2 + (unsigned)C * 2u; }
    __device__ __forceinline__ const char* b_ptr(const Unit& u) const { return B + (size_t)u.pn * BM * ldb2; }
};
struct PolMoeUp {
    const char* A; unsigned lda2; const char* B; unsigned ldb2; int K; const int* rowidx; const LAS int* tile_e; size_t estride;
    __device__ __forceinline__ size_t kstepA() const { return 128; }
    __device__ __forceinline__ size_t kstepB() const { return 128; }
    __device__ __forceinline__ unsigned a_off(const Unit& u, int h, int R, int C) const { return (unsigned)rowidx[u.pm * BM + h * HALF + R] * lda2 + (unsigned)C * 2u; }
    __device__ __forceinline__ const char* b_ptr(const Unit& u) const { return B + (size_t)tile_e[u.pm] * estride + (size_t)u.pn * BM * ldb2; }
};
struct PolMoeDown {
    const char* A; unsigned lda2; const char* B; unsigned ldb2; int K; int pmc0; const LAS int* tile_e; size_t estride;
    __device__ __forceinline__ size_t kstepA() const { return (size_t)MCH_ROWS * 128; }
    __device__ __forceinline__ size_t kstepB() const { return (size_t)DM * 128; }
    __device__ __forceinline__ unsigned a_off(const Unit& u, int h, int R, int C) const { return (unsigned)((u.pm - pmc0) * BM + h * HALF + R) * 128u + (unsigned)C * 2u; }
    __device__ __forceinline__ const char* b_ptr(const Unit& u) const { return B + (size_t)tile_e[u.pm] * estride + (size_t)u.pn * BM * 128; }
};
struct PolChunkA {
    const char* A; unsigned lda2; const char* B; unsigned ldb2; int K; int pmc0;
    __device__ __forceinline__ size_t kstepA() const { return (size_t)CHUNK_ROWS * 128; }
    __device__ __forceinline__ size_t kstepB() const { return (size_t)DM * 128; }
    __device__ __forceinline__ unsigned a_off(const Unit& u, int h, int R, int C) const { return (unsigned)((u.pm - pmc0) * BM + h * HALF + R) * 128u + (unsigned)C * 2u; }
    __device__ __forceinline__ const char* b_ptr(const Unit& u) const { return B + (size_t)u.pn * BM * 128; }
};

template <int I8> struct AccT { typedef f32x4 type; };
template <> struct AccT<1> { typedef i32x4 type; };
template <class Epi, class Pol, int I8 = 0>
__device__ __forceinline__ void gemm_phase(LAS unsigned char* lds, const Pol& P, const StaticOrder& S, const Epi& E) {
    typedef typename AccT<I8>::type acc_t;
    int tid_ = threadIdx.x; asm volatile("" : "+v"(tid_));
    const int tid = tid_, wid = __builtin_amdgcn_readfirstlane(tid >> 6), lane = tid & 63, wr = wid >> 2, wc = wid & 3, fr = lane & 15, fq = lane >> 4;
    const int K = P.K, nt = K / BK;
    int sR[2], sC[2]; unsigned voffB[2];
#pragma unroll
    for (int i = 0; i < 2; ++i) { int R, C; stage_rc(tid * 16 + i * 8192, R, C); sR[i] = R; sC[i] = C; const int Rb = (R & ~31) + perm32(R & 31); voffB[i] = (unsigned)Rb * P.ldb2 + (unsigned)C * 2u; }
    const size_t kstepA = P.kstepA(), kstepB = P.kstepB();
    const size_t hstepB = (size_t)HALF * P.ldb2;
    const unsigned ldsw = (unsigned)wid * 1024u;
    const int aoff = lds_byte(wr * 64 + fr, fq * 8), boff = lds_byte(wc * 32 + fr, fq * 8);
#define PG8_SA(b, h) (((b) * 2 + (h)) * HTB)
#define PG8_SB(b, h) ((4 + (b) * 2 + (h)) * HTB)
#define PG8_STAGE(bufoff, gbase, voff) do { _Pragma("unroll") for (int _i = 0; _i < 2; ++_i) \
        __builtin_amdgcn_global_load_lds((const unsigned*)((const char*)(gbase) + (voff)[_i]), (LAS unsigned*)(lds + (bufoff) + ldsw + _i * 8192), 16, 0, 0); } while (0)
#define PG8_LDA(dst, b, h) do { _Pragma("unroll") for (int m = 0; m < 4; ++m) _Pragma("unroll") for (int k = 0; k < 2; ++k) dst[m][k] = *(const LAS bf16x8*)(lds + PG8_SA(b, h) + aoff + m * 2048 + k * 1024); } while (0)
#define PG8_LDB(dst, b, h) do { _Pragma("unroll") for (int n = 0; n < 2; ++n) _Pragma("unroll") for (int k = 0; k < 2; ++k) dst[n][k] = *(const LAS bf16x8*)(lds + PG8_SB(b, h) + boff + n * 2048 + k * 1024); } while (0)
#define PG8_MMA(ai, bj, At, Bt) do { __builtin_amdgcn_s_setprio(1); _Pragma("unroll") for (int m = 0; m < 4; ++m) _Pragma("unroll") for (int n = 0; n < 2; ++n) _Pragma("unroll") for (int k = 0; k < 2; ++k) \
        { if constexpr (I8 == 1) acc[ai][bj][m][n] = __builtin_amdgcn_mfma_i32_16x16x64_i8(__builtin_bit_cast(i32x4, Bt[n][k]), __builtin_bit_cast(i32x4, At[m][k]), acc[ai][bj][m][n], 0, 0, 0); \
          else if constexpr (I8 == 4) { const i64x2 b_ = __builtin_bit_cast(i64x2, Bt[n][k]), a_ = __builtin_bit_cast(i64x2, At[m][k]); \
              acc[ai][bj][m][n] = __builtin_amdgcn_mfma_f32_16x16x32_fp8_fp8(b_[0], a_[0], acc[ai][bj][m][n], 0, 0, 0); acc[ai][bj][m][n] = __builtin_amdgcn_mfma_f32_16x16x32_fp8_fp8(b_[1], a_[1], acc[ai][bj][m][n], 0, 0, 0); } \
          else if constexpr (I8 == 3) acc[ai][bj][m][n] = __builtin_amdgcn_mfma_f32_16x16x32_f16(__builtin_bit_cast(h16x8, Bt[n][k]), __builtin_bit_cast(h16x8, At[m][k]), acc[ai][bj][m][n], 0, 0, 0); \
          else acc[ai][bj][m][n] = __builtin_amdgcn_mfma_f32_16x16x32_bf16(Bt[n][k], At[m][k], acc[ai][bj][m][n], 0, 0, 0); } __builtin_amdgcn_s_setprio(0); } while (0)
#define PG8_WAIT_V(n) asm volatile("s_waitcnt vmcnt(" #n ")" ::: "memory")
#define PG8_WAIT_L(n) asm volatile("s_waitcnt lgkmcnt(" #n ")" ::: "memory")
#define PG8_BAR __builtin_amdgcn_s_barrier()
#define PG8_SCHED __builtin_amdgcn_sched_barrier(0)
    Unit cur, nxt; int ui = 0;
    if (!S.next(0, cur)) return;
    LAS unsigned char* sl_ = lds + RING_BYTES + 4096;
#define PG8_SCALES(u_, slot) do { if constexpr (Epi::LDS_SCALES) { \
        if (wid == 0) __builtin_amdgcn_global_load_lds((const unsigned*)(E.row_src(u_)) + lane * 4, (LAS unsigned*)(sl_ + (slot) * 2048), 16, 0, 0); \
        else if (wid == 1) __builtin_amdgcn_global_load_lds((const unsigned*)(E.col_src(u_)) + lane * 4, (LAS unsigned*)(sl_ + (slot) * 2048 + 1024), 16, 0, 0); } } while (0)
    PG8_SCALES(cur, 0);
    acc_t acc[2][2][4][2];
#pragma unroll
    for (int a = 0; a < 2; ++a)
#pragma unroll
        for (int b = 0; b < 2; ++b)
#pragma unroll
            for (int m = 0; m < 4; ++m)
#pragma unroll
                for (int n = 0; n < 2; ++n) acc[a][b][m][n] = acc_t{};
    bf16x8 At[4][2], B0[2][2], B1[2][2];
    unsigned vC0[2], vC1[2], vN0[2], vN1[2];
#pragma unroll
    for (int i = 0; i < 2; ++i) { vC0[i] = P.a_off(cur, 0, sR[i], sC[i]); vC1[i] = P.a_off(cur, 1, sR[i], sC[i]); }
    const char* Ab = P.A; const char* cB = P.b_ptr(cur);
    PG8_STAGE(PG8_SB(0, 0), cB, voffB); PG8_STAGE(PG8_SB(0, 1), cB + hstepB, voffB); PG8_STAGE(PG8_SA(0, 0), Ab, vC0); PG8_STAGE(PG8_SA(0, 1), Ab, vC1);
    if (wr == 1) PG8_BAR;
    PG8_WAIT_V(2); PG8_BAR;
    PG8_STAGE(PG8_SB(1, 0), cB + kstepB, voffB); PG8_STAGE(PG8_SA(1, 0), Ab + kstepA, vC0); PG8_STAGE(PG8_SB(1, 1), cB + hstepB + kstepB, voffB);
    PG8_WAIT_V(6); PG8_BAR;
    for (;;) {
        const bool has_next = S.next(ui + 1, nxt);
        const char* nB = cB;
#pragma unroll
        for (int i = 0; i < 2; ++i) { vN0[i] = vC0[i]; vN1[i] = vC1[i]; }
        if (has_next) { nB = P.b_ptr(nxt);
#pragma unroll
            for (int i = 0; i < 2; ++i) { vN0[i] = P.a_off(nxt, 0, sR[i], sC[i]); vN1[i] = P.a_off(nxt, 1, sR[i], sC[i]); } }
        int tsc_ = 4; asm volatile("" : "+s"(tsc_));
#pragma unroll 1
        for (int t = 0; t < nt; t += 2) {
            const bool last = (t == nt - 2);
            if (t == tsc_ && has_next) PG8_SCALES(nxt, (ui + 1) & 1);
            const char* a1 = Ab + (size_t)(t + 1) * kstepA;
            const char* a2 = last ? Ab : Ab + (size_t)(t + 2) * kstepA; const char* b2 = last ? nB : cB + (size_t)(t + 2) * kstepB;
            const char* a3 = a2 + kstepA; const char* b3 = b2 + kstepB;
            unsigned v20[2], v21[2];
#pragma unroll
            for (int i = 0; i < 2; ++i) { v20[i] = last ? vN0[i] : vC0[i]; v21[i] = last ? vN1[i] : vC1[i]; }
            PG8_LDB(B0, 0, 0); PG8_LDB(B1, 0, 1); PG8_SCHED; PG8_LDA(At, 0, 0); PG8_STAGE(PG8_SA(1, 1), a1, vC1);
            PG8_WAIT_V(8); PG8_WAIT_L(0); PG8_BAR; PG8_MMA(0, 0, At, B0); PG8_MMA(0, 1, At, B1); PG8_BAR; PG8_SCHED;
            PG8_LDA(At, 0, 1); PG8_STAGE(PG8_SB(0, 0), b2, voffB); PG8_STAGE(PG8_SB(0, 1), b2 + hstepB, voffB); PG8_STAGE(PG8_SA(0, 0), a2, v20);
            PG8_WAIT_V(8); PG8_WAIT_L(0); PG8_BAR; PG8_MMA(1, 0, At, B0); PG8_MMA(1, 1, At, B1); PG8_BAR; PG8_SCHED;
            PG8_LDB(B0, 1, 0); PG8_LDB(B1, 1, 1); PG8_SCHED; PG8_LDA(At, 1, 0); PG8_STAGE(PG8_SA(0, 1), a2, v21);
            PG8_WAIT_V(8); PG8_WAIT_L(0); PG8_BAR; PG8_MMA(0, 0, At, B0); PG8_MMA(0, 1, At, B1); PG8_BAR; PG8_SCHED;
            PG8_LDA(At, 1, 1); PG8_STAGE(PG8_SB(1, 0), b3, voffB); PG8_STAGE(PG8_SB(1, 1), b3 + hstepB, voffB); PG8_STAGE(PG8_SA(1, 0), a3, v20);
            PG8_WAIT_V(8); PG8_WAIT_L(0); PG8_BAR; PG8_MMA(1, 0, At, B0); PG8_MMA(1, 1, At, B1); PG8_BAR; PG8_SCHED;
        }
        if (wr == 0) PG8_BAR;
        E(acc, cur, wr, wc, fr, fq, (const LAS unsigned char*)(sl_ + (ui & 1) * 2048));
        if (!has_next) break;
#pragma unroll
        for (int a = 0; a < 2; ++a)
#pragma unroll
            for (int b = 0; b < 2; ++b)
#pragma unroll
                for (int m = 0; m < 4; ++m)
#pragma unroll
                    for (int n = 0; n < 2; ++n) acc[a][b][m][n] = acc_t{};
        cur = nxt; cB = nB; ++ui;
#pragma unroll
        for (int i = 0; i < 2; ++i) { vC0[i] = vN0[i]; vC1[i] = vN1[i]; }
        if (wr == 1) PG8_BAR;
    }
    PG8_WAIT_V(0);
    PG8_BAR;
#undef PG8_SA
#undef PG8_SB
#undef PG8_STAGE
#undef PG8_SCALES
#undef PG8_LDA
#undef PG8_LDB
#undef PG8_MMA
#undef PG8_WAIT_V
#undef PG8_WAIT_L
#undef PG8_BAR
#undef PG8_SCHED
}

__device__ __forceinline__ float row_rstd(const float* ssq, int row, int nparts, float inv_n) {
    const f32x4* p = (const f32x4*)(ssq + (size_t)row * nparts); f32x4 s = p[0];
    for (int i = 1; i < nparts / 4; ++i) s += p[i];
    return __builtin_amdgcn_rsqf(((s[0] + s[1]) + (s[2] + s[3])) * inv_n + EPS);
}
template <int NP>
__device__ __forceinline__ void wave_row_rstd(const float* ssq, float inv_n, int rowbase, int wr, int wid, int fr, LAS float* xl, float (&rs)[8]) {
    const int lane = threadIdx.x & 63; LAS float* wl = xl + wid * 128;
    f32x4 sa = (f32x4){0.f, 0.f, 0.f, 0.f}, sb = sa;
    const f32x4* pa = (const f32x4*)(ssq + (size_t)(rowbase + wr * 64 + lane) * NP); const f32x4* pb = (const f32x4*)(ssq + (size_t)(rowbase + HALF + wr * 64 + lane) * NP);
#pragma unroll
    for (int i = 0; i < NP / 4; ++i) { sa += pa[i]; sb += pb[i]; }
    wl[lane] = __builtin_amdgcn_rsqf(((sa[0] + sa[1]) + (sa[2] + sa[3])) * inv_n + EPS);
    wl[64 + lane] = __builtin_amdgcn_rsqf(((sb[0] + sb[1]) + (sb[2] + sb[3])) * inv_n + EPS);
    asm volatile("s_waitcnt lgkmcnt(0)" ::: "memory");
#pragma unroll
    for (int ai = 0; ai < 2; ++ai)
#pragma unroll
        for (int m = 0; m < 4; ++m) rs[ai * 4 + m] = wl[ai * 64 + 16 * m + fr];
    asm volatile("s_waitcnt lgkmcnt(0)" ::: "memory");
}
__device__ __forceinline__ void rope8(f32x4& v0, f32x4& v1, const float* tab  ) {
    const f32x4 t0 = *(const f32x4*)tab, t1 = *(const f32x4*)(tab + 4);
    f32x4 a = v0, b = v1;
    v0[0] = a[0] * t0[0] - a[1] * t0[1]; v0[1] = a[1] * t0[0] + a[0] * t0[1]; v0[2] = a[2] * t0[2] - a[3] * t0[3]; v0[3] = a[3] * t0[2] + a[2] * t0[3];
    v1[0] = b[0] * t1[0] - b[1] * t1[1]; v1[1] = b[1] * t1[0] + b[0] * t1[1]; v1[2] = b[2] * t1[2] - b[3] * t1[3]; v1[3] = b[3] * t1[2] + b[2] * t1[3];
}
__device__ __forceinline__ u32x4 pack8(f32x4 v0, f32x4 v1) { u32x4 w; w.x = cvt_pk_bf16(v0[0], v0[1]); w.y = cvt_pk_bf16(v0[2], v0[3]); w.z = cvt_pk_bf16(v1[0], v1[1]); w.w = cvt_pk_bf16(v1[2], v1[3]); return w; }
__device__ __forceinline__ float sq8(f32x4 v0, f32x4 v1) { return (v0[0] * v0[0] + v0[1] * v0[1]) + (v0[2] * v0[2] + v0[3] * v0[3]) + (v1[0] * v1[0] + v1[1] * v1[1]) + (v1[2] * v1[2] + v1[3] * v1[3]); }

__device__ __forceinline__ f32x4 acc_f(const f32x4& a) { return a; }
__device__ __forceinline__ f32x4 acc_f(const i32x4& a) { return __builtin_convertvector(a, f32x4); }
template <int MODE, int NP> struct EpiStore {
    bf16_t* O; int ldc; const float* ssq; LAS float* xl; float inv_n;
    const float* rope; float* ssq_q; float* ssq_kv;
    bf16_t* O2; const bf16_t* Zsrc; float* Flog;
    const float* rowf; const unsigned* cmax;
    static constexpr bool LDS_SCALES = (MODE == 1 || MODE == 4);
    __device__ __forceinline__ const float* row_src(const Unit& u) const { return rowf + u.pm * BM; }
    __device__ __forceinline__ const unsigned* col_src(const Unit& u) const { return cmax + u.pn * BM; }
    template <class ACC>
    __device__ __forceinline__ void operator()(const ACC (&acc)[2][2][4][2], const Unit& u, int wr, int wc, int fr, int fq, const LAS unsigned char* lsc) const {
        const int row0 = u.pm * BM + wr * 64 + fr;
        float rs8[8];
        const LAS unsigned* cp = (const LAS unsigned*)(lsc + 1024) + wc * 32 + 8 * fq; const LAS float* rp = (const LAS float*)lsc + wr * 64 + fr;
        if (!LDS_SCALES) wave_row_rstd<NP>(ssq, inv_n, u.pm * BM, wr, wr * 4 + wc, fr, xl, rs8);
#pragma unroll
        for (int ai = 0; ai < 2; ++ai)
#pragma unroll
            for (int m = 0; m < 4; ++m) {
                const int row = row0 + ai * HALF + m * 16;
                const float rs = LDS_SCALES ? rp[ai * HALF + m * 16] * (1.f / 127.f) : rs8[ai * 4 + m];
                float sq = 0.f;
#pragma unroll
                for (int bj = 0; bj < 2; ++bj) {
                    const int col = u.pn * BM + bj * HALF + wc * 32 + 8 * fq;
                    f32x4 v0 = acc_f(acc[ai][bj][m][0]) * rs, v1 = acc_f(acc[ai][bj][m][1]) * rs;
                    if (LDS_SCALES) { const u32x4 c0 = *(const LAS u32x4*)(cp + bj * HALF), c1 = *(const LAS u32x4*)(cp + bj * HALF + 4);
                        v0 *= (f32x4){__uint_as_float(c0.x), __uint_as_float(c0.y), __uint_as_float(c0.z), __uint_as_float(c0.w)};
                        v1 *= (f32x4){__uint_as_float(c1.x), __uint_as_float(c1.y), __uint_as_float(c1.z), __uint_as_float(c1.w)}; }
                    if (MODE == 1) { if (col >= 1280 && col < 1344) rope8(v0, v1, rope + (size_t)row * 64 + (col - 1280)); sq += sq8(v0, v1); }
                    if (MODE == 2) { const int w = col % 192; if (w >= 128) rope8(v0, v1, rope + (size_t)row * 64 + (w - 128)); }
                    if (MODE == 3) {
                        if (bj == 0) *(u32x4*)(O + (size_t)row * KM_LD + u.pn * 192 + wc * 32 + 8 * fq) = pack8(v0, v1);
                        else *(u32x4*)(O2 + (size_t)row * VM_LD + u.pn * 128 + wc * 32 + 8 * fq) = pack8(v0, v1);
                    } else if (MODE == 4) {
                        if (u.pn < 24) *(u32x4*)(O + (size_t)row * ldc + col) = pack8(v0, v1);
                        else if (bj == 0 && wc == 0 && fq < 2) { *(f32x4*)(Flog + (size_t)row * 16 + 8 * fq) = v0; *(f32x4*)(Flog + (size_t)row * 16 + 8 * fq + 4) = v1; }
                    } else *(u32x4*)(O + (size_t)row * ldc + col) = pack8(v0, v1);
                }
                if (MODE == 1 && u.pn < 5) {
                    sq += __shfl_xor(sq, 16); sq += __shfl_xor(sq, 32);
                    if (fq == 0) { if (u.pn < 3) ssq_q[(size_t)row * 12 + u.pn * 4 + wc] = sq; else ssq_kv[(size_t)row * 8 + (u.pn - 3) * 4 + wc] = sq; }
                }
                asm volatile("" ::: "memory");
            }
        if (MODE == 3) {
            const int tid = (wr * 4 + wc) * 64 + fq * 16 + fr;
#pragma unroll
            for (int i = 0; i < 4; ++i) { const int idx = tid + 512 * i, r = idx >> 3, c = idx & 7; const size_t row = (size_t)u.pm * BM + r;
                *(u32x4*)(O + row * KM_LD + u.pn * 192 + 128 + c * 8) = *(const u32x4*)(Zsrc + row * Z0_LD + 1280 + c * 8); }
        }
    }
};
template <bool BF32> struct EpiRes {
    const void* base; unsigned short* out; float* ssq; float sc = 1.f;
    static constexpr bool LDS_SCALES = false;
    __device__ __forceinline__ void operator()(const f32x4 (&acc)[2][2][4][2], const Unit& u, int wr, int wc, int fr, int fq, const LAS unsigned char*) const {
        const int row0 = u.pm * BM + wr * 64 + fr; const int colb = u.pn * BM + wc * 32 + 8 * fq;
        f32x4 bA[2][2], bB[2][2];
#define ER_LOAD(dst, i) do { const size_t off_ = (size_t)(row0 + ((i) >> 2) * HALF + ((i) & 3) * 16) * DM + colb; \
        _Pragma("unroll") for (int bj = 0; bj < 2; ++bj) { \
            if constexpr (BF32) { dst[bj][0] = *(const f32x4*)((const float*)base + off_ + bj * HALF); dst[bj][1] = *(const f32x4*)((const float*)base + off_ + bj * HALF + 4); } \
            else { const u32x4 h_ = *(const u32x4*)((const unsigned short*)base + off_ + bj * HALF); dst[bj][0] = unpk_f16x4((u32x2){h_.x, h_.y}); dst[bj][1] = unpk_f16x4((u32x2){h_.z, h_.w}); } } } while (0)
#define ER_DO(src, i) do { const int ai = (i) >> 2, m = (i) & 3; const int row = row0 + ai * HALF + m * 16; float sq = 0.f; \
        _Pragma("unroll") for (int bj = 0; bj < 2; ++bj) { const size_t off = (size_t)row * DM + colb + bj * HALF; \
            const f32x4 v0 = acc[ai][bj][m][0] * sc + src[bj][0], v1 = acc[ai][bj][m][1] * sc + src[bj][1]; \
            u32x4 w_; w_.x = pk_f16(v0[0], v0[1]); w_.y = pk_f16(v0[2], v0[3]); w_.z = pk_f16(v1[0], v1[1]); w_.w = pk_f16(v1[2], v1[3]); \
            *(u32x4*)(out + off) = w_; sq += sq8(v0, v1); } \
        if (ssq) { sq += __shfl_xor(sq, 16); sq += __shfl_xor(sq, 32); if (fq == 0) ssq[(size_t)row * 32 + u.pn * 4 + wc] = sq; } } while (0)
        ER_LOAD(bA, 0); asm volatile("" ::: "memory");
#pragma unroll
        for (int i = 0; i < 8; i += 2) {
            ER_LOAD(bB, i + 1); asm volatile("" ::: "memory");
            ER_DO(bA, i); asm volatile("" ::: "memory");
            if (i + 2 < 8) { ER_LOAD(bA, i + 2); asm volatile("" ::: "memory"); }
            ER_DO(bB, i + 1); asm volatile("" ::: "memory");
        }
#undef ER_LOAD
#undef ER_DO
    }
};
template <int RS> struct EpiSwiGLU {
    bf16_t* H; int row_base; const float* ssq; const float* rsp; const unsigned* cmax; const LAS int* tile_e; int f8 = 0;
    static constexpr bool LDS_SCALES = (RS == 2);
    __device__ __forceinline__ const float* row_src(const Unit& u) const { return rsp + u.pm * BM; }
    __device__ __forceinline__ const unsigned* col_src(const Unit& u) const { return cmax + (size_t)(tile_e ? tile_e[u.pm] : 0) * (2 * DFF) + u.pn * BM; }
    template <class ACC>
    __device__ __forceinline__ void operator()(const ACC (&acc)[2][2][4][2], const Unit& u, int wr, int wc, int fr, int fq, const LAS unsigned char* lsc) const {
        const int row0 = u.pm * BM + wr * 64 + fr;
        f32x4 sg[2], su[2];
        if (RS == 2) { const LAS unsigned* cp = (const LAS unsigned*)(lsc + 1024) + wc * 32 + 8 * fq;
#pragma unroll
            for (int n = 0; n < 2; ++n) { const u32x4 a = *(const LAS u32x4*)(cp + 4 * n), b = *(const LAS u32x4*)(cp + HALF + 4 * n);
#pragma unroll
                for (int j = 0; j < 4; ++j) { sg[n][j] = __uint_as_float(a[j]) * (1.f / 127.f); su[n][j] = __uint_as_float(b[j]) * (1.f / 127.f); } } }
        float rs8[8];
#pragma unroll
        for (int i = 0; i < 8; ++i) { const int row = row0 + (i >> 2) * HALF + (i & 3) * 16;
            if (RS == 2) rs8[i] = ((const LAS float*)lsc)[wr * 64 + fr + (i >> 2) * HALF + (i & 3) * 16]; else rs8[i] = RS == 0 ? row_rstd(ssq, row, 32, 1.f / DM) : rsp[row]; }
#pragma unroll
        for (int ai = 0; ai < 2; ++ai)
#pragma unroll
            for (int m = 0; m < 4; ++m) {
                const int row = row0 + ai * HALF + m * 16;
                const float rs = rs8[ai * 4 + m];
                f32x4 o[2];
#pragma unroll
                for (int n = 0; n < 2; ++n) { f32x4 g = acc_f(acc[ai][0][m][n]) * rs, up = acc_f(acc[ai][1][m][n]) * rs;
                    if (RS == 2) { g *= sg[n]; up *= su[n]; }
#pragma unroll
                    for (int j = 0; j < 4; ++j) o[n][j] = g[j] * __builtin_amdgcn_rcpf(1.f + __builtin_amdgcn_exp2f(-LOG2E * g[j])) * up[j]; }
                if (RS == 2 && f8) {
                    _Pragma("unroll") for (int n = 0; n < 2; ++n) _Pragma("unroll") for (int j = 0; j < 4; ++j) o[n][j] = __builtin_amdgcn_fmed3f(o[n][j], -448.f, 448.f);
                    *(u32x2*)((unsigned char*)H + ((size_t)u.pn * MCH_ROWS + (row - row_base)) * 128 + wc * 32 + 8 * fq) = pack8_fp8(o[0], o[1]);
                } else
                *(u32x4*)(H + ((size_t)(u.pn * 2 + (wc >> 1)) * CHUNK_ROWS + (row - row_base)) * 64 + (wc & 1) * 32 + 8 * fq) = pack8(o[0], o[1]);
                asm volatile("" ::: "memory");
            }
    }
};
struct EpiMoeDown {
    bf16_t* Y; const float* gate;
    static constexpr bool LDS_SCALES = false;
    __device__ __forceinline__ void operator()(const f32x4 (&acc)[2][2][4][2], const Unit& u, int wr, int wc, int fr, int fq, const LAS unsigned char*) const {
        const int row0 = u.pm * BM + wr * 64 + fr;
        float g8[8];
#pragma unroll
        for (int i = 0; i < 8; ++i) g8[i] = gate[row0 + (i >> 2) * HALF + (i & 3) * 16] * (1.f / 64.f);
#pragma unroll
        for (int ai = 0; ai < 2; ++ai)
#pragma unroll
            for (int m = 0; m < 4; ++m) {
                const int row = row0 + ai * HALF + m * 16; const float g = g8[ai * 4 + m];
#pragma unroll
                for (int bj = 0; bj < 2; ++bj) *(u32x4*)(Y + (size_t)row * DM + u.pn * BM + bj * HALF + wc * 32 + 8 * fq) = pack8(acc[ai][bj][m][0] * g, acc[ai][bj][m][1] * g);
                asm volatile("" ::: "memory");
            }
    }
};
}

namespace fa {
#define SBAR() __builtin_amdgcn_sched_barrier(0)
template <int NDV> __device__ __forceinline__ int v_st(int k, int c) { const int kk = (k & ~0xC) | ((k & 4) << 1) | ((k & 8) >> 1); return ((kk >> 3) * NDV + (c >> 5)) * 512 + ((kk & 7) * 32 + (c & 31)) * 2; }
__device__ __forceinline__ int v_rd_base(int lane) { return ((lane & 3) << 3) | (((lane >> 2) & 3) << 6) | (((lane >> 4) & 1) << 5) | (((lane >> 5) & 1) << 8); }
__device__ __forceinline__ int crow(int r, int hi) { return (r & 3) + 8 * (r >> 2) + 4 * hi; }
__device__ __forceinline__ void mask_tile(f32x16& p0, f32x16& p1, int dq, unsigned W) {
    const float NEG = -__builtin_inff();
#pragma unroll
    for (int r = 0; r < 16; ++r) {
        const int c = (r & 3) + 8 * (r >> 2);
        if ((unsigned)(dq - c) >= W) p0[r] = NEG;
        if ((unsigned)(dq - c - 32) >= W) p1[r] = NEG;
    }
}
struct AttnArgs {
    const bf16_t* Q; int ldq; const bf16_t* K; int ldk; const bf16_t* V; int ldv; bf16_t* O; int ldo;
    int q0, j_lo, j_hi, W;
    const float* dec;
    float sinkl; const float* biasT;
    const float* sinks;
    float kmax;
};
template <int DK, int DV, int MODE>
__device__ __forceinline__ void attn_unit(const AttnArgs& a, LAS char* lds) {
    constexpr int KROWB = DK * 2 + 16  , SHM_K = 64 * KROWB, SHM_V = 64 * DV * 2, NDK = DK / 16, NDV = DV / 32, KCH = DK / 8, VCH = DV / 8, KPT = KCH * 64 / 512, VPT = VCH * 64 / 512;
    constexpr int RB = NDV * 512;
    constexpr float THR = 8.f;
    int tid_ = threadIdx.x; asm volatile("" : "+v"(tid_));
    const int tid = tid_, wid = __builtin_amdgcn_readfirstlane(tid >> 6), lane = tid & 63, r32 = lane & 31, hi = lane >> 5;
    LAS char* V_lds = lds; LAS char* K_lds = lds + 2 * SHM_V;
    LAS float* dec_l = (LAS float*)(K_lds + 2 * SHM_K);
    LAS float* ws = dec_l + 128 + wid * 64;
    LAS float* bias_l = dec_l + 128 + 512 + ((MODE == 2) ? wid * 128 : 0);
    const int NT = a.j_hi - a.j_lo;
    const int qlo = (MODE == 2) ? a.q0 : a.q0 + wid * 32, qpos = qlo + r32;
    const int hoff = (MODE == 2) ? wid * 64 : 0;
    static_assert(KPT == KCH / 8 && VPT == VCH / 8, "staging map");
    const int srow_ = tid >> 3, scg_ = tid & 7;
    const int kws0 = srow_ * KROWB + scg_ * 16, vws0 = v_st<NDV>(srow_, scg_ * 8);
    const unsigned ksrc0 = (unsigned)(srow_ * a.ldk + scg_ * 8) * 2u, vsrc0 = (unsigned)(srow_ * a.ldv + scg_ * 8) * 2u;
    bf16x8 qr[NDK];
#pragma unroll
    for (int d0 = 0; d0 < NDK; ++d0) qr[d0] = *(const bf16x8*)(a.Q + (size_t)qpos * a.ldq + hoff + d0 * 16 + hi * 8);
    __builtin_amdgcn_s_waitcnt(0x0F70);
    float m_reg = -1e30f, l_reg = 0.f;
    if (MODE == 2) { m_reg = a.sinks[wid] * LOG2E; l_reg = 1.f; }
    f32x16 o[NDV];
#pragma unroll
    for (int d = 0; d < NDV; ++d) o[d] = f32x16{};
    float clq = 0.f; if (MODE == 1) clq = a.dec[(size_t)qpos * 16];
    if (MODE == 2) { (dec_l + 128 + 512)[tid] = a.biasT[tid]; (dec_l + 128 + 512)[tid + 512] = a.biasT[tid + 512]; }
    const int vb0 = (int)(uintptr_t)V_lds + v_rd_base(lane);
    const int kq = r32 * KROWB;
    bf16x8 sk[2][KPT], sv[2][VPT]; float sdec[2] = {0.f, 0.f};
    if (wid >= 4) __builtin_amdgcn_s_setprio(1);
#define FA_LOADT(j, S_) do { const size_t kb_ = (size_t)(j) * 64; const char* kt_ = (const char*)(a.K + kb_ * a.ldk); const char* vt_ = (const char*)(a.V + kb_ * a.ldv); \
        _Pragma("unroll") for (int i = 0; i < KPT; ++i) sk[S_][i] = *(const bf16x8*)(kt_ + ksrc0 + i * 128); \
        _Pragma("unroll") for (int i = 0; i < VPT; ++i) sv[S_][i] = *(const bf16x8*)(vt_ + vsrc0 + i * 128); \
        if (MODE == 1) { if (tid < 64) sdec[S_] = a.dec[(kb_ + tid) * 16]; } } while (0)
#define FA_WRITET(bf, S_) do { \
        _Pragma("unroll") for (int i = 0; i < KPT; ++i) *(LAS bf16x8*)(K_lds + (bf) * SHM_K + kws0 + i * 128) = sk[S_][i]; \
        _Pragma("unroll") for (int i = 0; i < VPT; ++i) *(LAS bf16x8*)(V_lds + (bf) * SHM_V + vws0 + i * 1024) = sv[S_][i]; \
        if (MODE == 1) { if (tid < 64) dec_l[(bf) * 64 + tid] = sdec[S_]; } } while (0)
#define FA_TR(dst, off) asm volatile("ds_read_b64_tr_b16 %0, %1 offset:%2" : "=&v"(dst) : "v"(vb0), "i"(off) : "memory")
#define FA_VRD(S, BUF, d0) do { constexpr int b_ = (BUF) * SHM_V + (d0) * 512; \
        FA_TR(S##l[0], b_); FA_TR(S##h[0], b_ + RB); FA_TR(S##l[1], b_ + 2 * RB); FA_TR(S##h[1], b_ + 3 * RB); FA_TR(S##l[2], b_ + 4 * RB); FA_TR(S##h[2], b_ + 5 * RB); FA_TR(S##l[3], b_ + 6 * RB); FA_TR(S##h[3], b_ + 7 * RB); } while (0)
#define FA_VMM(S, d0) do { \
        o[d0] = __builtin_amdgcn_mfma_f32_32x32x16_bf16(pa0, (bf16x8){S##l[0][0], S##l[0][1], S##l[0][2], S##l[0][3], S##h[0][0], S##h[0][1], S##h[0][2], S##h[0][3]}, o[d0], 0, 0, 0); \
        o[d0] = __builtin_amdgcn_mfma_f32_32x32x16_bf16(pa1, (bf16x8){S##l[1][0], S##l[1][1], S##l[1][2], S##l[1][3], S##h[1][0], S##h[1][1], S##h[1][2], S##h[1][3]}, o[d0], 0, 0, 0); \
        o[d0] = __builtin_amdgcn_mfma_f32_32x32x16_bf16(pa2, (bf16x8){S##l[2][0], S##l[2][1], S##l[2][2], S##l[2][3], S##h[2][0], S##h[2][1], S##h[2][2], S##h[2][3]}, o[d0], 0, 0, 0); \
        o[d0] = __builtin_amdgcn_mfma_f32_32x32x16_bf16(pa3, (bf16x8){S##l[3][0], S##l[3][1], S##l[3][2], S##l[3][3], S##h[3][0], S##h[3][1], S##h[3][2], S##h[3][3]}, o[d0], 0, 0, 0); } while (0)
#define FA_LW(n) do { asm volatile("s_waitcnt lgkmcnt(" #n ")" ::: "memory"); SBAR(); } while (0)
#define FA_PVALL(BUF) do { s16x4 Al[4], Ah[4], Bl[4], Bh[4]; \
        FA_VRD(A, BUF, 0); FA_VRD(B, BUF, 1); FA_LW(8); FA_VMM(A, 0); \
        if constexpr (NDV == 4) { FA_VRD(A, BUF, 2); FA_LW(8); FA_VMM(B, 1); FA_VRD(B, BUF, 3); FA_LW(8); FA_VMM(A, 2); FA_LW(0); FA_VMM(B, 3); } \
        else { FA_LW(0); FA_VMM(B, 1); } } while (0)
#define FA_PK4(P, B_, OUT) do { unsigned a0 = cvt_pk_bf16(P[B_ + 0], P[B_ + 1]), a1 = cvt_pk_bf16(P[B_ + 2], P[B_ + 3]); \
        unsigned b0 = cvt_pk_bf16(P[B_ + 4], P[B_ + 5]), b1 = cvt_pk_bf16(P[B_ + 6], P[B_ + 7]); \
        auto r0 = __builtin_amdgcn_permlane32_swap(a0, b0, false, false); auto r1 = __builtin_amdgcn_permlane32_swap(a1, b1, false, false); \
        u32x4 w = {r0[0], r1[0], r0[1], r1[1]}; OUT = *reinterpret_cast<bf16x8*>(&w); } while (0)
#define FA_COMPUTE(BUF, kb) do { \
            f32x16 p0, p1; \
            if (MODE == 1) { _Pragma("unroll") for (int r = 0; r < 16; ++r) { p0[r] = clq - dec_l[(BUF) * 64 + crow(r, hi)]; p1[r] = clq - dec_l[(BUF) * 64 + 32 + crow(r, hi)]; } } \
            else { p0 = f32x16{}; p1 = f32x16{}; } \
            { const LAS char* kbp[4];     \
              kbp[0] = K_lds + (BUF) * SHM_K + kq + hi * 16; \
              bf16x8 ka0 = *(const LAS bf16x8*)kbp[0], ka1 = *(const LAS bf16x8*)(kbp[0] + 32 * KROWB), kb0, kb1; SBAR(); \
              _Pragma("unroll") for (int d0 = 0; d0 < NDK; d0 += 2) { \
                  { const LAS char* ap = kbp[0] + (d0 + 1) * 32; kb0 = *(const LAS bf16x8*)ap; kb1 = *(const LAS bf16x8*)(ap + 32 * KROWB); } SBAR(); \
                  p0 = __builtin_amdgcn_mfma_f32_32x32x16_bf16(ka0, qr[d0], p0, 0, 0, 0); p1 = __builtin_amdgcn_mfma_f32_32x32x16_bf16(ka1, qr[d0], p1, 0, 0, 0); SBAR(); \
                  if (d0 + 2 < NDK) { const LAS char* ap = kbp[0] + (d0 + 2) * 32; ka0 = *(const LAS bf16x8*)ap; ka1 = *(const LAS bf16x8*)(ap + 32 * KROWB); } SBAR(); \
                  p0 = __builtin_amdgcn_mfma_f32_32x32x16_bf16(kb0, qr[d0 + 1], p0, 0, 0, 0); p1 = __builtin_amdgcn_mfma_f32_32x32x16_bf16(kb1, qr[d0 + 1], p1, 0, 0, 0); SBAR(); } } \
            if (MODE == 2) { const int dq0 = qpos - (kb) - 4 * hi; \
                _Pragma("unroll") for (int r = 0; r < 16; ++r) { const int c = (r & 3) + 8 * (r >> 2); int i0 = dq0 - c, i1 = dq0 - c - 32; \
                    i0 = i0 < 0 ? 0 : (i0 > 127 ? 127 : i0); i1 = i1 < 0 ? 0 : (i1 > 127 ? 127 : i1); p0[r] += bias_l[i0]; p1[r] += bias_l[i1]; } } \
            if (MODE != 3) { if ((kb) + 63 > qlo || (kb) <= qlo + 31 - a.W) mask_tile(p0, p1, qpos - (kb) - 4 * hi, (unsigned)a.W); } \
            float pmax = p0[0]; \
            _Pragma("unroll") for (int r = 1; r < 16; ++r) pmax = fmaxf(pmax, p0[r]); \
            _Pragma("unroll") for (int r = 0; r < 16; ++r) pmax = fmaxf(pmax, p1[r]); \
            { auto rr = __builtin_amdgcn_permlane32_swap(__float_as_uint(pmax), __float_as_uint(pmax), false, false); pmax = fmaxf(__uint_as_float(rr[0]), __uint_as_float(rr[1])); } \
            float mn, alpha; \
            if (__builtin_expect(__all((pmax - m_reg) <= THR), 1)) { mn = m_reg; alpha = 1.f; } \
            else { mn = fmaxf(m_reg, pmax); alpha = __builtin_amdgcn_exp2f(m_reg - mn); m_reg = mn; } \
            _Pragma("unroll") for (int r = 0; r < 16; ++r) { p0[r] = __builtin_amdgcn_exp2f(p0[r] - mn); p1[r] = __builtin_amdgcn_exp2f(p1[r] - mn); } \
            float ps = 0.f; \
            _Pragma("unroll") for (int r = 0; r < 16; ++r) ps += p0[r]; \
            _Pragma("unroll") for (int r = 0; r < 16; ++r) ps += p1[r]; \
            { auto rr = __builtin_amdgcn_permlane32_swap(__float_as_uint(ps), __float_as_uint(ps), false, false); ps = __uint_as_float(rr[0]) + __uint_as_float(rr[1]); } \
            l_reg = l_reg * alpha + ps; \
            if (__any(alpha < 1.f)) { if (hi == 0) ws[32 + r32] = alpha; asm volatile("s_waitcnt lgkmcnt(0)" ::: "memory"); \
                _Pragma("unroll") for (int d_ = 0; d_ < NDV; ++d_) _Pragma("unroll") for (int r = 0; r < 16; ++r) o[d_][r] *= ws[32 + crow(r, hi)]; } \
            bf16x8 pa0, pa1, pa2, pa3; \
            FA_PK4(p0, 0, pa0); FA_PK4(p0, 8, pa1); FA_PK4(p1, 0, pa2); FA_PK4(p1, 8, pa3); SBAR(); \
            FA_PVALL(BUF); \
        } while (0)
    if constexpr (MODE != 1) {
#define FA_TILE(t, BUF) do { \
        const int kb = (a.j_lo + (t)) * 64; \
        bool act = true; if (MODE != 3) act = (kb <= qlo + 31) && (kb + 63 >= qlo - a.W + 1); \
        if ((t) + 2 < NT) FA_LOADT(a.j_lo + (t) + 2, BUF);              \
        if (act) FA_COMPUTE(BUF, kb); \
        if ((t) + 1 < NT) FA_WRITET((BUF) ^ 1, (BUF) ^ 1);              \
        __syncthreads(); } while (0)
        FA_LOADT(a.j_lo, 0); FA_WRITET(0, 0); if (NT > 1) FA_LOADT(a.j_lo + 1, 1); __syncthreads();
        for (int t = 0; t < NT; t += 2) {
            FA_TILE(t, 0);
            if (t + 1 < NT) FA_TILE(t + 1, 1);
        }
#undef FA_TILE
    } else {
        constexpr float TEXIT = 28.f;
        float qn2 = 0.f;
#pragma unroll
        for (int d0 = 0; d0 < NDK; ++d0)
#pragma unroll
            for (int e = 0; e < 8; ++e) { const float f = bf2f((unsigned short)qr[d0][e]); qn2 += f * f; }
        { auto rr = __builtin_amdgcn_permlane32_swap(__float_as_uint(qn2), __float_as_uint(qn2), false, false); qn2 = __uint_as_float(rr[0]) + __uint_as_float(rr[1]); }
        const float ubase = sqrtf(qn2) * a.kmax * 1.0001f + clq;
        LAS int* flags = (LAS int*)(dec_l + 128 + 512 + 128);
        bool wdone = false, stop = false;
#define FA_TILE_R(t, BUF) do { \
        const int kb = (a.j_lo + (t)) * 64; const bool more = (t) > 0; \
        const bool act = !wdone && (kb <= qlo + 31); \
        if ((t) > 1) FA_LOADT(a.j_lo + (t) - 2, BUF); \
        if (act) { FA_COMPUTE(BUF, kb); \
            wdone = __all((ubase - dec_l[(BUF) * 64]) < (m_reg - TEXIT)) != 0; } \
        if (more) FA_WRITET((BUF) ^ 1, (BUF) ^ 1); \
        if (lane == 0) flags[(BUF) * 8 + wid] = wdone ? 1 : 0; \
        __syncthreads(); \
        { int all_ = 1; _Pragma("unroll") for (int w_ = 0; w_ < 8; ++w_) all_ &= flags[(BUF) * 8 + w_]; stop = !more || (all_ != 0); } } while (0)
        FA_LOADT(a.j_lo + NT - 1, 0); FA_WRITET(0, 0); if (NT > 1) FA_LOADT(a.j_lo + NT - 2, 1); __syncthreads();
        for (int t = NT - 1;;) {
            FA_TILE_R(t, 0); if (stop) break; --t;
            FA_TILE_R(t, 1); if (stop) break; --t;
        }
#undef FA_TILE_R
    }
    __builtin_amdgcn_s_setprio(0);
    if (hi == 0) ws[r32] = l_reg; asm volatile("s_waitcnt lgkmcnt(0)" ::: "memory");
    float rli[16];
#pragma unroll
    for (int r = 0; r < 16; ++r) rli[r] = __builtin_amdgcn_rcpf(ws[crow(r, hi)]);
    bf16_t* Ow = a.O + (size_t)qlo * a.ldo + hoff;
#pragma unroll
    for (int r = 0; r < 16; ++r) { const int orow = crow(r, hi);
#pragma unroll
        for (int d0 = 0; d0 < NDV; ++d0) { const float v = o[d0][r] * rli[r]; const float vn = __shfl_xor(v, 1);
            if ((r32 & 1) == 0) *(unsigned*)(Ow + (size_t)orow * a.ldo + d0 * 32 + r32) = cvt_pk_bf16(v, vn); } }
    __syncthreads();
#undef FA_LOADT
#undef FA_WRITET
#undef FA_TR
#undef FA_VRD
#undef FA_VMM
#undef FA_LW
#undef FA_PVALL
#undef FA_PK4
#undef FA_COMPUTE
}
#undef SBAR
}

struct Args { const void* in[N_IN]; float* out; unsigned char* ws; int ph_lo, ph_hi; };

__device__ const float ROPE_INV[32] = {
    1.000000000e+00f, 7.498942614e-01f, 5.623413324e-01f, 4.216965139e-01f, 3.162277639e-01f, 2.371373773e-01f, 1.778279394e-01f, 1.333521307e-01f,
    1.000000015e-01f, 7.498941571e-02f, 5.623413250e-02f, 4.216965288e-02f, 3.162277490e-02f, 2.371373773e-02f, 1.778279431e-02f, 1.333521493e-02f,
    9.999999776e-03f, 7.498941850e-03f, 5.623413250e-03f, 4.216964822e-03f, 3.162277630e-03f, 2.371373586e-03f, 1.778279431e-03f, 1.333521446e-03f,
    1.000000047e-03f, 7.498942432e-04f, 5.623413017e-04f, 4.216965172e-04f, 3.162277571e-04f, 2.371373703e-04f, 1.778279402e-04f, 1.333521504e-04f };
__device__ const unsigned char T5_BUCKET[128] = {
    0, 1, 2, 3, 4, 5, 6, 7, 8, 9, 10, 11, 12, 13, 14, 15, 16, 16, 16, 17, 17, 18, 18, 18, 19, 19, 19, 20, 20, 20, 20, 21, 21, 21, 21, 22, 22, 22, 22, 22, 23, 23, 23, 23, 23, 23, 24, 24, 24, 24, 24, 24,
    25, 25, 25, 25, 25, 25, 25, 26, 26, 26, 26, 26, 26, 26, 26, 27, 27, 27, 27, 27, 27, 27, 27, 27, 27, 28, 28, 28, 28, 28, 28, 28, 28, 28, 28, 29, 29, 29, 29, 29, 29, 29, 29, 29, 29, 29, 29,
    30, 30, 30, 30, 30, 30, 30, 30, 30, 30, 30, 30, 30, 30, 31, 31, 31, 31, 31, 31, 31, 31, 31, 31, 31, 31, 31, 31, 31 };

struct CvtJob { const float* src; int K, Nsrc, Npad; const float* gain; bf16_t* dst; int ldd; int mode; int row_off; int kblk;   unsigned* amax;   int f8;   int f16;   };
__device__ __forceinline__ int cvt_row(int mode, int n) {
    if (mode == 1) { if (n >= 1280 && n < 1344) { const int j = n - 1280; return 1280 + 2 * (j & 31) + (j >> 5); } return n; }
    if (mode == 2) { const int h = n / 192, w = n - h * 192; if (w >= 128) { const int j = w - 128; return h * 192 + 128 + 2 * (j & 31) + (j >> 5); } return n; }
    if (mode == 4) return (n >> 7) * 256 + (n & 127);
    if (mode == 5) return (n >> 7) * 256 + 128 + (n & 127);
    return n;
}
__device__ __forceinline__ float cvt_cs(int mode, int n) {
    if (mode == 1) return (n >= 1344 && n < 2368) ? C2_SWA : 1.f;
    if (mode == 2) return C2_MLA;
    if (mode == 3) return C2_128;
    if (mode == 6) return n < 2048 ? C2_128 : 1.f;
    return 1.f;
}
constexpr int N_CVT_JOBS = 17 + 24;
__device__ __forceinline__ CvtJob get_job(const Args& a, int j) {
    unsigned char* ws = a.ws; CvtJob jb; jb.gain = nullptr; jb.mode = 0; jb.row_off = 0; jb.amax = nullptr; jb.kblk = 0; jb.f16 = 0; jb.f8 = 0;
    const float* nmix = (const float*)a.in[I_NMIX]; const float* ncross = (const float*)a.in[I_NCROSS]; const float* nmem = (const float*)a.in[I_NMEM]; const float* nffn = (const float*)a.in[I_NFFN];
    if (j >= 17) { const int t = (j - 17) >> 3, e = (j - 17) & 7;
        if (t == 0) { jb.src = (const float*)a.in[I_MG] + (size_t)e * DM * DFF; jb.K = DM; jb.Nsrc = jb.Npad = DFF; jb.gain = nffn + DM; jb.dst = (bf16_t*)(ws + WS_WGU1 + (size_t)e * E_GU); jb.ldd = DM; jb.mode = 4; jb.amax = (unsigned*)(ws + WS_CTL) + CW_AMAXW + e * 2 * DFF; }
        else if (t == 1) { jb.src = (const float*)a.in[I_MU] + (size_t)e * DM * DFF; jb.K = DM; jb.Nsrc = jb.Npad = DFF; jb.gain = nffn + DM; jb.dst = (bf16_t*)(ws + WS_WGU1 + (size_t)e * E_GU); jb.ldd = DM; jb.mode = 5; jb.amax = (unsigned*)(ws + WS_CTL) + CW_AMAXW + e * 2 * DFF; }
        else { jb.src = (const float*)a.in[I_MD] + (size_t)e * DFF * DM; jb.K = DFF; jb.Nsrc = jb.Npad = DM; jb.dst = (bf16_t*)(ws + WS_WD1 + (size_t)e * E_D)  ; jb.ldd = DFF; jb.kblk = 1; jb.f8 = 1; }
        return jb; }
    switch (j) {
    case 0: jb.src = (const float*)a.in[I_EVWIN]; jb.K = DM; jb.Nsrc = EVEN_IN; jb.Npad = Z0_LD; jb.gain = nmix; jb.dst = (bf16_t*)(ws + WS_WIN0)  ; jb.ldd = DM; jb.mode = 1; jb.amax = (unsigned*)(ws + WS_CTL) + CW_AMAX0; break;
    case 1: jb.src = (const float*)a.in[I_WUQ]; jb.K = 768; jb.Nsrc = jb.Npad = 1536; jb.gain = (const float*)a.in[I_QNORM]; jb.dst = (bf16_t*)(ws + WS_WUQ); jb.ldd = 768; jb.mode = 2; break;
    case 2: jb.src = (const float*)a.in[I_WUKV]; jb.K = 512; jb.Nsrc = jb.Npad = 2048; jb.gain = (const float*)a.in[I_KVNORM]; jb.dst = (bf16_t*)(ws + WS_WUKV); jb.ldd = 512; break;
    case 3: jb.src = (const float*)a.in[I_EVWO]; jb.K = DM; jb.Nsrc = jb.Npad = DM; jb.dst = (bf16_t*)(ws + WS_WO0); jb.ldd = DM; break;
    case 4: case 5: { const int l = j - 4; jb.src = (const float*)a.in[I_XWQ] + (size_t)l * DM * 512; jb.K = DM; jb.Nsrc = jb.Npad = 512; jb.gain = ncross + l * DM; jb.dst = (bf16_t*)(ws + WS_WXQ) + (size_t)l * E_XQ; jb.ldd = DM; jb.mode = 3; jb.f16 = 1; break; }
    case 6: case 7: { const int l = j - 6; jb.src = (const float*)a.in[I_XWK] + (size_t)l * DM * 512; jb.K = DM; jb.Nsrc = jb.Npad = 512; jb.gain = nmem + l * DM; jb.dst = (bf16_t*)(ws + WS_WXKV); jb.ldd = DM; jb.row_off = l * 1024; break; }
    case 8: case 9: { const int l = j - 8; jb.src = (const float*)a.in[I_XWV] + (size_t)l * DM * 512; jb.K = DM; jb.Nsrc = jb.Npad = 512; jb.gain = nmem + l * DM; jb.dst = (bf16_t*)(ws + WS_WXKV); jb.ldd = DM; jb.row_off = l * 1024 + 512; break; }
    case 10: case 11: { const int l = j - 10; jb.src = (const float*)a.in[I_XWO] + (size_t)l * 512 * DM; jb.K = 512; jb.Nsrc = jb.Npad = DM; jb.dst = (bf16_t*)(ws + WS_WXO) + (size_t)l * E_XO; jb.ldd = 512; break; }
    case 12: jb.src = (const float*)a.in[I_FG]; jb.K = DM; jb.Nsrc = jb.Npad = DFF; jb.gain = nffn; jb.dst = (bf16_t*)(ws + WS_WGU0); jb.ldd = DM; jb.mode = 4; jb.amax = (unsigned*)(ws + WS_CTL) + CW_AMAXW + 8 * 2 * DFF; break;
    case 13: jb.src = (const float*)a.in[I_FU]; jb.K = DM; jb.Nsrc = jb.Npad = DFF; jb.gain = nffn; jb.dst = (bf16_t*)(ws + WS_WGU0); jb.ldd = DM; jb.mode = 5; jb.amax = (unsigned*)(ws + WS_CTL) + CW_AMAXW + 8 * 2 * DFF; break;
    case 14: jb.src = (const float*)a.in[I_FD]; jb.K = DFF; jb.Nsrc = jb.Npad = DM; jb.dst = (bf16_t*)(ws + WS_WD0); jb.ldd = DFF; jb.kblk = 1; break;
    case 15: jb.src = (const float*)a.in[I_ODWIN]; jb.K = DM; jb.Nsrc = ODD_IN; jb.Npad = IN1_PAD; jb.gain = nmix + DM; jb.dst = (bf16_t*)(ws + WS_WIN1)  ; jb.ldd = DM; jb.mode = 6; jb.amax = (unsigned*)(ws + WS_CTL) + CW_AMAX15; break;
    default: jb.src = (const float*)a.in[I_ODWO]; jb.K = DM; jb.Nsrc = jb.Npad = DM; jb.dst = (bf16_t*)(ws + WS_WO1); jb.ldd = DM; break;
    }
    return jb;
}
__device__ __forceinline__ int cvt_find(const LAS int* cum, int it, int& j) { while (it >= cum[j + 1]) ++j; return it - cum[j]; }
__device__ __forceinline__ void cvt_load(const CvtJob& jb, int item, int lane, float (&v)[32]) {
    const int nblk = jb.Npad / 32, kb = item / nblk, nb = item % nblk, k0 = 64 * kb, n0 = 32 * nb;
    const int nn = n0 + (lane & 31); const bool ok = nn < jb.Nsrc;
    const float* p = jb.src + (size_t)(k0 + (lane >> 5)) * jb.Nsrc + nn; const size_t st = (size_t)2 * jb.Nsrc;
#pragma unroll
    for (int i = 0; i < 32; ++i) v[i] = ok ? __builtin_nontemporal_load(p + i * st) : 0.f;
}
__device__ __forceinline__ void cvt_store(const CvtJob& jb, LAS float* scr, int item, int lane, const float (&v)[32]) {
    const int nblk = jb.Npad / 32, kb = item / nblk, nb = item % nblk, k0 = 64 * kb, n0 = 32 * nb;
    const float cs = cvt_cs(jb.mode, n0 + (lane & 31));
    const int c = lane & 7;
    f32x4 g0 = (f32x4){1.f, 1.f, 1.f, 1.f}, g1 = g0;
    if (jb.gain) { g0 = *(const f32x4*)(jb.gain + k0 + 8 * c); g1 = *(const f32x4*)(jb.gain + k0 + 8 * c + 4); }
#pragma unroll
    for (int i = 0; i < 32; ++i) scr[(2 * i + (lane >> 5)) * 33 + (lane & 31)] = v[i] * cs;
    LDS_WAIT(); asm volatile("" ::: "memory");
#pragma unroll
    for (int j = 0; j < 4; ++j) { const int n = (lane >> 3) + 8 * j; const LAS float* s = scr + (8 * c) * 33 + n;
        u32x4 o;
        if (jb.f16) { o.x = pk_f16(s[0 * 33] * g0[0], s[1 * 33] * g0[1]); o.y = pk_f16(s[2 * 33] * g0[2], s[3 * 33] * g0[3]); o.z = pk_f16(s[4 * 33] * g1[0], s[5 * 33] * g1[1]); o.w = pk_f16(s[6 * 33] * g1[2], s[7 * 33] * g1[3]); }
        else { o.x = cvt_pk_bf16(s[0 * 33] * g0[0], s[1 * 33] * g0[1]); o.y = cvt_pk_bf16(s[2 * 33] * g0[2], s[3 * 33] * g0[3]); o.z = cvt_pk_bf16(s[4 * 33] * g1[0], s[5 * 33] * g1[1]); o.w = cvt_pk_bf16(s[6 * 33] * g1[2], s[7 * 33] * g1[3]); }
        const int drow = jb.row_off + cvt_row(jb.mode, n0 + n);
        if (jb.f8) {
            const f32x4 a_ = (f32x4){s[0 * 33] * g0[0], s[1 * 33] * g0[1], s[2 * 33] * g0[2], s[3 * 33] * g0[3]} * 64.f, b_ = (f32x4){s[4 * 33] * g1[0], s[5 * 33] * g1[1], s[6 * 33] * g1[2], s[7 * 33] * g1[3]} * 64.f;
            *(u32x2*)((unsigned char*)jb.dst + ((size_t)(k0 >> 7) * jb.Npad + drow) * 128 + (k0 & 64) + 8 * c) = pack8_fp8(a_, b_);
        } else { bf16_t* dp = jb.kblk ? jb.dst + ((size_t)(k0 >> 6) * jb.Npad + drow) * 64 + 8 * c : jb.dst + (size_t)drow * jb.ldd + k0 + 8 * c; *(u32x4*)dp = o; } }
    LDS_WAIT(); asm volatile("" ::: "memory");
}
__device__ __forceinline__ void cvt_amax(const CvtJob& jb, int item, int lane, const float (&v)[32]) {
    const int nblk = jb.Npad / 32, kb = item / nblk, nb = item % nblk, k0 = 64 * kb, n0 = 32 * nb;
    const int nn = n0 + (lane & 31); float mx = 0.f;
#pragma unroll
    for (int i = 0; i < 32; ++i) mx = fmaxf(mx, fabsf(v[i] * jb.gain[k0 + 2 * i + (lane >> 5)]));
    mx = fmaxf(mx, __shfl_xor(mx, 32)) * cvt_cs(jb.mode, nn);
    if (lane < 32 && nn < jb.Nsrc) atomicMax(jb.amax + jb.row_off + cvt_row(jb.mode, nn), __float_as_uint(mx));
}
__device__ __forceinline__ float cvt_amax_item(const CvtJob& jb, int item, int lane, const float (&v)[32]) {
    const int nblk = jb.Npad / 32, kb = item / nblk, nb = item % nblk, k0 = 64 * kb, n0 = 32 * nb;
    float mx = 0.f;
#pragma unroll
    for (int i = 0; i < 32; ++i) mx = fmaxf(mx, fabsf(v[i] * jb.gain[k0 + 2 * i + (lane >> 5)]));
    return fmaxf(mx, __shfl_xor(mx, 32)) * cvt_cs(jb.mode, n0 + (lane & 31));
}
__device__ __forceinline__ void cvt_store_q8(const CvtJob& jb, LAS float* scr, int item, int lane, const float (&v)[32], const LAS float* cam = nullptr) {
    const int nblk = jb.Npad / 32, kb = item / nblk, nb = item % nblk, k0 = 64 * kb, n0 = 32 * nb;
    const int c = lane & 7;
    const f32x4 g0 = *(const f32x4*)(jb.gain + k0 + 8 * c), g1 = *(const f32x4*)(jb.gain + k0 + 8 * c + 4);
#pragma unroll
    for (int i = 0; i < 32; ++i) scr[(2 * i + (lane >> 5)) * 33 + (lane & 31)] = v[i];
    LDS_WAIT(); asm volatile("" ::: "memory");
#pragma unroll
    for (int j = 0; j < 4; ++j) { const int n = (lane >> 3) + 8 * j; const LAS float* s = scr + (8 * c) * 33 + n;
        const int row = jb.row_off + cvt_row(jb.mode, n0 + n);
        const float am = cam ? cam[n] : __uint_as_float(__hip_atomic_load(jb.amax + row, RLX_AGENT)); const float inv = am > 0.f ? cvt_cs(jb.mode, n0 + n) * 127.f / am : 0.f;
        int q[8];
#pragma unroll
        for (int i = 0; i < 4; ++i) { q[i] = (int)__builtin_rintf(s[i * 33] * g0[i] * inv); q[4 + i] = (int)__builtin_rintf(s[(4 + i) * 33] * g1[i] * inv); }
#pragma unroll
        for (int i = 0; i < 8; ++i) q[i] = q[i] > 127 ? 127 : (q[i] < -127 ? -127 : q[i]);
        u32x2 o; o.x = (unsigned)(q[0] & 255) | ((unsigned)(q[1] & 255) << 8) | ((unsigned)(q[2] & 255) << 16) | ((unsigned)(q[3] & 255) << 24);
        o.y = (unsigned)(q[4] & 255) | ((unsigned)(q[5] & 255) << 8) | ((unsigned)(q[6] & 255) << 16) | ((unsigned)(q[7] & 255) << 24);
        *(u32x2*)((unsigned char*)jb.dst + (size_t)row * jb.ldd + k0 + 8 * c) = o; }
    LDS_WAIT(); asm volatile("" ::: "memory");
}
__device__ __forceinline__ void row_to_bf16_ssq(const float* xrow, bf16_t* orow, float* ssqrow, int lane) {
    const f32x4* xr = (const f32x4*)xrow + lane; f32x4 v[8]; float s = 0.f;
#pragma unroll
    for (int j = 0; j < 8; ++j) { v[j] = xr[64 * j]; s += (v[j][0] * v[j][0] + v[j][1] * v[j][1]) + (v[j][2] * v[j][2] + v[j][3] * v[j][3]); }
    s = wave_sum(s);
    u32x2* o8 = (u32x2*)orow + lane;
#pragma unroll
    for (int j = 0; j < 8; ++j) { u32x2 w; w.x = cvt_pk_bf16(v[j][0], v[j][1]); w.y = cvt_pk_bf16(v[j][2], v[j][3]); o8[64 * j] = w; }
    if (lane < 32) ssqrow[lane] = lane == 0 ? s : 0.f;
}

__global__ void __launch_bounds__(NWAVES * 64, 2) trunk_fwd(Args args) {
    extern __shared__ __attribute__((aligned(16))) unsigned char lds_raw[];
    LAS unsigned char* lds = (LAS unsigned char*)lds_raw;
    volatile LAS unsigned* MISC = (volatile LAS unsigned*)(lds + MISC_OFF);
    const int tid = threadIdx.x, lane = tid & 63, wave = __builtin_amdgcn_readfirstlane(tid >> 6);
    const int G = gridDim.x; const int bx = blockIdx.x; const int vcu = (G % 8 == 0) ? (bx % 8) * (G / 8) + bx / 8 : bx;
    const int gw = vcu * NWAVES + wave, NGW = G * NWAVES;
    unsigned* ctl = (unsigned*)(args.ws + WS_CTL);
    const int lo = args.ph_lo, hi = args.ph_hi;
    const bool fused = (hi - lo) > 1;
    for (int u = tid; u < (LDS_BYTES - RING_BYTES) / 4; u += NWAVES * 64) ((LAS unsigned*)(lds + RING_BYTES))[u] = 0u;
    __syncthreads();
    XcdBarrier bar; bar.bar = ctl + CW_BAR; bar.x = 0; bar.st = nullptr;
    if (fused) bar = xcd_barrier_post(ctl + CW_BAR, MISC + 8);
#ifndef PH_MASK
#define PH_MASK 0xFFFFFFFFFFFFFFFFull
#endif
#define IN(k) ((((unsigned long long)PH_MASK >> (k)) & 1ull) && lo <= (k) && (k) < hi)
#define GRID_BAR(k) do { if (fused && IN((k) + 1)) xcd_barrier(bar); } while (0)
#ifndef DUP_MASK
#define DUP_MASK 0ull
#endif
#ifndef DUP_SUB
#define DUP_SUB 0
#endif
#define NREP(k) ((((unsigned long long)DUP_MASK >> (k)) & 1ull) ? 2 : 1)
#define PHASE(k) for (int rep_ = 0; rep_ < NREP(k) && IN(k); ++rep_)

#define WSL() GAS unsigned char* wsg_ = (GAS unsigned char*)args.ws; asm volatile("" : "+s"(wsg_)); unsigned char* ws = (unsigned char*)wsg_
#define XB ((bf16_t*)(ws + WS_XB))
#define SSQ ((float*)(ws + WS_SSQ))
#define ROPE ((float*)(ws + WS_ROPE))
#define MEMN ((bf16_t*)(ws + WS_MEMN))
#define SSQM ((float*)(ws + WS_SSQM))
#define MEMKV ((bf16_t*)(ws + WS_MEMKV))
#define SSQQ ((float*)(ws + WS_SSQQ))
#define SSQKV ((float*)(ws + WS_SSQKV))
#define QX ((bf16_t*)(ws + WS_QX))
#define OX ((bf16_t*)(ws + WS_OX))
#define FL ((float*)(ws + WS_FL))
#define DEC ((float*)(ws + WS_DEC))
#define TOPE ((int*)(ws + WS_TOPE))
#define TOPS ((int*)(ws + WS_TOPS))
#define TOPG ((float*)(ws + WS_TOPG))
#define RSTDF ((float*)(ws + WS_RSTDF))
#define TOKPOS ((int*)(ws + WS_TOKPOS))
#define ROWIDX ((int*)(ws + WS_ROWIDX))
#define GATEP ((float*)(ws + WS_GATEP))
#define RSTDP ((float*)(ws + WS_RSTDP))
#define BIAST ((float*)(ws + WS_BIAST))
#define Z0 ((bf16_t*)(ws + WS_ARENA + AR_Z0))
#define QM ((bf16_t*)(ws + WS_ARENA + AR_QM))
#define KM ((bf16_t*)(ws + WS_ARENA + AR_KM))
#define VM ((bf16_t*)(ws + WS_ARENA + AR_VM))
#define O0 ((bf16_t*)(ws + WS_ARENA + AR_O0))
#define HIDB(i) ((bf16_t*)(ws + WS_ARENA + AR_HID + (size_t)((i) & 1) * HID_BYTES))
#define YB ((bf16_t*)(ws + WS_ARENA + AR_Y))
#define Z1 ((bf16_t*)(ws + WS_ARENA + AR_Z1))
#define O1 ((bf16_t*)(ws + WS_ARENA + AR_O1))
#define XQ ((unsigned char*)(ws + WS_QX))
#define XH ((unsigned short*)(ws + WS_XB))
#define XIN ((const float*)args.in[I_X])

    PHASE(0) {
        WSL();
        LAS float* scr = (LAS float*)(lds + wave * 16384);
        LAS int* cum = (LAS int*)(lds + RING_BYTES + 4096);
        if (tid < N_CVT_JOBS) { const CvtJob jb = get_job(args, tid); cum[64 + tid] = jb.amax ? 0   : (jb.K / 64) * (jb.Npad / 32); }
        __syncthreads();
        if (tid == 0) { int run = 0; for (int j = 0; j < N_CVT_JOBS; ++j) { cum[j] = run; run += cum[64 + j]; } cum[N_CVT_JOBS] = run; cum[N_CVT_JOBS + 1] = 0x7fffffff; }
        __syncthreads();
        {
            const int total = cum[N_CVT_JOBS];
            float va[32], vb[32]; int jL = 0, jP = 0;
            if (gw < total) { const int li = cvt_find(cum, gw, jL); cvt_load(get_job(args, jL), li, lane, va); }
#pragma unroll 1
            for (int it = gw; it < total; it += 2 * NGW) {
                const int it2 = it + NGW, it3 = it + 2 * NGW;
                if (it2 < total) { const int li = cvt_find(cum, it2, jL); cvt_load(get_job(args, jL), li, lane, vb); }
                { const int li = cvt_find(cum, it, jP); const CvtJob jb = get_job(args, jP); cvt_store(jb, scr, li, lane, va); }
                if (it2 < total) {
                    if (it3 < total) { const int li = cvt_find(cum, it3, jL); cvt_load(get_job(args, jL), li, lane, va); }
                    const int li = cvt_find(cum, it2, jP); const CvtJob jb = get_job(args, jP); cvt_store(jb, scr, li, lane, vb);
                }
            }
        }
        for (int m = gw; m < M; m += NGW) {
            const f32x4* xr = (const f32x4*)(XIN + (size_t)m * DM) + lane; f32x4 v[8]; float ss = 0.f, amx = 0.f;
#pragma unroll
            for (int j = 0; j < 8; ++j) { v[j] = xr[64 * j]; ss += (v[j][0] * v[j][0] + v[j][1] * v[j][1]) + (v[j][2] * v[j][2] + v[j][3] * v[j][3]);
                amx = fmaxf(amx, fmaxf(fmaxf(fabsf(v[j][0]), fabsf(v[j][1])), fmaxf(fabsf(v[j][2]), fabsf(v[j][3])))); }
            ss = wave_sum(ss);
#pragma unroll
            for (int o_ = 1; o_ < 64; o_ <<= 1) amx = fmaxf(amx, __shfl_xor(amx, o_));
            const float inv = amx > 0.f ? 127.f / amx : 0.f; unsigned* xq = (unsigned*)((unsigned char*)XB + (size_t)m * DM) + lane;
#pragma unroll
            for (int j = 0; j < 8; ++j) { const int q0 = (int)__builtin_rintf(v[j][0] * inv), q1 = (int)__builtin_rintf(v[j][1] * inv), q2 = (int)__builtin_rintf(v[j][2] * inv), q3 = (int)__builtin_rintf(v[j][3] * inv);
                xq[64 * j] = (unsigned)(q0 & 255) | ((unsigned)(q1 & 255) << 8) | ((unsigned)(q2 & 255) << 16) | ((unsigned)(q3 & 255) << 24); }
            if (lane == 0) RSTDF[m] = __builtin_amdgcn_rsqf(ss * (1.f / DM) + EPS) * amx * (1.f / 127.f);
        }
        for (int m = gw; m < MROWS; m += NGW) row_to_bf16_ssq((const float*)args.in[I_MEM] + (size_t)m * DM, MEMN + (size_t)m * DM, SSQM + (size_t)m * 32, lane);
        const int* pos = (const int*)args.in[I_POS];
        int gt0_ = tid; asm volatile("" : "+v"(gt0_)); gt0_ += bx * 512;
        for (int e = gt0_; e < M * 32; e += G * 512) {
            const int row = e >> 5, i = e & 31;
            const float ang = (float)pos[row] * ROPE_INV[i];
            const double rev = (double)ang * 0.15915494309189535; const float fr = (float)(rev - __builtin_rint(rev));
            ROPE[(size_t)e * 2] = __builtin_amdgcn_cosf(fr); ROPE[(size_t)e * 2 + 1] = __builtin_amdgcn_sinf(fr);
        }
        const float* relb = (const float*)args.in[I_RELB];
        for (int e = gt0_; e < 16 * 128; e += G * 512) { const int h = e >> 7, d = e & 127; BIAST[e] = relb[(int)T5_BUCKET[d] * 16 + h] * LOG2E; }
        if (fused && IN(1) && !IN(44)) xcd_barrier(bar);
        __syncthreads();
    }

    PHASE(44) {
        LAS float* scr = (LAS float*)(lds + wave * 16384);
        LAS float* cam = (LAS float*)(lds + RING_BYTES + 4096);
        constexpr int NBJ = DFF / 32, NB15 = IN1_PAD / 32, NB0 = Z0_LD / 32, NB = 18 * NBJ + NB15 + NB0;
#define Q8DEC(cb_, j_, nb_) const int j_ = (cb_) >= 18 * NBJ + NB15 ? 0 : ((cb_) >= 18 * NBJ ? 15 : ((cb_) / NBJ < 2 ? 12 + (cb_) / NBJ : 15 + (cb_) / NBJ)); \
        const int nb_ = (cb_) >= 18 * NBJ + NB15 ? (cb_) - 18 * NBJ - NB15 : ((cb_) >= 18 * NBJ ? (cb_) - 18 * NBJ : (cb_) % NBJ)
        float v0[32], v1[32], v2[32], v3[32];
        if (bx < NB) { Q8DEC(bx, j, nb); const CvtJob jb = get_job(args, j); const int nblk = jb.Npad / 32;
            cvt_load(jb, (4 * wave + 0) * nblk + nb, lane, v0); cvt_load(jb, (4 * wave + 1) * nblk + nb, lane, v1);
            cvt_load(jb, (4 * wave + 2) * nblk + nb, lane, v2); cvt_load(jb, (4 * wave + 3) * nblk + nb, lane, v3); }
#pragma unroll 1
        for (int cb = bx; cb < NB; cb += G) {
            Q8DEC(cb, j, nb); const CvtJob jb = get_job(args, j); const int nblk = jb.Npad / 32;
            const int cn = cb + G; const bool more = cn < NB; Q8DEC(more ? cn : cb, jn, nbn); const CvtJob jbn = get_job(args, jn); const int nblkn = jbn.Npad / 32;
            float mx = fmaxf(fmaxf(cvt_amax_item(jb, (4 * wave + 0) * nblk + nb, lane, v0), cvt_amax_item(jb, (4 * wave + 1) * nblk + nb, lane, v1)),
                             fmaxf(cvt_amax_item(jb, (4 * wave + 2) * nblk + nb, lane, v2), cvt_amax_item(jb, (4 * wave + 3) * nblk + nb, lane, v3)));
            __syncthreads();
            if (lane < 32) cam[wave * 32 + lane] = mx;
            __syncthreads();
            if (lane < 32) { float m = cam[lane];
#pragma unroll
                for (int w = 1; w < 8; ++w) m = fmaxf(m, cam[w * 32 + lane]);
                cam[256 + wave * 32 + lane] = m;
                const int nn = 32 * nb + lane; if (wave == 0 && nn < jb.Nsrc) jb.amax[jb.row_off + cvt_row(jb.mode, nn)] = __float_as_uint(m); }
            LDS_WAIT(); asm volatile("" ::: "memory");
            const LAS float* camw = cam + 256 + wave * 32;
            cvt_store_q8(jb, scr, (4 * wave + 0) * nblk + nb, lane, v0, camw); if (more) cvt_load(jbn, (4 * wave + 0) * nblkn + nbn, lane, v0);
            cvt_store_q8(jb, scr, (4 * wave + 1) * nblk + nb, lane, v1, camw); if (more) cvt_load(jbn, (4 * wave + 1) * nblkn + nbn, lane, v1);
            cvt_store_q8(jb, scr, (4 * wave + 2) * nblk + nb, lane, v2, camw); if (more) cvt_load(jbn, (4 * wave + 2) * nblkn + nbn, lane, v2);
            cvt_store_q8(jb, scr, (4 * wave + 3) * nblk + nb, lane, v3, camw); if (more) cvt_load(jbn, (4 * wave + 3) * nblkn + nbn, lane, v3);
        }
#undef Q8DEC
        GRID_BAR(0);
    }

    PHASE(1) {
        WSL();
        { pg8::PolPlain P{(const char*)XB  , DM, (const char*)(ws + WS_WIN0)  , DM, DM / 2};
          pg8::StaticOrder S; S.init(M / 256, Z0_LD / 256, G, bx, 0, WGM_K2048);
          pg8::EpiStore<1, 32> E{Z0, Z0_LD, nullptr, (LAS float*)(lds + RING_BYTES + 12288), 1.f / DM, ROPE, SSQQ, SSQKV, nullptr, nullptr, nullptr, RSTDF, ctl + CW_AMAX0};
          pg8::gemm_phase<pg8::EpiStore<1, 32>, pg8::PolPlain, 1>(lds, P, S, E); }
        { pg8::PolPlain P{(const char*)MEMN, DM * 2, (const char*)(ws + WS_WXKV), DM * 2, DM};
          pg8::StaticOrder S; S.init(MROWS / 256, 2048 / 256, G, (G - 1) - bx, 0);
          pg8::EpiStore<0, 32> E{MEMKV, 2048, SSQM, (LAS float*)(lds + RING_BYTES + 12288), 1.f / DM, nullptr, nullptr, nullptr, nullptr, nullptr, nullptr};
          pg8::gemm_phase(lds, P, S, E); }
        GRID_BAR(1);
    }
    PHASE(2) {
        WSL();
        { pg8::PolPlain P{(const char*)Z0, Z0_LD * 2, (const char*)(ws + WS_WUQ), 768 * 2, 768};
          pg8::StaticOrder S; S.init(M / 256, 1536 / 256, G, bx, 0);
          pg8::EpiStore<2, 12> E{QM, QM_LD, SSQQ, (LAS float*)(lds + RING_BYTES + 12288), 1.f / 768.f, ROPE, nullptr, nullptr, nullptr, nullptr, nullptr};
          pg8::gemm_phase(lds, P, S, E); }
        { pg8::PolPlain P{(const char*)(Z0 + 768), Z0_LD * 2, (const char*)(ws + WS_WUKV), 512 * 2, 512};
          pg8::StaticOrder S; S.init(M / 256, 2048 / 256, G, bx, 0);
          pg8::EpiStore<3, 8> E{KM, KM_LD, SSQKV, (LAS float*)(lds + RING_BYTES + 12288), 1.f / 512.f, nullptr, nullptr, nullptr, VM, Z0, nullptr};
          pg8::gemm_phase(lds, P, S, E); }
        GRID_BAR(2);
    }
    PHASE(3) {
        WSL();
#pragma unroll 1
        for (int r3_ = 0; r3_ < (DUP_SUB == 1 ? 2 : 1); ++r3_)
#pragma unroll 1
        for (int it = vcu; it < BATCH * 8 * 32; it += G) {
            const int bh = it >> 5, x = it & 31, b = bh >> 3, h = bh & 7;
#pragma unroll 1
            for (int pass = 0; pass < 2; ++pass) { const int qb = pass ? x : 63 - x;
                fa::AttnArgs a; a.Q = QM + (size_t)b * SEQ * QM_LD + h * 192; a.ldq = QM_LD; a.K = KM + (size_t)b * SEQ * KM_LD + h * 192; a.ldk = KM_LD;
                a.V = VM + (size_t)b * SEQ * VM_LD + h * 128; a.ldv = VM_LD; a.O = O0 + (size_t)b * SEQ * DM + h * 128; a.ldo = DM;
                a.q0 = qb * 256; a.j_lo = 0; a.j_hi = qb * 4 + 4; a.W = 0x3fffffff; a.dec = nullptr; a.sinkl = 0.f; a.sinks = nullptr; a.biasT = nullptr; a.kmax = 0.f;
                fa::attn_unit<192, 128, 0>(a, (LAS char*)lds); } }
        const float* sinks = (const float*)args.in[I_SINKS];
#pragma unroll 1
        for (int r3_ = 0; r3_ < (DUP_SUB == 2 ? 2 : 1); ++r3_)
#pragma unroll 1
        for (int it = vcu; it < BATCH * 2 * (SEQ / 32); it += G) {
            const int bk = it >> 9, qb = it & 511, b = bk >> 1, kvh = bk & 1, q0 = qb * 32;
            fa::AttnArgs a; const bf16_t* zb = Z0 + (size_t)b * SEQ * Z0_LD;
            a.Q = zb + 1344 + kvh * 512; a.ldq = Z0_LD; a.K = zb + 2368 + kvh * 64; a.ldk = Z0_LD; a.V = zb + 2496 + kvh * 64; a.ldv = Z0_LD;
            a.O = O0 + (size_t)b * SEQ * DM + 1024 + kvh * 512; a.ldo = DM;
            a.q0 = q0; a.j_lo = q0 - 127 < 0 ? 0 : (q0 - 127) >> 6; a.j_hi = ((q0 + 31) >> 6) + 1; a.W = 128; a.dec = nullptr; a.sinkl = 0.f; a.sinks = sinks + kvh * 8;
            a.biasT = BIAST + kvh * 8 * 128; a.kmax = 0.f;
            fa::attn_unit<64, 64, 2>(a, (LAS char*)lds); }
        GRID_BAR(3);
    }
    PHASE(4) {
        WSL();
        pg8::PolPlain P{(const char*)O0, DM * 2, (const char*)(ws + WS_WO0), DM * 2, DM};
        pg8::StaticOrder S; S.init(M / 256, DM / 256, G, bx, 0, WGM_K2048);
        pg8::EpiRes<true> E{XIN, XH, SSQ};
        pg8::gemm_phase(lds, P, S, E);
        GRID_BAR(4);
    }
#define CROSS_PHASES(l, s0) \
    PHASE(s0) { WSL(); \
        pg8::PolPlain P{(const char*)XH  , DM * 2, (const char*)(ws + WS_WXQ + (size_t)(l) * E_XQ * 2)  , DM * 2, DM}; \
        pg8::StaticOrder S; S.init(M / 256, 512 / 256, G, bx, 0, WGM_K2048); \
        pg8::EpiStore<0, 32> E{QX, 512, SSQ, (LAS float*)(lds + RING_BYTES + 12288), 1.f / DM, nullptr, nullptr, nullptr, nullptr, nullptr, nullptr}; \
        pg8::gemm_phase<pg8::EpiStore<0, 32>, pg8::PolPlain, 3>(lds, P, S, E); \
        GRID_BAR(s0); } \
    PHASE((s0) + 1) { WSL(); \
        _Pragma("unroll 1") for (int it = vcu; it < BATCH * 4 * 64; it += G) { \
            const int bh = it >> 6, qb = it & 63, b = bh >> 2, h = bh & 3; \
            fa::AttnArgs a; a.Q = QX + (size_t)b * SEQ * 512 + h * 128; a.ldq = 512; a.K = MEMKV + (size_t)b * MEMLEN * 2048 + (l) * 1024 + h * 128; a.ldk = 2048; \
            a.V = a.K + 512; a.ldv = 2048; a.O = OX + (size_t)b * SEQ * 512 + h * 128; a.ldo = 512; \
            a.q0 = qb * 256; a.j_lo = 0; a.j_hi = 4; a.W = 0x3fffffff; a.dec = nullptr; a.sinkl = 0.f; a.sinks = nullptr; a.biasT = nullptr; a.kmax = 0.f; \
            fa::attn_unit<128, 128, 3>(a, (LAS char*)lds); } \
        GRID_BAR((s0) + 1); } \
    PHASE((s0) + 2) { WSL(); \
        pg8::PolPlain P{(const char*)OX, 512 * 2, (const char*)(ws + WS_WXO + (size_t)(l) * E_XO * 2), 512 * 2, 512}; \
        pg8::StaticOrder S; S.init(M / 256, DM / 256, G, bx, 0); \
        pg8::EpiRes<false> E{XH, XH, nullptr};           \
        pg8::gemm_phase(lds, P, S, E); \
        GRID_BAR((s0) + 2); }
    CROSS_PHASES(0, 5)
    PHASE(45) {
        WSL();
#pragma unroll 1
        for (int m = gw; m < M; m += NGW) {
            const u32x2* xr = (const u32x2*)(XH + (size_t)m * DM) + lane; f32x4 v[8]; float ss = 0.f, amx = 0.f;
#pragma unroll
            for (int j = 0; j < 8; ++j) { v[j] = unpk_f16x4(xr[64 * j]); ss += (v[j][0] * v[j][0] + v[j][1] * v[j][1]) + (v[j][2] * v[j][2] + v[j][3] * v[j][3]);
                amx = fmaxf(amx, fmaxf(fmaxf(fabsf(v[j][0]), fabsf(v[j][1])), fmaxf(fabsf(v[j][2]), fabsf(v[j][3])))); }
            ss = wave_sum(ss);
#pragma unroll
            for (int o_ = 1; o_ < 64; o_ <<= 1) amx = fmaxf(amx, __shfl_xor(amx, o_));
            const float inv = amx > 0.f ? 127.f / amx : 0.f; unsigned* xq = (unsigned*)(XQ + (size_t)m * DM) + lane;
#pragma unroll
            for (int j = 0; j < 8; ++j) { const int q0 = (int)__builtin_rintf(v[j][0] * inv), q1 = (int)__builtin_rintf(v[j][1] * inv), q2 = (int)__builtin_rintf(v[j][2] * inv), q3 = (int)__builtin_rintf(v[j][3] * inv);
                xq[64 * j] = (unsigned)(q0 & 255) | ((unsigned)(q1 & 255) << 8) | ((unsigned)(q2 & 255) << 16) | ((unsigned)(q3 & 255) << 24); }
            if (lane == 0) RSTDF[m] = __builtin_amdgcn_rsqf(ss * (1.f / DM) + EPS) * amx * (1.f / 127.f);
        }
        GRID_BAR(7);
    }
#pragma unroll 1
    for (int p = 0; p < 5; ++p) {
        PHASE(8 + p) {
            if (p >= 1) {
                WSL();
                const int c = p - 1;
                pg8::PolChunkA P{(const char*)HIDB(c), 128, (const char*)(ws + WS_WD0), 128, DFF, c * CHUNK_TILES};
                pg8::StaticOrder S; S.init(CHUNK_TILES, DM / 256, G, bx, c * CHUNK_TILES, WGM_DOWN);
                pg8::EpiRes<false> E{XH, XH, SSQ};
                pg8::gemm_phase(lds, P, S, E);
            }
            int pg = p; asm volatile("" : "+s"(pg));
            if (pg <= 3) {
                WSL();
                pg8::PolPlain P{(const char*)XQ, DM, (const char*)(ws + WS_WGU0)  , DM, DM / 2};
                pg8::StaticOrder S; S.init(CHUNK_TILES, 2 * DFF / 256, G, bx, pg * CHUNK_TILES, WGM_GU);
                pg8::EpiSwiGLU<2> E{HIDB(pg), pg * CHUNK_ROWS, nullptr, RSTDF, ctl + CW_AMAXW + 8 * 2 * DFF, nullptr};
                pg8::gemm_phase<pg8::EpiSwiGLU<2>, pg8::PolPlain, 1>(lds, P, S, E);
            }
            GRID_BAR(8 + p);
        }
    }
    PHASE(46) {
        WSL();
#pragma unroll 1
        for (int m = gw; m < M; m += NGW) {
            const u32x2* xr = (const u32x2*)(XH + (size_t)m * DM) + lane; f32x4 v[8]; float ss = 0.f, amx = 0.f;
#pragma unroll
            for (int j = 0; j < 8; ++j) { v[j] = unpk_f16x4(xr[64 * j]); ss += (v[j][0] * v[j][0] + v[j][1] * v[j][1]) + (v[j][2] * v[j][2] + v[j][3] * v[j][3]);
                amx = fmaxf(amx, fmaxf(fmaxf(fabsf(v[j][0]), fabsf(v[j][1])), fmaxf(fabsf(v[j][2]), fabsf(v[j][3])))); }
            ss = wave_sum(ss);
#pragma unroll
            for (int o_ = 1; o_ < 64; o_ <<= 1) amx = fmaxf(amx, __shfl_xor(amx, o_));
            const float inv = amx > 0.f ? 127.f / amx : 0.f; unsigned* xq = (unsigned*)(XQ + (size_t)m * DM) + lane;
#pragma unroll
            for (int j = 0; j < 8; ++j) { const int q0 = (int)__builtin_rintf(v[j][0] * inv), q1 = (int)__builtin_rintf(v[j][1] * inv), q2 = (int)__builtin_rintf(v[j][2] * inv), q3 = (int)__builtin_rintf(v[j][3] * inv);
                xq[64 * j] = (unsigned)(q0 & 255) | ((unsigned)(q1 & 255) << 8) | ((unsigned)(q2 & 255) << 16) | ((unsigned)(q3 & 255) << 24); }
            if (lane == 0) RSTDF[m] = __builtin_amdgcn_rsqf(ss * (1.f / DM) + EPS) * amx * (1.f / 127.f);
        }
        GRID_BAR(15);
    }
    PHASE(16) {
        WSL();
        pg8::PolPlain P{(const char*)XQ  , DM, (const char*)(ws + WS_WIN1)  , DM, DM / 2};
        pg8::StaticOrder S; S.init(M / 256, IN1_PAD / 256, G, bx, 0, WGM_K2048);
        pg8::EpiStore<4, 32> E{Z1, Z1_LD, nullptr, (LAS float*)(lds + RING_BYTES + 12288), 1.f / DM, nullptr, nullptr, nullptr, nullptr, nullptr, FL, RSTDF, ctl + CW_AMAX15};
        pg8::gemm_phase<pg8::EpiStore<4, 32>, pg8::PolPlain, 1>(lds, P, S, E);
        GRID_BAR(16);
    }
    PHASE(17) {
        WSL();
#pragma unroll 1
        for (int b = 0; b < BATCH; ++b) {
            float kmx = 0.f;
#pragma unroll 1
            for (int r = gw; r < SEQ; r += NGW) {
                const u32x4* kp = (const u32x4*)(Z1 + ((size_t)b * SEQ + r) * Z1_LD + 2048 + lane * 32); float ss = 0.f;
#pragma unroll
                for (int q = 0; q < 4; ++q) { const u32x4 w = kp[q];
#pragma unroll
                    for (int e = 0; e < 4; ++e) { const float lo_ = __uint_as_float(w[e] << 16), hi_ = __uint_as_float(w[e] & 0xffff0000u); ss += lo_ * lo_ + hi_ * hi_; } }
                ss += __shfl_xor(ss, 1); ss += __shfl_xor(ss, 2);
                kmx = fmaxf(kmx, ss);
            }
            if ((lane & 3) == 0) atomicMax(ctl + CW_KMAX + 64 * (b * 16 + (lane >> 2)), __float_as_uint(kmx));
        }
        const float* bfv = (const float*)args.in[I_BF];
        LAS double* wtot = (LAS double*)lds;
#pragma unroll 1
        for (int bh = bx; bh < BATCH * 16; bh += G) {
            const int b = bh >> 4, h = bh & 15; const float bias = bfv[h];
            const size_t base = ((size_t)b * SEQ + (size_t)tid * 32) * 16 + h;
            float lf[32]; double run = 0.0;
#pragma unroll
            for (int i = 0; i < 32; ++i) { const float xv = FL[base + (size_t)i * 16] + bias; lf[i] = fminf(xv, 0.f) - log1pf(expf(-fabsf(xv))); }
#pragma unroll
            for (int i = 0; i < 32; ++i) run += (double)lf[i];
            double incl = run;
#pragma unroll
            for (int o = 1; o < 64; o <<= 1) { const double t = __shfl_up(incl, o); if (lane >= o) incl += t; }
            if (lane == 63) wtot[wave] = incl;
            __syncthreads();
            double off = incl - run;
            for (int w = 0; w < wave; ++w) off += wtot[w];
            double cacc = off;
#pragma unroll
            for (int i = 0; i < 32; ++i) { cacc += (double)lf[i]; DEC[base + (size_t)i * 16] = (float)(cacc * 1.4426950408889634); }
            __syncthreads();
        }
        GRID_BAR(17);
    }
    PHASE(18) {
        WSL();
        LAS int* qslot = (LAS int*)(lds + RING_BYTES + 8192);
#pragma unroll 1
        for (;;) {
            if (tid == 0) qslot[0] = (int)__hip_atomic_fetch_add(ctl + CW_Q18, 1u, RLX_AGENT);
            __syncthreads();
            const int u = qslot[0];
            __syncthreads();
            if (u >= BATCH * 16 * 64) break;
            const int qb = 63 - (u >> 5), bh = u & 31, b = bh >> 4, h = bh & 15;
            fa::AttnArgs a; const bf16_t* zb = Z1 + (size_t)b * SEQ * Z1_LD;
            a.Q = zb + h * 128; a.ldq = Z1_LD; a.K = zb + 2048 + h * 128; a.ldk = Z1_LD; a.V = zb + 4096 + h * 128; a.ldv = Z1_LD;
            a.O = O1 + (size_t)b * SEQ * DM + h * 128; a.ldo = DM;
            a.q0 = qb * 256; a.j_lo = 0; a.j_hi = qb * 4 + 4; a.W = 0x3fffffff; a.dec = DEC + (size_t)b * SEQ * 16 + h; a.sinkl = 0.f; a.sinks = nullptr; a.biasT = nullptr;
            a.kmax = sqrtf(__uint_as_float(__hip_atomic_load(ctl + CW_KMAX + 64 * bh, RLX_AGENT)));
            fa::attn_unit<128, 128, 1>(a, (LAS char*)lds);
        }
        GRID_BAR(18);
    }
    PHASE(19) {
        WSL();
        pg8::PolPlain P{(const char*)O1, DM * 2, (const char*)(ws + WS_WO1), DM * 2, DM};
        pg8::StaticOrder S; S.init(M / 256, DM / 256, G, bx, 0, WGM_K2048);
        pg8::EpiRes<false> E{XH, XH, SSQ};
        pg8::gemm_phase(lds, P, S, E);
        GRID_BAR(19);
    }
    CROSS_PHASES(1, 20)
    PHASE(23) {
        WSL();
        LAS float* WrT = (LAS float*)lds;
        const float* rw = (const float*)args.in[I_RW]; const float* gn = (const float*)args.in[I_NFFN] + DM; const float* rb = (const float*)args.in[I_RB];
        for (int i = tid; i < 8 * DM; i += 512) { const int e = i >> 11, k = i & 2047; WrT[i] = rw[k * 8 + e] * gn[k]; }
        __syncthreads();
#pragma unroll 1
        for (int g16 = gw; g16 < M / 16; g16 += NGW) {
            int e1 = 0, e2 = 0; float g1 = 0.f, g2 = 0.f, rstd = 0.f;
#pragma unroll 1
            for (int i = 0; i < 16; ++i) {
                const int row = g16 * 16 + i;
                const u32x2* xr = (const u32x2*)(XH + (size_t)row * DM) + lane;
                float pe[8], ss = 0.f, amx = 0.f;
#pragma unroll
                for (int e = 0; e < 8; ++e) pe[e] = 0.f;
#pragma unroll 2
                for (int j = 0; j < 8; ++j) { const f32x4 v = unpk_f16x4(xr[64 * j]); ss += (v[0] * v[0] + v[1] * v[1]) + (v[2] * v[2] + v[3] * v[3]);
                    amx = fmaxf(amx, fmaxf(fmaxf(fabsf(v[0]), fabsf(v[1])), fmaxf(fabsf(v[2]), fabsf(v[3]))));
#pragma unroll
                    for (int e = 0; e < 8; ++e) { const f32x4 w = *(const LAS f32x4*)(WrT + e * DM + 256 * j + lane * 4); pe[e] += (v[0] * w[0] + v[1] * w[1]) + (v[2] * w[2] + v[3] * w[3]); } }
                ss = wave_sum(ss);
#pragma unroll
                for (int e = 0; e < 8; ++e) pe[e] = wave_sum(pe[e]);
                const float rs = __builtin_amdgcn_rsqf(ss * (1.f / DM) + EPS);
#pragma unroll
                for (int o_ = 1; o_ < 64; o_ <<= 1) amx = fmaxf(amx, __shfl_xor(amx, o_));
                { const float inv = amx > 0.f ? 127.f / amx : 0.f; unsigned* xq = (unsigned*)(XQ + (size_t)row * DM) + lane;
#pragma unroll 2
                  for (int j = 0; j < 8; ++j) { const f32x4 v = unpk_f16x4(xr[64 * j]);
                      const int q0 = (int)__builtin_rintf(v[0] * inv), q1 = (int)__builtin_rintf(v[1] * inv), q2 = (int)__builtin_rintf(v[2] * inv), q3 = (int)__builtin_rintf(v[3] * inv);
                      xq[64 * j] = (unsigned)(q0 & 255) | ((unsigned)(q1 & 255) << 8) | ((unsigned)(q2 & 255) << 16) | ((unsigned)(q3 & 255) << 24); } }
                const float rowf = rs * amx * (1.f / 127.f);
                float lg[8];
#pragma unroll
                for (int e = 0; e < 8; ++e) lg[e] = pe[e] * rs + rb[e];
                int b1 = 0; float v1 = lg[0];
#pragma unroll
                for (int e = 1; e < 8; ++e) if (lg[e] > v1) { v1 = lg[e]; b1 = e; }
                int b2 = -1; float v2 = -__builtin_inff();
#pragma unroll
                for (int e = 0; e < 8; ++e) if (e != b1 && lg[e] > v2) { v2 = lg[e]; b2 = e; }
                const float ex = __expf(v2 - v1); const float gg2 = ex / (1.f + ex), gg1 = 1.f / (1.f + ex);
                if (lane == i) { e1 = b1; e2 = b2; g1 = gg1; g2 = gg2; rstd = rowf; }
            }
            int s1 = 0, s2 = 0;
#pragma unroll
            for (int e = 0; e < 8; ++e) {
                const unsigned long long m1 = __ballot(lane < 16 && e1 == e), m2 = __ballot(lane < 16 && e2 == e);
                const int c1 = __popcll(m1), c2 = __popcll(m2);
                int basev = 0;
                if (lane == 0 && c1 + c2 > 0) basev = (int)__hip_atomic_fetch_add(ctl + CW_CNT + 64 * e, (unsigned)(c1 + c2), RLX_AGENT);
                basev = __shfl(basev, 0);
                const unsigned long long lt = (1ull << lane) - 1ull;
                if (lane < 16 && e1 == e) s1 = basev + __popcll(m1 & lt);
                if (lane < 16 && e2 == e) s2 = basev + c1 + __popcll(m2 & lt);
            }
            if (lane < 16) { const int row = g16 * 16 + lane; TOPE[row * 2] = e1; TOPE[row * 2 + 1] = e2; TOPS[row * 2] = s1; TOPS[row * 2 + 1] = s2;
                TOPG[row * 2] = g1; TOPG[row * 2 + 1] = g2; RSTDF[row] = rstd; }
        }
        GRID_BAR(23);
    }
    if (hi > 24) {
#define EOFF() int eoff[9]; eoff[0] = 0; _Pragma("unroll") for (int e = 0; e < 8; ++e) { const int c_ = (int)__hip_atomic_load(ctl + CW_CNT + 64 * e, RLX_AGENT); eoff[e + 1] = eoff[e] + ((c_ + 255) & ~255); }
        PHASE(24) {
            WSL();
            EOFF();
            int ecnt[8];
#pragma unroll
            for (int e = 0; e < 8; ++e) ecnt[e] = (int)__hip_atomic_load(ctl + CW_CNT + 64 * e, RLX_AGENT);
            int gt1_ = tid; asm volatile("" : "+v"(gt1_)); gt1_ += bx * 512;
            for (int i = gt1_; i < M * 2; i += G * 512) {
                const int e = TOPE[i], sl = TOPS[i]; int off = 0;
#pragma unroll
                for (int q = 0; q < 8; ++q) if (q == e) off = eoff[q];
                const int pos = off + sl; ROWIDX[pos] = i >> 1; GATEP[pos] = TOPG[i]; RSTDP[pos] = RSTDF[i >> 1]; TOKPOS[i] = pos;
            }
            for (int i = gt1_; i < 8 * 256; i += G * 512) {
                const int e = i >> 8, j = i & 255; int off = 0, cnt = 0, nxt = 0;
#pragma unroll
                for (int q = 0; q < 8; ++q) if (q == e) { off = eoff[q]; cnt = ecnt[q]; nxt = eoff[q + 1]; }
                const int pos = off + cnt + j;
                if (pos < nxt) { ROWIDX[pos] = 0; GATEP[pos] = 0.f; RSTDP[pos] = 0.f; }
            }
            GRID_BAR(24);
        }
        LAS int* TILE_E = (LAS int*)(lds + RING_BYTES + 1024);
        if (hi > 25) {
            EOFF();
            for (int t = tid; t < MOE_MAX_TILES; t += 512) { int e = 0;
#pragma unroll
                for (int q = 1; q < 8; ++q) if (t * 256 >= eoff[q]) e = q;
                TILE_E[t] = e; }
            if (tid == 0) TILE_E[MOE_MAX_TILES] = eoff[8] >> 8;
            __syncthreads();
        }
#pragma unroll 1
        for (int p = 0; p <= MOE_CHUNKS; ++p) {
            PHASE(25 + p) {
                int ndown = 0;
                { WSL();
                const int ntiles = TILE_E[MOE_MAX_TILES], nch = (ntiles + MCH_TILES - 1) / MCH_TILES, t0 = ntiles - MCH_TILES * (nch - 1);
                if (p >= 1 && p - 1 < nch) {
                    const int c = p - 1, ft = c == 0 ? 0 : t0 + (c - 1) * MCH_TILES, nt_ = c == 0 ? t0 : MCH_TILES;
                    pg8::PolMoeDown P{(const char*)HIDB(c)  , 128, (const char*)(ws + WS_WD1)  , 128, DFF / 2, ft, TILE_E, E_D};
                    pg8::StaticOrder S; S.init(nt_, DM / 256, G, bx, ft, WGM_DOWN);
                    pg8::EpiMoeDown E{YB, GATEP};
                    pg8::gemm_phase<pg8::EpiMoeDown, pg8::PolMoeDown, 4>(lds, P, S, E);
                    ndown = nt_ * (DM / 256);
                } }
                int pg = p; asm volatile("" : "+s"(pg), "+s"(ndown));
                { WSL();
                const int ntiles = TILE_E[MOE_MAX_TILES], nch = (ntiles + MCH_TILES - 1) / MCH_TILES, t0 = ntiles - MCH_TILES * (nch - 1);
                if (pg < nch) {
                    const int ft = pg == 0 ? 0 : t0 + (pg - 1) * MCH_TILES, nt_ = pg == 0 ? t0 : MCH_TILES;
                    pg8::PolMoeUp P{(const char*)XQ  , DM, (const char*)(ws + WS_WGU1)  , DM, DM / 2, ROWIDX, TILE_E, E_GU};
                    pg8::StaticOrder S; S.init(nt_, 2 * DFF / 256, G, bx, ft, WGM_GU); S.quota(ndown);
                    pg8::EpiSwiGLU<2> E{HIDB(pg), ft * 256, nullptr, RSTDP, ctl + CW_AMAXW, TILE_E, 1};
                    pg8::gemm_phase<pg8::EpiSwiGLU<2>, pg8::PolMoeUp, 1>(lds, P, S, E);
                } }
                GRID_BAR(25 + p);
            }
        }
    }
    PHASE(43) {
        WSL();
        const float* fn = (const float*)args.in[I_FNORM];
#pragma unroll 1
        for (int m = gw; m < M; m += NGW) {
            const int p0 = TOKPOS[m * 2], p1 = TOKPOS[m * 2 + 1];
            const u32x2* xr = (const u32x2*)(XH + (size_t)m * DM) + lane; f32x4* orow = (f32x4*)(args.out + (size_t)m * DM) + lane;
            const u32x2* y0 = (const u32x2*)(YB + (size_t)p0 * DM) + lane; const u32x2* y1 = (const u32x2*)(YB + (size_t)p1 * DM) + lane;
            f32x4 v[8]; float s = 0.f;
#pragma unroll
            for (int j = 0; j < 8; ++j) { v[j] = unpk_f16x4(xr[64 * j]); const u32x2 a0 = y0[64 * j], a1 = y1[64 * j];
                v[j][0] += __uint_as_float(a0.x << 16) + __uint_as_float(a1.x << 16); v[j][1] += __uint_as_float(a0.x & 0xffff0000u) + __uint_as_float(a1.x & 0xffff0000u);
                v[j][2] += __uint_as_float(a0.y << 16) + __uint_as_float(a1.y << 16); v[j][3] += __uint_as_float(a0.y & 0xffff0000u) + __uint_as_float(a1.y & 0xffff0000u);
                s += (v[j][0] * v[j][0] + v[j][1] * v[j][1]) + (v[j][2] * v[j][2] + v[j][3] * v[j][3]); }
            s = wave_sum(s); const float rs = __builtin_amdgcn_rsqf(s * (1.f / DM) + EPS);
#pragma unroll
            for (int j = 0; j < 8; ++j) { const f32x4 g = *((const f32x4*)fn + lane + 64 * j); orow[64 * j] = v[j] * rs * g; }
        }
    }
#undef IN
#undef GRID_BAR
}

constexpr int N_STEPS = 47;
extern "C" void kernel_launch(void* const* d_in, const int* in_sizes, int n_in, void* d_out, int out_size, void* d_ws, size_t ws_size, hipStream_t stream) {
    static int grid = 0;
    if (grid == 0) {
        if (n_in != N_IN || in_sizes[0] != M * DM || out_size != M * DM || ws_size < WS_END) {
            fprintf(stderr, "kernel_launch: shape / workspace mismatch (n_in %d, in0 %d, out %d, ws %zu, need %zu); nothing launched\n", n_in, n_in > 0 ? in_sizes[0] : -1, out_size, ws_size, (size_t)WS_END); grid = -1; return; }
        int dev = 0, cus = 0, per_cu = 0;
        if (hipGetDevice(&dev) != hipSuccess || hipDeviceGetAttribute(&cus, hipDeviceAttributeMultiprocessorCount, dev) != hipSuccess) { grid = -1; return; }
        if (hipFuncSetAttribute((const void*)trunk_fwd, hipFuncAttributeMaxDynamicSharedMemorySize, LDS_BYTES) != hipSuccess) { fprintf(stderr, "kernel_launch: hipFuncSetAttribute failed\n"); grid = -1; return; }
        if (hipOccupancyMaxActiveBlocksPerMultiprocessor(&per_cu, (const void*)trunk_fwd, NWAVES * 64, LDS_BYTES) != hipSuccess || per_cu < 1)
            fprintf(stderr, "kernel_launch: note: occupancy query reports %d workgroups per CU\n", per_cu);
        (void)hipGetLastError();
        grid = cus;
    }
    if (grid < 0) return;
    if (hipMemsetAsync((char*)d_ws + WS_CTL, 0, CTL_BYTES, stream) != hipSuccess) return;
    Args a{};
    for (int i = 0; i < N_IN; ++i) a.in[i] = d_in[i];
    a.out = (float*)d_out; a.ws = (unsigned char*)d_ws;
#if MK_ONE_LAUNCH
    a.ph_lo = 0; a.ph_hi = N_STEPS;
    hipLaunchKernelGGL(trunk_fwd, dim3(grid), dim3(NWAVES * 64), LDS_BYTES, stream, a);
#else
    for (int i = 0; i < N_STEPS; ++i) { const int s = i == 0 ? 0 : (i == 1 ? 44 : (i <= 8 ? i - 1 : (i == 9 ? 45 : (i <= 14 ? i - 2 : (i == 15 ? 46 : i - 3))))); a.ph_lo = s; a.ph_hi = s + 1; hipLaunchKernelGGL(trunk_fwd, dim3(grid), dim3(NWAVES * 64), LDS_BYTES, stream, a); }
#endif
}
```

```cpp
#include <hip/hip_runtime.h>
#include <hip/hip_bf16.h>
#include <cstdio>
#include <cstdint>
#include <cmath>

#ifndef MK_ONE_LAUNCH
#define MK_ONE_LAUNCH 1
#endif

#define GAS __attribute__((address_space(1)))
#define LAS __attribute__((address_space(3)))
typedef unsigned short bf16_t;
typedef short bf16x8 __attribute__((ext_vector_type(8)));
typedef short s16x4 __attribute__((ext_vector_type(4)));
typedef float f32x2 __attribute__((ext_vector_type(2)));
typedef float f32x4 __attribute__((ext_vector_type(4)));
typedef float f32x16 __attribute__((ext_vector_type(16)));
typedef unsigned u32x2 __attribute__((ext_vector_type(2)));
typedef unsigned u32x4 __attribute__((ext_vector_type(4)));
typedef int i32x4 __attribute__((ext_vector_type(4)));
typedef long i64x2 __attribute__((ext_vector_type(2)));

constexpr int BATCH = 2, SEQ = 16384, DM = 2048, M = BATCH * SEQ, MEMLEN = 256, MROWS = BATCH * MEMLEN;
constexpr int EVEN_IN = 2624, Z0_LD = 2816, ODD_IN = 6160, Z1_LD = 6144, IN1_PAD = 6400;
constexpr int DFF = 7168, NEXP = 8;
constexpr int HLD = DFF + 64;
constexpr int QM_LD = 1536, KM_LD = 1536, VM_LD = 1024;
constexpr float LOG2E = 1.4426950408889634f;
constexpr float C2_MLA = LOG2E * 0.07216878364870323f;
constexpr float C2_SWA = LOG2E * 0.125f;
constexpr float C2_128 = LOG2E * 0.08838834764831845f;
constexpr float EPS = 1e-6f;
constexpr int CHUNK_ROWS = 8192, CHUNK_TILES = 32, MOE_MAX_TILES = 264, MOE_MAX_ROWS = MOE_MAX_TILES * 256;
constexpr int MCH_TILES = 64, MCH_ROWS = MCH_TILES * 256, MOE_CHUNKS = (MOE_MAX_TILES + MCH_TILES - 1) / MCH_TILES;

enum { I_X = 0, I_MEM, I_POS, I_RELB, I_NMIX, I_NCROSS, I_NMEM, I_NFFN, I_XWQ, I_XWK, I_XWV, I_XWO, I_EVWIN, I_QNORM, I_WUQ, I_KVNORM, I_WUKV, I_SINKS, I_EVWO,
       I_FG, I_FU, I_FD, I_ODWIN, I_BF, I_ODWO, I_RW, I_RB, I_MG, I_MU, I_MD, I_FNORM, N_IN };

constexpr size_t al256(size_t x) { return (x + 255) & ~(size_t)255; }
constexpr size_t WS_CTL = 0, CTL_BYTES = 1u << 20;
constexpr size_t E_IN0 = (size_t)Z0_LD * DM, E_UQ = (size_t)1536 * 768, E_UKV = (size_t)2048 * 512, E_SQ = (size_t)DM * DM, E_XQ = (size_t)512 * DM, E_XKV = (size_t)2048 * DM,
                 E_XO = (size_t)DM * 512, E_GU = (size_t)2 * DFF * DM, E_D = (size_t)DM * DFF, E_IN1 = (size_t)IN1_PAD * DM;
constexpr size_t WS_WIN0 = WS_CTL + CTL_BYTES;
constexpr size_t WS_WUQ = WS_WIN0 + 2 * E_IN0;
constexpr size_t WS_WUKV = WS_WUQ + 2 * E_UQ;
constexpr size_t WS_WO0 = WS_WUKV + 2 * E_UKV;
constexpr size_t WS_WXQ = WS_WO0 + 2 * E_SQ;
constexpr size_t WS_WXKV = WS_WXQ + 2 * 2 * E_XQ;
constexpr size_t WS_WXO = WS_WXKV + 2 * E_XKV;
constexpr size_t WS_WGU0 = WS_WXO + 2 * 2 * E_XO;
constexpr size_t WS_WD0 = WS_WGU0 + 2 * E_GU;
constexpr size_t WS_WIN1 = WS_WD0 + 2 * E_D;
constexpr size_t WS_WO1 = WS_WIN1 + 2 * E_IN1;
constexpr size_t WS_WGU1 = WS_WO1 + 2 * E_SQ;
constexpr size_t WS_WD1 = WS_WGU1 + 2 * 8 * E_GU;
constexpr size_t WS_XB = WS_WD1 + 2 * 8 * E_D;
constexpr size_t WS_SSQ = WS_XB + (size_t)M * DM * 2;
constexpr size_t WS_ROPE = WS_SSQ + (size_t)M * 32 * 4;
constexpr size_t WS_MEMN = WS_ROPE + (size_t)M * 64 * 4;
constexpr size_t WS_SSQM = WS_MEMN + (size_t)MROWS * DM * 2;
constexpr size_t WS_MEMKV = WS_SSQM + (size_t)MROWS * 32 * 4;
constexpr size_t WS_SSQQ = WS_MEMKV + (size_t)MROWS * 2048 * 2;
constexpr size_t WS_SSQKV = WS_SSQQ + (size_t)M * 12 * 4;
constexpr size_t WS_QX = WS_SSQKV + (size_t)M * 8 * 4;
constexpr size_t WS_OX = WS_QX + (size_t)M * 512 * 2;
constexpr size_t WS_FL = WS_OX + (size_t)M * 512 * 2;
constexpr size_t WS_DEC = WS_FL + (size_t)M * 16 * 4;
constexpr size_t WS_TOPE = WS_DEC + (size_t)M * 16 * 4;
constexpr size_t WS_TOPS = WS_TOPE + (size_t)M * 2 * 4;
constexpr size_t WS_TOPG = WS_TOPS + (size_t)M * 2 * 4;
constexpr size_t WS_RSTDF = WS_TOPG + (size_t)M * 2 * 4;
constexpr size_t WS_TOKPOS = WS_RSTDF + (size_t)M * 4;
constexpr size_t WS_ROWIDX = WS_TOKPOS + (size_t)M * 2 * 4;
constexpr size_t WS_GATEP = WS_ROWIDX + (size_t)MOE_MAX_ROWS * 4;
constexpr size_t WS_RSTDP = WS_GATEP + (size_t)MOE_MAX_ROWS * 4;
constexpr size_t WS_BIAST = WS_RSTDP + (size_t)MOE_MAX_ROWS * 4;
constexpr size_t WS_ARENA = al256(WS_BIAST + 16 * 128 * 4);
constexpr size_t AR_Z0 = 0;
constexpr size_t AR_QM = AR_Z0 + (size_t)M * Z0_LD * 2;
constexpr size_t AR_KM = AR_QM + (size_t)M * QM_LD * 2;
constexpr size_t AR_VM = AR_KM + (size_t)M * KM_LD * 2;
constexpr size_t AR_O0 = AR_VM + (size_t)M * VM_LD * 2;
constexpr size_t AR_END0 = AR_O0 + (size_t)M * DM * 2;
constexpr size_t AR_HID = 0;
constexpr size_t HID_BYTES = (size_t)CHUNK_ROWS * DFF * 2;
constexpr size_t AR_Y = AR_HID + 2 * HID_BYTES;
constexpr size_t AR_END2 = AR_Y + (size_t)MOE_MAX_ROWS * DM * 2;
constexpr size_t AR_Z1 = 0;
constexpr size_t AR_O1 = AR_Z1 + (size_t)M * Z1_LD * 2;
constexpr size_t AR_END1 = AR_O1 + (size_t)M * DM * 2;
constexpr size_t AR_SIZE = AR_END0 > AR_END1 ? (AR_END0 > AR_END2 ? AR_END0 : AR_END2) : (AR_END1 > AR_END2 ? AR_END1 : AR_END2);
constexpr size_t WS_END = WS_ARENA + AR_SIZE;

constexpr int CW_BAR = 4096;
constexpr int CW_CNT = 16384;
constexpr int CW_KMAX = 20480;
constexpr int CW_Q18 = 24576;
constexpr int CW_AMAX15 = 32768;
constexpr int CW_AMAX0 = 40960;
constexpr int CW_NEFF = 65536;
constexpr int CW_AMAXW = 131072;
static_assert((CW_AMAXW + 9 * 14336) * 4 <= (int)CTL_BYTES, "CTL map");

constexpr int RING_BYTES = 131072;
constexpr int MISC_OFF = RING_BYTES + 320;
constexpr int LDS_BYTES = 147456;
constexpr int NWAVES = 8;
#ifndef WGM_GU
#define WGM_GU 4
#endif
#ifndef WGM_K2048
#define WGM_K2048 4
#endif
#ifndef WGM_DOWN
#define WGM_DOWN 8
#endif

#define LDS_WAIT() asm volatile("s_waitcnt lgkmcnt(0)" ::: "memory")
#define VM_WAIT() asm volatile("s_waitcnt vmcnt(0)" ::: "memory")
#define RLX_AGENT __ATOMIC_RELAXED, __HIP_MEMORY_SCOPE_AGENT
__device__ __forceinline__ unsigned cvt_pk_bf16(float lo, float hi) { unsigned r; asm volatile("v_cvt_pk_bf16_f32 %0, %1, %2" : "=v"(r) : "v"(lo), "v"(hi)); return r; }
typedef _Float16 h16x2 __attribute__((ext_vector_type(2)));
typedef _Float16 h16x8 __attribute__((ext_vector_type(8)));
__device__ __forceinline__ unsigned pk_f16(float lo, float hi) { const h16x2 v = {(_Float16)lo, (_Float16)hi}; return __builtin_bit_cast(unsigned, v); }
__device__ __forceinline__ f32x2 unpk_f16(unsigned u) { const h16x2 v = __builtin_bit_cast(h16x2, u); return (f32x2){(float)v.x, (float)v.y}; }
__device__ __forceinline__ f32x4 unpk_f16x4(u32x2 u) { const f32x2 a = unpk_f16(u.x), b = unpk_f16(u.y); return (f32x4){a.x, a.y, b.x, b.y}; }
__device__ __forceinline__ u32x2 pack8_fp8(f32x4 a, f32x4 b) {
    int lo = 0, hi = 0;
    lo = __builtin_amdgcn_cvt_pk_fp8_f32(a[0], a[1], lo, false); lo = __builtin_amdgcn_cvt_pk_fp8_f32(a[2], a[3], lo, true);
    hi = __builtin_amdgcn_cvt_pk_fp8_f32(b[0], b[1], hi, false); hi = __builtin_amdgcn_cvt_pk_fp8_f32(b[2], b[3], hi, true);
    return (u32x2){(unsigned)lo, (unsigned)hi};
}
__device__ __forceinline__ float bf2f(unsigned short b) { return __uint_as_float((unsigned)b << 16); }
__device__ __forceinline__ float wave_sum(float v) {
#pragma unroll
    for (int o = 1; o < 64; o <<= 1) v += __shfl_xor(v, o);
    return v;
}

#define XB_TMO      128
#define XB_XCNT(j)  (256  + 64 * (j))
#define XB_XSUB(j)  (1280 + 64 * (j))
#define XB_XGEN(j)  (2304 + 64 * (j))
#define XB_TOP      3328
#define XB_TOPGEN   3392
#define XCD_BAR_WORDS 3456
#define XB_SPIN_CAP (1u << 18)
__device__ __forceinline__ unsigned xb_ld(unsigned* p)              { return __hip_atomic_load(p, __ATOMIC_RELAXED, __HIP_MEMORY_SCOPE_AGENT); }
__device__ __forceinline__ unsigned xb_add(unsigned* p, unsigned v) { return __hip_atomic_fetch_add(p, v, __ATOMIC_RELAXED, __HIP_MEMORY_SCOPE_AGENT); }
__device__ __forceinline__ unsigned xb_xcc_id() { return (unsigned)__builtin_amdgcn_s_getreg((3 << 11) | 20) & 0xFu; }
#define XB_SPIN(cond, bar) do { unsigned _sp = 0; while (cond) { __builtin_amdgcn_s_sleep(1); \
    if ((++_sp & 255u) == 0u) { if (xb_ld(&(bar)[XB_TMO])) break; if (_sp > XB_SPIN_CAP) { atomicAdd(&(bar)[XB_TMO], 1u); break; } } } } while (0)
struct XcdBarrier { unsigned* bar; unsigned x; volatile LAS unsigned* st; };
__device__ __forceinline__ XcdBarrier xcd_barrier_post(unsigned* bar, volatile LAS unsigned* st) {
    XcdBarrier b; b.bar = bar; b.x = xb_xcc_id(); b.st = st;
    if (threadIdx.x == 0) (void)xb_add(&bar[XB_XCNT(b.x)], 1u);
    return b;
}
__device__ __forceinline__ void xcd_barrier_complete(unsigned* bar, unsigned x, unsigned& nloc, unsigned& nx) {
    const unsigned G = gridDim.x * gridDim.y * gridDim.z;
    unsigned sum, cnt, mine, sp = 0u;
    for (;;) {
        sum = 0u; cnt = 0u; mine = 0u;
#pragma unroll
        for (unsigned j = 0; j < 16; ++j) { const unsigned c = xb_ld(&bar[XB_XCNT(j)]); sum += c; cnt += (c > 0u) ? 1u : 0u; mine = (j == x) ? c : mine; }
        if (sum == G) break;
        __builtin_amdgcn_s_sleep(1);
        if ((++sp & 255u) == 0u) { if (xb_ld(&bar[XB_TMO])) break; if (sp > XB_SPIN_CAP) { atomicAdd(&bar[XB_TMO], 1u); break; } }
    }
    nloc = mine > 0u ? mine : 1u; nx = cnt > 0u ? cnt : 1u;
}
__device__ __forceinline__ void xcd_barrier(const XcdBarrier& b) {
    asm volatile("s_waitcnt vmcnt(0)" ::: "memory");
    __syncthreads();
    if (threadIdx.x == 0) {
        unsigned* bar = b.bar;
        __builtin_amdgcn_s_waitcnt(0);
        unsigned nloc = b.st[0], nx = b.st[1];
        if (nloc == 0u) { xcd_barrier_complete(bar, b.x, nloc, nx); b.st[0] = nloc; b.st[1] = nx; }
        const unsigned old = xb_add(&bar[XB_XSUB(b.x)], 1u);
        const unsigned gen = old / nloc;
        if (old + 1u == (gen + 1u) * nloc) {
            __builtin_amdgcn_fence(__ATOMIC_RELEASE, "agent");
            asm volatile("s_waitcnt vmcnt(0)" ::: "memory");
            const unsigned og = xb_add(&bar[XB_TOP], 1u);
            const unsigned tg = og / nx;
            if (og + 1u == (tg + 1u) * nx) xb_add(&bar[XB_TOPGEN], 1u);
            else XB_SPIN(xb_ld(&bar[XB_TOPGEN]) == tg, bar);
            __builtin_amdgcn_fence(__ATOMIC_ACQUIRE, "agent");
            xb_add(&bar[XB_XGEN(b.x)], 1u);
            asm volatile("s_waitcnt vmcnt(0)" ::: "memory");
        } else {
            XB_SPIN(xb_ld(&bar[XB_XGEN(b.x)]) == gen, bar);
            __builtin_amdgcn_fence(__ATOMIC_ACQUIRE, "agent");
            asm volatile("s_waitcnt vmcnt(0)" ::: "memory");
        }
    }
    __syncthreads();
}

namespace pg8 {
constexpr int BM = 256, BK = 64, HALF = 128, HTB = HALF * BK * 2, STAGE_BYTES = 8 * HTB, NXCD = 8, WGM = 8;
__host__ __device__ __forceinline__ int lds_byte(int r, int c) { const int st = (r >> 4) * 2 + (c >> 5), rr = r & 15, cc = c & 31, ob = rr * 64 + cc * 2; return st * 1024 + (ob ^ (((ob >> 9) & 1) << 5)); }
__host__ __device__ __forceinline__ void stage_rc(int b, int& R, int& C) { const int st = b / 1024, sb = b % 1024, swz = sb ^ (((sb >> 9) & 1) << 5); R = (st >> 1) * 16 + swz / 64; C = (st & 1) * 32 + (swz % 64) / 2; }
__host__ __device__ __forceinline__ int perm32(int rho) { const int n = rho >> 4, i = rho & 15; return 8 * (i >> 2) + 4 * n + (i & 3); }
struct Unit { int pm, pn; };
struct StaticOrder {
    int nM, nN, nwg, G, c, pm0, nd, qd, wgm;
    __device__ __forceinline__ void init(int nM_, int nN_, int G_, int c_, int pm0_, int wgm_ = WGM) { nM = nM_; nN = nN_; nwg = nM * nN; G = G_; c = c_; pm0 = pm0_; nd = 0; qd = 0; wgm = wgm_; }
    __device__ __forceinline__ void quota(int nd_) { nd = nd_ < G ? nd_ : 0; if (nd_ >= G) return; const int q = (nwg + 5 * nd + G - 1) / G; qd = q > 5 ? q - 5 : 0; }
    __device__ __forceinline__ bool next(int i, Unit& u) const {
        long L;
        if (nd == 0) L = (long)i * G + c;
        else if (c < nd) { if (i >= qd) return false; L = (long)i * G + c; }
        else L = i < qd ? (long)i * G + c : (long)qd * G + (long)(i - qd) * (G - nd) + (c - nd);
        if (L >= nwg) return false;
        int wgid = (int)L; { const int q = nwg / NXCD, r = nwg % NXCD, xcd = wgid % NXCD, off = wgid / NXCD; wgid = (xcd < r ? xcd * (q + 1) : r * (q + 1) + (xcd - r) * q) + off; }
        const int nig = wgm * nN, gid = wgid / nig, fm = gid * wgm, gsz = (nM - fm) < wgm ? (nM - fm) : wgm;
        u.pm = pm0 + fm + ((wgid % nig) % gsz); u.pn = (wgid % nig) / gsz; return true;
    }
};
struct PolPlain {
    const char* A; unsigned lda2; const char* B; unsigned ldb2; int K;
    __device__ __forceinline__ size_t kstepA() const { return 128; }
    __device__ __forceinline__ size_t kstepB() const { return 128; }
    __device__ __forceinline__ unsigned a_off(const Unit& u, int h, int R, int C) const { return (unsigned)(u.pm * BM + h * HALF + R) * lda2 + (unsigned)C * 2u; }
    __device__ __forceinline__ const char* b_ptr(const Unit& u) const { return B + (size_t)u.pn * BM * ldb2; }
};
struct PolMoeUp {
    const char* A; unsigned lda2; const char* B; unsigned ldb2; int K; const int* rowidx; const LAS int* tile_e; size_t estride;
    __device__ __forceinline__ size_t kstepA() const { return 128; }
    __device__ __forceinline__ size_t kstepB() const { return 128; }
    __device__ __forceinline__ unsigned a_off(const Unit& u, int h, int R, int C) const { return (unsigned)rowidx[u.pm * BM + h * HALF + R] * lda2 + (unsigned)C * 2u; }
    __device__ __forceinline__ const char* b_ptr(const Unit& u) const { return B + (size_t)tile_e[u.pm] * estride + (size_t)u.pn * BM * ldb2; }
};
struct PolMoeDown {
    const char* A; unsigned lda2; const char* B; unsigned ldb2; int K; int pmc0; const LAS int* tile_e; size_t estride;
    __device__ __forceinline__ size_t kstepA() const { return (size_t)MCH_ROWS * 128; }
    __device__ __forceinline__ size_t kstepB() const { return (size_t)DM * 128; }
    __device__ __forceinline__ unsigned a_off(const Unit& u, int h, int R, int C) const { return (unsigned)((u.pm - pmc0) * BM + h * HALF + R) * 128u + (unsigned)C * 2u; }
    __device__ __forceinline__ const char* b_ptr(const Unit& u) const { return B + (size_t)tile_e[u.pm] * estride + (size_t)u.pn * BM * 128; }
};
struct PolChunkA {
    const char* A; unsigned lda2; const char* B; unsigned ldb2; int K; int pmc0;
    __device__ __forceinline__ size_t kstepA() const { return (size_t)CHUNK_ROWS * 128; }
    __device__ __forceinline__ size_t kstepB() const { return (size_t)DM * 128; }
    __device__ __forceinline__ unsigned a_off(const Unit& u, int h, int R, int C) const { return (unsigned)((u.pm - pmc0) * BM + h * HALF + R) * 128u + (unsigned)C * 2u; }
    __device__ __forceinline__ const char* b_ptr(const Unit& u) const { return B + (size_t)u.pn * BM * 128; }
};

template <int I8> struct AccT { typedef f32x4 type; };
template <> struct AccT<1> { typedef i32x4 type; };
template <class Epi, class Pol, int I8 = 0>
__device__ __forceinline__ void gemm_phase(LAS unsigned char* lds, const Pol& P, const StaticOrder& S, const Epi& E) {
    typedef typename AccT<I8>::type acc_t;
    int tid_ = threadIdx.x; asm volatile("" : "+v"(tid_));
    const int tid = tid_, wid = __builtin_amdgcn_readfirstlane(tid >> 6), lane = tid & 63, wr = wid >> 2, wc = wid & 3, fr = lane & 15, fq = lane >> 4;
    const int K = P.K, nt = K / BK;
    int sR[2], sC[2]; unsigned voffB[2];
#pragma unroll
    for (int i = 0; i < 2; ++i) { int R, C; stage_rc(tid * 16 + i * 8192, R, C); sR[i] = R; sC[i] = C; const int Rb = (R & ~31) + perm32(R & 31); voffB[i] = (unsigned)Rb * P.ldb2 + (unsigned)C * 2u; }
    const size_t kstepA = P.kstepA(), kstepB = P.kstepB();
    const size_t hstepB = (size_t)HALF * P.ldb2;
    const unsigned ldsw = (unsigned)wid * 1024u;
    const int aoff = lds_byte(wr * 64 + fr, fq * 8), boff = lds_byte(wc * 32 + fr, fq * 8);
#define PG8_SA(b, h) (((b) * 2 + (h)) * HTB)
#define PG8_SB(b, h) ((4 + (b) * 2 + (h)) * HTB)
#define PG8_STAGE(bufoff, gbase, voff) do { _Pragma("unroll") for (int _i = 0; _i < 2; ++_i) \
        __builtin_amdgcn_global_load_lds((const unsigned*)((const char*)(gbase) + (voff)[_i]), (LAS unsigned*)(lds + (bufoff) + ldsw + _i * 8192), 16, 0, 0); } while (0)
#define PG8_LDA(dst, b, h) do { _Pragma("unroll") for (int m = 0; m < 4; ++m) _Pragma("unroll") for (int k = 0; k < 2; ++k) dst[m][k] = *(const LAS bf16x8*)(lds + PG8_SA(b, h) + aoff + m * 2048 + k * 1024); } while (0)
#define PG8_LDB(dst, b, h) do { _Pragma("unroll") for (int n = 0; n < 2; ++n) _Pragma("unroll") for (int k = 0; k < 2; ++k) dst[n][k] = *(const LAS bf16x8*)(lds + PG8_SB(b, h) + boff + n * 2048 + k * 1024); } while (0)
#define PG8_MMA(ai, bj, At, Bt) do { __builtin_amdgcn_s_setprio(1); _Pragma("unroll") for (int m = 0; m < 4; ++m) _Pragma("unroll") for (int n = 0; n < 2; ++n) _Pragma("unroll") for (int k = 0; k < 2; ++k) \
        { if constexpr (I8 == 1) acc[ai][bj][m][n] = __builtin_amdgcn_mfma_i32_16x16x64_i8(__builtin_bit_cast(i32x4, Bt[n][k]), __builtin_bit_cast(i32x4, At[m][k]), acc[ai][bj][m][n], 0, 0, 0); \
          else if constexpr (I8 == 4) { const i64x2 b_ = __builtin_bit_cast(i64x2, Bt[n][k]), a_ = __builtin_bit_cast(i64x2, At[m][k]); \
              acc[ai][bj][m][n] = __builtin_amdgcn_mfma_f32_16x16x32_fp8_fp8(b_[0], a_[0], acc[ai][bj][m][n], 0, 0, 0); acc[ai][bj][m][n] = __builtin_amdgcn_mfma_f32_16x16x32_fp8_fp8(b_[1], a_[1], acc[ai][bj][m][n], 0, 0, 0); } \
          else if constexpr (I8 == 3) acc[ai][bj][m][n] = __builtin_amdgcn_mfma_f32_16x16x32_f16(__builtin_bit_cast(h16x8, Bt[n][k]), __builtin_bit_cast(h16x8, At[m][k]), acc[ai][bj][m][n], 0, 0, 0); \
          else acc[ai][bj][m][n] = __builtin_amdgcn_mfma_f32_16x16x32_bf16(Bt[n][k], At[m][k], acc[ai][bj][m][n], 0, 0, 0); } __builtin_amdgcn_s_setprio(0); } while (0)
#define PG8_WAIT_V(n) asm volatile("s_waitcnt vmcnt(" #n ")" ::: "memory")
#define PG8_WAIT_L(n) asm volatile("s_waitcnt lgkmcnt(" #n ")" ::: "memory")
#define PG8_BAR __builtin_amdgcn_s_barrier()
#define PG8_SCHED __builtin_amdgcn_sched_barrier(0)
    Unit cur, nxt; int ui = 0;
    if (!S.next(0, cur)) return;
    LAS unsigned char* sl_ = lds + RING_BYTES + 4096;
#define PG8_SCALES(u_, slot) do { if constexpr (Epi::LDS_SCALES) { \
        if (wid == 0) __builtin_amdgcn_global_load_lds((const unsigned*)(E.row_src(u_)) + lane * 4, (LAS unsigned*)(sl_ + (slot) * 2048), 16, 0, 0); \
        else if (wid == 1) __builtin_amdgcn_global_load_lds((const unsigned*)(E.col_src(u_)) + lane * 4, (LAS unsigned*)(sl_ + (slot) * 2048 + 1024), 16, 0, 0); } } while (0)
    PG8_SCALES(cur, 0);
    acc_t acc[2][2][4][2];
#pragma unroll
    for (int a = 0; a < 2; ++a)
#pragma unroll
        for (int b = 0; b < 2; ++b)
#pragma unroll
            for (int m = 0; m < 4; ++m)
#pragma unroll
                for (int n = 0; n < 2; ++n) acc[a][b][m][n] = acc_t{};
    bf16x8 At[4][2], B0[2][2], B1[2][2];
    unsigned vC0[2], vC1[2], vN0[2], vN1[2];
#pragma unroll
    for (int i = 0; i < 2; ++i) { vC0[i] = P.a_off(cur, 0, sR[i], sC[i]); vC1[i] = P.a_off(cur, 1, sR[i], sC[i]); }
    const char* Ab = P.A; const char* cB = P.b_ptr(cur);
    PG8_STAGE(PG8_SB(0, 0), cB, voffB); PG8_STAGE(PG8_SB(0, 1), cB + hstepB, voffB); PG8_STAGE(PG8_SA(0, 0), Ab, vC0); PG8_STAGE(PG8_SA(0, 1), Ab, vC1);
    if (wr == 1) PG8_BAR;
    PG8_WAIT_V(2); PG8_BAR;
    PG8_STAGE(PG8_SB(1, 0), cB + kstepB, voffB); PG8_STAGE(PG8_SA(1, 0), Ab + kstepA, vC0); PG8_STAGE(PG8_SB(1, 1), cB + hstepB + kstepB, voffB);
    PG8_WAIT_V(6); PG8_BAR;
    for (;;) {
        const bool has_next = S.next(ui + 1, nxt);
        const char* nB = cB;
#pragma unroll
        for (int i = 0; i < 2; ++i) { vN0[i] = vC0[i]; vN1[i] = vC1[i]; }
        if (has_next) { nB = P.b_ptr(nxt);
#pragma unroll
            for (int i = 0; i < 2; ++i) { vN0[i] = P.a_off(nxt, 0, sR[i], sC[i]); vN1[i] = P.a_off(nxt, 1, sR[i], sC[i]); } }
        int tsc_ = 4; asm volatile("" : "+s"(tsc_));
#pragma unroll 1
        for (int t = 0; t < nt; t += 2) {
            const bool last = (t == nt - 2);
            if (t == tsc_ && has_next) PG8_SCALES(nxt, (ui + 1) & 1);
            const char* a1 = Ab + (size_t)(t + 1) * kstepA;
            const char* a2 = last ? Ab : Ab + (size_t)(t + 2) * kstepA; const char* b2 = last ? nB : cB + (size_t)(t + 2) * kstepB;
            const char* a3 = a2 + kstepA; const char* b3 = b2 + kstepB;
            unsigned v20[2], v21[2];
#pragma unroll
            for (int i = 0; i < 2; ++i) { v20[i] = last ? vN0[i] : vC0[i]; v21[i] = last ? vN1[i] : vC1[i]; }
            PG8_LDB(B0, 0, 0); PG8_LDB(B1, 0, 1); PG8_SCHED; PG8_LDA(At, 0, 0); PG8_STAGE(PG8_SA(1, 1), a1, vC1);
            PG8_WAIT_V(8); PG8_WAIT_L(0); PG8_BAR; PG8_MMA(0, 0, At, B0); PG8_MMA(0, 1, At, B1); PG8_BAR; PG8_SCHED;
            PG8_LDA(At, 0, 1); PG8_STAGE(PG8_SB(0, 0), b2, voffB); PG8_STAGE(PG8_SB(0, 1), b2 + hstepB, voffB); PG8_STAGE(PG8_SA(0, 0), a2, v20);
            PG8_WAIT_V(8); PG8_WAIT_L(0); PG8_BAR; PG8_MMA(1, 0, At, B0); PG8_MMA(1, 1, At, B1); PG8_BAR; PG8_SCHED;
            PG8_LDB(B0, 1, 0); PG8_LDB(B1, 1, 1); PG8_SCHED; PG8_LDA(At, 1, 0); PG8_STAGE(PG8_SA(0, 1), a2, v21);
            PG8_WAIT_V(8); PG8_WAIT_L(0); PG8_BAR; PG8_MMA(0, 0, At, B0); PG8_MMA(0, 1, At, B1); PG8_BAR; PG8_SCHED;
            PG8_LDA(At, 1, 1); PG8_STAGE(PG8_SB(1, 0), b3, voffB); PG8_STAGE(PG8_SB(1, 1), b3 + hstepB, voffB); PG8_STAGE(PG8_SA(1, 0), a3, v20);
            PG8_WAIT_V(8); PG8_WAIT_L(0); PG8_BAR; PG8_MMA(1, 0, At, B0); PG8_MMA(1, 1, At, B1); PG8_BAR; PG8_SCHED;
        }
        if (wr == 0) PG8_BAR;
        E(acc, cur, wr, wc, fr, fq, (const LAS unsigned char*)(sl_ + (ui & 1) * 2048));
        if (!has_next) break;
#pragma unroll
        for (int a = 0; a < 2; ++a)
#pragma unroll
            for (int b = 0; b < 2; ++b)
#pragma unroll
                for (int m = 0; m < 4; ++m)
#pragma unroll
                    for (int n = 0; n < 2; ++n) acc[a][b][m][n] = acc_t{};
        cur = nxt; cB = nB; ++ui;
#pragma unroll
        for (int i = 0; i < 2; ++i) { vC0[i] = vN0[i]; vC1[i] = vN1[i]; }
        if (wr == 1) PG8_BAR;
    }
    PG8_WAIT_V(0);
    PG8_BAR;
#undef PG8_SA
#undef PG8_SB
#undef PG8_STAGE
#undef PG8_SCALES
#undef PG8_LDA
#undef PG8_LDB
#undef PG8_MMA
#undef PG8_WAIT_V
#undef PG8_WAIT_L
#undef PG8_BAR
#undef PG8_SCHED
}

__device__ __forceinline__ float row_rstd(const float* ssq, int row, int nparts, float inv_n) {
    const f32x4* p = (const f32x4*)(ssq + (size_t)row * nparts); f32x4 s = p[0];
    for (int i = 1; i < nparts / 4; ++i) s += p[i];
    return __builtin_amdgcn_rsqf(((s[0] + s[1]) + (s[2] + s[3])) * inv_n + EPS);
}
template <int NP>
__device__ __forceinline__ void wave_row_rstd(const float* ssq, float inv_n, int rowbase, int wr, int wid, int fr, LAS float* xl, float (&rs)[8]) {
    const int lane = threadIdx.x & 63; LAS float* wl = xl + wid * 128;
    f32x4 sa = (f32x4){0.f, 0.f, 0.f, 0.f}, sb = sa;
    const f32x4* pa = (const f32x4*)(ssq + (size_t)(rowbase + wr * 64 + lane) * NP); const f32x4* pb = (const f32x4*)(ssq + (size_t)(rowbase + HALF + wr * 64 + lane) * NP);
#pragma unroll
    for (int i = 0; i < NP / 4; ++i) { sa += pa[i]; sb += pb[i]; }
    wl[lane] = __builtin_amdgcn_rsqf(((sa[0] + sa[1]) + (sa[2] + sa[3])) * inv_n + EPS);
    wl[64 + lane] = __builtin_amdgcn_rsqf(((sb[0] + sb[1]) + (sb[2] + sb[3])) * inv_n + EPS);
    asm volatile("s_waitcnt lgkmcnt(0)" ::: "memory");
#pragma unroll
    for (int ai = 0; ai < 2; ++ai)
#pragma unroll
        for (int m = 0; m < 4; ++m) rs[ai * 4 + m] = wl[ai * 64 + 16 * m + fr];
    asm volatile("s_waitcnt lgkmcnt(0)" ::: "memory");
}
__device__ __forceinline__ void rope8(f32x4& v0, f32x4& v1, const float* tab  ) {
    const f32x4 t0 = *(const f32x4*)tab, t1 = *(const f32x4*)(tab + 4);
    f32x4 a = v0, b = v1;
    v0[0] = a[0] * t0[0] - a[1] * t0[1]; v0[1] = a[1] * t0[0] + a[0] * t0[1]; v0[2] = a[2] * t0[2] - a[3] * t0[3]; v0[3] = a[3] * t0[2] + a[2] * t0[3];
    v1[0] = b[0] * t1[0] - b[1] * t1[1]; v1[1] = b[1] * t1[0] + b[0] * t1[1]; v1[2] = b[2] * t1[2] - b[3] * t1[3]; v1[3] = b[3] * t1[2] + b[2] * t1[3];
}
__device__ __forceinline__ u32x4 pack8(f32x4 v0, f32x4 v1) { u32x4 w; w.x = cvt_pk_bf16(v0[0], v0[1]); w.y = cvt_pk_bf16(v0[2], v0[3]); w.z = cvt_pk_bf16(v1[0], v1[1]); w.w = cvt_pk_bf16(v1[2], v1[3]); return w; }
__device__ __forceinline__ float sq8(f32x4 v0, f32x4 v1) { return (v0[0] * v0[0] + v0[1] * v0[1]) + (v0[2] * v0[2] + v0[3] * v0[3]) + (v1[0] * v1[0] + v1[1] * v1[1]) + (v1[2] * v1[2] + v1[3] * v1[3]); }

__device__ __forceinline__ f32x4 acc_f(const f32x4& a) { return a; }
__device__ __forceinline__ f32x4 acc_f(const i32x4& a) { return __builtin_convertvector(a, f32x4); }
template <int MODE, int NP> struct EpiStore {
    bf16_t* O; int ldc; const float* ssq; LAS float* xl; float inv_n;
    const float* rope; float* ssq_q; float* ssq_kv;
    bf16_t* O2; const bf16_t* Zsrc; float* Flog;
    const float* rowf; const unsigned* cmax;
    static constexpr bool LDS_SCALES = (MODE == 1 || MODE == 4);
    __device__ __forceinline__ const float* row_src(const Unit& u) const { return rowf + u.pm * BM; }
    __device__ __forceinline__ const unsigned* col_src(const Unit& u) const { return cmax + u.pn * BM; }
    template <class ACC>
    __device__ __forceinline__ void operator()(const ACC (&acc)[2][2][4][2], const Unit& u, int wr, int wc, int fr, int fq, const LAS unsigned char* lsc) const {
        const int row0 = u.pm * BM + wr * 64 + fr;
        float rs8[8];
        const LAS unsigned* cp = (const LAS unsigned*)(lsc + 1024) + wc * 32 + 8 * fq; const LAS float* rp = (const LAS float*)lsc + wr * 64 + fr;
        if (!LDS_SCALES) wave_row_rstd<NP>(ssq, inv_n, u.pm * BM, wr, wr * 4 + wc, fr, xl, rs8);
#pragma unroll
        for (int ai = 0; ai < 2; ++ai)
#pragma unroll
            for (int m = 0; m < 4; ++m) {
                const int row = row0 + ai * HALF + m * 16;
                const float rs = LDS_SCALES ? rp[ai * HALF + m * 16] * (1.f / 127.f) : rs8[ai * 4 + m];
                float sq = 0.f;
#pragma unroll
                for (int bj = 0; bj < 2; ++bj) {
                    const int col = u.pn * BM + bj * HALF + wc * 32 + 8 * fq;
                    f32x4 v0 = acc_f(acc[ai][bj][m][0]) * rs, v1 = acc_f(acc[ai][bj][m][1]) * rs;
                    if (LDS_SCALES) { const u32x4 c0 = *(const LAS u32x4*)(cp + bj * HALF), c1 = *(const LAS u32x4*)(cp + bj * HALF + 4);
                        v0 *= (f32x4){__uint_as_float(c0.x), __uint_as_float(c0.y), __uint_as_float(c0.z), __uint_as_float(c0.w)};
                        v1 *= (f32x4){__uint_as_float(c1.x), __uint_as_float(c1.y), __uint_as_float(c1.z), __uint_as_float(c1.w)}; }
                    if (MODE == 1) { if (col >= 1280 && col < 1344) rope8(v0, v1, rope + (size_t)row * 64 + (col - 1280)); sq += sq8(v0, v1); }
                    if (MODE == 2) { const int w = col % 192; if (w >= 128) rope8(v0, v1, rope + (size_t)row * 64 + (w - 128)); }
                    if (MODE == 3) {
                        if (bj == 0) *(u32x4*)(O + (size_t)row * KM_LD + u.pn * 192 + wc * 32 + 8 * fq) = pack8(v0, v1);
                        else *(u32x4*)(O2 + (size_t)row * VM_LD + u.pn * 128 + wc * 32 + 8 * fq) = pack8(v0, v1);
                    } else if (MODE == 4) {
                        if (u.pn < 24) *(u32x4*)(O + (size_t)row * ldc + col) = pack8(v0, v1);
                        else if (bj == 0 && wc == 0 && fq < 2) { *(f32x4*)(Flog + (size_t)row * 16 + 8 * fq) = v0; *(f32x4*)(Flog + (size_t)row * 16 + 8 * fq + 4) = v1; }
                    } else *(u32x4*)(O + (size_t)row * ldc + col) = pack8(v0, v1);
                }
                if (MODE == 1 && u.pn < 5) {
                    sq += __shfl_xor(sq, 16); sq += __shfl_xor(sq, 32);
                    if (fq == 0) { if (u.pn < 3) ssq_q[(size_t)row * 12 + u.pn * 4 + wc] = sq; else ssq_kv[(size_t)row * 8 + (u.pn - 3) * 4 + wc] = sq; }
                }
                asm volatile("" ::: "memory");
            }
        if (MODE == 3) {
            const int tid = (wr * 4 + wc) * 64 + fq * 16 + fr;
#pragma unroll
            for (int i = 0; i < 4; ++i) { const int idx = tid + 512 * i, r = idx >> 3, c = idx & 7; const size_t row = (size_t)u.pm * BM + r;
                *(u32x4*)(O + row * KM_LD + u.pn * 192 + 128 + c * 8) = *(const u32x4*)(Zsrc + row * Z0_LD + 1280 + c * 8); }
        }
    }
};
template <bool BF32> struct EpiRes {
    const void* base; unsigned short* out; float* ssq; float sc = 1.f;
    static constexpr bool LDS_SCALES = false;
    __device__ __forceinline__ void operator()(const f32x4 (&acc)[2][2][4][2], const Unit& u, int wr, int wc, int fr, int fq, const LAS unsigned char*) const {
        const int row0 = u.pm * BM + wr * 64 + fr; const int colb = u.pn * BM + wc * 32 + 8 * fq;
        f32x4 bA[2][2], bB[2][2];
#define ER_LOAD(dst, i) do { const size_t off_ = (size_t)(row0 + ((i) >> 2) * HALF + ((i) & 3) * 16) * DM + colb; \
        _Pragma("unroll") for (int bj = 0; bj < 2; ++bj) { \
            if constexpr (BF32) { dst[bj][0] = *(const f32x4*)((const float*)base + off_ + bj * HALF); dst[bj][1] = *(const f32x4*)((const float*)base + off_ + bj * HALF + 4); } \
            else { const u32x4 h_ = *(const u32x4*)((const unsigned short*)base + off_ + bj * HALF); dst[bj][0] = unpk_f16x4((u32x2){h_.x, h_.y}); dst[bj][1] = unpk_f16x4((u32x2){h_.z, h_.w}); } } } while (0)
#define ER_DO(src, i) do { const int ai = (i) >> 2, m = (i) & 3; const int row = row0 + ai * HALF + m * 16; float sq = 0.f; \
        _Pragma("unroll") for (int bj = 0; bj < 2; ++bj) { const size_t off = (size_t)row * DM + colb + bj * HALF; \
            const f32x4 v0 = acc[ai][bj][m][0] * sc + src[bj][0], v1 = acc[ai][bj][m][1] * sc + src[bj][1]; \
            u32x4 w_; w_.x = pk_f16(v0[0], v0[1]); w_.y = pk_f16(v0[2], v0[3]); w_.z = pk_f16(v1[0], v1[1]); w_.w = pk_f16(v1[2], v1[3]); \
            *(u32x4*)(out + off) = w_; sq += sq8(v0, v1); } \
        if (ssq) { sq += __shfl_xor(sq, 16); sq += __shfl_xor(sq, 32); if (fq == 0) ssq[(size_t)row * 32 + u.pn * 4 + wc] = sq; } } while (0)
        ER_LOAD(bA, 0); asm volatile("" ::: "memory");
#pragma unroll
        for (int i = 0; i < 8; i += 2) {
            ER_LOAD(bB, i + 1); asm volatile("" ::: "memory");
            ER_DO(bA, i); asm volatile("" ::: "memory");
            if (i + 2 < 8) { ER_LOAD(bA, i + 2); asm volatile("" ::: "memory"); }
            ER_DO(bB, i + 1); asm volatile("" ::: "memory");
        }
#undef ER_LOAD
#undef ER_DO
    }
};
template <int RS> struct EpiSwiGLU {
    bf16_t* H; int row_base; const float* ssq; const float* rsp; const unsigned* cmax; const LAS int* tile_e; int f8 = 0;
    static constexpr bool LDS_SCALES = (RS == 2);
    __device__ __forceinline__ const float* row_src(const Unit& u) const { return rsp + u.pm * BM; }
    __device__ __forceinline__ const unsigned* col_src(const Unit& u) const { return cmax + (size_t)(tile_e ? tile_e[u.pm] : 0) * (2 * DFF) + u.pn * BM; }
    template <class ACC>
    __device__ __forceinline__ void operator()(const ACC (&acc)[2][2][4][2], const Unit& u, int wr, int wc, int fr, int fq, const LAS unsigned char* lsc) const {
        const int row0 = u.pm * BM + wr * 64 + fr;
        f32x4 sg[2], su[2];
        if (RS == 2) { const LAS unsigned* cp = (const LAS unsigned*)(lsc + 1024) + wc * 32 + 8 * fq;
#pragma unroll
            for (int n = 0; n < 2; ++n) { const u32x4 a = *(const LAS u32x4*)(cp + 4 * n), b = *(const LAS u32x4*)(cp + HALF + 4 * n);
#pragma unroll
                for (int j = 0; j < 4; ++j) { sg[n][j] = __uint_as_float(a[j]) * (1.f / 127.f); su[n][j] = __uint_as_float(b[j]) * (1.f / 127.f); } } }
        float rs8[8];
#pragma unroll
        for (int i = 0; i < 8; ++i) { const int row = row0 + (i >> 2) * HALF + (i & 3) * 16;
            if (RS == 2) rs8[i] = ((const LAS float*)lsc)[wr * 64 + fr + (i >> 2) * HALF + (i & 3) * 16]; else rs8[i] = RS == 0 ? row_rstd(ssq, row, 32, 1.f / DM) : rsp[row]; }
#pragma unroll
        for (int ai = 0; ai < 2; ++ai)
#pragma unroll
            for (int m = 0; m < 4; ++m) {
                const int row = row0 + ai * HALF + m * 16;
                const float rs = rs8[ai * 4 + m];
                f32x4 o[2];
#pragma unroll
                for (int n = 0; n < 2; ++n) { f32x4 g = acc_f(acc[ai][0][m][n]) * rs, up = acc_f(acc[ai][1][m][n]) * rs;
                    if (RS == 2) { g *= sg[n]; up *= su[n]; }
#pragma unroll
                    for (int j = 0; j < 4; ++j) o[n][j] = g[j] * __builtin_amdgcn_rcpf(1.f + __builtin_amdgcn_exp2f(-LOG2E * g[j])) * up[j]; }
                if (RS == 2 && f8) {
                    _Pragma("unroll") for (int n = 0; n < 2; ++n) _Pragma("unroll") for (int j = 0; j < 4; ++j) o[n][j] = __builtin_amdgcn_fmed3f(o[n][j], -448.f, 448.f);
                    *(u32x2*)((unsigned char*)H + ((size_t)u.pn * MCH_ROWS + (row - row_base)) * 128 + wc * 32 + 8 * fq) = pack8_fp8(o[0], o[1]);
                } else
                *(u32x4*)(H + ((size_t)(u.pn * 2 + (wc >> 1)) * CHUNK_ROWS + (row - row_base)) * 64 + (wc & 1) * 32 + 8 * fq) = pack8(o[0], o[1]);
                asm volatile("" ::: "memory");
            }
    }
};
struct EpiMoeDown {
    bf16_t* Y; const float* gate;
    static constexpr bool LDS_SCALES = false;
    __device__ __forceinline__ void operator()(const f32x4 (&acc)[2][2][4][2], const Unit& u, int wr, int wc, int fr, int fq, const LAS unsigned char*) const {
        const int row0 = u.pm * BM + wr * 64 + fr;
        float g8[8];
#pragma unroll
        for (int i = 0; i < 8; ++i) g8[i] = gate[row0 + (i >> 2) * HALF + (i & 3) * 16] * (1.f / 64.f);
#pragma unroll
        for (int ai = 0; ai < 2; ++ai)
#pragma unroll
            for (int m = 0; m < 4; ++m) {
                const int row = row0 + ai * HALF + m * 16; const float g = g8[ai * 4 + m];
#pragma unroll
                for (int bj = 0; bj < 2; ++bj) *(u32x4*)(Y + (size_t)row * DM + u.pn * BM + bj * HALF + wc * 32 + 8 * fq) = pack8(acc[ai][bj][m][0] * g, acc[ai][bj][m][1] * g);
                asm volatile("" ::: "memory");
            }
    }
};
}

namespace fa {
#define SBAR() __builtin_amdgcn_sched_barrier(0)
template <int NDV> __device__ __forceinline__ int v_st(int k, int c) { const int kk = (k & ~0xC) | ((k & 4) << 1) | ((k & 8) >> 1); return ((kk >> 3) * NDV + (c >> 5)) * 512 + ((kk & 7) * 32 + (c & 31)) * 2; }
__device__ __forceinline__ int v_rd_base(int lane) { return ((lane & 3) << 3) | (((lane >> 2) & 3) << 6) | (((lane >> 4) & 1) << 5) | (((lane >> 5) & 1) << 8); }
__device__ __forceinline__ int crow(int r, int hi) { return (r & 3) + 8 * (r >> 2) + 4 * hi; }
__device__ __forceinline__ void mask_tile(f32x16& p0, f32x16& p1, int dq, unsigned W) {
    const float NEG = -__builtin_inff();
#pragma unroll
    for (int r = 0; r < 16; ++r) {
        const int c = (r & 3) + 8 * (r >> 2);
        if ((unsigned)(dq - c) >= W) p0[r] = NEG;
        if ((unsigned)(dq - c - 32) >= W) p1[r] = NEG;
    }
}
struct AttnArgs {
    const bf16_t* Q; int ldq; const bf16_t* K; int ldk; const bf16_t* V; int ldv; bf16_t* O; int ldo;
    int q0, j_lo, j_hi, W;
    const float* dec;
    float sinkl; const float* biasT;
    const float* sinks;
    float kmax;
    const float* neff;
};
template <int DK, int DV, int MODE>
__device__ __forceinline__ void attn_unit(const AttnArgs& a, LAS char* lds) {
    constexpr int KROWB = DK * 2 + 16  , SHM_K = 64 * KROWB, SHM_V = 64 * DV * 2, NDK = DK / 16, NDV = DV / 32, KCH = DK / 8, VCH = DV / 8, KPT = KCH * 64 / 512, VPT = VCH * 64 / 512;
    constexpr int RB = NDV * 512;
    constexpr float THR = 8.f;
    int tid_ = threadIdx.x; asm volatile("" : "+v"(tid_));
    const int tid = tid_, wid = __builtin_amdgcn_readfirstlane(tid >> 6), lane = tid & 63, r32 = lane & 31, hi = lane >> 5;
    LAS char* V_lds = lds; LAS char* K_lds = lds + 2 * SHM_V;
    LAS float* dec_l = (LAS float*)(K_lds + 2 * SHM_K);
    LAS float* ws = dec_l + 128 + wid * 64;
    LAS float* bias_l = dec_l + 128 + 512 + ((MODE == 2) ? wid * 128 : 0);
    const int NT = a.j_hi - a.j_lo;
    const int qlo = (MODE == 2) ? a.q0 : a.q0 + wid * 32, qpos = qlo + r32;
    const int hoff = (MODE == 2) ? wid * 64 : 0;
    static_assert(KPT == KCH / 8 && VPT == VCH / 8, "staging map");
    const int srow_ = tid >> 3, scg_ = tid & 7;
    const int kws0 = srow_ * KROWB + scg_ * 16, vws0 = v_st<NDV>(srow_, scg_ * 8);
    const unsigned ksrc0 = (unsigned)(srow_ * a.ldk + scg_ * 8) * 2u, vsrc0 = (unsigned)(srow_ * a.ldv + scg_ * 8) * 2u;
    bf16x8 qr[NDK];
#pragma unroll
    for (int d0 = 0; d0 < NDK; ++d0) qr[d0] = *(const bf16x8*)(a.Q + (size_t)qpos * a.ldq + hoff + d0 * 16 + hi * 8);
    __builtin_amdgcn_s_waitcnt(0x0F70);
    float m_reg = -1e30f, l_reg = 0.f;
    if (MODE == 2) { m_reg = a.sinks[wid] * LOG2E; l_reg = 1.f; }
    f32x16 o[NDV];
#pragma unroll
    for (int d = 0; d < NDV; ++d) o[d] = f32x16{};
    float clq = 0.f; if (MODE == 1) clq = a.dec[(size_t)qpos * 16];
    if (MODE == 2) { (dec_l + 128 + 512)[tid] = a.biasT[tid]; (dec_l + 128 + 512)[tid + 512] = a.biasT[tid + 512]; }
    const int vb0 = (int)(uintptr_t)V_lds + v_rd_base(lane);
    const int kq = r32 * KROWB;
    bf16x8 sk[2][KPT], sv[2][VPT]; float sdec[2] = {0.f, 0.f};
    if (wid >= 4) __builtin_amdgcn_s_setprio(1);
#define FA_LOADT(j, S_) do { const size_t kb_ = (size_t)(j) * 64; const char* kt_ = (const char*)(a.K + kb_ * a.ldk); const char* vt_ = (const char*)(a.V + kb_ * a.ldv); \
        _Pragma("unroll") for (int i = 0; i < KPT; ++i) sk[S_][i] = *(const bf16x8*)(kt_ + ksrc0 + i * 128); \
        _Pragma("unroll") for (int i = 0; i < VPT; ++i) sv[S_][i] = *(const bf16x8*)(vt_ + vsrc0 + i * 128); \
        if (MODE == 1) { if (tid < 64) sdec[S_] = a.dec[(kb_ + tid) * 16]; else if (tid == 64) sdec[S_] = a.neff[(j)]; } } while (0)
#define FA_WRITET(bf, S_) do { \
        _Pragma("unroll") for (int i = 0; i < KPT; ++i) *(LAS bf16x8*)(K_lds + (bf) * SHM_K + kws0 + i * 128) = sk[S_][i]; \
        _Pragma("unroll") for (int i = 0; i < VPT; ++i) *(LAS bf16x8*)(V_lds + (bf) * SHM_V + vws0 + i * 1024) = sv[S_][i]; \
        if (MODE == 1) { if (tid < 64) dec_l[(bf) * 64 + tid] = sdec[S_]; else if (tid == 64) dec_l[800 + (bf)] = sdec[S_]; } } while (0)
#define FA_TR(dst, off) asm volatile("ds_read_b64_tr_b16 %0, %1 offset:%2" : "=&v"(dst) : "v"(vb0), "i"(off) : "memory")
#define FA_VRD(S, BUF, d0) do { constexpr int b_ = (BUF) * SHM_V + (d0) * 512; \
        FA_TR(S##l[0], b_); FA_TR(S##h[0], b_ + RB); FA_TR(S##l[1], b_ + 2 * RB); FA_TR(S##h[1], b_ + 3 * RB); FA_TR(S##l[2], b_ + 4 * RB); FA_TR(S##h[2], b_ + 5 * RB); FA_TR(S##l[3], b_ + 6 * RB); FA_TR(S##h[3], b_ + 7 * RB); } while (0)
#define FA_VMM(S, d0) do { \
        o[d0] = __builtin_amdgcn_mfma_f32_32x32x16_bf16(pa0, (bf16x8){S##l[0][0], S##l[0][1], S##l[0][2], S##l[0][3], S##h[0][0], S##h[0][1], S##h[0][2], S##h[0][3]}, o[d0], 0, 0, 0); \
        o[d0] = __builtin_amdgcn_mfma_f32_32x32x16_bf16(pa1, (bf16x8){S##l[1][0], S##l[1][1], S##l[1][2], S##l[1][3], S##h[1][0], S##h[1][1], S##h[1][2], S##h[1][3]}, o[d0], 0, 0, 0); \
        o[d0] = __builtin_amdgcn_mfma_f32_32x32x16_bf16(pa2, (bf16x8){S##l[2][0], S##l[2][1], S##l[2][2], S##l[2][3], S##h[2][0], S##h[2][1], S##h[2][2], S##h[2][3]}, o[d0], 0, 0, 0); \
        o[d0] = __builtin_amdgcn_mfma_f32_32x32x16_bf16(pa3, (bf16x8){S##l[3][0], S##l[3][1], S##l[3][2], S##l[3][3], S##h[3][0], S##h[3][1], S##h[3][2], S##h[3][3]}, o[d0], 0, 0, 0); } while (0)
#define FA_LW(n) do { asm volatile("s_waitcnt lgkmcnt(" #n ")" ::: "memory"); SBAR(); } while (0)
#define FA_PVALL(BUF) do { s16x4 Al[4], Ah[4], Bl[4], Bh[4]; \
        FA_VRD(A, BUF, 0); FA_VRD(B, BUF, 1); FA_LW(8); FA_VMM(A, 0); \
        if constexpr (NDV == 4) { FA_VRD(A, BUF, 2); FA_LW(8); FA_VMM(B, 1); FA_VRD(B, BUF, 3); FA_LW(8); FA_VMM(A, 2); FA_LW(0); FA_VMM(B, 3); } \
        else { FA_LW(0); FA_VMM(B, 1); } } while (0)
#define FA_PK4(P, B_, OUT) do { unsigned a0 = cvt_pk_bf16(P[B_ + 0], P[B_ + 1]), a1 = cvt_pk_bf16(P[B_ + 2], P[B_ + 3]); \
        unsigned b0 = cvt_pk_bf16(P[B_ + 4], P[B_ + 5]), b1 = cvt_pk_bf16(P[B_ + 6], P[B_ + 7]); \
        auto r0 = __builtin_amdgcn_permlane32_swap(a0, b0, false, false); auto r1 = __builtin_amdgcn_permlane32_swap(a1, b1, false, false); \
        u32x4 w = {r0[0], r1[0], r0[1], r1[1]}; OUT = *reinterpret_cast<bf16x8*>(&w); } while (0)
#define FA_COMPUTE(BUF, kb) do { \
            f32x16 p0, p1; \
            if (MODE == 1) { _Pragma("unroll") for (int r = 0; r < 16; ++r) { p0[r] = clq - dec_l[(BUF) * 64 + crow(r, hi)]; p1[r] = clq - dec_l[(BUF) * 64 + 32 + crow(r, hi)]; } } \
            else { p0 = f32x16{}; p1 = f32x16{}; } \
            { const LAS char* kbp[4];     \
              kbp[0] = K_lds + (BUF) * SHM_K + kq + hi * 16; \
              bf16x8 ka0 = *(const LAS bf16x8*)kbp[0], ka1 = *(const LAS bf16x8*)(kbp[0] + 32 * KROWB), kb0, kb1; SBAR(); \
              _Pragma("unroll") for (int d0 = 0; d0 < NDK; d0 += 2) { \
                  { const LAS char* ap = kbp[0] + (d0 + 1) * 32; kb0 = *(const LAS bf16x8*)ap; kb1 = *(const LAS bf16x8*)(ap + 32 * KROWB); } SBAR(); \
                  p0 = __builtin_amdgcn_mfma_f32_32x32x16_bf16(ka0, qr[d0], p0, 0, 0, 0); p1 = __builtin_amdgcn_mfma_f32_32x32x16_bf16(ka1, qr[d0], p1, 0, 0, 0); SBAR(); \
                  if (d0 + 2 < NDK) { const LAS char* ap = kbp[0] + (d0 + 2) * 32; ka0 = *(const LAS bf16x8*)ap; ka1 = *(const LAS bf16x8*)(ap + 32 * KROWB); } SBAR(); \
                  p0 = __builtin_amdgcn_mfma_f32_32x32x16_bf16(kb0, qr[d0 + 1], p0, 0, 0, 0); p1 = __builtin_amdgcn_mfma_f32_32x32x16_bf16(kb1, qr[d0 + 1], p1, 0, 0, 0); SBAR(); } } \
            if (MODE == 2) { const int dq0 = qpos - (kb) - 4 * hi; \
                _Pragma("unroll") for (int r = 0; r < 16; ++r) { const int c = (r & 3) + 8 * (r >> 2); int i0 = dq0 - c, i1 = dq0 - c - 32; \
                    i0 = i0 < 0 ? 0 : (i0 > 127 ? 127 : i0); i1 = i1 < 0 ? 0 : (i1 > 127 ? 127 : i1); p0[r] += bias_l[i0]; p1[r] += bias_l[i1]; } } \
            if (MODE != 3) { if ((kb) + 63 > qlo || (kb) <= qlo + 31 - a.W) mask_tile(p0, p1, qpos - (kb) - 4 * hi, (unsigned)a.W); } \
            float pmax = p0[0]; \
            _Pragma("unroll") for (int r = 1; r < 16; ++r) pmax = fmaxf(pmax, p0[r]); \
            _Pragma("unroll") for (int r = 0; r < 16; ++r) pmax = fmaxf(pmax, p1[r]); \
            { auto rr = __builtin_amdgcn_permlane32_swap(__float_as_uint(pmax), __float_as_uint(pmax), false, false); pmax = fmaxf(__uint_as_float(rr[0]), __uint_as_float(rr[1])); } \
            float mn, alpha; \
            if (__builtin_expect(__all((pmax - m_reg) <= THR), 1)) { mn = m_reg; alpha = 1.f; } \
            else { mn = fmaxf(m_reg, pmax); alpha = __builtin_amdgcn_exp2f(m_reg - mn); m_reg = mn; } \
            _Pragma("unroll") for (int r = 0; r < 16; ++r) { p0[r] = __builtin_amdgcn_exp2f(p0[r] - mn); p1[r] = __builtin_amdgcn_exp2f(p1[r] - mn); } \
            float ps = 0.f; \
            _Pragma("unroll") for (int r = 0; r < 16; ++r) ps += p0[r]; \
            _Pragma("unroll") for (int r = 0; r < 16; ++r) ps += p1[r]; \
            { auto rr = __builtin_amdgcn_permlane32_swap(__float_as_uint(ps), __float_as_uint(ps), false, false); ps = __uint_as_float(rr[0]) + __uint_as_float(rr[1]); } \
            l_reg = l_reg * alpha + ps; \
            if (__any(alpha < 1.f)) { if (hi == 0) ws[32 + r32] = alpha; asm volatile("s_waitcnt lgkmcnt(0)" ::: "memory"); \
                _Pragma("unroll") for (int d_ = 0; d_ < NDV; ++d_) _Pragma("unroll") for (int r = 0; r < 16; ++r) o[d_][r] *= ws[32 + crow(r, hi)]; } \
            bf16x8 pa0, pa1, pa2, pa3; \
            FA_PK4(p0, 0, pa0); FA_PK4(p0, 8, pa1); FA_PK4(p1, 0, pa2); FA_PK4(p1, 8, pa3); SBAR(); \
            FA_PVALL(BUF); \
        } while (0)
    if constexpr (MODE != 1) {
#define FA_TILE(t, BUF) do { \
        const int kb = (a.j_lo + (t)) * 64; \
        bool act = true; if (MODE != 3) act = (kb <= qlo + 31) && (kb + 63 >= qlo - a.W + 1); \
        if ((t) + 2 < NT) FA_LOADT(a.j_lo + (t) + 2, BUF);              \
        if (act) FA_COMPUTE(BUF, kb); \
        if ((t) + 1 < NT) FA_WRITET((BUF) ^ 1, (BUF) ^ 1);              \
        __syncthreads(); } while (0)
        FA_LOADT(a.j_lo, 0); FA_WRITET(0, 0); if (NT > 1) FA_LOADT(a.j_lo + 1, 1); __syncthreads();
        for (int t = 0; t < NT; t += 2) {
            FA_TILE(t, 0);
            if (t + 1 < NT) FA_TILE(t + 1, 1);
        }
#undef FA_TILE
    } else {
        constexpr float TEXIT = 14.f;
        float qn2 = 0.f;
#pragma unroll
        for (int d0 = 0; d0 < NDK; ++d0)
#pragma unroll
            for (int e = 0; e < 8; ++e) { const float f = bf2f((unsigned short)qr[d0][e]); qn2 += f * f; }
        { auto rr = __builtin_amdgcn_permlane32_swap(__float_as_uint(qn2), __float_as_uint(qn2), false, false); qn2 = __uint_as_float(rr[0]) + __uint_as_float(rr[1]); }
        const float ubase = sqrtf(qn2) * a.kmax * 1.0001f + clq;
        LAS int* flags = (LAS int*)(dec_l + 128 + 512 + 128);
        bool wdone = false, stop = false;
#define FA_TILE_R(t, BUF) do { \
        const int kb = (a.j_lo + (t)) * 64; const bool more = (t) > 0; \
        const bool act = !wdone && (kb <= qlo + 31); \
        if ((t) > 1) FA_LOADT(a.j_lo + (t) - 2, BUF); \
        if (act) { FA_COMPUTE(BUF, kb); \
            wdone = __all((ubase - dec_l[(BUF) * 64] + dec_l[800 + (BUF)]) < (m_reg - TEXIT)) != 0; } \
        if (more) FA_WRITET((BUF) ^ 1, (BUF) ^ 1); \
        if (lane == 0) flags[(BUF) * 8 + wid] = wdone ? 1 : 0; \
        __syncthreads(); \
        { int all_ = 1; _Pragma("unroll") for (int w_ = 0; w_ < 8; ++w_) all_ &= flags[(BUF) * 8 + w_]; stop = !more || (all_ != 0); } } while (0)
        FA_LOADT(a.j_lo + NT - 1, 0); FA_WRITET(0, 0); if (NT > 1) FA_LOADT(a.j_lo + NT - 2, 1); __syncthreads();
        for (int t = NT - 1;;) {
            FA_TILE_R(t, 0); if (stop) break; --t;
            FA_TILE_R(t, 1); if (stop) break; --t;
        }
#undef FA_TILE_R
    }
    __builtin_amdgcn_s_setprio(0);
    if (hi == 0) ws[r32] = l_reg; asm volatile("s_waitcnt lgkmcnt(0)" ::: "memory");
    float rli[16];
#pragma unroll
    for (int r = 0; r < 16; ++r) rli[r] = __builtin_amdgcn_rcpf(ws[crow(r, hi)]);
    bf16_t* Ow = a.O + (size_t)qlo * a.ldo + hoff;
#pragma unroll
    for (int r = 0; r < 16; ++r) { const int orow = crow(r, hi);
#pragma unroll
        for (int d0 = 0; d0 < NDV; ++d0) { const float v = o[d0][r] * rli[r]; const float vn = __shfl_xor(v, 1);
            if ((r32 & 1) == 0) *(unsigned*)(Ow + (size_t)orow * a.ldo + d0 * 32 + r32) = cvt_pk_bf16(v, vn); } }
    __syncthreads();
#undef FA_LOADT
#undef FA_WRITET
#undef FA_TR
#undef FA_VRD
#undef FA_VMM
#undef FA_LW
#undef FA_PVALL
#undef FA_PK4
#undef FA_COMPUTE
}
#undef SBAR
}

struct Args { const void* in[N_IN]; float* out; unsigned char* ws; int ph_lo, ph_hi; };

__device__ const float ROPE_INV[32] = {
    1.000000000e+00f, 7.498942614e-01f, 5.623413324e-01f, 4.216965139e-01f, 3.162277639e-01f, 2.371373773e-01f, 1.778279394e-01f, 1.333521307e-01f,
    1.000000015e-01f, 7.498941571e-02f, 5.623413250e-02f, 4.216965288e-02f, 3.162277490e-02f, 2.371373773e-02f, 1.778279431e-02f, 1.333521493e-02f,
    9.999999776e-03f, 7.498941850e-03f, 5.623413250e-03f, 4.216964822e-03f, 3.162277630e-03f, 2.371373586e-03f, 1.778279431e-03f, 1.333521446e-03f,
    1.000000047e-03f, 7.498942432e-04f, 5.623413017e-04f, 4.216965172e-04f, 3.162277571e-04f, 2.371373703e-04f, 1.778279402e-04f, 1.333521504e-04f };
__device__ const unsigned char T5_BUCKET[128] = {
    0, 1, 2, 3, 4, 5, 6, 7, 8, 9, 10, 11, 12, 13, 14, 15, 16, 16, 16, 17, 17, 18, 18, 18, 19, 19, 19, 20, 20, 20, 20, 21, 21, 21, 21, 22, 22, 22, 22, 22, 23, 23, 23, 23, 23, 23, 24, 24, 24, 24, 24, 24,
    25, 25, 25, 25, 25, 25, 25, 26, 26, 26, 26, 26, 26, 26, 26, 27, 27, 27, 27, 27, 27, 27, 27, 27, 27, 28, 28, 28, 28, 28, 28, 28, 28, 28, 28, 29, 29, 29, 29, 29, 29, 29, 29, 29, 29, 29, 29,
    30, 30, 30, 30, 30, 30, 30, 30, 30, 30, 30, 30, 30, 30, 31, 31, 31, 31, 31, 31, 31, 31, 31, 31, 31, 31, 31, 31, 31 };

struct CvtJob { const float* src; int K, Nsrc, Npad; const float* gain; bf16_t* dst; int ldd; int mode; int row_off; int kblk;   unsigned* amax;   int f8;   int f16;   };
__device__ __forceinline__ int cvt_row(int mode, int n) {
    if (mode == 1) { if (n >= 1280 && n < 1344) { const int j = n - 1280; return 1280 + 2 * (j & 31) + (j >> 5); } return n; }
    if (mode == 2) { const int h = n / 192, w = n - h * 192; if (w >= 128) { const int j = w - 128; return h * 192 + 128 + 2 * (j & 31) + (j >> 5); } return n; }
    if (mode == 4) return (n >> 7) * 256 + (n & 127);
    if (mode == 5) return (n >> 7) * 256 + 128 + (n & 127);
    return n;
}
__device__ __forceinline__ float cvt_cs(int mode, int n) {
    if (mode == 1) return (n >= 1344 && n < 2368) ? C2_SWA : 1.f;
    if (mode == 2) return C2_MLA;
    if (mode == 3) return C2_128;
    if (mode == 6) return n < 2048 ? C2_128 : 1.f;
    return 1.f;
}
constexpr int N_CVT_JOBS = 17 + 24;
__device__ __forceinline__ CvtJob get_job(const Args& a, int j) {
    unsigned char* ws = a.ws; CvtJob jb; jb.gain = nullptr; jb.mode = 0; jb.row_off = 0; jb.amax = nullptr; jb.kblk = 0; jb.f16 = 0; jb.f8 = 0;
    const float* nmix = (const float*)a.in[I_NMIX]; const float* ncross = (const float*)a.in[I_NCROSS]; const float* nmem = (const float*)a.in[I_NMEM]; const float* nffn = (const float*)a.in[I_NFFN];
    if (j >= 17) { const int t = (j - 17) >> 3, e = (j - 17) & 7;
        if (t == 0) { jb.src = (const float*)a.in[I_MG] + (size_t)e * DM * DFF; jb.K = DM; jb.Nsrc = jb.Npad = DFF; jb.gain = nffn + DM; jb.dst = (bf16_t*)(ws + WS_WGU1 + (size_t)e * E_GU); jb.ldd = DM; jb.mode = 4; jb.amax = (unsigned*)(ws + WS_CTL) + CW_AMAXW + e * 2 * DFF; }
        else if (t == 1) { jb.src = (const float*)a.in[I_MU] + (size_t)e * DM * DFF; jb.K = DM; jb.Nsrc = jb.Npad = DFF; jb.gain = nffn + DM; jb.dst = (bf16_t*)(ws + WS_WGU1 + (size_t)e * E_GU); jb.ldd = DM; jb.mode = 5; jb.amax = (unsigned*)(ws + WS_CTL) + CW_AMAXW + e * 2 * DFF; }
        else { jb.src = (const float*)a.in[I_MD] + (size_t)e * DFF * DM; jb.K = DFF; jb.Nsrc = jb.Npad = DM; jb.dst = (bf16_t*)(ws + WS_WD1 + (size_t)e * E_D)  ; jb.ldd = DFF; jb.kblk = 1; jb.f8 = 1; }
        return jb; }
    switch (j) {
    case 0: jb.src = (const float*)a.in[I_EVWIN]; jb.K = DM; jb.Nsrc = EVEN_IN; jb.Npad = Z0_LD; jb.gain = nmix; jb.dst = (bf16_t*)(ws + WS_WIN0)  ; jb.ldd = DM; jb.mode = 1; jb.amax = (unsigned*)(ws + WS_CTL) + CW_AMAX0; break;
    case 1: jb.src = (const float*)a.in[I_WUQ]; jb.K = 768; jb.Nsrc = jb.Npad = 1536; jb.gain = (const float*)a.in[I_QNORM]; jb.dst = (bf16_t*)(ws + WS_WUQ); jb.ldd = 768; jb.mode = 2; break;
    case 2: jb.src = (const float*)a.in[I_WUKV]; jb.K = 512; jb.Nsrc = jb.Npad = 2048; jb.gain = (const float*)a.in[I_KVNORM]; jb.dst = (bf16_t*)(ws + WS_WUKV); jb.ldd = 512; break;
    case 3: jb.src = (const float*)a.in[I_EVWO]; jb.K = DM; jb.Nsrc = jb.Npad = DM; jb.dst = (bf16_t*)(ws + WS_WO0); jb.ldd = DM; break;
    case 4: case 5: { const int l = j - 4; jb.src = (const float*)a.in[I_XWQ] + (size_t)l * DM * 512; jb.K = DM; jb.Nsrc = jb.Npad = 512; jb.gain = ncross + l * DM; jb.dst = (bf16_t*)(ws + WS_WXQ) + (size_t)l * E_XQ; jb.ldd = DM; jb.mode = 3; jb.f16 = 1; break; }
    case 6: case 7: { const int l = j - 6; jb.src = (const float*)a.in[I_XWK] + (size_t)l * DM * 512; jb.K = DM; jb.Nsrc = jb.Npad = 512; jb.gain = nmem + l * DM; jb.dst = (bf16_t*)(ws + WS_WXKV); jb.ldd = DM; jb.row_off = l * 1024; break; }
    case 8: case 9: { const int l = j - 8; jb.src = (const float*)a.in[I_XWV] + (size_t)l * DM * 512; jb.K = DM; jb.Nsrc = jb.Npad = 512; jb.gain = nmem + l * DM; jb.dst = (bf16_t*)(ws + WS_WXKV); jb.ldd = DM; jb.row_off = l * 1024 + 512; break; }
    case 10: case 11: { const int l = j - 10; jb.src = (const float*)a.in[I_XWO] + (size_t)l * 512 * DM; jb.K = 512; jb.Nsrc = jb.Npad = DM; jb.dst = (bf16_t*)(ws + WS_WXO) + (size_t)l * E_XO; jb.ldd = 512; break; }
    case 12: jb.src = (const float*)a.in[I_FG]; jb.K = DM; jb.Nsrc = jb.Npad = DFF; jb.gain = nffn; jb.dst = (bf16_t*)(ws + WS_WGU0); jb.ldd = DM; jb.mode = 4; jb.amax = (unsigned*)(ws + WS_CTL) + CW_AMAXW + 8 * 2 * DFF; break;
    case 13: jb.src = (const float*)a.in[I_FU]; jb.K = DM; jb.Nsrc = jb.Npad = DFF; jb.gain = nffn; jb.dst = (bf16_t*)(ws + WS_WGU0); jb.ldd = DM; jb.mode = 5; jb.amax = (unsigned*)(ws + WS_CTL) + CW_AMAXW + 8 * 2 * DFF; break;
    case 14: jb.src = (const float*)a.in[I_FD]; jb.K = DFF; jb.Nsrc = jb.Npad = DM; jb.dst = (bf16_t*)(ws + WS_WD0); jb.ldd = DFF; jb.kblk = 1; break;
    case 15: jb.src = (const float*)a.in[I_ODWIN]; jb.K = DM; jb.Nsrc = ODD_IN; jb.Npad = IN1_PAD; jb.gain = nmix + DM; jb.dst = (bf16_t*)(ws + WS_WIN1)  ; jb.ldd = DM; jb.mode = 6; jb.amax = (unsigned*)(ws + WS_CTL) + CW_AMAX15; break;
    default: jb.src = (const float*)a.in[I_ODWO]; jb.K = DM; jb.Nsrc = jb.Npad = DM; jb.dst = (bf16_t*)(ws + WS_WO1); jb.ldd = DM; break;
    }
    return jb;
}
__device__ __forceinline__ int cvt_find(const LAS int* cum, int it, int& j) { while (it >= cum[j + 1]) ++j; return it - cum[j]; }
__device__ __forceinline__ void cvt_load(const CvtJob& jb, int item, int lane, float (&v)[32]) {
    const int nblk = jb.Npad / 32, kb = item / nblk, nb = item % nblk, k0 = 64 * kb, n0 = 32 * nb;
    const int nn = n0 + (lane & 31); const bool ok = nn < jb.Nsrc;
    const float* p = jb.src + (size_t)(k0 + (lane >> 5)) * jb.Nsrc + nn; const size_t st = (size_t)2 * jb.Nsrc;
#pragma unroll
    for (int i = 0; i < 32; ++i) v[i] = ok ? __builtin_nontemporal_load(p + i * st) : 0.f;
}
__device__ __forceinline__ void cvt_store(const CvtJob& jb, LAS float* scr, int item, int lane, const float (&v)[32]) {
    const int nblk = jb.Npad / 32, kb = item / nblk, nb = item % nblk, k0 = 64 * kb, n0 = 32 * nb;
    const float cs = cvt_cs(jb.mode, n0 + (lane & 31));
    const int c = lane & 7;
    f32x4 g0 = (f32x4){1.f, 1.f, 1.f, 1.f}, g1 = g0;
    if (jb.gain) { g0 = *(const f32x4*)(jb.gain + k0 + 8 * c); g1 = *(const f32x4*)(jb.gain + k0 + 8 * c + 4); }
#pragma unroll
    for (int i = 0; i < 32; ++i) scr[(2 * i + (lane >> 5)) * 33 + (lane & 31)] = v[i] * cs;
    LDS_WAIT(); asm volatile("" ::: "memory");
#pragma unroll
    for (int j = 0; j < 4; ++j) { const int n = (lane >> 3) + 8 * j; const LAS float* s = scr + (8 * c) * 33 + n;
        u32x4 o;
        if (jb.f16) { o.x = pk_f16(s[0 * 33] * g0[0], s[1 * 33] * g0[1]); o.y = pk_f16(s[2 * 33] * g0[2], s[3 * 33] * g0[3]); o.z = pk_f16(s[4 * 33] * g1[0], s[5 * 33] * g1[1]); o.w = pk_f16(s[6 * 33] * g1[2], s[7 * 33] * g1[3]); }
        else { o.x = cvt_pk_bf16(s[0 * 33] * g0[0], s[1 * 33] * g0[1]); o.y = cvt_pk_bf16(s[2 * 33] * g0[2], s[3 * 33] * g0[3]); o.z = cvt_pk_bf16(s[4 * 33] * g1[0], s[5 * 33] * g1[1]); o.w = cvt_pk_bf16(s[6 * 33] * g1[2], s[7 * 33] * g1[3]); }
        const int drow = jb.row_off + cvt_row(jb.mode, n0 + n);
        if (jb.f8) {
            const f32x4 a_ = (f32x4){s[0 * 33] * g0[0], s[1 * 33] * g0[1], s[2 * 33] * g0[2], s[3 * 33] * g0[3]} * 64.f, b_ = (f32x4){s[4 * 33] * g1[0], s[5 * 33] * g1[1], s[6 * 33] * g1[2], s[7 * 33] * g1[3]} * 64.f;
            *(u32x2*)((unsigned char*)jb.dst + ((size_t)(k0 >> 7) * jb.Npad + drow) * 128 + (k0 & 64) + 8 * c) = pack8_fp8(a_, b_);
        } else { bf16_t* dp = jb.kblk ? jb.dst + ((size_t)(k0 >> 6) * jb.Npad + drow) * 64 + 8 * c : jb.dst + (size_t)drow * jb.ldd + k0 + 8 * c; *(u32x4*)dp = o; } }
    LDS_WAIT(); asm volatile("" ::: "memory");
}
__device__ __forceinline__ void cvt_amax(const CvtJob& jb, int item, int lane, const float (&v)[32]) {
    const int nblk = jb.Npad / 32, kb = item / nblk, nb = item % nblk, k0 = 64 * kb, n0 = 32 * nb;
    const int nn = n0 + (lane & 31); float mx = 0.f;
#pragma unroll
    for (int i = 0; i < 32; ++i) mx = fmaxf(mx, fabsf(v[i] * jb.gain[k0 + 2 * i + (lane >> 5)]));
    mx = fmaxf(mx, __shfl_xor(mx, 32)) * cvt_cs(jb.mode, nn);
    if (lane < 32 && nn < jb.Nsrc) atomicMax(jb.amax + jb.row_off + cvt_row(jb.mode, nn), __float_as_uint(mx));
}
__device__ __forceinline__ float cvt_amax_item(const CvtJob& jb, int item, int lane, const float (&v)[32]) {
    const int nblk = jb.Npad / 32, kb = item / nblk, nb = item % nblk, k0 = 64 * kb, n0 = 32 * nb;
    float mx = 0.f;
#pragma unroll
    for (int i = 0; i < 32; ++i) mx = fmaxf(mx, fabsf(v[i] * jb.gain[k0 + 2 * i + (lane >> 5)]));
    return fmaxf(mx, __shfl_xor(mx, 32)) * cvt_cs(jb.mode, n0 + (lane & 31));
}
__device__ __forceinline__ void cvt_store_q8(const CvtJob& jb, LAS float* scr, int item, int lane, const float (&v)[32], const LAS float* cam = nullptr) {
    const int nblk = jb.Npad / 32, kb = item / nblk, nb = item % nblk, k0 = 64 * kb, n0 = 32 * nb;
    const int c = lane & 7;
    const f32x4 g0 = *(const f32x4*)(jb.gain + k0 + 8 * c), g1 = *(const f32x4*)(jb.gain + k0 + 8 * c + 4);
#pragma unroll
    for (int i = 0; i < 32; ++i) scr[(2 * i + (lane >> 5)) * 33 + (lane & 31)] = v[i];
    LDS_WAIT(); asm volatile("" ::: "memory");
#pragma unroll
    for (int j = 0; j < 4; ++j) { const int n = (lane >> 3) + 8 * j; const LAS float* s = scr + (8 * c) * 33 + n;
        const int row = jb.row_off + cvt_row(jb.mode, n0 + n);
        const float am = cam ? cam[n] : __uint_as_float(__hip_atomic_load(jb.amax + row, RLX_AGENT)); const float inv = am > 0.f ? cvt_cs(jb.mode, n0 + n) * 127.f / am : 0.f;
        int q[8];
#pragma unroll
        for (int i = 0; i < 4; ++i) { q[i] = (int)__builtin_rintf(s[i * 33] * g0[i] * inv); q[4 + i] = (int)__builtin_rintf(s[(4 + i) * 33] * g1[i] * inv); }
#pragma unroll
        for (int i = 0; i < 8; ++i) q[i] = q[i] > 127 ? 127 : (q[i] < -127 ? -127 : q[i]);
        u32x2 o; o.x = (unsigned)(q[0] & 255) | ((unsigned)(q[1] & 255) << 8) | ((unsigned)(q[2] & 255) << 16) | ((unsigned)(q[3] & 255) << 24);
        o.y = (unsigned)(q[4] & 255) | ((unsigned)(q[5] & 255) << 8) | ((unsigned)(q[6] & 255) << 16) | ((unsigned)(q[7] & 255) << 24);
        *(u32x2*)((unsigned char*)jb.dst + (size_t)row * jb.ldd + k0 + 8 * c) = o; }
    LDS_WAIT(); asm volatile("" ::: "memory");
}
__device__ __forceinline__ void row_to_bf16_ssq(const float* xrow, bf16_t* orow, float* ssqrow, int lane) {
    const f32x4* xr = (const f32x4*)xrow + lane; f32x4 v[8]; float s = 0.f;
#pragma unroll
    for (int j = 0; j < 8; ++j) { v[j] = xr[64 * j]; s += (v[j][0] * v[j][0] + v[j][1] * v[j][1]) + (v[j][2] * v[j][2] + v[j][3] * v[j][3]); }
    s = wave_sum(s);
    u32x2* o8 = (u32x2*)orow + lane;
#pragma unroll
    for (int j = 0; j < 8; ++j) { u32x2 w; w.x = cvt_pk_bf16(v[j][0], v[j][1]); w.y = cvt_pk_bf16(v[j][2], v[j][3]); o8[64 * j] = w; }
    if (lane < 32) ssqrow[lane] = lane == 0 ? s : 0.f;
}

__global__ void __launch_bounds__(NWAVES * 64, 2) trunk_fwd(Args args) {
    extern __shared__ __attribute__((aligned(16))) unsigned char lds_raw[];
    LAS unsigned char* lds = (LAS unsigned char*)lds_raw;
    volatile LAS unsigned* MISC = (volatile LAS unsigned*)(lds + MISC_OFF);
    const int tid = threadIdx.x, lane = tid & 63, wave = __builtin_amdgcn_readfirstlane(tid >> 6);
    const int G = gridDim.x; const int bx = blockIdx.x; const int vcu = (G % 8 == 0) ? (bx % 8) * (G / 8) + bx / 8 : bx;
    const int gw = vcu * NWAVES + wave, NGW = G * NWAVES;
    unsigned* ctl = (unsigned*)(args.ws + WS_CTL);
    const int lo = args.ph_lo, hi = args.ph_hi;
    const bool fused = (hi - lo) > 1;
    for (int u = tid; u < (LDS_BYTES - RING_BYTES) / 4; u += NWAVES * 64) ((LAS unsigned*)(lds + RING_BYTES))[u] = 0u;
    __syncthreads();
    XcdBarrier bar; bar.bar = ctl + CW_BAR; bar.x = 0; bar.st = nullptr;
    if (fused) bar = xcd_barrier_post(ctl + CW_BAR, MISC + 8);
#ifndef PH_MASK
#define PH_MASK 0xFFFFFFFFFFFFFFFFull
#endif
#define IN(k) ((((unsigned long long)PH_MASK >> (k)) & 1ull) && lo <= (k) && (k) < hi)
#define GRID_BAR(k) do { if (fused && IN((k) + 1)) xcd_barrier(bar); } while (0)
#ifndef DUP_MASK
#define DUP_MASK 0ull
#endif
#ifndef DUP_SUB
#define DUP_SUB 0
#endif
#define NREP(k) ((((unsigned long long)DUP_MASK >> (k)) & 1ull) ? 2 : 1)
#define PHASE(k) for (int rep_ = 0; rep_ < NREP(k) && IN(k); ++rep_)

#define WSL() GAS unsigned char* wsg_ = (GAS unsigned char*)args.ws; asm volatile("" : "+s"(wsg_)); unsigned char* ws = (unsigned char*)wsg_
#define XB ((bf16_t*)(ws + WS_XB))
#define SSQ ((float*)(ws + WS_SSQ))
#define ROPE ((float*)(ws + WS_ROPE))
#define MEMN ((bf16_t*)(ws + WS_MEMN))
#define SSQM ((float*)(ws + WS_SSQM))
#define MEMKV ((bf16_t*)(ws + WS_MEMKV))
#define SSQQ ((float*)(ws + WS_SSQQ))
#define SSQKV ((float*)(ws + WS_SSQKV))
#define QX ((bf16_t*)(ws + WS_QX))
#define OX ((bf16_t*)(ws + WS_OX))
#define FL ((float*)(ws + WS_FL))
#define DEC ((float*)(ws + WS_DEC))
#define TOPE ((int*)(ws + WS_TOPE))
#define TOPS ((int*)(ws + WS_TOPS))
#define TOPG ((float*)(ws + WS_TOPG))
#define RSTDF ((float*)(ws + WS_RSTDF))
#define TOKPOS ((int*)(ws + WS_TOKPOS))
#define ROWIDX ((int*)(ws + WS_ROWIDX))
#define GATEP ((float*)(ws + WS_GATEP))
#define RSTDP ((float*)(ws + WS_RSTDP))
#define BIAST ((float*)(ws + WS_BIAST))
#define Z0 ((bf16_t*)(ws + WS_ARENA + AR_Z0))
#define QM ((bf16_t*)(ws + WS_ARENA + AR_QM))
#define KM ((bf16_t*)(ws + WS_ARENA + AR_KM))
#define VM ((bf16_t*)(ws + WS_ARENA + AR_VM))
#define O0 ((bf16_t*)(ws + WS_ARENA + AR_O0))
#define HIDB(i) ((bf16_t*)(ws + WS_ARENA + AR_HID + (size_t)((i) & 1) * HID_BYTES))
#define YB ((bf16_t*)(ws + WS_ARENA + AR_Y))
#define Z1 ((bf16_t*)(ws + WS_ARENA + AR_Z1))
#define O1 ((bf16_t*)(ws + WS_ARENA + AR_O1))
#define XQ ((unsigned char*)(ws + WS_QX))
#define XH ((unsigned short*)(ws + WS_XB))
#define XIN ((const float*)args.in[I_X])

    PHASE(0) {
        WSL();
        LAS float* scr = (LAS float*)(lds + wave * 16384);
        LAS int* cum = (LAS int*)(lds + RING_BYTES + 4096);
        if (tid < N_CVT_JOBS) { const CvtJob jb = get_job(args, tid); cum[64 + tid] = jb.amax ? 0   : (jb.K / 64) * (jb.Npad / 32); }
        __syncthreads();
        if (tid == 0) { int run = 0; for (int j = 0; j < N_CVT_JOBS; ++j) { cum[j] = run; run += cum[64 + j]; } cum[N_CVT_JOBS] = run; cum[N_CVT_JOBS + 1] = 0x7fffffff; }
        __syncthreads();
        {
            const int total = cum[N_CVT_JOBS];
            float va[32], vb[32]; int jL = 0, jP = 0;
            if (gw < total) { const int li = cvt_find(cum, gw, jL); cvt_load(get_job(args, jL), li, lane, va); }
#pragma unroll 1
            for (int it = gw; it < total; it += 2 * NGW) {
                const int it2 = it + NGW, it3 = it + 2 * NGW;
                if (it2 < total) { const int li = cvt_find(cum, it2, jL); cvt_load(get_job(args, jL), li, lane, vb); }
                { const int li = cvt_find(cum, it, jP); const CvtJob jb = get_job(args, jP); cvt_store(jb, scr, li, lane, va); }
                if (it2 < total) {
                    if (it3 < total) { const int li = cvt_find(cum, it3, jL); cvt_load(get_job(args, jL), li, lane, va); }
                    const int li = cvt_find(cum, it2, jP); const CvtJob jb = get_job(args, jP); cvt_store(jb, scr, li, lane, vb);
                }
            }
        }
        for (int m = gw; m < M; m += NGW) {
            const f32x4* xr = (const f32x4*)(XIN + (size_t)m * DM) + lane; f32x4 v[8]; float ss = 0.f, amx = 0.f;
#pragma unroll
            for (int j = 0; j < 8; ++j) { v[j] = xr[64 * j]; ss += (v[j][0] * v[j][0] + v[j][1] * v[j][1]) + (v[j][2] * v[j][2] + v[j][3] * v[j][3]);
                amx = fmaxf(amx, fmaxf(fmaxf(fabsf(v[j][0]), fabsf(v[j][1])), fmaxf(fabsf(v[j][2]), fabsf(v[j][3])))); }
            ss = wave_sum(ss);
#pragma unroll
            for (int o_ = 1; o_ < 64; o_ <<= 1) amx = fmaxf(amx, __shfl_xor(amx, o_));
            const float inv = amx > 0.f ? 127.f / amx : 0.f; unsigned* xq = (unsigned*)((unsigned char*)XB + (size_t)m * DM) + lane;
#pragma unroll
            for (int j = 0; j < 8; ++j) { const int q0 = (int)__builtin_rintf(v[j][0] * inv), q1 = (int)__builtin_rintf(v[j][1] * inv), q2 = (int)__builtin_rintf(v[j][2] * inv), q3 = (int)__builtin_rintf(v[j][3] * inv);
                xq[64 * j] = (unsigned)(q0 & 255) | ((unsigned)(q1 & 255) << 8) | ((unsigned)(q2 & 255) << 16) | ((unsigned)(q3 & 255) << 24); }
            if (lane == 0) RSTDF[m] = __builtin_amdgcn_rsqf(ss * (1.f / DM) + EPS) * amx * (1.f / 127.f);
        }
        for (int m = gw; m < MROWS; m += NGW) row_to_bf16_ssq((const float*)args.in[I_MEM] + (size_t)m * DM, MEMN + (size_t)m * DM, SSQM + (size_t)m * 32, lane);
        const int* pos = (const int*)args.in[I_POS];
        int gt0_ = tid; asm volatile("" : "+v"(gt0_)); gt0_ += bx * 512;
        for (int e = gt0_; e < M * 32; e += G * 512) {
            const int row = e >> 5, i = e & 31;
            const float ang = (float)pos[row] * ROPE_INV[i];
            const double rev = (double)ang * 0.15915494309189535; const float fr = (float)(rev - __builtin_rint(rev));
            ROPE[(size_t)e * 2] = __builtin_amdgcn_cosf(fr); ROPE[(size_t)e * 2 + 1] = __builtin_amdgcn_sinf(fr);
        }
        const float* relb = (const float*)args.in[I_RELB];
        for (int e = gt0_; e < 16 * 128; e += G * 512) { const int h = e >> 7, d = e & 127; BIAST[e] = relb[(int)T5_BUCKET[d] * 16 + h] * LOG2E; }
        if (fused && IN(1) && !IN(44)) xcd_barrier(bar);
        __syncthreads();
    }

    PHASE(44) {
        LAS float* scr = (LAS float*)(lds + wave * 16384);
        LAS float* cam = (LAS float*)(lds + RING_BYTES + 4096);
        constexpr int NBJ = DFF / 32, NB15 = IN1_PAD / 32, NB0 = Z0_LD / 32, NB = 18 * NBJ + NB15 + NB0;
#define Q8DEC(cb_, j_, nb_) const int j_ = (cb_) >= 18 * NBJ + NB15 ? 0 : ((cb_) >= 18 * NBJ ? 15 : ((cb_) / NBJ < 2 ? 12 + (cb_) / NBJ : 15 + (cb_) / NBJ)); \
        const int nb_ = (cb_) >= 18 * NBJ + NB15 ? (cb_) - 18 * NBJ - NB15 : ((cb_) >= 18 * NBJ ? (cb_) - 18 * NBJ : (cb_) % NBJ)
        float v0[32], v1[32], v2[32], v3[32];
        if (bx < NB) { Q8DEC(bx, j, nb); const CvtJob jb = get_job(args, j); const int nblk = jb.Npad / 32;
            cvt_load(jb, (4 * wave + 0) * nblk + nb, lane, v0); cvt_load(jb, (4 * wave + 1) * nblk + nb, lane, v1);
            cvt_load(jb, (4 * wave + 2) * nblk + nb, lane, v2); cvt_load(jb, (4 * wave + 3) * nblk + nb, lane, v3); }
#pragma unroll 1
        for (int cb = bx; cb < NB; cb += G) {
            Q8DEC(cb, j, nb); const CvtJob jb = get_job(args, j); const int nblk = jb.Npad / 32;
            const int cn = cb + G; const bool more = cn < NB; Q8DEC(more ? cn : cb, jn, nbn); const CvtJob jbn = get_job(args, jn); const int nblkn = jbn.Npad / 32;
            float mx = fmaxf(fmaxf(cvt_amax_item(jb, (4 * wave + 0) * nblk + nb, lane, v0), cvt_amax_item(jb, (4 * wave + 1) * nblk + nb, lane, v1)),
                             fmaxf(cvt_amax_item(jb, (4 * wave + 2) * nblk + nb, lane, v2), cvt_amax_item(jb, (4 * wave + 3) * nblk + nb, lane, v3)));
            __syncthreads();
            if (lane < 32) cam[wave * 32 + lane] = mx;
            __syncthreads();
            if (lane < 32) { float m = cam[lane];
#pragma unroll
                for (int w = 1; w < 8; ++w) m = fmaxf(m, cam[w * 32 + lane]);
                cam[256 + wave * 32 + lane] = m;
                const int nn = 32 * nb + lane; if (wave == 0 && nn < jb.Nsrc) jb.amax[jb.row_off + cvt_row(jb.mode, nn)] = __float_as_uint(m); }
            LDS_WAIT(); asm volatile("" ::: "memory");
            const LAS float* camw = cam + 256 + wave * 32;
            cvt_store_q8(jb, scr, (4 * wave + 0) * nblk + nb, lane, v0, camw); if (more) cvt_load(jbn, (4 * wave + 0) * nblkn + nbn, lane, v0);
            cvt_store_q8(jb, scr, (4 * wave + 1) * nblk + nb, lane, v1, camw); if (more) cvt_load(jbn, (4 * wave + 1) * nblkn + nbn, lane, v1);
            cvt_store_q8(jb, scr, (4 * wave + 2) * nblk + nb, lane, v2, camw); if (more) cvt_load(jbn, (4 * wave + 2) * nblkn + nbn, lane, v2);
            cvt_store_q8(jb, scr, (4 * wave + 3) * nblk + nb, lane, v3, camw); if (more) cvt_load(jbn, (4 * wave + 3) * nblkn + nbn, lane, v3);
        }
#undef Q8DEC
        GRID_BAR(0);
    }

    PHASE(1) {
        WSL();
        { pg8::PolPlain P{(const char*)XB  , DM, (const char*)(ws + WS_WIN0)  , DM, DM / 2};
          pg8::StaticOrder S; S.init(M / 256, Z0_LD / 256, G, bx, 0, WGM_K2048);
          pg8::EpiStore<1, 32> E{Z0, Z0_LD, nullptr, (LAS float*)(lds + RING_BYTES + 12288), 1.f / DM, ROPE, SSQQ, SSQKV, nullptr, nullptr, nullptr, RSTDF, ctl + CW_AMAX0};
          pg8::gemm_phase<pg8::EpiStore<1, 32>, pg8::PolPlain, 1>(lds, P, S, E); }
        { pg8::PolPlain P{(const char*)MEMN, DM * 2, (const char*)(ws + WS_WXKV), DM * 2, DM};
          pg8::StaticOrder S; S.init(MROWS / 256, 2048 / 256, G, (G - 1) - bx, 0);
          pg8::EpiStore<0, 32> E{MEMKV, 2048, SSQM, (LAS float*)(lds + RING_BYTES + 12288), 1.f / DM, nullptr, nullptr, nullptr, nullptr, nullptr, nullptr};
          pg8::gemm_phase(lds, P, S, E); }
        GRID_BAR(1);
    }
    PHASE(2) {
        WSL();
        { pg8::PolPlain P{(const char*)Z0, Z0_LD * 2, (const char*)(ws + WS_WUQ), 768 * 2, 768};
          pg8::StaticOrder S; S.init(M / 256, 1536 / 256, G, bx, 0);
          pg8::EpiStore<2, 12> E{QM, QM_LD, SSQQ, (LAS float*)(lds + RING_BYTES + 12288), 1.f / 768.f, ROPE, nullptr, nullptr, nullptr, nullptr, nullptr};
          pg8::gemm_phase(lds, P, S, E); }
        { pg8::PolPlain P{(const char*)(Z0 + 768), Z0_LD * 2, (const char*)(ws + WS_WUKV), 512 * 2, 512};
          pg8::StaticOrder S; S.init(M / 256, 2048 / 256, G, bx, 0);
          pg8::EpiStore<3, 8> E{KM, KM_LD, SSQKV, (LAS float*)(lds + RING_BYTES + 12288), 1.f / 512.f, nullptr, nullptr, nullptr, VM, Z0, nullptr};
          pg8::gemm_phase(lds, P, S, E); }
        GRID_BAR(2);
    }
    PHASE(3) {
        WSL();
#pragma unroll 1
        for (int r3_ = 0; r3_ < (DUP_SUB == 1 ? 2 : 1); ++r3_)
#pragma unroll 1
        for (int it = vcu; it < BATCH * 8 * 32; it += G) {
            const int bh = it >> 5, x = it & 31, b = bh >> 3, h = bh & 7;
#pragma unroll 1
            for (int pass = 0; pass < 2; ++pass) { const int qb = pass ? x : 63 - x;
                fa::AttnArgs a; a.Q = QM + (size_t)b * SEQ * QM_LD + h * 192; a.ldq = QM_LD; a.K = KM + (size_t)b * SEQ * KM_LD + h * 192; a.ldk = KM_LD;
                a.V = VM + (size_t)b * SEQ * VM_LD + h * 128; a.ldv = VM_LD; a.O = O0 + (size_t)b * SEQ * DM + h * 128; a.ldo = DM;
                a.q0 = qb * 256; a.j_lo = 0; a.j_hi = qb * 4 + 4; a.W = 0x3fffffff; a.dec = nullptr; a.sinkl = 0.f; a.sinks = nullptr; a.biasT = nullptr; a.kmax = 0.f;
                fa::attn_unit<192, 128, 0>(a, (LAS char*)lds); } }
        const float* sinks = (const float*)args.in[I_SINKS];
#pragma unroll 1
        for (int r3_ = 0; r3_ < (DUP_SUB == 2 ? 2 : 1); ++r3_)
#pragma unroll 1
        for (int it = vcu; it < BATCH * 2 * (SEQ / 32); it += G) {
            const int bk = it >> 9, qb = it & 511, b = bk >> 1, kvh = bk & 1, q0 = qb * 32;
            fa::AttnArgs a; const bf16_t* zb = Z0 + (size_t)b * SEQ * Z0_LD;
            a.Q = zb + 1344 + kvh * 512; a.ldq = Z0_LD; a.K = zb + 2368 + kvh * 64; a.ldk = Z0_LD; a.V = zb + 2496 + kvh * 64; a.ldv = Z0_LD;
            a.O = O0 + (size_t)b * SEQ * DM + 1024 + kvh * 512; a.ldo = DM;
            a.q0 = q0; a.j_lo = q0 - 127 < 0 ? 0 : (q0 - 127) >> 6; a.j_hi = ((q0 + 31) >> 6) + 1; a.W = 128; a.dec = nullptr; a.sinkl = 0.f; a.sinks = sinks + kvh * 8;
            a.biasT = BIAST + kvh * 8 * 128; a.kmax = 0.f;
            fa::attn_unit<64, 64, 2>(a, (LAS char*)lds); }
        GRID_BAR(3);
    }
    PHASE(4) {
        WSL();
        pg8::PolPlain P{(const char*)O0, DM * 2, (const char*)(ws + WS_WO0), DM * 2, DM};
        pg8::StaticOrder S; S.init(M / 256, DM / 256, G, bx, 0, WGM_K2048);
        pg8::EpiRes<true> E{XIN, XH, SSQ};
        pg8::gemm_phase(lds, P, S, E);
        GRID_BAR(4);
    }
#define CROSS_PHASES(l, s0) \
    PHASE(s0) { WSL(); \
        pg8::PolPlain P{(const char*)XH  , DM * 2, (const char*)(ws + WS_WXQ + (size_t)(l) * E_XQ * 2)  , DM * 2, DM}; \
        pg8::StaticOrder S; S.init(M / 256, 512 / 256, G, bx, 0, WGM_K2048); \
        pg8::EpiStore<0, 32> E{QX, 512, SSQ, (LAS float*)(lds + RING_BYTES + 12288), 1.f / DM, nullptr, nullptr, nullptr, nullptr, nullptr, nullptr}; \
        pg8::gemm_phase<pg8::EpiStore<0, 32>, pg8::PolPlain, 3>(lds, P, S, E); \
        GRID_BAR(s0); } \
    PHASE((s0) + 1) { WSL(); \
        _Pragma("unroll 1") for (int it = vcu; it < BATCH * 4 * 64; it += G) { \
            const int bh = it >> 6, qb = it & 63, b = bh >> 2, h = bh & 3; \
            fa::AttnArgs a; a.Q = QX + (size_t)b * SEQ * 512 + h * 128; a.ldq = 512; a.K = MEMKV + (size_t)b * MEMLEN * 2048 + (l) * 1024 + h * 128; a.ldk = 2048; \
            a.V = a.K + 512; a.ldv = 2048; a.O = OX + (size_t)b * SEQ * 512 + h * 128; a.ldo = 512; \
            a.q0 = qb * 256; a.j_lo = 0; a.j_hi = 4; a.W = 0x3fffffff; a.dec = nullptr; a.sinkl = 0.f; a.sinks = nullptr; a.biasT = nullptr; a.kmax = 0.f; \
            fa::attn_unit<128, 128, 3>(a, (LAS char*)lds); } \
        GRID_BAR((s0) + 1); } \
    PHASE((s0) + 2) { WSL(); \
        pg8::PolPlain P{(const char*)OX, 512 * 2, (const char*)(ws + WS_WXO + (size_t)(l) * E_XO * 2), 512 * 2, 512}; \
        pg8::StaticOrder S; S.init(M / 256, DM / 256, G, bx, 0); \
        pg8::EpiRes<false> E{XH, XH, nullptr};           \
        pg8::gemm_phase(lds, P, S, E); \
        GRID_BAR((s0) + 2); }
    CROSS_PHASES(0, 5)
    PHASE(45) {
        WSL();
#pragma unroll 1
        for (int m = gw; m < M; m += NGW) {
            const u32x2* xr = (const u32x2*)(XH + (size_t)m * DM) + lane; f32x4 v[8]; float ss = 0.f, amx = 0.f;
#pragma unroll
            for (int j = 0; j < 8; ++j) { v[j] = unpk_f16x4(xr[64 * j]); ss += (v[j][0] * v[j][0] + v[j][1] * v[j][1]) + (v[j][2] * v[j][2] + v[j][3] * v[j][3]);
                amx = fmaxf(amx, fmaxf(fmaxf(fabsf(v[j][0]), fabsf(v[j][1])), fmaxf(fabsf(v[j][2]), fabsf(v[j][3])))); }
            ss = wave_sum(ss);
#pragma unroll
            for (int o_ = 1; o_ < 64; o_ <<= 1) amx = fmaxf(amx, __shfl_xor(amx, o_));
            const float inv = amx > 0.f ? 127.f / amx : 0.f; unsigned* xq = (unsigned*)(XQ + (size_t)m * DM) + lane;
#pragma unroll
            for (int j = 0; j < 8; ++j) { const int q0 = (int)__builtin_rintf(v[j][0] * inv), q1 = (int)__builtin_rintf(v[j][1] * inv), q2 = (int)__builtin_rintf(v[j][2] * inv), q3 = (int)__builtin_rintf(v[j][3] * inv);
                xq[64 * j] = (unsigned)(q0 & 255) | ((unsigned)(q1 & 255) << 8) | ((unsigned)(q2 & 255) << 16) | ((unsigned)(q3 & 255) << 24); }
            if (lane == 0) RSTDF[m] = __builtin_amdgcn_rsqf(ss * (1.f / DM) + EPS) * amx * (1.f / 127.f);
        }
        GRID_BAR(7);
    }
#pragma unroll 1
    for (int p = 0; p < 5; ++p) {
        PHASE(8 + p) {
            if (p >= 1) {
                WSL();
                const int c = p - 1;
                pg8::PolChunkA P{(const char*)HIDB(c), 128, (const char*)(ws + WS_WD0), 128, DFF, c * CHUNK_TILES};
                pg8::StaticOrder S; S.init(CHUNK_TILES, DM / 256, G, bx, c * CHUNK_TILES, WGM_DOWN);
                pg8::EpiRes<false> E{XH, XH, SSQ};
                pg8::gemm_phase(lds, P, S, E);
            }
            int pg = p; asm volatile("" : "+s"(pg));
            if (pg <= 3) {
                WSL();
                pg8::PolPlain P{(const char*)XQ, DM, (const char*)(ws + WS_WGU0)  , DM, DM / 2};
                pg8::StaticOrder S; S.init(CHUNK_TILES, 2 * DFF / 256, G, bx, pg * CHUNK_TILES, WGM_GU);
                pg8::EpiSwiGLU<2> E{HIDB(pg), pg * CHUNK_ROWS, nullptr, RSTDF, ctl + CW_AMAXW + 8 * 2 * DFF, nullptr};
                pg8::gemm_phase<pg8::EpiSwiGLU<2>, pg8::PolPlain, 1>(lds, P, S, E);
            }
            GRID_BAR(8 + p);
        }
    }
    PHASE(46) {
        WSL();
#pragma unroll 1
        for (int m = gw; m < M; m += NGW) {
            const u32x2* xr = (const u32x2*)(XH + (size_t)m * DM) + lane; f32x4 v[8]; float ss = 0.f, amx = 0.f;
#pragma unroll
            for (int j = 0; j < 8; ++j) { v[j] = unpk_f16x4(xr[64 * j]); ss += (v[j][0] * v[j][0] + v[j][1] * v[j][1]) + (v[j][2] * v[j][2] + v[j][3] * v[j][3]);
                amx = fmaxf(amx, fmaxf(fmaxf(fabsf(v[j][0]), fabsf(v[j][1])), fmaxf(fabsf(v[j][2]), fabsf(v[j][3])))); }
            ss = wave_sum(ss);
#pragma unroll
            for (int o_ = 1; o_ < 64; o_ <<= 1) amx = fmaxf(amx, __shfl_xor(amx, o_));
            const float inv = amx > 0.f ? 127.f / amx : 0.f; unsigned* xq = (unsigned*)(XQ + (size_t)m * DM) + lane;
#pragma unroll
            for (int j = 0; j < 8; ++j) { const int q0 = (int)__builtin_rintf(v[j][0] * inv), q1 = (int)__builtin_rintf(v[j][1] * inv), q2 = (int)__builtin_rintf(v[j][2] * inv), q3 = (int)__builtin_rintf(v[j][3] * inv);
                xq[64 * j] = (unsigned)(q0 & 255) | ((unsigned)(q1 & 255) << 8) | ((unsigned)(q2 & 255) << 16) | ((unsigned)(q3 & 255) << 24); }
            if (lane == 0) RSTDF[m] = __builtin_amdgcn_rsqf(ss * (1.f / DM) + EPS) * amx * (1.f / 127.f);
        }
        GRID_BAR(15);
    }
    PHASE(16) {
        WSL();
        pg8::PolPlain P{(const char*)XQ  , DM, (const char*)(ws + WS_WIN1)  , DM, DM / 2};
        pg8::StaticOrder S; S.init(M / 256, IN1_PAD / 256, G, bx, 0, WGM_K2048);
        pg8::EpiStore<4, 32> E{Z1, Z1_LD, nullptr, (LAS float*)(lds + RING_BYTES + 12288), 1.f / DM, nullptr, nullptr, nullptr, nullptr, nullptr, FL, RSTDF, ctl + CW_AMAX15};
        pg8::gemm_phase<pg8::EpiStore<4, 32>, pg8::PolPlain, 1>(lds, P, S, E);
        GRID_BAR(16);
    }
    PHASE(17) {
        WSL();
#pragma unroll 1
        for (int b = 0; b < BATCH; ++b) {
            float kmx = 0.f;
#pragma unroll 1
            for (int r = gw; r < SEQ; r += NGW) {
                const u32x4* kp = (const u32x4*)(Z1 + ((size_t)b * SEQ + r) * Z1_LD + 2048 + lane * 32); float ss = 0.f;
#pragma unroll
                for (int q = 0; q < 4; ++q) { const u32x4 w = kp[q];
#pragma unroll
                    for (int e = 0; e < 4; ++e) { const float lo_ = __uint_as_float(w[e] << 16), hi_ = __uint_as_float(w[e] & 0xffff0000u); ss += lo_ * lo_ + hi_ * hi_; } }
                ss += __shfl_xor(ss, 1); ss += __shfl_xor(ss, 2);
                kmx = fmaxf(kmx, ss);
            }
            if ((lane & 3) == 0) atomicMax(ctl + CW_KMAX + 64 * (b * 16 + (lane >> 2)), __float_as_uint(kmx));
        }
        const float* bfv = (const float*)args.in[I_BF];
        LAS double* wtot = (LAS double*)lds;
#pragma unroll 1
        for (int bh = bx; bh < BATCH * 16; bh += G) {
            const int b = bh >> 4, h = bh & 15; const float bias = bfv[h];
            const size_t base = ((size_t)b * SEQ + (size_t)tid * 32) * 16 + h;
            float lf[32]; double run = 0.0;
#pragma unroll
            for (int i = 0; i < 32; ++i) { const float xv = FL[base + (size_t)i * 16] + bias; lf[i] = fminf(xv, 0.f) - log1pf(expf(-fabsf(xv))); }
#pragma unroll
            for (int i = 0; i < 32; ++i) run += (double)lf[i];
            double incl = run;
#pragma unroll
            for (int o = 1; o < 64; o <<= 1) { const double t = __shfl_up(incl, o); if (lane >= o) incl += t; }
            float Aa = 1.f, Bb = 0.f;
#pragma unroll
            for (int i = 0; i < 32; ++i) { const float a_ = __expf(lf[i]); Bb = a_ * Bb + 1.f; Aa *= a_; }
            float Ai = Aa, Bi = Bb;
#pragma unroll
            for (int o = 1; o < 64; o <<= 1) { const float Ap = __shfl_up(Ai, o), Bp = __shfl_up(Bi, o); if (lane >= o) { Bi = Ai * Bp + Bi; Ai = Ai * Ap; } }
            LAS float* wAB = (LAS float*)(lds + 256);
            if (lane == 63) { wtot[wave] = incl; wAB[wave] = Ai; wAB[8 + wave] = Bi; }
            __syncthreads();
            { float Ss = 0.f; for (int w = 0; w < wave; ++w) Ss = wAB[w] * Ss + wAB[8 + w];
              float Ae = __shfl_up(Ai, 1), Be = __shfl_up(Bi, 1); if (lane == 0) { Ae = 1.f; Be = 0.f; }
              const float nk = __expf(lf[0]) * (Ae * Ss + Be);
              if ((tid & 1) == 0) ((float*)ctl)[CW_NEFF + bh * 256 + (tid >> 1)] = nk > 0.f ? log2f(nk) + 0.01f : -100.f; }
            double off = incl - run;
            for (int w = 0; w < wave; ++w) off += wtot[w];
            double cacc = off;
#pragma unroll
            for (int i = 0; i < 32; ++i) { cacc += (double)lf[i]; DEC[base + (size_t)i * 16] = (float)(cacc * 1.4426950408889634); }
            __syncthreads();
        }
        GRID_BAR(17);
    }
    PHASE(18) {
        WSL();
        LAS int* qslot = (LAS int*)(lds + RING_BYTES + 8192);
#pragma unroll 1
        for (;;) {
            if (tid == 0) qslot[0] = (int)__hip_atomic_fetch_add(ctl + CW_Q18, 1u, RLX_AGENT);
            __syncthreads();
            const int u = qslot[0];
            __syncthreads();
            if (u >= BATCH * 16 * 64) break;
            const int qb = 63 - (u >> 5), bh = u & 31, b = bh >> 4, h = bh & 15;
            fa::AttnArgs a; const bf16_t* zb = Z1 + (size_t)b * SEQ * Z1_LD;
            a.Q = zb + h * 128; a.ldq = Z1_LD; a.K = zb + 2048 + h * 128; a.ldk = Z1_LD; a.V = zb + 4096 + h * 128; a.ldv = Z1_LD;
            a.O = O1 + (size_t)b * SEQ * DM + h * 128; a.ldo = DM;
            a.q0 = qb * 256; a.j_lo = 0; a.j_hi = qb * 4 + 4; a.W = 0x3fffffff; a.dec = DEC + (size_t)b * SEQ * 16 + h; a.sinkl = 0.f; a.sinks = nullptr; a.biasT = nullptr;
            a.kmax = sqrtf(__uint_as_float(__hip_atomic_load(ctl + CW_KMAX + 64 * bh, RLX_AGENT))); a.neff = (const float*)ctl + CW_NEFF + bh * 256;
            fa::attn_unit<128, 128, 1>(a, (LAS char*)lds);
        }
        GRID_BAR(18);
    }
    PHASE(19) {
        WSL();
        pg8::PolPlain P{(const char*)O1, DM * 2, (const char*)(ws + WS_WO1), DM * 2, DM};
        pg8::StaticOrder S; S.init(M / 256, DM / 256, G, bx, 0, WGM_K2048);
        pg8::EpiRes<false> E{XH, XH, SSQ};
        pg8::gemm_phase(lds, P, S, E);
        GRID_BAR(19);
    }
    CROSS_PHASES(1, 20)
    PHASE(23) {
        WSL();
        LAS float* WrT = (LAS float*)lds;
        const float* rw = (const float*)args.in[I_RW]; const float* gn = (const float*)args.in[I_NFFN] + DM; const float* rb = (const float*)args.in[I_RB];
        for (int i = tid; i < 8 * DM; i += 512) { const int e = i >> 11, k = i & 2047; WrT[i] = rw[k * 8 + e] * gn[k]; }
        __syncthreads();
#pragma unroll 1
        for (int g16 = gw; g16 < M / 16; g16 += NGW) {
            int e1 = 0, e2 = 0; float g1 = 0.f, g2 = 0.f, rstd = 0.f;
#pragma unroll 1
            for (int i = 0; i < 16; ++i) {
                const int row = g16 * 16 + i;
                const u32x2* xr = (const u32x2*)(XH + (size_t)row * DM) + lane;
                float pe[8], ss = 0.f, amx = 0.f;
#pragma unroll
                for (int e = 0; e < 8; ++e) pe[e] = 0.f;
#pragma unroll 2
                for (int j = 0; j < 8; ++j) { const f32x4 v = unpk_f16x4(xr[64 * j]); ss += (v[0] * v[0] + v[1] * v[1]) + (v[2] * v[2] + v[3] * v[3]);
                    amx = fmaxf(amx, fmaxf(fmaxf(fabsf(v[0]), fabsf(v[1])), fmaxf(fabsf(v[2]), fabsf(v[3]))));
#pragma unroll
                    for (int e = 0; e < 8; ++e) { const f32x4 w = *(const LAS f32x4*)(WrT + e * DM + 256 * j + lane * 4); pe[e] += (v[0] * w[0] + v[1] * w[1]) + (v[2] * w[2] + v[3] * w[3]); } }
                ss = wave_sum(ss);
#pragma unroll
                for (int e = 0; e < 8; ++e) pe[e] = wave_sum(pe[e]);
                const float rs = __builtin_amdgcn_rsqf(ss * (1.f / DM) + EPS);
#pragma unroll
                for (int o_ = 1; o_ < 64; o_ <<= 1) amx = fmaxf(amx, __shfl_xor(amx, o_));
                { const float inv = amx > 0.f ? 127.f / amx : 0.f; unsigned* xq = (unsigned*)(XQ + (size_t)row * DM) + lane;
#pragma unroll 2
                  for (int j = 0; j < 8; ++j) { const f32x4 v = unpk_f16x4(xr[64 * j]);
                      const int q0 = (int)__builtin_rintf(v[0] * inv), q1 = (int)__builtin_rintf(v[1] * inv), q2 = (int)__builtin_rintf(v[2] * inv), q3 = (int)__builtin_rintf(v[3] * inv);
                      xq[64 * j] = (unsigned)(q0 & 255) | ((unsigned)(q1 & 255) << 8) | ((unsigned)(q2 & 255) << 16) | ((unsigned)(q3 & 255) << 24); } }
                const float rowf = rs * amx * (1.f / 127.f);
                float lg[8];
#pragma unroll
                for (int e = 0; e < 8; ++e) lg[e] = pe[e] * rs + rb[e];
                int b1 = 0; float v1 = lg[0];
#pragma unroll
                for (int e = 1; e < 8; ++e) if (lg[e] > v1) { v1 = lg[e]; b1 = e; }
                int b2 = -1; float v2 = -__builtin_inff();
#pragma unroll
                for (int e = 0; e < 8; ++e) if (e != b1 && lg[e] > v2) { v2 = lg[e]; b2 = e; }
                const float ex = __expf(v2 - v1); const float gg2 = ex / (1.f + ex), gg1 = 1.f / (1.f + ex);
                if (lane == i) { e1 = b1; e2 = b2; g1 = gg1; g2 = gg2; rstd = rowf; }
            }
            int s1 = 0, s2 = 0;
#pragma unroll
            for (int e = 0; e < 8; ++e) {
                const unsigned long long m1 = __ballot(lane < 16 && e1 == e), m2 = __ballot(lane < 16 && e2 == e);
                const int c1 = __popcll(m1), c2 = __popcll(m2);
                int basev = 0;
                if (lane == 0 && c1 + c2 > 0) basev = (int)__hip_atomic_fetch_add(ctl + CW_CNT + 64 * e, (unsigned)(c1 + c2), RLX_AGENT);
                basev = __shfl(basev, 0);
                const unsigned long long lt = (1ull << lane) - 1ull;
                if (lane < 16 && e1 == e) s1 = basev + __popcll(m1 & lt);
                if (lane < 16 && e2 == e) s2 = basev + c1 + __popcll(m2 & lt);
            }
            if (lane < 16) { const int row = g16 * 16 + lane; TOPE[row * 2] = e1; TOPE[row * 2 + 1] = e2; TOPS[row * 2] = s1; TOPS[row * 2 + 1] = s2;
                TOPG[row * 2] = g1; TOPG[row * 2 + 1] = g2; RSTDF[row] = rstd; }
        }
        GRID_BAR(23);
    }
    if (hi > 24) {
#define EOFF() int eoff[9]; eoff[0] = 0; _Pragma("unroll") for (int e = 0; e < 8; ++e) { const int c_ = (int)__hip_atomic_load(ctl + CW_CNT + 64 * e, RLX_AGENT); eoff[e + 1] = eoff[e] + ((c_ + 255) & ~255); }
        PHASE(24) {
            WSL();
            EOFF();
            int ecnt[8];
#pragma unroll
            for (int e = 0; e < 8; ++e) ecnt[e] = (int)__hip_atomic_load(ctl + CW_CNT + 64 * e, RLX_AGENT);
            int gt1_ = tid; asm volatile("" : "+v"(gt1_)); gt1_ += bx * 512;
            for (int i = gt1_; i < M * 2; i += G * 512) {
                const int e = TOPE[i], sl = TOPS[i]; int off = 0;
#pragma unroll
                for (int q = 0; q < 8; ++q) if (q == e) off = eoff[q];
                const int pos = off + sl; ROWIDX[pos] = i >> 1; GATEP[pos] = TOPG[i]; RSTDP[pos] = RSTDF[i >> 1]; TOKPOS[i] = pos;
            }
            for (int i = gt1_; i < 8 * 256; i += G * 512) {
                const int e = i >> 8, j = i & 255; int off = 0, cnt = 0, nxt = 0;
#pragma unroll
                for (int q = 0; q < 8; ++q) if (q == e) { off = eoff[q]; cnt = ecnt[q]; nxt = eoff[q + 1]; }
                const int pos = off + cnt + j;
                if (pos < nxt) { ROWIDX[pos] = 0; GATEP[pos] = 0.f; RSTDP[pos] = 0.f; }
            }
            GRID_BAR(24);
        }
        LAS int* TILE_E = (LAS int*)(lds + RING_BYTES + 1024);
        if (hi > 25) {
            EOFF();
            for (int t = tid; t < MOE_MAX_TILES; t += 512) { int e = 0;
#pragma unroll
                for (int q = 1; q < 8; ++q) if (t * 256 >= eoff[q]) e = q;
                TILE_E[t] = e; }
            if (tid == 0) TILE_E[MOE_MAX_TILES] = eoff[8] >> 8;
            __syncthreads();
        }
#pragma unroll 1
        for (int p = 0; p <= MOE_CHUNKS; ++p) {
            PHASE(25 + p) {
                int ndown = 0;
                { WSL();
                const int ntiles = TILE_E[MOE_MAX_TILES], nch = (ntiles + MCH_TILES - 1) / MCH_TILES, t0 = ntiles - MCH_TILES * (nch - 1);
                if (p >= 1 && p - 1 < nch) {
                    const int c = p - 1, ft = c == 0 ? 0 : t0 + (c - 1) * MCH_TILES, nt_ = c == 0 ? t0 : MCH_TILES;
                    pg8::PolMoeDown P{(const char*)HIDB(c)  , 128, (const char*)(ws + WS_WD1)  , 128, DFF / 2, ft, TILE_E, E_D};
                    pg8::StaticOrder S; S.init(nt_, DM / 256, G, bx, ft, WGM_DOWN);
                    pg8::EpiMoeDown E{YB, GATEP};
                    pg8::gemm_phase<pg8::EpiMoeDown, pg8::PolMoeDown, 4>(lds, P, S, E);
                    ndown = nt_ * (DM / 256);
                } }
                int pg = p; asm volatile("" : "+s"(pg), "+s"(ndown));
                { WSL();
                const int ntiles = TILE_E[MOE_MAX_TILES], nch = (ntiles + MCH_TILES - 1) / MCH_TILES, t0 = ntiles - MCH_TILES * (nch - 1);
                if (pg < nch) {
                    const int ft = pg == 0 ? 0 : t0 + (pg - 1) * MCH_TILES, nt_ = pg == 0 ? t0 : MCH_TILES;
                    pg8::PolMoeUp P{(const char*)XQ  , DM, (const char*)(ws + WS_WGU1)  , DM, DM / 2, ROWIDX, TILE_E, E_GU};
                    pg8::StaticOrder S; S.init(nt_, 2 * DFF / 256, G, bx, ft, WGM_GU); S.quota(ndown);
                    pg8::EpiSwiGLU<2> E{HIDB(pg), ft * 256, nullptr, RSTDP, ctl + CW_AMAXW, TILE_E, 1};
                    pg8::gemm_phase<pg8::EpiSwiGLU<2>, pg8::PolMoeUp, 1>(lds, P, S, E);
                } }
                GRID_BAR(25 + p);
            }
        }
    }
    PHASE(43) {
        WSL();
        const float* fn = (const float*)args.in[I_FNORM];
#pragma unroll 1
        for (int m = gw; m < M; m += NGW) {
            const int p0 = TOKPOS[m * 2], p1 = TOKPOS[m * 2 + 1];
            const u32x2* xr = (const u32x2*)(XH + (size_t)m * DM) + lane; f32x4* orow = (f32x4*)(args.out + (size_t)m * DM) + lane;
            const u32x2* y0 = (const u32x2*)(YB + (size_t)p0 * DM) + lane; const u32x2* y1 = (const u32x2*)(YB + (size_t)p1 * DM) + lane;
            f32x4 v[8]; float s = 0.f;
#pragma unroll
            for (int j = 0; j < 8; ++j) { v[j] = unpk_f16x4(xr[64 * j]); const u32x2 a0 = y0[64 * j], a1 = y1[64 * j];
                v[j][0] += __uint_as_float(a0.x << 16) + __uint_as_float(a1.x << 16); v[j][1] += __uint_as_float(a0.x & 0xffff0000u) + __uint_as_float(a1.x & 0xffff0000u);
                v[j][2] += __uint_as_float(a0.y << 16) + __uint_as_float(a1.y << 16); v[j][3] += __uint_as_float(a0.y & 0xffff0000u) + __uint_as_float(a1.y & 0xffff0000u);
                s += (v[j][0] * v[j][0] + v[j][1] * v[j][1]) + (v[j][2] * v[j][2] + v[j][3] * v[j][3]); }
            s = wave_sum(s); const float rs = __builtin_amdgcn_rsqf(s * (1.f / DM) + EPS);
#pragma unroll
            for (int j = 0; j < 8; ++j) { const f32x4 g = *((const f32x4*)fn + lane + 64 * j); orow[64 * j] = v[j] * rs * g; }
        }
    }
#undef IN
#undef GRID_BAR
}

constexpr int N_STEPS = 47;
extern "C" void kernel_launch(void* const* d_in, const int* in_sizes, int n_in, void* d_out, int out_size, void* d_ws, size_t ws_size, hipStream_t stream) {
    static int grid = 0;
    if (grid == 0) {
        if (n_in != N_IN || in_sizes[0] != M * DM || out_size != M * DM || ws_size < WS_END) {
            fprintf(stderr, "kernel_launch: shape / workspace mismatch (n_in %d, in0 %d, out %d, ws %zu, need %zu); nothing launched\n", n_in, n_in > 0 ? in_sizes[0] : -1, out_size, ws_size, (size_t)WS_END); grid = -1; return; }
        int dev = 0, cus = 0, per_cu = 0;
        if (hipGetDevice(&dev) != hipSuccess || hipDeviceGetAttribute(&cus, hipDeviceAttributeMultiprocessorCount, dev) != hipSuccess) { grid = -1; return; }
        if (hipFuncSetAttribute((const void*)trunk_fwd, hipFuncAttributeMaxDynamicSharedMemorySize, LDS_BYTES) != hipSuccess) { fprintf(stderr, "kernel_launch: hipFuncSetAttribute failed\n"); grid = -1; return; }
        if (hipOccupancyMaxActiveBlocksPerMultiprocessor(&per_cu, (const void*)trunk_fwd, NWAVES * 64, LDS_BYTES) != hipSuccess || per_cu < 1)
            fprintf(stderr, "kernel_launch: note: occupancy query reports %d workgroups per CU\n", per_cu);
        (void)hipGetLastError();
        grid = cus;
    }
    if (grid < 0) return;
    if (hipMemsetAsync((char*)d_ws + WS_CTL, 0, CTL_BYTES, stream) != hipSuccess) return;
    Args a{};
    for (int i = 0; i < N_IN; ++i) a.in[i] = d_in[i];
    a.out = (float*)d_out; a.ws = (unsigned char*)d_ws;
#if MK_ONE_LAUNCH
    a.ph_lo = 0; a.ph_hi = N_STEPS;
    hipLaunchKernelGGL(trunk_fwd, dim3(grid), dim3(NWAVES * 64), LDS_BYTES, stream, a);
#else
    for (int i = 0; i < N_STEPS; ++i) { const int s = i == 0 ? 0 : (i == 1 ? 44 : (i <= 8 ? i - 1 : (i == 9 ? 45 : (i <= 14 ? i - 2 : (i == 15 ? 46 : i - 3))))); a.ph_lo = s; a.ph_hi = s + 1; hipLaunchKernelGGL(trunk_fwd, dim3(grid), dim3(NWAVES * 64), LDS_BYTES, stream, a); }
#endif
}
```

```cpp
#include <hip/hip_runtime.h>
#include <hip/hip_bf16.h>
#include <cstdio>
#include <cstdint>
#include <cmath>

#ifndef MK_ONE_LAUNCH
#define MK_ONE_LAUNCH 1
#endif

#define GAS __attribute__((address_space(1)))
#define LAS __attribute__((address_space(3)))
typedef unsigned short bf16_t;
typedef short bf16x8 __attribute__((ext_vector_type(8)));
typedef short s16x4 __attribute__((ext_vector_type(4)));
typedef float f32x2 __attribute__((ext_vector_type(2)));
typedef float f32x4 __attribute__((ext_vector_type(4)));
typedef float f32x16 __attribute__((ext_vector_type(16)));
typedef unsigned u32x2 __attribute__((ext_vector_type(2)));
typedef unsigned u32x4 __attribute__((ext_vector_type(4)));
typedef int i32x4 __attribute__((ext_vector_type(4)));
typedef long i64x2 __attribute__((ext_vector_type(2)));

constexpr int BATCH = 2, SEQ = 16384, DM = 2048, M = BATCH * SEQ, MEMLEN = 256, MROWS = BATCH * MEMLEN;
constexpr int EVEN_IN = 2624, Z0_LD = 2816, ODD_IN = 6160, Z1_LD = 6144, IN1_PAD = 6400;
constexpr int DFF = 7168, NEXP = 8;
constexpr int HLD = DFF + 64;
constexpr int QM_LD = 1536, KM_LD = 1536, VM_LD = 1024;
constexpr float LOG2E = 1.4426950408889634f;
constexpr float C2_MLA = LOG2E * 0.07216878364870323f;
constexpr float C2_SWA = LOG2E * 0.125f;
constexpr float C2_128 = LOG2E * 0.08838834764831845f;
constexpr float EPS = 1e-6f;
constexpr int CHUNK_ROWS = 8192, CHUNK_TILES = 32, MOE_MAX_TILES = 264, MOE_MAX_ROWS = MOE_MAX_TILES * 256;
constexpr int MCH_TILES = 64, MCH_ROWS = MCH_TILES * 256, MOE_CHUNKS = (MOE_MAX_TILES + MCH_TILES - 1) / MCH_TILES;

enum { I_X = 0, I_MEM, I_POS, I_RELB, I_NMIX, I_NCROSS, I_NMEM, I_NFFN, I_XWQ, I_XWK, I_XWV, I_XWO, I_EVWIN, I_QNORM, I_WUQ, I_KVNORM, I_WUKV, I_SINKS, I_EVWO,
       I_FG, I_FU, I_FD, I_ODWIN, I_BF, I_ODWO, I_RW, I_RB, I_MG, I_MU, I_MD, I_FNORM, N_IN };

constexpr size_t al256(size_t x) { return (x + 255) & ~(size_t)255; }
constexpr size_t WS_CTL = 0, CTL_BYTES = 1u << 20;
constexpr size_t E_IN0 = (size_t)Z0_LD * DM, E_UQ = (size_t)1536 * 768, E_UKV = (size_t)2048 * 512, E_SQ = (size_t)DM * DM, E_XQ = (size_t)512 * DM, E_XKV = (size_t)2048 * DM,
                 E_XO = (size_t)DM * 512, E_GU = (size_t)2 * DFF * DM, E_D = (size_t)DM * DFF, E_IN1 = (size_t)IN1_PAD * DM;
constexpr size_t WS_WIN0 = WS_CTL + CTL_BYTES;
constexpr size_t WS_WUQ = WS_WIN0 + 2 * E_IN0;
constexpr size_t WS_WUKV = WS_WUQ + 2 * E_UQ;
constexpr size_t WS_WO0 = WS_WUKV + 2 * E_UKV;
constexpr size_t WS_WXQ = WS_WO0 + 2 * E_SQ;
constexpr size_t WS_WXKV = WS_WXQ + 2 * 2 * E_XQ;
constexpr size_t WS_WXO = WS_WXKV + 2 * E_XKV;
constexpr size_t WS_WGU0 = WS_WXO + 2 * 2 * E_XO;
constexpr size_t WS_WD0 = WS_WGU0 + 2 * E_GU;
constexpr size_t WS_WIN1 = WS_WD0 + 2 * E_D;
constexpr size_t WS_WO1 = WS_WIN1 + 2 * E_IN1;
constexpr size_t WS_WGU1 = WS_WO1 + 2 * E_SQ;
constexpr size_t WS_WD1 = WS_WGU1 + 2 * 8 * E_GU;
constexpr size_t WS_XB = WS_WD1 + 2 * 8 * E_D;
constexpr size_t WS_SSQ = WS_XB + (size_t)M * DM * 2;
constexpr size_t WS_ROPE = WS_SSQ + (size_t)M * 32 * 4;
constexpr size_t WS_MEMN = WS_ROPE + (size_t)M * 64 * 4;
constexpr size_t WS_SSQM = WS_MEMN + (size_t)MROWS * DM * 2;
constexpr size_t WS_MEMKV = WS_SSQM + (size_t)MROWS * 32 * 4;
constexpr size_t WS_SSQQ = WS_MEMKV + (size_t)MROWS * 2048 * 2;
constexpr size_t WS_SSQKV = WS_SSQQ + (size_t)M * 12 * 4;
constexpr size_t WS_QX = WS_SSQKV + (size_t)M * 8 * 4;
constexpr size_t WS_OX = WS_QX + (size_t)M * 512 * 2;
constexpr size_t WS_FL = WS_OX + (size_t)M * 512 * 2;
constexpr size_t WS_DEC = WS_FL + (size_t)M * 16 * 4;
constexpr size_t WS_TOPE = WS_DEC + (size_t)M * 16 * 4;
constexpr size_t WS_TOPS = WS_TOPE + (size_t)M * 2 * 4;
constexpr size_t WS_TOPG = WS_TOPS + (size_t)M * 2 * 4;
constexpr size_t WS_RSTDF = WS_TOPG + (size_t)M * 2 * 4;
constexpr size_t WS_TOKPOS = WS_RSTDF + (size_t)M * 4;
constexpr size_t WS_ROWIDX = WS_TOKPOS + (size_t)M * 2 * 4;
constexpr size_t WS_GATEP = WS_ROWIDX + (size_t)MOE_MAX_ROWS * 4;
constexpr size_t WS_RSTDP = WS_GATEP + (size_t)MOE_MAX_ROWS * 4;
constexpr size_t WS_BIAST = WS_RSTDP + (size_t)MOE_MAX_ROWS * 4;
constexpr size_t WS_ARENA = al256(WS_BIAST + 16 * 128 * 4);
constexpr size_t AR_Z0 = 0;
constexpr size_t AR_QM = AR_Z0 + (size_t)M * Z0_LD * 2;
constexpr size_t AR_KM = AR_QM + (size_t)M * QM_LD * 2;
constexpr size_t AR_VM = AR_KM + (size_t)M * KM_LD * 2;
constexpr size_t AR_O0 = AR_VM + (size_t)M * VM_LD * 2;
constexpr size_t AR_END0 = AR_O0 + (size_t)M * DM * 2;
constexpr size_t AR_HID = 0;
constexpr size_t HID_BYTES = (size_t)CHUNK_ROWS * DFF * 2;
constexpr size_t AR_Y = AR_HID + 2 * HID_BYTES;
constexpr size_t AR_END2 = AR_Y + (size_t)MOE_MAX_ROWS * DM * 2;
constexpr size_t AR_Z1 = 0;
constexpr size_t AR_O1 = AR_Z1 + (size_t)M * Z1_LD * 2;
constexpr size_t AR_END1 = AR_O1 + (size_t)M * DM * 2;
constexpr size_t AR_SIZE = AR_END0 > AR_END1 ? (AR_END0 > AR_END2 ? AR_END0 : AR_END2) : (AR_END1 > AR_END2 ? AR_END1 : AR_END2);
constexpr size_t WS_END = WS_ARENA + AR_SIZE;

constexpr int CW_BAR = 4096;
constexpr int CW_CNT = 16384;
constexpr int CW_KMAX = 20480;
constexpr int CW_Q18 = 24576;
constexpr int CW_AMAX15 = 32768;
constexpr int CW_AMAX0 = 40960;
constexpr int CW_NEFF = 65536;
constexpr int CW_AMAXW = 131072;
static_assert((CW_AMAXW + 9 * 14336) * 4 <= (int)CTL_BYTES, "CTL map");

constexpr int RING_BYTES = 131072;
constexpr int MISC_OFF = RING_BYTES + 320;
constexpr int LDS_BYTES = 147456;
constexpr int NWAVES = 8;
#ifndef WGM_GU
#define WGM_GU 4
#endif
#ifndef WGM_K2048
#define WGM_K2048 4
#endif
#ifndef WGM_DOWN
#define WGM_DOWN 8
#endif

#define LDS_WAIT() asm volatile("s_waitcnt lgkmcnt(0)" ::: "memory")
#define VM_WAIT() asm volatile("s_waitcnt vmcnt(0)" ::: "memory")
#define RLX_AGENT __ATOMIC_RELAXED, __HIP_MEMORY_SCOPE_AGENT
__device__ __forceinline__ unsigned cvt_pk_bf16(float lo, float hi) { unsigned r; asm volatile("v_cvt_pk_bf16_f32 %0, %1, %2" : "=v"(r) : "v"(lo), "v"(hi)); return r; }
typedef _Float16 h16x2 __attribute__((ext_vector_type(2)));
typedef _Float16 h16x8 __attribute__((ext_vector_type(8)));
__device__ __forceinline__ unsigned pk_f16(float lo, float hi) { const h16x2 v = {(_Float16)lo, (_Float16)hi}; return __builtin_bit_cast(unsigned, v); }
__device__ __forceinline__ f32x2 unpk_f16(unsigned u) { const h16x2 v = __builtin_bit_cast(h16x2, u); return (f32x2){(float)v.x, (float)v.y}; }
__device__ __forceinline__ f32x4 unpk_f16x4(u32x2 u) { const f32x2 a = unpk_f16(u.x), b = unpk_f16(u.y); return (f32x4){a.x, a.y, b.x, b.y}; }
__device__ __forceinline__ u32x2 pack8_fp8(f32x4 a, f32x4 b) {
    int lo = 0, hi = 0;
    lo = __builtin_amdgcn_cvt_pk_fp8_f32(a[0], a[1], lo, false); lo = __builtin_amdgcn_cvt_pk_fp8_f32(a[2], a[3], lo, true);
    hi = __builtin_amdgcn_cvt_pk_fp8_f32(b[0], b[1], hi, false); hi = __builtin_amdgcn_cvt_pk_fp8_f32(b[2], b[3], hi, true);
    return (u32x2){(unsigned)lo, (unsigned)hi};
}
__device__ __forceinline__ float bf2f(unsigned short b) { return __uint_as_float((unsigned)b << 16); }
__device__ __forceinline__ float wave_sum(float v) {
#pragma unroll
    for (int o = 1; o < 64; o <<= 1) v += __shfl_xor(v, o);
    return v;
}

#define XB_TMO      128
#define XB_XCNT(j)  (256  + 64 * (j))
#define XB_XSUB(j)  (1280 + 64 * (j))
#define XB_XGEN(j)  (2304 + 64 * (j))
#define XB_TOP      3328
#define XB_TOPGEN   3392
#define XCD_BAR_WORDS 3456
#define XB_SPIN_CAP (1u << 18)
__device__ __forceinline__ unsigned xb_ld(unsigned* p)              { return __hip_atomic_load(p, __ATOMIC_RELAXED, __HIP_MEMORY_SCOPE_AGENT); }
__device__ __forceinline__ unsigned xb_add(unsigned* p, unsigned v) { return __hip_atomic_fetch_add(p, v, __ATOMIC_RELAXED, __HIP_MEMORY_SCOPE_AGENT); }
__device__ __forceinline__ unsigned xb_xcc_id() { return (unsigned)__builtin_amdgcn_s_getreg((3 << 11) | 20) & 0xFu; }
#define XB_SPIN(cond, bar) do { unsigned _sp = 0; while (cond) { __builtin_amdgcn_s_sleep(1); \
    if ((++_sp & 255u) == 0u) { if (xb_ld(&(bar)[XB_TMO])) break; if (_sp > XB_SPIN_CAP) { atomicAdd(&(bar)[XB_TMO], 1u); break; } } } } while (0)
struct XcdBarrier { unsigned* bar; unsigned x; volatile LAS unsigned* st; };
__device__ __forceinline__ XcdBarrier xcd_barrier_post(unsigned* bar, volatile LAS unsigned* st) {
    XcdBarrier b; b.bar = bar; b.x = xb_xcc_id(); b.st = st;
    if (threadIdx.x == 0) (void)xb_add(&bar[XB_XCNT(b.x)], 1u);
    return b;
}
__device__ __forceinline__ void xcd_barrier_complete(unsigned* bar, unsigned x, unsigned& nloc, unsigned& nx) {
    const unsigned G = gridDim.x * gridDim.y * gridDim.z;
    unsigned sum, cnt, mine, sp = 0u;
    for (;;) {
        sum = 0u; cnt = 0u; mine = 0u;
#pragma unroll
        for (unsigned j = 0; j < 16; ++j) { const unsigned c = xb_ld(&bar[XB_XCNT(j)]); sum += c; cnt += (c > 0u) ? 1u : 0u; mine = (j == x) ? c : mine; }
        if (sum == G) break;
        __builtin_amdgcn_s_sleep(1);
        if ((++sp & 255u) == 0u) { if (xb_ld(&bar[XB_TMO])) break; if (sp > XB_SPIN_CAP) { atomicAdd(&bar[XB_TMO], 1u); break; } }
    }
    nloc = mine > 0u ? mine : 1u; nx = cnt > 0u ? cnt : 1u;
}
__device__ __forceinline__ void xcd_barrier(const XcdBarrier& b) {
    asm volatile("s_waitcnt vmcnt(0)" ::: "memory");
    __syncthreads();
    if (threadIdx.x == 0) {
        unsigned* bar = b.bar;
        __builtin_amdgcn_s_waitcnt(0);
        unsigned nloc = b.st[0], nx = b.st[1];
        if (nloc == 0u) { xcd_barrier_complete(bar, b.x, nloc, nx); b.st[0] = nloc; b.st[1] = nx; }
        const unsigned old = xb_add(&bar[XB_XSUB(b.x)], 1u);
        const unsigned gen = old / nloc;
        if (old + 1u == (gen + 1u) * nloc) {
            __builtin_amdgcn_fence(__ATOMIC_RELEASE, "agent");
            asm volatile("s_waitcnt vmcnt(0)" ::: "memory");
            const unsigned og = xb_add(&bar[XB_TOP], 1u);
            const unsigned tg = og / nx;
            if (og + 1u == (tg + 1u) * nx) xb_add(&bar[XB_TOPGEN], 1u);
            else XB_SPIN(xb_ld(&bar[XB_TOPGEN]) == tg, bar);
            __builtin_amdgcn_fence(__ATOMIC_ACQUIRE, "agent");
            xb_add(&bar[XB_XGEN(b.x)], 1u);
            asm volatile("s_waitcnt vmcnt(0)" ::: "memory");
        } else {
            XB_SPIN(xb_ld(&bar[XB_XGEN(b.x)]) == gen, bar);
            __builtin_amdgcn_fence(__ATOMIC_ACQUIRE, "agent");
            asm volatile("s_waitcnt vmcnt(0)" ::: "memory");
        }
    }
    __syncthreads();
}

namespace pg8 {
constexpr int BM = 256, BK = 64, HALF = 128, HTB = HALF * BK * 2, STAGE_BYTES = 8 * HTB, NXCD = 8, WGM = 8;
__host__ __device__ __forceinline__ int lds_byte(int r, int c) { const int st = (r >> 4) * 2 + (c >> 5), rr = r & 15, cc = c & 31, ob = rr * 64 + cc * 2; return st * 1024 + (ob ^ (((ob >> 9) & 1) << 5)); }
__host__ __device__ __forceinline__ void stage_rc(int b, int& R, int& C) { const int st = b / 1024, sb = b % 1024, swz = sb ^ (((sb >> 9) & 1) << 5); R = (st >> 1) * 16 + swz / 64; C = (st & 1) * 32 + (swz % 64) / 2; }
__host__ __device__ __forceinline__ int perm32(int rho) { const int n = rho >> 4, i = rho & 15; return 8 * (i >> 2) + 4 * n + (i & 3); }
struct Unit { int pm, pn; };
struct StaticOrder {
    int nM, nN, nwg, G, c, pm0, nd, qd, wgm;
    __device__ __forceinline__ void init(int nM_, int nN_, int G_, int c_, int pm0_, int wgm_ = WGM) { nM = nM_; nN = nN_; nwg = nM * nN; G = G_; c = c_; pm0 = pm0_; nd = 0; qd = 0; wgm = wgm_; }
    __device__ __forceinline__ void quota(int nd_) { nd = nd_ < G ? nd_ : 0; if (nd_ >= G) return; const int q = (nwg + 5 * nd + G - 1) / G; qd = q > 5 ? q - 5 : 0; }
    __device__ __forceinline__ bool next(int i, Unit& u) const {
        long L;
        if (nd == 0) L = (long)i * G + c;
        else if (c < nd) { if (i >= qd) return false; L = (long)i * G + c; }
        else L = i < qd ? (long)i * G + c : (long)qd * G + (long)(i - qd) * (G - nd) + (c - nd);
        if (L >= nwg) return false;
        int wgid = (int)L; { const int q = nwg / NXCD, r = nwg % NXCD, xcd = wgid % NXCD, off = wgid / NXCD; wgid = (xcd < r ? xcd * (q + 1) : r * (q + 1) + (xcd - r) * q) + off; }
        const int nig = wgm * nN, gid = wgid / nig, fm = gid * wgm, gsz = (nM - fm) < wgm ? (nM - fm) : wgm;
        u.pm = pm0 + fm + ((wgid % nig) % gsz); u.pn = (wgid % nig) / gsz; return true;
    }
};
struct PolPlain {
    const char* A; unsigned lda2; const char* B; unsigned ldb2; int K;
    __device__ __forceinline__ size_t kstepA() const { return 128; }
    __device__ __forceinline__ size_t kstepB() const { return 128; }
    __device__ __forceinline__ unsigned a_off(const Unit& u, int h, int R, int C) const { return (unsigned)(u.pm * BM + h * HALF + R) * lda2 + (unsigned)C * 2u; }
    __device__ __forceinline__ const char* b_ptr(const Unit& u) const { return B + (size_t)u.pn * BM * ldb2; }
};
struct PolMoeUp {
    const char* A; unsigned lda2; const char* B; unsigned ldb2; int K; const int* rowidx; const LAS int* tile_e; size_t estride;
    __device__ __forceinline__ size_t kstepA() const { return 128; }
    __device__ __forceinline__ size_t kstepB() const { return 128; }
    __device__ __forceinline__ unsigned a_off(const Unit& u, int h, int R, int C) const { return (unsigned)rowidx[u.pm * BM + h * HALF + R] * lda2 + (unsigned)C * 2u; }
    __device__ __forceinline__ const char* b_ptr(const Unit& u) const { return B + (size_t)tile_e[u.pm] * estride + (size_t)u.pn * BM * ldb2; }
};
struct PolMoeDown {
    const char* A; unsigned lda2; const char* B; unsigned ldb2; int K; int pmc0; const LAS int* tile_e; size_t estride;
    __device__ __forceinline__ size_t kstepA() const { return (size_t)MCH_ROWS * 128; }
    __device__ __forceinline__ size_t kstepB() const { return (size_t)DM * 128; }
    __device__ __forceinline__ unsigned a_off(const Unit& u, int h, int R, int C) const { return (unsigned)((u.pm - pmc0) * BM + h * HALF + R) * 128u + (unsigned)C * 2u; }
    __device__ __forceinline__ const char* b_ptr(const Unit& u) const { return B + (size_t)tile_e[u.pm] * estride + (size_t)u.pn * BM * 128; }
};
struct PolChunkA {
    const char* A; unsigned lda2; const char* B; unsigned ldb2; int K; int pmc0;
    __device__ __forceinline__ size_t kstepA() const { return (size_t)CHUNK_ROWS * 128; }
    __device__ __forceinline__ size_t kstepB() const { return (size_t)DM * 128; }
    __device__ __forceinline__ unsigned a_off(const Unit& u, int h, int R, int C) const { return (unsigned)((u.pm - pmc0) * BM + h * HALF + R) * 128u + (unsigned)C * 2u; }
    __device__ __forceinline__ const char* b_ptr(const Unit& u) const { return B + (size_t)u.pn * BM * 128; }
};

template <int I8> struct AccT { typedef f32x4 type; };
template <> struct AccT<1> { typedef i32x4 type; };
template <class Epi, class Pol, int I8 = 0>
__device__ __forceinline__ void gemm_phase(LAS unsigned char* lds, const Pol& P, const StaticOrder& S, const Epi& E) {
    typedef typename AccT<I8>::type acc_t;
    int tid_ = threadIdx.x; asm volatile("" : "+v"(tid_));
    const int tid = tid_, wid = __builtin_amdgcn_readfirstlane(tid >> 6), lane = tid & 63, wr = wid >> 2, wc = wid & 3, fr = lane & 15, fq = lane >> 4;
    const int K = P.K, nt = K / BK;
    int sR[2], sC[2]; unsigned voffB[2];
#pragma unroll
    for (int i = 0; i < 2; ++i) { int R, C; stage_rc(tid * 16 + i * 8192, R, C); sR[i] = R; sC[i] = C; const int Rb = (R & ~31) + perm32(R & 31); voffB[i] = (unsigned)Rb * P.ldb2 + (unsigned)C * 2u; }
    const size_t kstepA = P.kstepA(), kstepB = P.kstepB();
    const size_t hstepB = (size_t)HALF * P.ldb2;
    const unsigned ldsw = (unsigned)wid * 1024u;
    const int aoff = lds_byte(wr * 64 + fr, fq * 8), boff = lds_byte(wc * 32 + fr, fq * 8);
#define PG8_SA(b, h) (((b) * 2 + (h)) * HTB)
#define PG8_SB(b, h) ((4 + (b) * 2 + (h)) * HTB)
#define PG8_STAGE(bufoff, gbase, voff) do { _Pragma("unroll") for (int _i = 0; _i < 2; ++_i) \
        __builtin_amdgcn_global_load_lds((const unsigned*)((const char*)(gbase) + (voff)[_i]), (LAS unsigned*)(lds + (bufoff) + ldsw + _i * 8192), 16, 0, 0); } while (0)
#define PG8_LDA(dst, b, h) do { _Pragma("unroll") for (int m = 0; m < 4; ++m) _Pragma("unroll") for (int k = 0; k < 2; ++k) dst[m][k] = *(const LAS bf16x8*)(lds + PG8_SA(b, h) + aoff + m * 2048 + k * 1024); } while (0)
#define PG8_LDB(dst, b, h) do { _Pragma("unroll") for (int n = 0; n < 2; ++n) _Pragma("unroll") for (int k = 0; k < 2; ++k) dst[n][k] = *(const LAS bf16x8*)(lds + PG8_SB(b, h) + boff + n * 2048 + k * 1024); } while (0)
#define PG8_MMA(ai, bj, At, Bt) do { __builtin_amdgcn_s_setprio(1); _Pragma("unroll") for (int m = 0; m < 4; ++m) _Pragma("unroll") for (int n = 0; n < 2; ++n) _Pragma("unroll") for (int k = 0; k < 2; ++k) \
        { if constexpr (I8 == 1) acc[ai][bj][m][n] = __builtin_amdgcn_mfma_i32_16x16x64_i8(__builtin_bit_cast(i32x4, Bt[n][k]), __builtin_bit_cast(i32x4, At[m][k]), acc[ai][bj][m][n], 0, 0, 0); \
          else if constexpr (I8 == 4) { const i64x2 b_ = __builtin_bit_cast(i64x2, Bt[n][k]), a_ = __builtin_bit_cast(i64x2, At[m][k]); \
              acc[ai][bj][m][n] = __builtin_amdgcn_mfma_f32_16x16x32_fp8_fp8(b_[0], a_[0], acc[ai][bj][m][n], 0, 0, 0); acc[ai][bj][m][n] = __builtin_amdgcn_mfma_f32_16x16x32_fp8_fp8(b_[1], a_[1], acc[ai][bj][m][n], 0, 0, 0); } \
          else if constexpr (I8 == 3) acc[ai][bj][m][n] = __builtin_amdgcn_mfma_f32_16x16x32_f16(__builtin_bit_cast(h16x8, Bt[n][k]), __builtin_bit_cast(h16x8, At[m][k]), acc[ai][bj][m][n], 0, 0, 0); \
          else acc[ai][bj][m][n] = __builtin_amdgcn_mfma_f32_16x16x32_bf16(Bt[n][k], At[m][k], acc[ai][bj][m][n], 0, 0, 0); } __builtin_amdgcn_s_setprio(0); } while (0)
#define PG8_WAIT_V(n) asm volatile("s_waitcnt vmcnt(" #n ")" ::: "memory")
#define PG8_WAIT_L(n) asm volatile("s_waitcnt lgkmcnt(" #n ")" ::: "memory")
#define PG8_BAR __builtin_amdgcn_s_barrier()
#define PG8_SCHED __builtin_amdgcn_sched_barrier(0)
    Unit cur, nxt; int ui = 0;
    if (!S.next(0, cur)) return;
    LAS unsigned char* sl_ = lds + RING_BYTES + 4096;
#define PG8_SCALES(u_, slot) do { if constexpr (Epi::LDS_SCALES) { \
        if (wid == 0) __builtin_amdgcn_global_load_lds((const unsigned*)(E.row_src(u_)) + lane * 4, (LAS unsigned*)(sl_ + (slot) * 2048), 16, 0, 0); \
        else if (wid == 1) __builtin_amdgcn_global_load_lds((const unsigned*)(E.col_src(u_)) + lane * 4, (LAS unsigned*)(sl_ + (slot) * 2048 + 1024), 16, 0, 0); } } while (0)
    PG8_SCALES(cur, 0);
    acc_t acc[2][2][4][2];
#pragma unroll
    for (int a = 0; a < 2; ++a)
#pragma unroll
        for (int b = 0; b < 2; ++b)
#pragma unroll
            for (int m = 0; m < 4; ++m)
#pragma unroll
                for (int n = 0; n < 2; ++n) acc[a][b][m][n] = acc_t{};
    bf16x8 At[4][2], B0[2][2], B1[2][2];
    unsigned vC0[2], vC1[2], vN0[2], vN1[2];
#pragma unroll
    for (int i = 0; i < 2; ++i) { vC0[i] = P.a_off(cur, 0, sR[i], sC[i]); vC1[i] = P.a_off(cur, 1, sR[i], sC[i]); }
    const char* Ab = P.A; const char* cB = P.b_ptr(cur);
    PG8_STAGE(PG8_SB(0, 0), cB, voffB); PG8_STAGE(PG8_SB(0, 1), cB + hstepB, voffB); PG8_STAGE(PG8_SA(0, 0), Ab, vC0); PG8_STAGE(PG8_SA(0, 1), Ab, vC1);
    if (wr == 1) PG8_BAR;
    PG8_WAIT_V(2); PG8_BAR;
    PG8_STAGE(PG8_SB(1, 0), cB + kstepB, voffB); PG8_STAGE(PG8_SA(1, 0), Ab + kstepA, vC0); PG8_STAGE(PG8_SB(1, 1), cB + hstepB + kstepB, voffB);
    PG8_WAIT_V(6); PG8_BAR;
    for (;;) {
        const bool has_next = S.next(ui + 1, nxt);
        const char* nB = cB;
#pragma unroll
        for (int i = 0; i < 2; ++i) { vN0[i] = vC0[i]; vN1[i] = vC1[i]; }
        if (has_next) { nB = P.b_ptr(nxt);
#pragma unroll
            for (int i = 0; i < 2; ++i) { vN0[i] = P.a_off(nxt, 0, sR[i], sC[i]); vN1[i] = P.a_off(nxt, 1, sR[i], sC[i]); } }
        int tsc_ = 4; asm volatile("" : "+s"(tsc_));
#pragma unroll 1
        for (int t = 0; t < nt; t += 2) {
            const bool last = (t == nt - 2);
            if (t == tsc_ && has_next) PG8_SCALES(nxt, (ui + 1) & 1);
            const char* a1 = Ab + (size_t)(t + 1) * kstepA;
            const char* a2 = last ? Ab : Ab + (size_t)(t + 2) * kstepA; const char* b2 = last ? nB : cB + (size_t)(t + 2) * kstepB;
            const char* a3 = a2 + kstepA; const char* b3 = b2 + kstepB;
            unsigned v20[2], v21[2];
#pragma unroll
            for (int i = 0; i < 2; ++i) { v20[i] = last ? vN0[i] : vC0[i]; v21[i] = last ? vN1[i] : vC1[i]; }
            PG8_LDB(B0, 0, 0); PG8_LDB(B1, 0, 1); PG8_SCHED; PG8_LDA(At, 0, 0); PG8_STAGE(PG8_SA(1, 1), a1, vC1);
            PG8_WAIT_V(8); PG8_WAIT_L(0); PG8_BAR; PG8_MMA(0, 0, At, B0); PG8_MMA(0, 1, At, B1); PG8_BAR; PG8_SCHED;
            PG8_LDA(At, 0, 1); PG8_STAGE(PG8_SB(0, 0), b2, voffB); PG8_STAGE(PG8_SB(0, 1), b2 + hstepB, voffB); PG8_STAGE(PG8_SA(0, 0), a2, v20);
            PG8_WAIT_V(8); PG8_WAIT_L(0); PG8_BAR; PG8_MMA(1, 0, At, B0); PG8_MMA(1, 1, At, B1); PG8_BAR; PG8_SCHED;
            PG8_LDB(B0, 1, 0); PG8_LDB(B1, 1, 1); PG8_SCHED; PG8_LDA(At, 1, 0); PG8_STAGE(PG8_SA(0, 1), a2, v21);
            PG8_WAIT_V(8); PG8_WAIT_L(0); PG8_BAR; PG8_MMA(0, 0, At, B0); PG8_MMA(0, 1, At, B1); PG8_BAR; PG8_SCHED;
            PG8_LDA(At, 1, 1); PG8_STAGE(PG8_SB(1, 0), b3, voffB); PG8_STAGE(PG8_SB(1, 1), b3 + hstepB, voffB); PG8_STAGE(PG8_SA(1, 0), a3, v20);
            PG8_WAIT_V(8); PG8_WAIT_L(0); PG8_BAR; PG8_MMA(1, 0, At, B0); PG8_MMA(1, 1, At, B1); PG8_BAR; PG8_SCHED;
        }
        if (wr == 0) PG8_BAR;
        E(acc, cur, wr, wc, fr, fq, (const LAS unsigned char*)(sl_ + (ui & 1) * 2048));
        if (!has_next) break;
#pragma unroll
        for (int a = 0; a < 2; ++a)
#pragma unroll
            for (int b = 0; b < 2; ++b)
#pragma unroll
                for (int m = 0; m < 4; ++m)
#pragma unroll
                    for (int n = 0; n < 2; ++n) acc[a][b][m][n] = acc_t{};
        cur = nxt; cB = nB; ++ui;
#pragma unroll
        for (int i = 0; i < 2; ++i) { vC0[i] = vN0[i]; vC1[i] = vN1[i]; }
        if (wr == 1) PG8_BAR;
    }
    PG8_WAIT_V(0);
    PG8_BAR;
#undef PG8_SA
#undef PG8_SB
#undef PG8_STAGE
#undef PG8_SCALES
#undef PG8_LDA
#undef PG8_LDB
#undef PG8_MMA
#undef PG8_WAIT_V
#undef PG8_WAIT_L
#undef PG8_BAR
#undef PG8_SCHED
}

__device__ __forceinline__ float row_rstd(const float* ssq, int row, int nparts, float inv_n) {
    const f32x4* p = (const f32x4*)(ssq + (size_t)row * nparts); f32x4 s = p[0];
    for (int i = 1; i < nparts / 4; ++i) s += p[i];
    return __builtin_amdgcn_rsqf(((s[0] + s[1]) + (s[2] + s[3])) * inv_n + EPS);
}
template <int NP>
__device__ __forceinline__ void wave_row_rstd(const float* ssq, float inv_n, int rowbase, int wr, int wid, int fr, LAS float* xl, float (&rs)[8]) {
    const int lane = threadIdx.x & 63; LAS float* wl = xl + wid * 128;
    f32x4 sa = (f32x4){0.f, 0.f, 0.f, 0.f}, sb = sa;
    const f32x4* pa = (const f32x4*)(ssq + (size_t)(rowbase + wr * 64 + lane) * NP); const f32x4* pb = (const f32x4*)(ssq + (size_t)(rowbase + HALF + wr * 64 + lane) * NP);
#pragma unroll
    for (int i = 0; i < NP / 4; ++i) { sa += pa[i]; sb += pb[i]; }
    wl[lane] = __builtin_amdgcn_rsqf(((sa[0] + sa[1]) + (sa[2] + sa[3])) * inv_n + EPS);
    wl[64 + lane] = __builtin_amdgcn_rsqf(((sb[0] + sb[1]) + (sb[2] + sb[3])) * inv_n + EPS);
    asm volatile("s_waitcnt lgkmcnt(0)" ::: "memory");
#pragma unroll
    for (int ai = 0; ai < 2; ++ai)
#pragma unroll
        for (int m = 0; m < 4; ++m) rs[ai * 4 + m] = wl[ai * 64 + 16 * m + fr];
    asm volatile("s_waitcnt lgkmcnt(0)" ::: "memory");
}
__device__ __forceinline__ void rope8(f32x4& v0, f32x4& v1, const float* tab  ) {
    const f32x4 t0 = *(const f32x4*)tab, t1 = *(const f32x4*)(tab + 4);
    f32x4 a = v0, b = v1;
    v0[0] = a[0] * t0[0] - a[1] * t0[1]; v0[1] = a[1] * t0[0] + a[0] * t0[1]; v0[2] = a[2] * t0[2] - a[3] * t0[3]; v0[3] = a[3] * t0[2] + a[2] * t0[3];
    v1[0] = b[0] * t1[0] - b[1] * t1[1]; v1[1] = b[1] * t1[0] + b[0] * t1[1]; v1[2] = b[2] * t1[2] - b[3] * t1[3]; v1[3] = b[3] * t1[2] + b[2] * t1[3];
}
__device__ __forceinline__ u32x4 pack8(f32x4 v0, f32x4 v1) { u32x4 w; w.x = cvt_pk_bf16(v0[0], v0[1]); w.y = cvt_pk_bf16(v0[2], v0[3]); w.z = cvt_pk_bf16(v1[0], v1[1]); w.w = cvt_pk_bf16(v1[2], v1[3]); return w; }
__device__ __forceinline__ float sq8(f32x4 v0, f32x4 v1) { return (v0[0] * v0[0] + v0[1] * v0[1]) + (v0[2] * v0[2] + v0[3] * v0[3]) + (v1[0] * v1[0] + v1[1] * v1[1]) + (v1[2] * v1[2] + v1[3] * v1[3]); }

__device__ __forceinline__ f32x4 acc_f(const f32x4& a) { return a; }
__device__ __forceinline__ f32x4 acc_f(const i32x4& a) { return __builtin_convertvector(a, f32x4); }
template <int MODE, int NP> struct EpiStore {
    bf16_t* O; int ldc; const float* ssq; LAS float* xl; float inv_n;
    const float* rope; float* ssq_q; float* ssq_kv;
    bf16_t* O2; const bf16_t* Zsrc; float* Flog;
    const float* rowf; const unsigned* cmax;
    static constexpr bool LDS_SCALES = (MODE == 1 || MODE == 4);
    __device__ __forceinline__ const float* row_src(const Unit& u) const { return rowf + u.pm * BM; }
    __device__ __forceinline__ const unsigned* col_src(const Unit& u) const { return cmax + u.pn * BM; }
    template <class ACC>
    __device__ __forceinline__ void operator()(const ACC (&acc)[2][2][4][2], const Unit& u, int wr, int wc, int fr, int fq, const LAS unsigned char* lsc) const {
        const int row0 = u.pm * BM + wr * 64 + fr;
        float rs8[8];
        const LAS unsigned* cp = (const LAS unsigned*)(lsc + 1024) + wc * 32 + 8 * fq; const LAS float* rp = (const LAS float*)lsc + wr * 64 + fr;
        if (!LDS_SCALES) wave_row_rstd<NP>(ssq, inv_n, u.pm * BM, wr, wr * 4 + wc, fr, xl, rs8);
#pragma unroll
        for (int ai = 0; ai < 2; ++ai)
#pragma unroll
            for (int m = 0; m < 4; ++m) {
                const int row = row0 + ai * HALF + m * 16;
                const float rs = LDS_SCALES ? rp[ai * HALF + m * 16] * (1.f / 127.f) : rs8[ai * 4 + m];
                float sq = 0.f;
#pragma unroll
                for (int bj = 0; bj < 2; ++bj) {
                    const int col = u.pn * BM + bj * HALF + wc * 32 + 8 * fq;
                    f32x4 v0 = acc_f(acc[ai][bj][m][0]) * rs, v1 = acc_f(acc[ai][bj][m][1]) * rs;
                    if (LDS_SCALES) { const u32x4 c0 = *(const LAS u32x4*)(cp + bj * HALF), c1 = *(const LAS u32x4*)(cp + bj * HALF + 4);
                        v0 *= (f32x4){__uint_as_float(c0.x), __uint_as_float(c0.y), __uint_as_float(c0.z), __uint_as_float(c0.w)};
                        v1 *= (f32x4){__uint_as_float(c1.x), __uint_as_float(c1.y), __uint_as_float(c1.z), __uint_as_float(c1.w)}; }
                    if (MODE == 1) { if (col >= 1280 && col < 1344) rope8(v0, v1, rope + (size_t)row * 64 + (col - 1280)); sq += sq8(v0, v1); }
                    if (MODE == 2) { const int w = col % 192; if (w >= 128) rope8(v0, v1, rope + (size_t)row * 64 + (w - 128)); }
                    if (MODE == 3) {
                        if (bj == 0) *(u32x4*)(O + (size_t)row * KM_LD + u.pn * 192 + wc * 32 + 8 * fq) = pack8(v0, v1);
                        else *(u32x4*)(O2 + (size_t)row * VM_LD + u.pn * 128 + wc * 32 + 8 * fq) = pack8(v0, v1);
                    } else if (MODE == 4) {
                        if (u.pn < 24) *(u32x4*)(O + (size_t)row * ldc + col) = pack8(v0, v1);
                        else if (bj == 0 && wc == 0 && fq < 2) { *(f32x4*)(Flog + (size_t)row * 16 + 8 * fq) = v0; *(f32x4*)(Flog + (size_t)row * 16 + 8 * fq + 4) = v1; }
                    } else *(u32x4*)(O + (size_t)row * ldc + col) = pack8(v0, v1);
                }
                if (MODE == 1 && u.pn < 5) {
                    sq += __shfl_xor(sq, 16); sq += __shfl_xor(sq, 32);
                    if (fq == 0) { if (u.pn < 3) ssq_q[(size_t)row * 12 + u.pn * 4 + wc] = sq; else ssq_kv[(size_t)row * 8 + (u.pn - 3) * 4 + wc] = sq; }
                }
                asm volatile("" ::: "memory");
            }
        if (MODE == 3) {
            const int tid = (wr * 4 + wc) * 64 + fq * 16 + fr;
#pragma unroll
            for (int i = 0; i < 4; ++i) { const int idx = tid + 512 * i, r = idx >> 3, c = idx & 7; const size_t row = (size_t)u.pm * BM + r;
                *(u32x4*)(O + row * KM_LD + u.pn * 192 + 128 + c * 8) = *(const u32x4*)(Zsrc + row * Z0_LD + 1280 + c * 8); }
        }
    }
};
template <bool BF32> struct EpiRes {
    const void* base; unsigned short* out; float* ssq; float sc = 1.f;
    static constexpr bool LDS_SCALES = false;
    __device__ __forceinline__ void operator()(const f32x4 (&acc)[2][2][4][2], const Unit& u, int wr, int wc, int fr, int fq, const LAS unsigned char*) const {
        const int row0 = u.pm * BM + wr * 64 + fr; const int colb = u.pn * BM + wc * 32 + 8 * fq;
        f32x4 bA[2][2], bB[2][2];
#define ER_LOAD(dst, i) do { const size_t off_ = (size_t)(row0 + ((i) >> 2) * HALF + ((i) & 3) * 16) * DM + colb; \
        _Pragma("unroll") for (int bj = 0; bj < 2; ++bj) { \
            if constexpr (BF32) { dst[bj][0] = *(const f32x4*)((const float*)base + off_ + bj * HALF); dst[bj][1] = *(const f32x4*)((const float*)base + off_ + bj * HALF + 4); } \
            else { const u32x4 h_ = *(const u32x4*)((const unsigned short*)base + off_ + bj * HALF); dst[bj][0] = unpk_f16x4((u32x2){h_.x, h_.y}); dst[bj][1] = unpk_f16x4((u32x2){h_.z, h_.w}); } } } while (0)
#define ER_DO(src, i) do { const int ai = (i) >> 2, m = (i) & 3; const int row = row0 + ai * HALF + m * 16; float sq = 0.f; \
        _Pragma("unroll") for (int bj = 0; bj < 2; ++bj) { const size_t off = (size_t)row * DM + colb + bj * HALF; \
            const f32x4 v0 = acc[ai][bj][m][0] * sc + src[bj][0], v1 = acc[ai][bj][m][1] * sc + src[bj][1]; \
            u32x4 w_; w_.x = pk_f16(v0[0], v0[1]); w_.y = pk_f16(v0[2], v0[3]); w_.z = pk_f16(v1[0], v1[1]); w_.w = pk_f16(v1[2], v1[3]); \
            *(u32x4*)(out + off) = w_; sq += sq8(v0, v1); } \
        if (ssq) { sq += __shfl_xor(sq, 16); sq += __shfl_xor(sq, 32); if (fq == 0) ssq[(size_t)row * 32 + u.pn * 4 + wc] = sq; } } while (0)
        ER_LOAD(bA, 0); asm volatile("" ::: "memory");
#pragma unroll
        for (int i = 0; i < 8; i += 2) {
            ER_LOAD(bB, i + 1); asm volatile("" ::: "memory");
            ER_DO(bA, i); asm volatile("" ::: "memory");
            if (i + 2 < 8) { ER_LOAD(bA, i + 2); asm volatile("" ::: "memory"); }
            ER_DO(bB, i + 1); asm volatile("" ::: "memory");
        }
#undef ER_LOAD
#undef ER_DO
    }
};
template <int RS> struct EpiSwiGLU {
    bf16_t* H; int row_base; const float* ssq; const float* rsp; const unsigned* cmax; const LAS int* tile_e; int f8 = 0;
    static constexpr bool LDS_SCALES = (RS == 2);
    __device__ __forceinline__ const float* row_src(const Unit& u) const { return rsp + u.pm * BM; }
    __device__ __forceinline__ const unsigned* col_src(const Unit& u) const { return cmax + (size_t)(tile_e ? tile_e[u.pm] : 0) * (2 * DFF) + u.pn * BM; }
    template <class ACC>
    __device__ __forceinline__ void operator()(const ACC (&acc)[2][2][4][2], const Unit& u, int wr, int wc, int fr, int fq, const LAS unsigned char* lsc) const {
        const int row0 = u.pm * BM + wr * 64 + fr;
        f32x4 sg[2], su[2];
        if (RS == 2) { const LAS unsigned* cp = (const LAS unsigned*)(lsc + 1024) + wc * 32 + 8 * fq;
#pragma unroll
            for (int n = 0; n < 2; ++n) { const u32x4 a = *(const LAS u32x4*)(cp + 4 * n), b = *(const LAS u32x4*)(cp + HALF + 4 * n);
#pragma unroll
                for (int j = 0; j < 4; ++j) { sg[n][j] = __uint_as_float(a[j]) * (1.f / 127.f); su[n][j] = __uint_as_float(b[j]) * (1.f / 127.f); } } }
        float rs8[8];
#pragma unroll
        for (int i = 0; i < 8; ++i) { const int row = row0 + (i >> 2) * HALF + (i & 3) * 16;
            if (RS == 2) rs8[i] = ((const LAS float*)lsc)[wr * 64 + fr + (i >> 2) * HALF + (i & 3) * 16]; else rs8[i] = RS == 0 ? row_rstd(ssq, row, 32, 1.f / DM) : rsp[row]; }
#pragma unroll
        for (int ai = 0; ai < 2; ++ai)
#pragma unroll
            for (int m = 0; m < 4; ++m) {
                const int row = row0 + ai * HALF + m * 16;
                const float rs = rs8[ai * 4 + m];
                f32x4 o[2];
#pragma unroll
                for (int n = 0; n < 2; ++n) { f32x4 g = acc_f(acc[ai][0][m][n]) * rs, up = acc_f(acc[ai][1][m][n]) * rs;
                    if (RS == 2) { g *= sg[n]; up *= su[n]; }
#pragma unroll
                    for (int j = 0; j < 4; ++j) o[n][j] = g[j] * __builtin_amdgcn_rcpf(1.f + __builtin_amdgcn_exp2f(-LOG2E * g[j])) * up[j]; }
                if (RS == 2 && f8) {
                    _Pragma("unroll") for (int n = 0; n < 2; ++n) _Pragma("unroll") for (int j = 0; j < 4; ++j) o[n][j] = __builtin_amdgcn_fmed3f(o[n][j], -448.f, 448.f);
                    *(u32x2*)((unsigned char*)H + ((size_t)u.pn * MCH_ROWS + (row - row_base)) * 128 + wc * 32 + 8 * fq) = pack8_fp8(o[0], o[1]);
                } else
                *(u32x4*)(H + ((size_t)(u.pn * 2 + (wc >> 1)) * CHUNK_ROWS + (row - row_base)) * 64 + (wc & 1) * 32 + 8 * fq) = pack8(o[0], o[1]);
                asm volatile("" ::: "memory");
            }
    }
};
struct EpiMoeDown {
    bf16_t* Y; const float* gate;
    static constexpr bool LDS_SCALES = false;
    __device__ __forceinline__ void operator()(const f32x4 (&acc)[2][2][4][2], const Unit& u, int wr, int wc, int fr, int fq, const LAS unsigned char*) const {
        const int row0 = u.pm * BM + wr * 64 + fr;
        float g8[8];
#pragma unroll
        for (int i = 0; i < 8; ++i) g8[i] = gate[row0 + (i >> 2) * HALF + (i & 3) * 16] * (1.f / 64.f);
#pragma unroll
        for (int ai = 0; ai < 2; ++ai)
#pragma unroll
            for (int m = 0; m < 4; ++m) {
                const int row = row0 + ai * HALF + m * 16; const float g = g8[ai * 4 + m];
#pragma unroll
                for (int bj = 0; bj < 2; ++bj) *(u32x4*)(Y + (size_t)row * DM + u.pn * BM + bj * HALF + wc * 32 + 8 * fq) = pack8(acc[ai][bj][m][0] * g, acc[ai][bj][m][1] * g);
                asm volatile("" ::: "memory");
            }
    }
};
}

namespace fa {
#define SBAR() __builtin_amdgcn_sched_barrier(0)
template <int NDV> __device__ __forceinline__ int v_st(int k, int c) { const int kk = (k & ~0xC) | ((k & 4) << 1) | ((k & 8) >> 1); return ((kk >> 3) * NDV + (c >> 5)) * 512 + ((kk & 7) * 32 + (c & 31)) * 2; }
__device__ __forceinline__ int v_rd_base(int lane) { return ((lane & 3) << 3) | (((lane >> 2) & 3) << 6) | (((lane >> 4) & 1) << 5) | (((lane >> 5) & 1) << 8); }
__device__ __forceinline__ int crow(int r, int hi) { return (r & 3) + 8 * (r >> 2) + 4 * hi; }
__device__ __forceinline__ void mask_tile(f32x16& p0, f32x16& p1, int dq, unsigned W) {
    const float NEG = -__builtin_inff();
#pragma unroll
    for (int r = 0; r < 16; ++r) {
        const int c = (r & 3) + 8 * (r >> 2);
        if ((unsigned)(dq - c) >= W) p0[r] = NEG;
        if ((unsigned)(dq - c - 32) >= W) p1[r] = NEG;
    }
}
struct AttnArgs {
    const bf16_t* Q; int ldq; const bf16_t* K; int ldk; const bf16_t* V; int ldv; bf16_t* O; int ldo;
    int q0, j_lo, j_hi, W;
    const float* dec;
    float sinkl; const float* biasT;
    const float* sinks;
    float kmax;
    const float* neff;
};
template <int DK, int DV, int MODE>
__device__ __forceinline__ void attn_unit(const AttnArgs& a, LAS char* lds) {
    constexpr int KROWB = DK * 2 + 16  , SHM_K = 64 * KROWB, SHM_V = 64 * DV * 2, NDK = DK / 16, NDV = DV / 32, KCH = DK / 8, VCH = DV / 8, KPT = KCH * 64 / 512, VPT = VCH * 64 / 512;
    constexpr int RB = NDV * 512;
    constexpr float THR = 8.f;
    int tid_ = threadIdx.x; asm volatile("" : "+v"(tid_));
    const int tid = tid_, wid = __builtin_amdgcn_readfirstlane(tid >> 6), lane = tid & 63, r32 = lane & 31, hi = lane >> 5;
    LAS char* V_lds = lds; LAS char* K_lds = lds + 2 * SHM_V;
    LAS float* dec_l = (LAS float*)(K_lds + 2 * SHM_K);
    LAS float* ws = dec_l + 128 + wid * 64;
    LAS float* bias_l = dec_l + 128 + 512 + ((MODE == 2) ? wid * 128 : 0);
    const int NT = a.j_hi - a.j_lo;
    const int qlo = (MODE == 2) ? a.q0 : a.q0 + wid * 32, qpos = qlo + r32;
    const int hoff = (MODE == 2) ? wid * 64 : 0;
    static_assert(KPT == KCH / 8 && VPT == VCH / 8, "staging map");
    const int srow_ = tid >> 3, scg_ = tid & 7;
    const int kws0 = srow_ * KROWB + scg_ * 16, vws0 = v_st<NDV>(srow_, scg_ * 8);
    const unsigned ksrc0 = (unsigned)(srow_ * a.ldk + scg_ * 8) * 2u, vsrc0 = (unsigned)(srow_ * a.ldv + scg_ * 8) * 2u;
    bf16x8 qr[NDK];
#pragma unroll
    for (int d0 = 0; d0 < NDK; ++d0) qr[d0] = *(const bf16x8*)(a.Q + (size_t)qpos * a.ldq + hoff + d0 * 16 + hi * 8);
    __builtin_amdgcn_s_waitcnt(0x0F70);
    float m_reg = -1e30f, l_reg = 0.f;
    if (MODE == 2) { m_reg = a.sinks[wid] * LOG2E; l_reg = 1.f; }
    f32x16 o[NDV];
#pragma unroll
    for (int d = 0; d < NDV; ++d) o[d] = f32x16{};
    float clq = 0.f; if (MODE == 1) clq = a.dec[(size_t)qpos * 16];
    if (MODE == 2) { (dec_l + 128 + 512)[tid] = a.biasT[tid]; (dec_l + 128 + 512)[tid + 512] = a.biasT[tid + 512]; }
    const int vb0 = (int)(uintptr_t)V_lds + v_rd_base(lane);
    const int kq = r32 * KROWB;
    bf16x8 sk[2][KPT], sv[2][VPT]; float sdec[2] = {0.f, 0.f};
    if (wid >= 4) __builtin_amdgcn_s_setprio(1);
#define FA_LOADT(j, S_) do { const size_t kb_ = (size_t)(j) * 64; const char* kt_ = (const char*)(a.K + kb_ * a.ldk); const char* vt_ = (const char*)(a.V + kb_ * a.ldv); \
        _Pragma("unroll") for (int i = 0; i < KPT; ++i) sk[S_][i] = *(const bf16x8*)(kt_ + ksrc0 + i * 128); \
        _Pragma("unroll") for (int i = 0; i < VPT; ++i) sv[S_][i] = *(const bf16x8*)(vt_ + vsrc0 + i * 128); \
        if (MODE == 1) { if (tid < 64) sdec[S_] = a.dec[(kb_ + tid) * 16]; else if (tid == 64) sdec[S_] = a.neff[(j)]; } } while (0)
#define FA_WRITET(bf, S_) do { \
        _Pragma("unroll") for (int i = 0; i < KPT; ++i) *(LAS bf16x8*)(K_lds + (bf) * SHM_K + kws0 + i * 128) = sk[S_][i]; \
        _Pragma("unroll") for (int i = 0; i < VPT; ++i) *(LAS bf16x8*)(V_lds + (bf) * SHM_V + vws0 + i * 1024) = sv[S_][i]; \
        if (MODE == 1) { if (tid < 64) dec_l[(bf) * 64 + tid] = sdec[S_]; else if (tid == 64) dec_l[800 + (bf)] = sdec[S_]; } } while (0)
#define FA_TR(dst, off) asm volatile("ds_read_b64_tr_b16 %0, %1 offset:%2" : "=&v"(dst) : "v"(vb0), "i"(off) : "memory")
#define FA_VRD(S, BUF, d0) do { constexpr int b_ = (BUF) * SHM_V + (d0) * 512; \
        FA_TR(S##l[0], b_); FA_TR(S##h[0], b_ + RB); FA_TR(S##l[1], b_ + 2 * RB); FA_TR(S##h[1], b_ + 3 * RB); FA_TR(S##l[2], b_ + 4 * RB); FA_TR(S##h[2], b_ + 5 * RB); FA_TR(S##l[3], b_ + 6 * RB); FA_TR(S##h[3], b_ + 7 * RB); } while (0)
#define FA_VMM(S, d0) do { \
        o[d0] = __builtin_amdgcn_mfma_f32_32x32x16_bf16(pa0, (bf16x8){S##l[0][0], S##l[0][1], S##l[0][2], S##l[0][3], S##h[0][0], S##h[0][1], S##h[0][2], S##h[0][3]}, o[d0], 0, 0, 0); \
        o[d0] = __builtin_amdgcn_mfma_f32_32x32x16_bf16(pa1, (bf16x8){S##l[1][0], S##l[1][1], S##l[1][2], S##l[1][3], S##h[1][0], S##h[1][1], S##h[1][2], S##h[1][3]}, o[d0], 0, 0, 0); \
        o[d0] = __builtin_amdgcn_mfma_f32_32x32x16_bf16(pa2, (bf16x8){S##l[2][0], S##l[2][1], S##l[2][2], S##l[2][3], S##h[2][0], S##h[2][1], S##h[2][2], S##h[2][3]}, o[d0], 0, 0, 0); \
        o[d0] = __builtin_amdgcn_mfma_f32_32x32x16_bf16(pa3, (bf16x8){S##l[3][0], S##l[3][1], S##l[3][2], S##l[3][3], S##h[3][0], S##h[3][1], S##h[3][2], S##h[3][3]}, o[d0], 0, 0, 0); } while (0)
#define FA_LW(n) do { asm volatile("s_waitcnt lgkmcnt(" #n ")" ::: "memory"); SBAR(); } while (0)
#define FA_PVALL(BUF) do { s16x4 Al[4], Ah[4], Bl[4], Bh[4]; \
        FA_VRD(A, BUF, 0); FA_VRD(B, BUF, 1); FA_LW(8); FA_VMM(A, 0); \
        if constexpr (NDV == 4) { FA_VRD(A, BUF, 2); FA_LW(8); FA_VMM(B, 1); FA_VRD(B, BUF, 3); FA_LW(8); FA_VMM(A, 2); FA_LW(0); FA_VMM(B, 3); } \
        else { FA_LW(0); FA_VMM(B, 1); } } while (0)
#define FA_PK4(P, B_, OUT) do { unsigned a0 = cvt_pk_bf16(P[B_ + 0], P[B_ + 1]), a1 = cvt_pk_bf16(P[B_ + 2], P[B_ + 3]); \
        unsigned b0 = cvt_pk_bf16(P[B_ + 4], P[B_ + 5]), b1 = cvt_pk_bf16(P[B_ + 6], P[B_ + 7]); \
        auto r0 = __builtin_amdgcn_permlane32_swap(a0, b0, false, false); auto r1 = __builtin_amdgcn_permlane32_swap(a1, b1, false, false); \
        u32x4 w = {r0[0], r1[0], r0[1], r1[1]}; OUT = *reinterpret_cast<bf16x8*>(&w); } while (0)
#define FA_COMPUTE(BUF, kb) do { \
            f32x16 p0, p1; \
            if (MODE == 1) { _Pragma("unroll") for (int r = 0; r < 16; ++r) { p0[r] = clq - dec_l[(BUF) * 64 + crow(r, hi)]; p1[r] = clq - dec_l[(BUF) * 64 + 32 + crow(r, hi)]; } } \
            else { p0 = f32x16{}; p1 = f32x16{}; } \
            { const LAS char* kbp[4];     \
              kbp[0] = K_lds + (BUF) * SHM_K + kq + hi * 16; \
              bf16x8 ka0 = *(const LAS bf16x8*)kbp[0], ka1 = *(const LAS bf16x8*)(kbp[0] + 32 * KROWB), kb0, kb1; SBAR(); \
              _Pragma("unroll") for (int d0 = 0; d0 < NDK; d0 += 2) { \
                  { const LAS char* ap = kbp[0] + (d0 + 1) * 32; kb0 = *(const LAS bf16x8*)ap; kb1 = *(const LAS bf16x8*)(ap + 32 * KROWB); } SBAR(); \
                  p0 = __builtin_amdgcn_mfma_f32_32x32x16_bf16(ka0, qr[d0], p0, 0, 0, 0); p1 = __builtin_amdgcn_mfma_f32_32x32x16_bf16(ka1, qr[d0], p1, 0, 0, 0); SBAR(); \
                  if (d0 + 2 < NDK) { const LAS char* ap = kbp[0] + (d0 + 2) * 32; ka0 = *(const LAS bf16x8*)ap; ka1 = *(const LAS bf16x8*)(ap + 32 * KROWB); } SBAR(); \
                  p0 = __builtin_amdgcn_mfma_f32_32x32x16_bf16(kb0, qr[d0 + 1], p0, 0, 0, 0); p1 = __builtin_amdgcn_mfma_f32_32x32x16_bf16(kb1, qr[d0 + 1], p1, 0, 0, 0); SBAR(); } } \
            if (MODE == 2) { const int dq0 = qpos - (kb) - 4 * hi; \
                _Pragma("unroll") for (int r = 0; r < 16; ++r) { const int c = (r & 3) + 8 * (r >> 2); int i0 = dq0 - c, i1 = dq0 - c - 32; \
                    i0 = i0 < 0 ? 0 : (i0 > 127 ? 127 : i0); i1 = i1 < 0 ? 0 : (i1 > 127 ? 127 : i1); p0[r] += bias_l[i0]; p1[r] += bias_l[i1]; } } \
            if (MODE != 3) { if ((kb) + 63 > qlo || (kb) <= qlo + 31 - a.W) mask_tile(p0, p1, qpos - (kb) - 4 * hi, (unsigned)a.W); } \
            float pmax = p0[0]; \
            _Pragma("unroll") for (int r = 1; r < 16; ++r) pmax = fmaxf(pmax, p0[r]); \
            _Pragma("unroll") for (int r = 0; r < 16; ++r) pmax = fmaxf(pmax, p1[r]); \
            { auto rr = __builtin_amdgcn_permlane32_swap(__float_as_uint(pmax), __float_as_uint(pmax), false, false); pmax = fmaxf(__uint_as_float(rr[0]), __uint_as_float(rr[1])); } \
              \
            if (MODE != 1 || !__all((pmax - m_reg) < -28.f)) { \
            float mn, alpha; \
            if (__builtin_expect(__all((pmax - m_reg) <= THR), 1)) { mn = m_reg; alpha = 1.f; } \
            else { mn = fmaxf(m_reg, pmax); alpha = __builtin_amdgcn_exp2f(m_reg - mn); m_reg = mn; } \
            _Pragma("unroll") for (int r = 0; r < 16; ++r) { p0[r] = __builtin_amdgcn_exp2f(p0[r] - mn); p1[r] = __builtin_amdgcn_exp2f(p1[r] - mn); } \
            float ps = 0.f; \
            _Pragma("unroll") for (int r = 0; r < 16; ++r) ps += p0[r]; \
            _Pragma("unroll") for (int r = 0; r < 16; ++r) ps += p1[r]; \
            { auto rr = __builtin_amdgcn_permlane32_swap(__float_as_uint(ps), __float_as_uint(ps), false, false); ps = __uint_as_float(rr[0]) + __uint_as_float(rr[1]); } \
            l_reg = l_reg * alpha + ps; \
            if (__any(alpha < 1.f)) { if (hi == 0) ws[32 + r32] = alpha; asm volatile("s_waitcnt lgkmcnt(0)" ::: "memory"); \
                _Pragma("unroll") for (int d_ = 0; d_ < NDV; ++d_) _Pragma("unroll") for (int r = 0; r < 16; ++r) o[d_][r] *= ws[32 + crow(r, hi)]; } \
            bf16x8 pa0, pa1, pa2, pa3; \
            FA_PK4(p0, 0, pa0); FA_PK4(p0, 8, pa1); FA_PK4(p1, 0, pa2); FA_PK4(p1, 8, pa3); SBAR(); \
            FA_PVALL(BUF); } \
        } while (0)
    if constexpr (MODE != 1) {
#define FA_TILE(t, BUF) do { \
        const int kb = (a.j_lo + (t)) * 64; \
        bool act = true; if (MODE != 3) act = (kb <= qlo + 31) && (kb + 63 >= qlo - a.W + 1); \
        if ((t) + 2 < NT) FA_LOADT(a.j_lo + (t) + 2, BUF);              \
        if (act) FA_COMPUTE(BUF, kb); \
        if ((t) + 1 < NT) FA_WRITET((BUF) ^ 1, (BUF) ^ 1);              \
        __syncthreads(); } while (0)
        FA_LOADT(a.j_lo, 0); FA_WRITET(0, 0); if (NT > 1) FA_LOADT(a.j_lo + 1, 1); __syncthreads();
        for (int t = 0; t < NT; t += 2) {
            FA_TILE(t, 0);
            if (t + 1 < NT) FA_TILE(t + 1, 1);
        }
#undef FA_TILE
    } else {
        constexpr float TEXIT = 14.f;
        float qn2 = 0.f;
#pragma unroll
        for (int d0 = 0; d0 < NDK; ++d0)
#pragma unroll
            for (int e = 0; e < 8; ++e) { const float f = bf2f((unsigned short)qr[d0][e]); qn2 += f * f; }
        { auto rr = __builtin_amdgcn_permlane32_swap(__float_as_uint(qn2), __float_as_uint(qn2), false, false); qn2 = __uint_as_float(rr[0]) + __uint_as_float(rr[1]); }
        const float ubase = sqrtf(qn2) * a.kmax * 1.0001f + clq;
        LAS int* flags = (LAS int*)(dec_l + 128 + 512 + 128);
        bool wdone = false, stop = false;
#define FA_TILE_R(t, BUF) do { \
        const int kb = (a.j_lo + (t)) * 64; const bool more = (t) > 0; \
        const bool act = !wdone && (kb <= qlo + 31); \
        if ((t) > 1) FA_LOADT(a.j_lo + (t) - 2, BUF); \
        if (act) { FA_COMPUTE(BUF, kb); \
            wdone = __all((ubase - dec_l[(BUF) * 64] + dec_l[800 + (BUF)]) < (m_reg - TEXIT)) != 0; } \
        if (more) FA_WRITET((BUF) ^ 1, (BUF) ^ 1); \
        if (lane == 0) flags[(BUF) * 8 + wid] = wdone ? 1 : 0; \
        __syncthreads(); \
        { int all_ = 1; _Pragma("unroll") for (int w_ = 0; w_ < 8; ++w_) all_ &= flags[(BUF) * 8 + w_]; stop = !more || (all_ != 0); } } while (0)
        FA_LOADT(a.j_lo + NT - 1, 0); FA_WRITET(0, 0); if (NT > 1) FA_LOADT(a.j_lo + NT - 2, 1); __syncthreads();
        for (int t = NT - 1;;) {
            FA_TILE_R(t, 0); if (stop) break; --t;
            FA_TILE_R(t, 1); if (stop) break; --t;
        }
#undef FA_TILE_R
    }
    __builtin_amdgcn_s_setprio(0);
    if (hi == 0) ws[r32] = l_reg; asm volatile("s_waitcnt lgkmcnt(0)" ::: "memory");
    float rli[16];
#pragma unroll
    for (int r = 0; r < 16; ++r) rli[r] = __builtin_amdgcn_rcpf(ws[crow(r, hi)]);
    bf16_t* Ow = a.O + (size_t)qlo * a.ldo + hoff;
#pragma unroll
    for (int r = 0; r < 16; ++r) { const int orow = crow(r, hi);
#pragma unroll
        for (int d0 = 0; d0 < NDV; ++d0) { const float v = o[d0][r] * rli[r]; const float vn = __shfl_xor(v, 1);
            if ((r32 & 1) == 0) *(unsigned*)(Ow + (size_t)orow * a.ldo + d0 * 32 + r32) = cvt_pk_bf16(v, vn); } }
    __syncthreads();
#undef FA_LOADT
#undef FA_WRITET
#undef FA_TR
#undef FA_VRD
#undef FA_VMM
#undef FA_LW
#undef FA_PVALL
#undef FA_PK4
#undef FA_COMPUTE
}
#undef SBAR
}

struct Args { const void* in[N_IN]; float* out; unsigned char* ws; int ph_lo, ph_hi; };

__device__ const float ROPE_INV[32] = {
    1.000000000e+00f, 7.498942614e-01f, 5.623413324e-01f, 4.216965139e-01f, 3.162277639e-01f, 2.371373773e-01f, 1.778279394e-01f, 1.333521307e-01f,
    1.000000015e-01f, 7.498941571e-02f, 5.623413250e-02f, 4.216965288e-02f, 3.162277490e-02f, 2.371373773e-02f, 1.778279431e-02f, 1.333521493e-02f,
    9.999999776e-03f, 7.498941850e-03f, 5.623413250e-03f, 4.216964822e-03f, 3.162277630e-03f, 2.371373586e-03f, 1.778279431e-03f, 1.333521446e-03f,
    1.000000047e-03f, 7.498942432e-04f, 5.623413017e-04f, 4.216965172e-04f, 3.162277571e-04f, 2.371373703e-04f, 1.778279402e-04f, 1.333521504e-04f };
__device__ const unsigned char T5_BUCKET[128] = {
    0, 1, 2, 3, 4, 5, 6, 7, 8, 9, 10, 11, 12, 13, 14, 15, 16, 16, 16, 17, 17, 18, 18, 18, 19, 19, 19, 20, 20, 20, 20, 21, 21, 21, 21, 22, 22, 22, 22, 22, 23, 23, 23, 23, 23, 23, 24, 24, 24, 24, 24, 24,
    25, 25, 25, 25, 25, 25, 25, 26, 26, 26, 26, 26, 26, 26, 26, 27, 27, 27, 27, 27, 27, 27, 27, 27, 27, 28, 28, 28, 28, 28, 28, 28, 28, 28, 28, 29, 29, 29, 29, 29, 29, 29, 29, 29, 29, 29, 29,
    30, 30, 30, 30, 30, 30, 30, 30, 30, 30, 30, 30, 30, 30, 31, 31, 31, 31, 31, 31, 31, 31, 31, 31, 31, 31, 31, 31, 31 };

struct CvtJob { const float* src; int K, Nsrc, Npad; const float* gain; bf16_t* dst; int ldd; int mode; int row_off; int kblk;   unsigned* amax;   int f8;   int f16;   };
__device__ __forceinline__ int cvt_row(int mode, int n) {
    if (mode == 1) { if (n >= 1280 && n < 1344) { const int j = n - 1280; return 1280 + 2 * (j & 31) + (j >> 5); } return n; }
    if (mode == 2) { const int h = n / 192, w = n - h * 192; if (w >= 128) { const int j = w - 128; return h * 192 + 128 + 2 * (j & 31) + (j >> 5); } return n; }
    if (mode == 4) return (n >> 7) * 256 + (n & 127);
    if (mode == 5) return (n >> 7) * 256 + 128 + (n & 127);
    return n;
}
__device__ __forceinline__ float cvt_cs(int mode, int n) {
    if (mode == 1) return (n >= 1344 && n < 2368) ? C2_SWA : 1.f;
    if (mode == 2) return C2_MLA;
    if (mode == 3) return C2_128;
    if (mode == 6) return n < 2048 ? C2_128 : 1.f;
    return 1.f;
}
constexpr int N_CVT_JOBS = 17 + 24;
__device__ __forceinline__ CvtJob get_job(const Args& a, int j) {
    unsigned char* ws = a.ws; CvtJob jb; jb.gain = nullptr; jb.mode = 0; jb.row_off = 0; jb.amax = nullptr; jb.kblk = 0; jb.f16 = 0; jb.f8 = 0;
    const float* nmix = (const float*)a.in[I_NMIX]; const float* ncross = (const float*)a.in[I_NCROSS]; const float* nmem = (const float*)a.in[I_NMEM]; const float* nffn = (const float*)a.in[I_NFFN];
    if (j >= 17) { const int t = (j - 17) >> 3, e = (j - 17) & 7;
        if (t == 0) { jb.src = (const float*)a.in[I_MG] + (size_t)e * DM * DFF; jb.K = DM; jb.Nsrc = jb.Npad = DFF; jb.gain = nffn + DM; jb.dst = (bf16_t*)(ws + WS_WGU1 + (size_t)e * E_GU); jb.ldd = DM; jb.mode = 4; jb.amax = (unsigned*)(ws + WS_CTL) + CW_AMAXW + e * 2 * DFF; }
        else if (t == 1) { jb.src = (const float*)a.in[I_MU] + (size_t)e * DM * DFF; jb.K = DM; jb.Nsrc = jb.Npad = DFF; jb.gain = nffn + DM; jb.dst = (bf16_t*)(ws + WS_WGU1 + (size_t)e * E_GU); jb.ldd = DM; jb.mode = 5; jb.amax = (unsigned*)(ws + WS_CTL) + CW_AMAXW + e * 2 * DFF; }
        else { jb.src = (const float*)a.in[I_MD] + (size_t)e * DFF * DM; jb.K = DFF; jb.Nsrc = jb.Npad = DM; jb.dst = (bf16_t*)(ws + WS_WD1 + (size_t)e * E_D)  ; jb.ldd = DFF; jb.kblk = 1; jb.f8 = 1; }
        return jb; }
    switch (j) {
    case 0: jb.src = (const float*)a.in[I_EVWIN]; jb.K = DM; jb.Nsrc = EVEN_IN; jb.Npad = Z0_LD; jb.gain = nmix; jb.dst = (bf16_t*)(ws + WS_WIN0)  ; jb.ldd = DM; jb.mode = 1; jb.amax = (unsigned*)(ws + WS_CTL) + CW_AMAX0; break;
    case 1: jb.src = (const float*)a.in[I_WUQ]; jb.K = 768; jb.Nsrc = jb.Npad = 1536; jb.gain = (const float*)a.in[I_QNORM]; jb.dst = (bf16_t*)(ws + WS_WUQ); jb.ldd = 768; jb.mode = 2; break;
    case 2: jb.src = (const float*)a.in[I_WUKV]; jb.K = 512; jb.Nsrc = jb.Npad = 2048; jb.gain = (const float*)a.in[I_KVNORM]; jb.dst = (bf16_t*)(ws + WS_WUKV); jb.ldd = 512; break;
    case 3: jb.src = (const float*)a.in[I_EVWO]; jb.K = DM; jb.Nsrc = jb.Npad = DM; jb.dst = (bf16_t*)(ws + WS_WO0); jb.ldd = DM; break;
    case 4: case 5: { const int l = j - 4; jb.src = (const float*)a.in[I_XWQ] + (size_t)l * DM * 512; jb.K = DM; jb.Nsrc = jb.Npad = 512; jb.gain = ncross + l * DM; jb.dst = (bf16_t*)(ws + WS_WXQ) + (size_t)l * E_XQ; jb.ldd = DM; jb.mode = 3; jb.f16 = 1; break; }
    case 6: case 7: { const int l = j - 6; jb.src = (const float*)a.in[I_XWK] + (size_t)l * DM * 512; jb.K = DM; jb.Nsrc = jb.Npad = 512; jb.gain = nmem + l * DM; jb.dst = (bf16_t*)(ws + WS_WXKV); jb.ldd = DM; jb.row_off = l * 1024; break; }
    case 8: case 9: { const int l = j - 8; jb.src = (const float*)a.in[I_XWV] + (size_t)l * DM * 512; jb.K = DM; jb.Nsrc = jb.Npad = 512; jb.gain = nmem + l * DM; jb.dst = (bf16_t*)(ws + WS_WXKV); jb.ldd = DM; jb.row_off = l * 1024 + 512; break; }
    case 10: case 11: { const int l = j - 10; jb.src = (const float*)a.in[I_XWO] + (size_t)l * 512 * DM; jb.K = 512; jb.Nsrc = jb.Npad = DM; jb.dst = (bf16_t*)(ws + WS_WXO) + (size_t)l * E_XO; jb.ldd = 512; break; }
    case 12: jb.src = (const float*)a.in[I_FG]; jb.K = DM; jb.Nsrc = jb.Npad = DFF; jb.gain = nffn; jb.dst = (bf16_t*)(ws + WS_WGU0); jb.ldd = DM; jb.mode = 4; jb.amax = (unsigned*)(ws + WS_CTL) + CW_AMAXW + 8 * 2 * DFF; break;
    case 13: jb.src = (const float*)a.in[I_FU]; jb.K = DM; jb.Nsrc = jb.Npad = DFF; jb.gain = nffn; jb.dst = (bf16_t*)(ws + WS_WGU0); jb.ldd = DM; jb.mode = 5; jb.amax = (unsigned*)(ws + WS_CTL) + CW_AMAXW + 8 * 2 * DFF; break;
    case 14: jb.src = (const float*)a.in[I_FD]; jb.K = DFF; jb.Nsrc = jb.Npad = DM; jb.dst = (bf16_t*)(ws + WS_WD0); jb.ldd = DFF; jb.kblk = 1; break;
    case 15: jb.src = (const float*)a.in[I_ODWIN]; jb.K = DM; jb.Nsrc = ODD_IN; jb.Npad = IN1_PAD; jb.gain = nmix + DM; jb.dst = (bf16_t*)(ws + WS_WIN1)  ; jb.ldd = DM; jb.mode = 6; jb.amax = (unsigned*)(ws + WS_CTL) + CW_AMAX15; break;
    default: jb.src = (const float*)a.in[I_ODWO]; jb.K = DM; jb.Nsrc = jb.Npad = DM; jb.dst = (bf16_t*)(ws + WS_WO1); jb.ldd = DM; break;
    }
    return jb;
}
__device__ __forceinline__ int cvt_find(const LAS int* cum, int it, int& j) { while (it >= cum[j + 1]) ++j; return it - cum[j]; }
__device__ __forceinline__ void cvt_load(const CvtJob& jb, int item, int lane, float (&v)[32]) {
    const int nblk = jb.Npad / 32, kb = item / nblk, nb = item % nblk, k0 = 64 * kb, n0 = 32 * nb;
    const int nn = n0 + (lane & 31); const bool ok = nn < jb.Nsrc;
    const float* p = jb.src + (size_t)(k0 + (lane >> 5)) * jb.Nsrc + nn; const size_t st = (size_t)2 * jb.Nsrc;
#pragma unroll
    for (int i = 0; i < 32; ++i) v[i] = ok ? __builtin_nontemporal_load(p + i * st) : 0.f;
}
__device__ __forceinline__ void cvt_store(const CvtJob& jb, LAS float* scr, int item, int lane, const float (&v)[32]) {
    const int nblk = jb.Npad / 32, kb = item / nblk, nb = item % nblk, k0 = 64 * kb, n0 = 32 * nb;
    const float cs = cvt_cs(jb.mode, n0 + (lane & 31));
    const int c = lane & 7;
    f32x4 g0 = (f32x4){1.f, 1.f, 1.f, 1.f}, g1 = g0;
    if (jb.gain) { g0 = *(const f32x4*)(jb.gain + k0 + 8 * c); g1 = *(const f32x4*)(jb.gain + k0 + 8 * c + 4); }
#pragma unroll
    for (int i = 0; i < 32; ++i) scr[(2 * i + (lane >> 5)) * 33 + (lane & 31)] = v[i] * cs;
    LDS_WAIT(); asm volatile("" ::: "memory");
#pragma unroll
    for (int j = 0; j < 4; ++j) { const int n = (lane >> 3) + 8 * j; const LAS float* s = scr + (8 * c) * 33 + n;
        u32x4 o;
        if (jb.f16) { o.x = pk_f16(s[0 * 33] * g0[0], s[1 * 33] * g0[1]); o.y = pk_f16(s[2 * 33] * g0[2], s[3 * 33] * g0[3]); o.z = pk_f16(s[4 * 33] * g1[0], s[5 * 33] * g1[1]); o.w = pk_f16(s[6 * 33] * g1[2], s[7 * 33] * g1[3]); }
        else { o.x = cvt_pk_bf16(s[0 * 33] * g0[0], s[1 * 33] * g0[1]); o.y = cvt_pk_bf16(s[2 * 33] * g0[2], s[3 * 33] * g0[3]); o.z = cvt_pk_bf16(s[4 * 33] * g1[0], s[5 * 33] * g1[1]); o.w = cvt_pk_bf16(s[6 * 33] * g1[2], s[7 * 33] * g1[3]); }
        const int drow = jb.row_off + cvt_row(jb.mode, n0 + n);
        if (jb.f8) {
            const f32x4 a_ = (f32x4){s[0 * 33] * g0[0], s[1 * 33] * g0[1], s[2 * 33] * g0[2], s[3 * 33] * g0[3]} * 64.f, b_ = (f32x4){s[4 * 33] * g1[0], s[5 * 33] * g1[1], s[6 * 33] * g1[2], s[7 * 33] * g1[3]} * 64.f;
            *(u32x2*)((unsigned char*)jb.dst + ((size_t)(k0 >> 7) * jb.Npad + drow) * 128 + (k0 & 64) + 8 * c) = pack8_fp8(a_, b_);
        } else { bf16_t* dp = jb.kblk ? jb.dst + ((size_t)(k0 >> 6) * jb.Npad + drow) * 64 + 8 * c : jb.dst + (size_t)drow * jb.ldd + k0 + 8 * c; *(u32x4*)dp = o; } }
    LDS_WAIT(); asm volatile("" ::: "memory");
}
__device__ __forceinline__ void cvt_amax(const CvtJob& jb, int item, int lane, const float (&v)[32]) {
    const int nblk = jb.Npad / 32, kb = item / nblk, nb = item % nblk, k0 = 64 * kb, n0 = 32 * nb;
    const int nn = n0 + (lane & 31); float mx = 0.f;
#pragma unroll
    for (int i = 0; i < 32; ++i) mx = fmaxf(mx, fabsf(v[i] * jb.gain[k0 + 2 * i + (lane >> 5)]));
    mx = fmaxf(mx, __shfl_xor(mx, 32)) * cvt_cs(jb.mode, nn);
    if (lane < 32 && nn < jb.Nsrc) atomicMax(jb.amax + jb.row_off + cvt_row(jb.mode, nn), __float_as_uint(mx));
}
__device__ __forceinline__ float cvt_amax_item(const CvtJob& jb, int item, int lane, const float (&v)[32]) {
    const int nblk = jb.Npad / 32, kb = item / nblk, nb = item % nblk, k0 = 64 * kb, n0 = 32 * nb;
    float mx = 0.f;
#pragma unroll
    for (int i = 0; i < 32; ++i) mx = fmaxf(mx, fabsf(v[i] * jb.gain[k0 + 2 * i + (lane >> 5)]));
    return fmaxf(mx, __shfl_xor(mx, 32)) * cvt_cs(jb.mode, n0 + (lane & 31));
}
__device__ __forceinline__ void cvt_store_q8(const CvtJob& jb, LAS float* scr, int item, int lane, const float (&v)[32], const LAS float* cam = nullptr) {
    const int nblk = jb.Npad / 32, kb = item / nblk, nb = item % nblk, k0 = 64 * kb, n0 = 32 * nb;
    const int c = lane & 7;
    const f32x4 g0 = *(const f32x4*)(jb.gain + k0 + 8 * c), g1 = *(const f32x4*)(jb.gain + k0 + 8 * c + 4);
#pragma unroll
    for (int i = 0; i < 32; ++i) scr[(2 * i + (lane >> 5)) * 33 + (lane & 31)] = v[i];
    LDS_WAIT(); asm volatile("" ::: "memory");
#pragma unroll
    for (int j = 0; j < 4; ++j) { const int n = (lane >> 3) + 8 * j; const LAS float* s = scr + (8 * c) * 33 + n;
        const int row = jb.row_off + cvt_row(jb.mode, n0 + n);
        const float am = cam ? cam[n] : __uint_as_float(__hip_atomic_load(jb.amax + row, RLX_AGENT)); const float inv = am > 0.f ? cvt_cs(jb.mode, n0 + n) * 127.f / am : 0.f;
        int q[8];
#pragma unroll
        for (int i = 0; i < 4; ++i) { q[i] = (int)__builtin_rintf(s[i * 33] * g0[i] * inv); q[4 + i] = (int)__builtin_rintf(s[(4 + i) * 33] * g1[i] * inv); }
#pragma unroll
        for (int i = 0; i < 8; ++i) q[i] = q[i] > 127 ? 127 : (q[i] < -127 ? -127 : q[i]);
        u32x2 o; o.x = (unsigned)(q[0] & 255) | ((unsigned)(q[1] & 255) << 8) | ((unsigned)(q[2] & 255) << 16) | ((unsigned)(q[3] & 255) << 24);
        o.y = (unsigned)(q[4] & 255) | ((unsigned)(q[5] & 255) << 8) | ((unsigned)(q[6] & 255) << 16) | ((unsigned)(q[7] & 255) << 24);
        *(u32x2*)((unsigned char*)jb.dst + (size_t)row * jb.ldd + k0 + 8 * c) = o; }
    LDS_WAIT(); asm volatile("" ::: "memory");
}
__device__ __forceinline__ void row_to_bf16_ssq(const float* xrow, bf16_t* orow, float* ssqrow, int lane) {
    const f32x4* xr = (const f32x4*)xrow + lane; f32x4 v[8]; float s = 0.f;
#pragma unroll
    for (int j = 0; j < 8; ++j) { v[j] = xr[64 * j]; s += (v[j][0] * v[j][0] + v[j][1] * v[j][1]) + (v[j][2] * v[j][2] + v[j][3] * v[j][3]); }
    s = wave_sum(s);
    u32x2* o8 = (u32x2*)orow + lane;
#pragma unroll
    for (int j = 0; j < 8; ++j) { u32x2 w; w.x = cvt_pk_bf16(v[j][0], v[j][1]); w.y = cvt_pk_bf16(v[j][2], v[j][3]); o8[64 * j] = w; }
    if (lane < 32) ssqrow[lane] = lane == 0 ? s : 0.f;
}

__global__ void __launch_bounds__(NWAVES * 64, 2) trunk_fwd(Args args) {
    extern __shared__ __attribute__((aligned(16))) unsigned char lds_raw[];
    LAS unsigned char* lds = (LAS unsigned char*)lds_raw;
    volatile LAS unsigned* MISC = (volatile LAS unsigned*)(lds + MISC_OFF);
    const int tid = threadIdx.x, lane = tid & 63, wave = __builtin_amdgcn_readfirstlane(tid >> 6);
    const int G = gridDim.x; const int bx = blockIdx.x; const int vcu = (G % 8 == 0) ? (bx % 8) * (G / 8) + bx / 8 : bx;
    const int gw = vcu * NWAVES + wave, NGW = G * NWAVES;
    unsigned* ctl = (unsigned*)(args.ws + WS_CTL);
    const int lo = args.ph_lo, hi = args.ph_hi;
    const bool fused = (hi - lo) > 1;
    for (int u = tid; u < (LDS_BYTES - RING_BYTES) / 4; u += NWAVES * 64) ((LAS unsigned*)(lds + RING_BYTES))[u] = 0u;
    __syncthreads();
    XcdBarrier bar; bar.bar = ctl + CW_BAR; bar.x = 0; bar.st = nullptr;
    if (fused) bar = xcd_barrier_post(ctl + CW_BAR, MISC + 8);
#ifndef PH_MASK
#define PH_MASK 0xFFFFFFFFFFFFFFFFull
#endif
#define IN(k) ((((unsigned long long)PH_MASK >> (k)) & 1ull) && lo <= (k) && (k) < hi)
#define GRID_BAR(k) do { if (fused && IN((k) + 1)) xcd_barrier(bar); } while (0)
#ifndef DUP_MASK
#define DUP_MASK 0ull
#endif
#ifndef DUP_SUB
#define DUP_SUB 0
#endif
#define NREP(k) ((((unsigned long long)DUP_MASK >> (k)) & 1ull) ? 2 : 1)
#define PHASE(k) for (int rep_ = 0; rep_ < NREP(k) && IN(k); ++rep_)

#define WSL() GAS unsigned char* wsg_ = (GAS unsigned char*)args.ws; asm volatile("" : "+s"(wsg_)); unsigned char* ws = (unsigned char*)wsg_
#define XB ((bf16_t*)(ws + WS_XB))
#define SSQ ((float*)(ws + WS_SSQ))
#define ROPE ((float*)(ws + WS_ROPE))
#define MEMN ((bf16_t*)(ws + WS_MEMN))
#define SSQM ((float*)(ws + WS_SSQM))
#define MEMKV ((bf16_t*)(ws + WS_MEMKV))
#define SSQQ ((float*)(ws + WS_SSQQ))
#define SSQKV ((float*)(ws + WS_SSQKV))
#define QX ((bf16_t*)(ws + WS_QX))
#define OX ((bf16_t*)(ws + WS_OX))
#define FL ((float*)(ws + WS_FL))
#define DEC ((float*)(ws + WS_DEC))
#define TOPE ((int*)(ws + WS_TOPE))
#define TOPS ((int*)(ws + WS_TOPS))
#define TOPG ((float*)(ws + WS_TOPG))
#define RSTDF ((float*)(ws + WS_RSTDF))
#define TOKPOS ((int*)(ws + WS_TOKPOS))
#define ROWIDX ((int*)(ws + WS_ROWIDX))
#define GATEP ((float*)(ws + WS_GATEP))
#define RSTDP ((float*)(ws + WS_RSTDP))
#define BIAST ((float*)(ws + WS_BIAST))
#define Z0 ((bf16_t*)(ws + WS_ARENA + AR_Z0))
#define QM ((bf16_t*)(ws + WS_ARENA + AR_QM))
#define KM ((bf16_t*)(ws + WS_ARENA + AR_KM))
#define VM ((bf16_t*)(ws + WS_ARENA + AR_VM))
#define O0 ((bf16_t*)(ws + WS_ARENA + AR_O0))
#define HIDB(i) ((bf16_t*)(ws + WS_ARENA + AR_HID + (size_t)((i) & 1) * HID_BYTES))
#define YB ((bf16_t*)(ws + WS_ARENA + AR_Y))
#define Z1 ((bf16_t*)(ws + WS_ARENA + AR_Z1))
#define O1 ((bf16_t*)(ws + WS_ARENA + AR_O1))
#define XQ ((unsigned char*)(ws + WS_QX))
#define XH ((unsigned short*)(ws + WS_XB))
#define XIN ((const float*)args.in[I_X])

    PHASE(0) {
        WSL();
        LAS float* scr = (LAS float*)(lds + wave * 16384);
        LAS int* cum = (LAS int*)(lds + RING_BYTES + 4096);
        if (tid < N_CVT_JOBS) { const CvtJob jb = get_job(args, tid); cum[64 + tid] = jb.amax ? 0   : (jb.K / 64) * (jb.Npad / 32); }
        __syncthreads();
        if (tid == 0) { int run = 0; for (int j = 0; j < N_CVT_JOBS; ++j) { cum[j] = run; run += cum[64 + j]; } cum[N_CVT_JOBS] = run; cum[N_CVT_JOBS + 1] = 0x7fffffff; }
        __syncthreads();
        {
            const int total = cum[N_CVT_JOBS];
            float va[32], vb[32]; int jL = 0, jP = 0;
            if (gw < total) { const int li = cvt_find(cum, gw, jL); cvt_load(get_job(args, jL), li, lane, va); }
#pragma unroll 1
            for (int it = gw; it < total; it += 2 * NGW) {
                const int it2 = it + NGW, it3 = it + 2 * NGW;
                if (it2 < total) { const int li = cvt_find(cum, it2, jL); cvt_load(get_job(args, jL), li, lane, vb); }
                { const int li = cvt_find(cum, it, jP); const CvtJob jb = get_job(args, jP); cvt_store(jb, scr, li, lane, va); }
                if (it2 < total) {
                    if (it3 < total) { const int li = cvt_find(cum, it3, jL); cvt_load(get_job(args, jL), li, lane, va); }
                    const int li = cvt_find(cum, it2, jP); const CvtJob jb = get_job(args, jP); cvt_store(jb, scr, li, lane, vb);
                }
            }
        }
        for (int m = gw; m < M; m += NGW) {
            const f32x4* xr = (const f32x4*)(XIN + (size_t)m * DM) + lane; f32x4 v[8]; float ss = 0.f, amx = 0.f;
#pragma unroll
            for (int j = 0; j < 8; ++j) { v[j] = xr[64 * j]; ss += (v[j][0] * v[j][0] + v[j][1] * v[j][1]) + (v[j][2] * v[j][2] + v[j][3] * v[j][3]);
                amx = fmaxf(amx, fmaxf(fmaxf(fabsf(v[j][0]), fabsf(v[j][1])), fmaxf(fabsf(v[j][2]), fabsf(v[j][3])))); }
            ss = wave_sum(ss);
#pragma unroll
            for (int o_ = 1; o_ < 64; o_ <<= 1) amx = fmaxf(amx, __shfl_xor(amx, o_));
            const float inv = amx > 0.f ? 127.f / amx : 0.f; unsigned* xq = (unsigned*)((unsigned char*)XB + (size_t)m * DM) + lane;
#pragma unroll
            for (int j = 0; j < 8; ++j) { const int q0 = (int)__builtin_rintf(v[j][0] * inv), q1 = (int)__builtin_rintf(v[j][1] * inv), q2 = (int)__builtin_rintf(v[j][2] * inv), q3 = (int)__builtin_rintf(v[j][3] * inv);
                xq[64 * j] = (unsigned)(q0 & 255) | ((unsigned)(q1 & 255) << 8) | ((unsigned)(q2 & 255) << 16) | ((unsigned)(q3 & 255) << 24); }
            if (lane == 0) RSTDF[m] = __builtin_amdgcn_rsqf(ss * (1.f / DM) + EPS) * amx * (1.f / 127.f);
        }
        for (int m = gw; m < MROWS; m += NGW) row_to_bf16_ssq((const float*)args.in[I_MEM] + (size_t)m * DM, MEMN + (size_t)m * DM, SSQM + (size_t)m * 32, lane);
        const int* pos = (const int*)args.in[I_POS];
        int gt0_ = tid; asm volatile("" : "+v"(gt0_)); gt0_ += bx * 512;
        for (int e = gt0_; e < M * 32; e += G * 512) {
            const int row = e >> 5, i = e & 31;
            const float ang = (float)pos[row] * ROPE_INV[i];
            const double rev = (double)ang * 0.15915494309189535; const float fr = (float)(rev - __builtin_rint(rev));
            ROPE[(size_t)e * 2] = __builtin_amdgcn_cosf(fr); ROPE[(size_t)e * 2 + 1] = __builtin_amdgcn_sinf(fr);
        }
        const float* relb = (const float*)args.in[I_RELB];
        for (int e = gt0_; e < 16 * 128; e += G * 512) { const int h = e >> 7, d = e & 127; BIAST[e] = relb[(int)T5_BUCKET[d] * 16 + h] * LOG2E; }
        if (fused && IN(1) && !IN(44)) xcd_barrier(bar);
        __syncthreads();
    }

    PHASE(44) {
        LAS float* scr = (LAS float*)(lds + wave * 16384);
        LAS float* cam = (LAS float*)(lds + RING_BYTES + 4096);
        constexpr int NBJ = DFF / 32, NB15 = IN1_PAD / 32, NB0 = Z0_LD / 32, NB = 18 * NBJ + NB15 + NB0;
#define Q8DEC(cb_, j_, nb_) const int j_ = (cb_) >= 18 * NBJ + NB15 ? 0 : ((cb_) >= 18 * NBJ ? 15 : ((cb_) / NBJ < 2 ? 12 + (cb_) / NBJ : 15 + (cb_) / NBJ)); \
        const int nb_ = (cb_) >= 18 * NBJ + NB15 ? (cb_) - 18 * NBJ - NB15 : ((cb_) >= 18 * NBJ ? (cb_) - 18 * NBJ : (cb_) % NBJ)
        float v0[32], v1[32], v2[32], v3[32];
        if (bx < NB) { Q8DEC(bx, j, nb); const CvtJob jb = get_job(args, j); const int nblk = jb.Npad / 32;
            cvt_load(jb, (4 * wave + 0) * nblk + nb, lane, v0); cvt_load(jb, (4 * wave + 1) * nblk + nb, lane, v1);
            cvt_load(jb, (4 * wave + 2) * nblk + nb, lane, v2); cvt_load(jb, (4 * wave + 3) * nblk + nb, lane, v3); }
#pragma unroll 1
        for (int cb = bx; cb < NB; cb += G) {
            Q8DEC(cb, j, nb); const CvtJob jb = get_job(args, j); const int nblk = jb.Npad / 32;
            const int cn = cb + G; const bool more = cn < NB; Q8DEC(more ? cn : cb, jn, nbn); const CvtJob jbn = get_job(args, jn); const int nblkn = jbn.Npad / 32;
            float mx = fmaxf(fmaxf(cvt_amax_item(jb, (4 * wave + 0) * nblk + nb, lane, v0), cvt_amax_item(jb, (4 * wave + 1) * nblk + nb, lane, v1)),
                             fmaxf(cvt_amax_item(jb, (4 * wave + 2) * nblk + nb, lane, v2), cvt_amax_item(jb, (4 * wave + 3) * nblk + nb, lane, v3)));
            __syncthreads();
            if (lane < 32) cam[wave * 32 + lane] = mx;
            __syncthreads();
            if (lane < 32) { float m = cam[lane];
#pragma unroll
                for (int w = 1; w < 8; ++w) m = fmaxf(m, cam[w * 32 + lane]);
                cam[256 + wave * 32 + lane] = m;
                const int nn = 32 * nb + lane; if (wave == 0 && nn < jb.Nsrc) jb.amax[jb.row_off + cvt_row(jb.mode, nn)] = __float_as_uint(m); }
            LDS_WAIT(); asm volatile("" ::: "memory");
            const LAS float* camw = cam + 256 + wave * 32;
            cvt_store_q8(jb, scr, (4 * wave + 0) * nblk + nb, lane, v0, camw); if (more) cvt_load(jbn, (4 * wave + 0) * nblkn + nbn, lane, v0);
            cvt_store_q8(jb, scr, (4 * wave + 1) * nblk + nb, lane, v1, camw); if (more) cvt_load(jbn, (4 * wave + 1) * nblkn + nbn, lane, v1);
            cvt_store_q8(jb, scr, (4 * wave + 2) * nblk + nb, lane, v2, camw); if (more) cvt_load(jbn, (4 * wave + 2) * nblkn + nbn, lane, v2);
            cvt_store_q8(jb, scr, (4 * wave + 3) * nblk + nb, lane, v3, camw); if (more) cvt_load(jbn, (4 * wave + 3) * nblkn + nbn, lane, v3);
        }
#undef Q8DEC
        GRID_BAR(0);
    }

    PHASE(1) {
        WSL();
        { pg8::PolPlain P{(const char*)XB  , DM, (const char*)(ws + WS_WIN0)  , DM, DM / 2};
          pg8::StaticOrder S; S.init(M / 256, Z0_LD / 256, G, bx, 0, WGM_K2048);
          pg8::EpiStore<1, 32> E{Z0, Z0_LD, nullptr, (LAS float*)(lds + RING_BYTES + 12288), 1.f / DM, ROPE, SSQQ, SSQKV, nullptr, nullptr, nullptr, RSTDF, ctl + CW_AMAX0};
          pg8::gemm_phase<pg8::EpiStore<1, 32>, pg8::PolPlain, 1>(lds, P, S, E); }
        { pg8::PolPlain P{(const char*)MEMN, DM * 2, (const char*)(ws + WS_WXKV), DM * 2, DM};
          pg8::StaticOrder S; S.init(MROWS / 256, 2048 / 256, G, (G - 1) - bx, 0);
          pg8::EpiStore<0, 32> E{MEMKV, 2048, SSQM, (LAS float*)(lds + RING_BYTES + 12288), 1.f / DM, nullptr, nullptr, nullptr, nullptr, nullptr, nullptr};
          pg8::gemm_phase(lds, P, S, E); }
        GRID_BAR(1);
    }
    PHASE(2) {
        WSL();
        { pg8::PolPlain P{(const char*)Z0, Z0_LD * 2, (const char*)(ws + WS_WUQ), 768 * 2, 768};
          pg8::StaticOrder S; S.init(M / 256, 1536 / 256, G, bx, 0);
          pg8::EpiStore<2, 12> E{QM, QM_LD, SSQQ, (LAS float*)(lds + RING_BYTES + 12288), 1.f / 768.f, ROPE, nullptr, nullptr, nullptr, nullptr, nullptr};
          pg8::gemm_phase(lds, P, S, E); }
        { pg8::PolPlain P{(const char*)(Z0 + 768), Z0_LD * 2, (const char*)(ws + WS_WUKV), 512 * 2, 512};
          pg8::StaticOrder S; S.init(M / 256, 2048 / 256, G, bx, 0);
          pg8::EpiStore<3, 8> E{KM, KM_LD, SSQKV, (LAS float*)(lds + RING_BYTES + 12288), 1.f / 512.f, nullptr, nullptr, nullptr, VM, Z0, nullptr};
          pg8::gemm_phase(lds, P, S, E); }
        GRID_BAR(2);
    }
    PHASE(3) {
        WSL();
#pragma unroll 1
        for (int r3_ = 0; r3_ < (DUP_SUB == 1 ? 2 : 1); ++r3_)
#pragma unroll 1
        for (int it = vcu; it < BATCH * 8 * 32; it += G) {
            const int bh = it >> 5, x = it & 31, b = bh >> 3, h = bh & 7;
#pragma unroll 1
            for (int pass = 0; pass < 2; ++pass) { const int qb = pass ? x : 63 - x;
                fa::AttnArgs a; a.Q = QM + (size_t)b * SEQ * QM_LD + h * 192; a.ldq = QM_LD; a.K = KM + (size_t)b * SEQ * KM_LD + h * 192; a.ldk = KM_LD;
                a.V = VM + (size_t)b * SEQ * VM_LD + h * 128; a.ldv = VM_LD; a.O = O0 + (size_t)b * SEQ * DM + h * 128; a.ldo = DM;
                a.q0 = qb * 256; a.j_lo = 0; a.j_hi = qb * 4 + 4; a.W = 0x3fffffff; a.dec = nullptr; a.sinkl = 0.f; a.sinks = nullptr; a.biasT = nullptr; a.kmax = 0.f;
                fa::attn_unit<192, 128, 0>(a, (LAS char*)lds); } }
        const float* sinks = (const float*)args.in[I_SINKS];
#pragma unroll 1
        for (int r3_ = 0; r3_ < (DUP_SUB == 2 ? 2 : 1); ++r3_)
#pragma unroll 1
        for (int it = vcu; it < BATCH * 2 * (SEQ / 32); it += G) {
            const int bk = it >> 9, qb = it & 511, b = bk >> 1, kvh = bk & 1, q0 = qb * 32;
            fa::AttnArgs a; const bf16_t* zb = Z0 + (size_t)b * SEQ * Z0_LD;
            a.Q = zb + 1344 + kvh * 512; a.ldq = Z0_LD; a.K = zb + 2368 + kvh * 64; a.ldk = Z0_LD; a.V = zb + 2496 + kvh * 64; a.ldv = Z0_LD;
            a.O = O0 + (size_t)b * SEQ * DM + 1024 + kvh * 512; a.ldo = DM;
            a.q0 = q0; a.j_lo = q0 - 127 < 0 ? 0 : (q0 - 127) >> 6; a.j_hi = ((q0 + 31) >> 6) + 1; a.W = 128; a.dec = nullptr; a.sinkl = 0.f; a.sinks = sinks + kvh * 8;
            a.biasT = BIAST + kvh * 8 * 128; a.kmax = 0.f;
            fa::attn_unit<64, 64, 2>(a, (LAS char*)lds); }
        GRID_BAR(3);
    }
    PHASE(4) {
        WSL();
        pg8::PolPlain P{(const char*)O0, DM * 2, (const char*)(ws + WS_WO0), DM * 2, DM};
        pg8::StaticOrder S; S.init(M / 256, DM / 256, G, bx, 0, WGM_K2048);
        pg8::EpiRes<true> E{XIN, XH, SSQ};
        pg8::gemm_phase(lds, P, S, E);
        GRID_BAR(4);
    }
#define CROSS_PHASES(l, s0) \
    PHASE(s0) { WSL(); \
        pg8::PolPlain P{(const char*)XH  , DM * 2, (const char*)(ws + WS_WXQ + (size_t)(l) * E_XQ * 2)  , DM * 2, DM}; \
        pg8::StaticOrder S; S.init(M / 256, 512 / 256, G, bx, 0, WGM_K2048); \
        pg8::EpiStore<0, 32> E{QX, 512, SSQ, (LAS float*)(lds + RING_BYTES + 12288), 1.f / DM, nullptr, nullptr, nullptr, nullptr, nullptr, nullptr}; \
        pg8::gemm_phase<pg8::EpiStore<0, 32>, pg8::PolPlain, 3>(lds, P, S, E); \
        GRID_BAR(s0); } \
    PHASE((s0) + 1) { WSL(); \
        _Pragma("unroll 1") for (int it = vcu; it < BATCH * 4 * 64; it += G) { \
            const int bh = it >> 6, qb = it & 63, b = bh >> 2, h = bh & 3; \
            fa::AttnArgs a; a.Q = QX + (size_t)b * SEQ * 512 + h * 128; a.ldq = 512; a.K = MEMKV + (size_t)b * MEMLEN * 2048 + (l) * 1024 + h * 128; a.ldk = 2048; \
            a.V = a.K + 512; a.ldv = 2048; a.O = OX + (size_t)b * SEQ * 512 + h * 128; a.ldo = 512; \
            a.q0 = qb * 256; a.j_lo = 0; a.j_hi = 4; a.W = 0x3fffffff; a.dec = nullptr; a.sinkl = 0.f; a.sinks = nullptr; a.biasT = nullptr; a.kmax = 0.f; \
            fa::attn_unit<128, 128, 3>(a, (LAS char*)lds); } \
        GRID_BAR((s0) + 1); } \
    PHASE((s0) + 2) { WSL(); \
        pg8::PolPlain P{(const char*)OX, 512 * 2, (const char*)(ws + WS_WXO + (size_t)(l) * E_XO * 2), 512 * 2, 512}; \
        pg8::StaticOrder S; S.init(M / 256, DM / 256, G, bx, 0); \
        pg8::EpiRes<false> E{XH, XH, nullptr};           \
        pg8::gemm_phase(lds, P, S, E); \
        GRID_BAR((s0) + 2); }
    CROSS_PHASES(0, 5)
    PHASE(45) {
        WSL();
#pragma unroll 1
        for (int m = gw; m < M; m += NGW) {
            const u32x2* xr = (const u32x2*)(XH + (size_t)m * DM) + lane; f32x4 v[8]; float ss = 0.f, amx = 0.f;
#pragma unroll
            for (int j = 0; j < 8; ++j) { v[j] = unpk_f16x4(xr[64 * j]); ss += (v[j][0] * v[j][0] + v[j][1] * v[j][1]) + (v[j][2] * v[j][2] + v[j][3] * v[j][3]);
                amx = fmaxf(amx, fmaxf(fmaxf(fabsf(v[j][0]), fabsf(v[j][1])), fmaxf(fabsf(v[j][2]), fabsf(v[j][3])))); }
            ss = wave_sum(ss);
#pragma unroll
            for (int o_ = 1; o_ < 64; o_ <<= 1) amx = fmaxf(amx, __shfl_xor(amx, o_));
            const float inv = amx > 0.f ? 127.f / amx : 0.f; unsigned* xq = (unsigned*)(XQ + (size_t)m * DM) + lane;
#pragma unroll
            for (int j = 0; j < 8; ++j) { const int q0 = (int)__builtin_rintf(v[j][0] * inv), q1 = (int)__builtin_rintf(v[j][1] * inv), q2 = (int)__builtin_rintf(v[j][2] * inv), q3 = (int)__builtin_rintf(v[j][3] * inv);
                xq[64 * j] = (unsigned)(q0 & 255) | ((unsigned)(q1 & 255) << 8) | ((unsigned)(q2 & 255) << 16) | ((unsigned)(q3 & 255) << 24); }
            if (lane == 0) RSTDF[m] = __builtin_amdgcn_rsqf(ss * (1.f / DM) + EPS) * amx * (1.f / 127.f);
        }
        GRID_BAR(7);
    }
#pragma unroll 1
    for (int p = 0; p < 5; ++p) {
        PHASE(8 + p) {
            if (p >= 1) {
                WSL();
                const int c = p - 1;
                pg8::PolChunkA P{(const char*)HIDB(c), 128, (const char*)(ws + WS_WD0), 128, DFF, c * CHUNK_TILES};
                pg8::StaticOrder S; S.init(CHUNK_TILES, DM / 256, G, bx, c * CHUNK_TILES, WGM_DOWN);
                pg8::EpiRes<false> E{XH, XH, SSQ};
                pg8::gemm_phase(lds, P, S, E);
            }
            int pg = p; asm volatile("" : "+s"(pg));
            if (pg <= 3) {
                WSL();
                pg8::PolPlain P{(const char*)XQ, DM, (const char*)(ws + WS_WGU0)  , DM, DM / 2};
                pg8::StaticOrder S; S.init(CHUNK_TILES, 2 * DFF / 256, G, bx, pg * CHUNK_TILES, WGM_GU);
                pg8::EpiSwiGLU<2> E{HIDB(pg), pg * CHUNK_ROWS, nullptr, RSTDF, ctl + CW_AMAXW + 8 * 2 * DFF, nullptr};
                pg8::gemm_phase<pg8::EpiSwiGLU<2>, pg8::PolPlain, 1>(lds, P, S, E);
            }
            GRID_BAR(8 + p);
        }
    }
    PHASE(46) {
        WSL();
#pragma unroll 1
        for (int m = gw; m < M; m += NGW) {
            const u32x2* xr = (const u32x2*)(XH + (size_t)m * DM) + lane; f32x4 v[8]; float ss = 0.f, amx = 0.f;
#pragma unroll
            for (int j = 0; j < 8; ++j) { v[j] = unpk_f16x4(xr[64 * j]); ss += (v[j][0] * v[j][0] + v[j][1] * v[j][1]) + (v[j][2] * v[j][2] + v[j][3] * v[j][3]);
                amx = fmaxf(amx, fmaxf(fmaxf(fabsf(v[j][0]), fabsf(v[j][1])), fmaxf(fabsf(v[j][2]), fabsf(v[j][3])))); }
            ss = wave_sum(ss);
#pragma unroll
            for (int o_ = 1; o_ < 64; o_ <<= 1) amx = fmaxf(amx, __shfl_xor(amx, o_));
            const float inv = amx > 0.f ? 127.f / amx : 0.f; unsigned* xq = (unsigned*)(XQ + (size_t)m * DM) + lane;
#pragma unroll
            for (int j = 0; j < 8; ++j) { const int q0 = (int)__builtin_rintf(v[j][0] * inv), q1 = (int)__builtin_rintf(v[j][1] * inv), q2 = (int)__builtin_rintf(v[j][2] * inv), q3 = (int)__builtin_rintf(v[j][3] * inv);
                xq[64 * j] = (unsigned)(q0 & 255) | ((unsigned)(q1 & 255) << 8) | ((unsigned)(q2 & 255) << 16) | ((unsigned)(q3 & 255) << 24); }
            if (lane == 0) RSTDF[m] = __builtin_amdgcn_rsqf(ss * (1.f / DM) + EPS) * amx * (1.f / 127.f);
        }
        GRID_BAR(15);
    }
    PHASE(16) {
        WSL();
        pg8::PolPlain P{(const char*)XQ  , DM, (const char*)(ws + WS_WIN1)  , DM, DM / 2};
        pg8::StaticOrder S; S.init(M / 256, IN1_PAD / 256, G, bx, 0, WGM_K2048);
        pg8::EpiStore<4, 32> E{Z1, Z1_LD, nullptr, (LAS float*)(lds + RING_BYTES + 12288), 1.f / DM, nullptr, nullptr, nullptr, nullptr, nullptr, FL, RSTDF, ctl + CW_AMAX15};
        pg8::gemm_phase<pg8::EpiStore<4, 32>, pg8::PolPlain, 1>(lds, P, S, E);
        GRID_BAR(16);
    }
    PHASE(17) {
        WSL();
#pragma unroll 1
        for (int b = 0; b < BATCH; ++b) {
            float kmx = 0.f;
#pragma unroll 1
            for (int r = gw; r < SEQ; r += NGW) {
                const u32x4* kp = (const u32x4*)(Z1 + ((size_t)b * SEQ + r) * Z1_LD + 2048 + lane * 32); float ss = 0.f;
#pragma unroll
                for (int q = 0; q < 4; ++q) { const u32x4 w = kp[q];
#pragma unroll
                    for (int e = 0; e < 4; ++e) { const float lo_ = __uint_as_float(w[e] << 16), hi_ = __uint_as_float(w[e] & 0xffff0000u); ss += lo_ * lo_ + hi_ * hi_; } }
                ss += __shfl_xor(ss, 1); ss += __shfl_xor(ss, 2);
                kmx = fmaxf(kmx, ss);
            }
            if ((lane & 3) == 0) atomicMax(ctl + CW_KMAX + 64 * (b * 16 + (lane >> 2)), __float_as_uint(kmx));
        }
        const float* bfv = (const float*)args.in[I_BF];
        LAS double* wtot = (LAS double*)lds;
#pragma unroll 1
        for (int bh = bx; bh < BATCH * 16; bh += G) {
            const int b = bh >> 4, h = bh & 15; const float bias = bfv[h];
            const size_t base = ((size_t)b * SEQ + (size_t)tid * 32) * 16 + h;
            float lf[32]; double run = 0.0;
#pragma unroll
            for (int i = 0; i < 32; ++i) { const float xv = FL[base + (size_t)i * 16] + bias; lf[i] = fminf(xv, 0.f) - log1pf(expf(-fabsf(xv))); }
#pragma unroll
            for (int i = 0; i < 32; ++i) run += (double)lf[i];
            double incl = run;
#pragma unroll
            for (int o = 1; o < 64; o <<= 1) { const double t = __shfl_up(incl, o); if (lane >= o) incl += t; }
            float Aa = 1.f, Bb = 0.f;
#pragma unroll
            for (int i = 0; i < 32; ++i) { const float a_ = __expf(lf[i]); Bb = a_ * Bb + 1.f; Aa *= a_; }
            float Ai = Aa, Bi = Bb;
#pragma unroll
            for (int o = 1; o < 64; o <<= 1) { const float Ap = __shfl_up(Ai, o), Bp = __shfl_up(Bi, o); if (lane >= o) { Bi = Ai * Bp + Bi; Ai = Ai * Ap; } }
            LAS float* wAB = (LAS float*)(lds + 256);
            if (lane == 63) { wtot[wave] = incl; wAB[wave] = Ai; wAB[8 + wave] = Bi; }
            __syncthreads();
            { float Ss = 0.f; for (int w = 0; w < wave; ++w) Ss = wAB[w] * Ss + wAB[8 + w];
              float Ae = __shfl_up(Ai, 1), Be = __shfl_up(Bi, 1); if (lane == 0) { Ae = 1.f; Be = 0.f; }
              const float nk = __expf(lf[0]) * (Ae * Ss + Be);
              if ((tid & 1) == 0) ((float*)ctl)[CW_NEFF + bh * 256 + (tid >> 1)] = nk > 0.f ? log2f(nk) + 0.01f : -100.f; }
            double off = incl - run;
            for (int w = 0; w < wave; ++w) off += wtot[w];
            double cacc = off;
#pragma unroll
            for (int i = 0; i < 32; ++i) { cacc += (double)lf[i]; DEC[base + (size_t)i * 16] = (float)(cacc * 1.4426950408889634); }
            __syncthreads();
        }
        GRID_BAR(17);
    }
    PHASE(18) {
        WSL();
        LAS int* qslot = (LAS int*)(lds + RING_BYTES + 8192);
#pragma unroll 1
        for (;;) {
            if (tid == 0) qslot[0] = (int)__hip_atomic_fetch_add(ctl + CW_Q18, 1u, RLX_AGENT);
            __syncthreads();
            const int u = qslot[0];
            __syncthreads();
            if (u >= BATCH * 16 * 64) break;
            const int qb = 63 - (u >> 5), bh = u & 31, b = bh >> 4, h = bh & 15;
            fa::AttnArgs a; const bf16_t* zb = Z1 + (size_t)b * SEQ * Z1_LD;
            a.Q = zb + h * 128; a.ldq = Z1_LD; a.K = zb + 2048 + h * 128; a.ldk = Z1_LD; a.V = zb + 4096 + h * 128; a.ldv = Z1_LD;
            a.O = O1 + (size_t)b * SEQ * DM + h * 128; a.ldo = DM;
            a.q0 = qb * 256; a.j_lo = 0; a.j_hi = qb * 4 + 4; a.W = 0x3fffffff; a.dec = DEC + (size_t)b * SEQ * 16 + h; a.sinkl = 0.f; a.sinks = nullptr; a.biasT = nullptr;
            a.kmax = sqrtf(__uint_as_float(__hip_atomic_load(ctl + CW_KMAX + 64 * bh, RLX_AGENT))); a.neff = (const float*)ctl + CW_NEFF + bh * 256;
            fa::attn_unit<128, 128, 1>(a, (LAS char*)lds);
        }
        GRID_BAR(18);
    }
    PHASE(19) {
        WSL();
        pg8::PolPlain P{(const char*)O1, DM * 2, (const char*)(ws + WS_WO1), DM * 2, DM};
        pg8::StaticOrder S; S.init(M / 256, DM / 256, G, bx, 0, WGM_K2048);
        pg8::EpiRes<false> E{XH, XH, SSQ};
        pg8::gemm_phase(lds, P, S, E);
        GRID_BAR(19);
    }
    CROSS_PHASES(1, 20)
    PHASE(23) {
        WSL();
        LAS float* WrT = (LAS float*)lds;
        const float* rw = (const float*)args.in[I_RW]; const float* gn = (const float*)args.in[I_NFFN] + DM; const float* rb = (const float*)args.in[I_RB];
        for (int i = tid; i < 8 * DM; i += 512) { const int e = i >> 11, k = i & 2047; WrT[i] = rw[k * 8 + e] * gn[k]; }
        __syncthreads();
#pragma unroll 1
        for (int g16 = gw; g16 < M / 16; g16 += NGW) {
            int e1 = 0, e2 = 0; float g1 = 0.f, g2 = 0.f, rstd = 0.f;
#pragma unroll 1
            for (int i = 0; i < 16; ++i) {
                const int row = g16 * 16 + i;
                const u32x2* xr = (const u32x2*)(XH + (size_t)row * DM) + lane;
                float pe[8], ss = 0.f, amx = 0.f;
#pragma unroll
                for (int e = 0; e < 8; ++e) pe[e] = 0.f;
#pragma unroll 2
                for (int j = 0; j < 8; ++j) { const f32x4 v = unpk_f16x4(xr[64 * j]); ss += (v[0] * v[0] + v[1] * v[1]) + (v[2] * v[2] + v[3] * v[3]);
                    amx = fmaxf(amx, fmaxf(fmaxf(fabsf(v[0]), fabsf(v[1])), fmaxf(fabsf(v[2]), fabsf(v[3]))));
#pragma unroll
                    for (int e = 0; e < 8; ++e) { const f32x4 w = *(const LAS f32x4*)(WrT + e * DM + 256 * j + lane * 4); pe[e] += (v[0] * w[0] + v[1] * w[1]) + (v[2] * w[2] + v[3] * w[3]); } }
                ss = wave_sum(ss);
#pragma unroll
                for (int e = 0; e < 8; ++e) pe[e] = wave_sum(pe[e]);
                const float rs = __builtin_amdgcn_rsqf(ss * (1.f / DM) + EPS);
#pragma unroll
                for (int o_ = 1; o_ < 64; o_ <<= 1) amx = fmaxf(amx, __shfl_xor(amx, o_));
                { const float inv = amx > 0.f ? 127.f / amx : 0.f; unsigned* xq = (unsigned*)(XQ + (size_t)row * DM) + lane;
#pragma unroll 2
                  for (int j = 0; j < 8; ++j) { const f32x4 v = unpk_f16x4(xr[64 * j]);
                      const int q0 = (int)__builtin_rintf(v[0] * inv), q1 = (int)__builtin_rintf(v[1] * inv), q2 = (int)__builtin_rintf(v[2] * inv), q3 = (int)__builtin_rintf(v[3] * inv);
                      xq[64 * j] = (unsigned)(q0 & 255) | ((unsigned)(q1 & 255) << 8) | ((unsigned)(q2 & 255) << 16) | ((unsigned)(q3 & 255) << 24); } }
                const float rowf = rs * amx * (1.f / 127.f);
                float lg[8];
#pragma unroll
                for (int e = 0; e < 8; ++e) lg[e] = pe[e] * rs + rb[e];
                int b1 = 0; float v1 = lg[0];
#pragma unroll
                for (int e = 1; e < 8; ++e) if (lg[e] > v1) { v1 = lg[e]; b1 = e; }
                int b2 = -1; float v2 = -__builtin_inff();
#pragma unroll
                for (int e = 0; e < 8; ++e) if (e != b1 && lg[e] > v2) { v2 = lg[e]; b2 = e; }
                const float ex = __expf(v2 - v1); const float gg2 = ex / (1.f + ex), gg1 = 1.f / (1.f + ex);
                if (lane == i) { e1 = b1; e2 = b2; g1 = gg1; g2 = gg2; rstd = rowf; }
            }
            int s1 = 0, s2 = 0;
#pragma unroll
            for (int e = 0; e < 8; ++e) {
                const unsigned long long m1 = __ballot(lane < 16 && e1 == e), m2 = __ballot(lane < 16 && e2 == e);
                const int c1 = __popcll(m1), c2 = __popcll(m2);
                int basev = 0;
                if (lane == 0 && c1 + c2 > 0) basev = (int)__hip_atomic_fetch_add(ctl + CW_CNT + 64 * e, (unsigned)(c1 + c2), RLX_AGENT);
                basev = __shfl(basev, 0);
                const unsigned long long lt = (1ull << lane) - 1ull;
                if (lane < 16 && e1 == e) s1 = basev + __popcll(m1 & lt);
                if (lane < 16 && e2 == e) s2 = basev + c1 + __popcll(m2 & lt);
            }
            if (lane < 16) { const int row = g16 * 16 + lane; TOPE[row * 2] = e1; TOPE[row * 2 + 1] = e2; TOPS[row * 2] = s1; TOPS[row * 2 + 1] = s2;
                TOPG[row * 2] = g1; TOPG[row * 2 + 1] = g2; RSTDF[row] = rstd; }
        }
        GRID_BAR(23);
    }
    if (hi > 24) {
#define EOFF() int eoff[9]; eoff[0] = 0; _Pragma("unroll") for (int e = 0; e < 8; ++e) { const int c_ = (int)__hip_atomic_load(ctl + CW_CNT + 64 * e, RLX_AGENT); eoff[e + 1] = eoff[e] + ((c_ + 255) & ~255); }
        PHASE(24) {
            WSL();
            EOFF();
            int ecnt[8];
#pragma unroll
            for (int e = 0; e < 8; ++e) ecnt[e] = (int)__hip_atomic_load(ctl + CW_CNT + 64 * e, RLX_AGENT);
            int gt1_ = tid; asm volatile("" : "+v"(gt1_)); gt1_ += bx * 512;
            for (int i = gt1_; i < M * 2; i += G * 512) {
                const int e = TOPE[i], sl = TOPS[i]; int off = 0;
#pragma unroll
                for (int q = 0; q < 8; ++q) if (q == e) off = eoff[q];
                const int pos = off + sl; ROWIDX[pos] = i >> 1; GATEP[pos] = TOPG[i]; RSTDP[pos] = RSTDF[i >> 1]; TOKPOS[i] = pos;
            }
            for (int i = gt1_; i < 8 * 256; i += G * 512) {
                const int e = i >> 8, j = i & 255; int off = 0, cnt = 0, nxt = 0;
#pragma unroll
                for (int q = 0; q < 8; ++q) if (q == e) { off = eoff[q]; cnt = ecnt[q]; nxt = eoff[q + 1]; }
                const int pos = off + cnt + j;
                if (pos < nxt) { ROWIDX[pos] = 0; GATEP[pos] = 0.f; RSTDP[pos] = 0.f; }
            }
            GRID_BAR(24);
        }
        LAS int* TILE_E = (LAS int*)(lds + RING_BYTES + 1024);
        if (hi > 25) {
            EOFF();
            for (int t = tid; t < MOE_MAX_TILES; t += 512) { int e = 0;
#pragma unroll
                for (int q = 1; q < 8; ++q) if (t * 256 >= eoff[q]) e = q;
                TILE_E[t] = e; }
            if (tid == 0) TILE_E[MOE_MAX_TILES] = eoff[8] >> 8;
            __syncthreads();
        }
#pragma unroll 1
        for (int p = 0; p <= MOE_CHUNKS; ++p) {
            PHASE(25 + p) {
                int ndown = 0;
                { WSL();
                const int ntiles = TILE_E[MOE_MAX_TILES], nch = (ntiles + MCH_TILES - 1) / MCH_TILES, t0 = ntiles - MCH_TILES * (nch - 1);
                if (p >= 1 && p - 1 < nch) {
                    const int c = p - 1, ft = c == 0 ? 0 : t0 + (c - 1) * MCH_TILES, nt_ = c == 0 ? t0 : MCH_TILES;
                    pg8::PolMoeDown P{(const char*)HIDB(c)  , 128, (const char*)(ws + WS_WD1)  , 128, DFF / 2, ft, TILE_E, E_D};
                    pg8::StaticOrder S; S.init(nt_, DM / 256, G, bx, ft, WGM_DOWN);
                    pg8::EpiMoeDown E{YB, GATEP};
                    pg8::gemm_phase<pg8::EpiMoeDown, pg8::PolMoeDown, 4>(lds, P, S, E);
                    ndown = nt_ * (DM / 256);
                } }
                int pg = p; asm volatile("" : "+s"(pg), "+s"(ndown));
                { WSL();
                const int ntiles = TILE_E[MOE_MAX_TILES], nch = (ntiles + MCH_TILES - 1) / MCH_TILES, t0 = ntiles - MCH_TILES * (nch - 1);
                if (pg < nch) {
                    const int ft = pg == 0 ? 0 : t0 + (pg - 1) * MCH_TILES, nt_ = pg == 0 ? t0 : MCH_TILES;
                    pg8::PolMoeUp P{(const char*)XQ  , DM, (const char*)(ws + WS_WGU1)  , DM, DM / 2, ROWIDX, TILE_E, E_GU};
                    pg8::StaticOrder S; S.init(nt_, 2 * DFF / 256, G, bx, ft, WGM_GU); S.quota(ndown);
                    pg8::EpiSwiGLU<2> E{HIDB(pg), ft * 256, nullptr, RSTDP, ctl + CW_AMAXW, TILE_E, 1};
                    pg8::gemm_phase<pg8::EpiSwiGLU<2>, pg8::PolMoeUp, 1>(lds, P, S, E);
                } }
                GRID_BAR(25 + p);
            }
        }
    }
    PHASE(43) {
        WSL();
        const float* fn = (const float*)args.in[I_FNORM];
#pragma unroll 1
        for (int m = gw; m < M; m += NGW) {
            const int p0 = TOKPOS[m * 2], p1 = TOKPOS[m * 2 + 1];
            const u32x2* xr = (const u32x2*)(XH + (size_t)m * DM) + lane; f32x4* orow = (f32x4*)(args.out + (size_t)m * DM) + lane;
            const u32x2* y0 = (const u32x2*)(YB + (size_t)p0 * DM) + lane; const u32x2* y1 = (const u32x2*)(YB + (size_t)p1 * DM) + lane;
            f32x4 v[8]; float s = 0.f;
#pragma unroll
            for (int j = 0; j < 8; ++j) { v[j] = unpk_f16x4(xr[64 * j]); const u32x2 a0 = y0[64 * j], a1 = y1[64 * j];
                v[j][0] += __uint_as_float(a0.x << 16) + __uint_as_float(a1.x << 16); v[j][1] += __uint_as_float(a0.x & 0xffff0000u) + __uint_as_float(a1.x & 0xffff0000u);
                v[j][2] += __uint_as_float(a0.y << 16) + __uint_as_float(a1.y << 16); v[j][3] += __uint_as_float(a0.y & 0xffff0000u) + __uint_as_float(a1.y & 0xffff0000u);
                s += (v[j][0] * v[j][0] + v[j][1] * v[j][1]) + (v[j][2] * v[j][2] + v[j][3] * v[j][3]); }
            s = wave_sum(s); const float rs = __builtin_amdgcn_rsqf(s * (1.f / DM) + EPS);
#pragma unroll
            for (int j = 0; j < 8; ++j) { const f32x4 g = *((const f32x4*)fn + lane + 64 * j); orow[64 * j] = v[j] * rs * g; }
        }
    }
#undef IN
#undef GRID_BAR
}

constexpr int N_STEPS = 47;
extern "C" void kernel_launch(void* const* d_in, const int* in_sizes, int n_in, void* d_out, int out_size, void* d_ws, size_t ws_size, hipStream_t stream) {
    static int grid = 0;
    if (grid == 0) {
        if (n_in != N_IN || in_sizes[0] != M * DM || out_size != M * DM || ws_size < WS_END) {
            fprintf(stderr, "kernel_launch: shape / workspace mismatch (n_in %d, in0 %d, out %d, ws %zu, need %zu); nothing launched\n", n_in, n_in > 0 ? in_sizes[0] : -1, out_size, ws_size, (size_t)WS_END); grid = -1; return; }
        int dev = 0, cus = 0, per_cu = 0;
        if (hipGetDevice(&dev) != hipSuccess || hipDeviceGetAttribute(&cus, hipDeviceAttributeMultiprocessorCount, dev) != hipSuccess) { grid = -1; return; }
        if (hipFuncSetAttribute((const void*)trunk_fwd, hipFuncAttributeMaxDynamicSharedMemorySize, LDS_BYTES) != hipSuccess) { fprintf(stderr, "kernel_launch: hipFuncSetAttribute failed\n"); grid = -1; return; }
        if (hipOccupancyMaxActiveBlocksPerMultiprocessor(&per_cu, (const void*)trunk_fwd, NWAVES * 64, LDS_BYTES) != hipSuccess || per_cu < 1)
            fprintf(stderr, "kernel_launch: note: occupancy query reports %d workgroups per CU\n", per_cu);
        (void)hipGetLastError();
        grid = cus;
    }
    if (grid < 0) return;
    if (hipMemsetAsync((char*)d_ws + WS_CTL, 0, CTL_BYTES, stream) != hipSuccess) return;
    Args a{};
    for (int i = 0; i < N_IN; ++i) a.in[i] = d_in[i];
    a.out = (float*)d_out; a.ws = (unsigned char*)d_ws;
#if MK_ONE_LAUNCH
    a.ph_lo = 0; a.ph_hi = N_STEPS;
    hipLaunchKernelGGL(trunk_fwd, dim3(grid), dim3(NWAVES * 64), LDS_BYTES, stream, a);
#else
    for (int i = 0; i < N_STEPS; ++i) { const int s = i == 0 ? 0 : (i == 1 ? 44 : (i <= 8 ? i - 1 : (i == 9 ? 45 : (i <= 14 ? i - 2 : (i == 15 ? 46 : i - 3))))); a.ph_lo = s; a.ph_hi = s + 1; hipLaunchKernelGGL(trunk_fwd, dim3(grid), dim3(NWAVES * 64), LDS_BYTES, stream, a); }
#endif
}
```

```cpp
#include <hip/hip_runtime.h>
#include <hip/hip_bf16.h>
#include <cstdio>
#include <cstdint>
#include <cmath>

#ifndef MK_ONE_LAUNCH
#define MK_ONE_LAUNCH 1
#endif

#define GAS __attribute__((address_space(1)))
#define LAS __attribute__((address_space(3)))
typedef unsigned short bf16_t;
typedef short bf16x8 __attribute__((ext_vector_type(8)));
typedef short s16x4 __attribute__((ext_vector_type(4)));
typedef float f32x2 __attribute__((ext_vector_type(2)));
typedef float f32x4 __attribute__((ext_vector_type(4)));
typedef float f32x16 __attribute__((ext_vector_type(16)));
typedef unsigned u32x2 __attribute__((ext_vector_type(2)));
typedef unsigned u32x4 __attribute__((ext_vector_type(4)));
typedef int i32x4 __attribute__((ext_vector_type(4)));
typedef long i64x2 __attribute__((ext_vector_type(2)));

constexpr int BATCH = 2, SEQ = 16384, DM = 2048, M = BATCH * SEQ, MEMLEN = 256, MROWS = BATCH * MEMLEN;
constexpr int EVEN_IN = 2624, Z0_LD = 2816, ODD_IN = 6160, Z1_LD = 6144, IN1_PAD = 6400;
constexpr int DFF = 7168, NEXP = 8;
constexpr int HLD = DFF + 64;
constexpr int QM_LD = 1536, KM_LD = 1536, VM_LD = 1024;
constexpr float LOG2E = 1.4426950408889634f;
constexpr float C2_MLA = LOG2E * 0.07216878364870323f;
constexpr float C2_SWA = LOG2E * 0.125f;
constexpr float C2_128 = LOG2E * 0.08838834764831845f;
constexpr float EPS = 1e-6f;
constexpr int CHUNK_ROWS = 8192, CHUNK_TILES = 32, MOE_MAX_TILES = 264, MOE_MAX_ROWS = MOE_MAX_TILES * 256;
constexpr int MCH_TILES = 64, MCH_ROWS = MCH_TILES * 256, MOE_CHUNKS = (MOE_MAX_TILES + MCH_TILES - 1) / MCH_TILES;

enum { I_X = 0, I_MEM, I_POS, I_RELB, I_NMIX, I_NCROSS, I_NMEM, I_NFFN, I_XWQ, I_XWK, I_XWV, I_XWO, I_EVWIN, I_QNORM, I_WUQ, I_KVNORM, I_WUKV, I_SINKS, I_EVWO,
       I_FG, I_FU, I_FD, I_ODWIN, I_BF, I_ODWO, I_RW, I_RB, I_MG, I_MU, I_MD, I_FNORM, N_IN };

constexpr size_t al256(size_t x) { return (x + 255) & ~(size_t)255; }
constexpr size_t WS_CTL = 0, CTL_BYTES = 1u << 20;
constexpr size_t E_IN0 = (size_t)Z0_LD * DM, E_UQ = (size_t)1536 * 768, E_UKV = (size_t)2048 * 512, E_SQ = (size_t)DM * DM, E_XQ = (size_t)512 * DM, E_XKV = (size_t)2048 * DM,
                 E_XO = (size_t)DM * 512, E_GU = (size_t)2 * DFF * DM, E_D = (size_t)DM * DFF, E_IN1 = (size_t)IN1_PAD * DM;
constexpr size_t WS_WIN0 = WS_CTL + CTL_BYTES;
constexpr size_t WS_WUQ = WS_WIN0 + 2 * E_IN0;
constexpr size_t WS_WUKV = WS_WUQ + 2 * E_UQ;
constexpr size_t WS_WO0 = WS_WUKV + 2 * E_UKV;
constexpr size_t WS_WXQ = WS_WO0 + 2 * E_SQ;
constexpr size_t WS_WXKV = WS_WXQ + 2 * 2 * E_XQ;
constexpr size_t WS_WXO = WS_WXKV + 2 * E_XKV;
constexpr size_t WS_WGU0 = WS_WXO + 2 * 2 * E_XO;
constexpr size_t WS_WD0 = WS_WGU0 + 2 * E_GU;
constexpr size_t WS_WIN1 = WS_WD0 + 2 * E_D;
constexpr size_t WS_WO1 = WS_WIN1 + 2 * E_IN1;
constexpr size_t WS_WGU1 = WS_WO1 + 2 * E_SQ;
constexpr size_t WS_WD1 = WS_WGU1 + 2 * 8 * E_GU;
constexpr size_t WS_XB = WS_WD1 + 2 * 8 * E_D;
constexpr size_t WS_SSQ = WS_XB + (size_t)M * DM * 2;
constexpr size_t WS_ROPE = WS_SSQ + (size_t)M * 32 * 4;
constexpr size_t WS_MEMN = WS_ROPE + (size_t)M * 64 * 4;
constexpr size_t WS_SSQM = WS_MEMN + (size_t)MROWS * DM * 2;
constexpr size_t WS_MEMKV = WS_SSQM + (size_t)MROWS * 32 * 4;
constexpr size_t WS_SSQQ = WS_MEMKV + (size_t)MROWS * 2048 * 2;
constexpr size_t WS_SSQKV = WS_SSQQ + (size_t)M * 12 * 4;
constexpr size_t WS_QX = WS_SSQKV + (size_t)M * 8 * 4;
constexpr size_t WS_OX = WS_QX + (size_t)M * 512 * 2;
constexpr size_t WS_FL = WS_OX + (size_t)M * 512 * 2;
constexpr size_t WS_DEC = WS_FL + (size_t)M * 16 * 4;
constexpr size_t WS_TOPE = WS_DEC + (size_t)M * 16 * 4;
constexpr size_t WS_TOPS = WS_TOPE + (size_t)M * 2 * 4;
constexpr size_t WS_TOPG = WS_TOPS + (size_t)M * 2 * 4;
constexpr size_t WS_RSTDF = WS_TOPG + (size_t)M * 2 * 4;
constexpr size_t WS_TOKPOS = WS_RSTDF + (size_t)M * 4;
constexpr size_t WS_ROWIDX = WS_TOKPOS + (size_t)M * 2 * 4;
constexpr size_t WS_GATEP = WS_ROWIDX + (size_t)MOE_MAX_ROWS * 4;
constexpr size_t WS_RSTDP = WS_GATEP + (size_t)MOE_MAX_ROWS * 4;
constexpr size_t WS_BIAST = WS_RSTDP + (size_t)MOE_MAX_ROWS * 4;
constexpr size_t WS_ARENA = al256(WS_BIAST + 16 * 128 * 4);
constexpr size_t AR_Z0 = 0;
constexpr size_t AR_QM = AR_Z0 + (size_t)M * Z0_LD * 2;
constexpr size_t AR_KM = AR_QM + (size_t)M * QM_LD * 2;
constexpr size_t AR_VM = AR_KM + (size_t)M * KM_LD * 2;
constexpr size_t AR_O0 = AR_VM + (size_t)M * VM_LD * 2;
constexpr size_t AR_END0 = AR_O0 + (size_t)M * DM * 2;
constexpr size_t AR_HID = 0;
constexpr size_t HID_BYTES = (size_t)CHUNK_ROWS * DFF * 2;
constexpr size_t AR_Y = AR_HID + 2 * HID_BYTES;
constexpr size_t AR_END2 = AR_Y + (size_t)MOE_MAX_ROWS * DM * 2;
constexpr size_t AR_Z1 = 0;
constexpr size_t AR_O1 = AR_Z1 + (size_t)M * Z1_LD * 2;
constexpr size_t AR_END1 = AR_O1 + (size_t)M * DM * 2;
constexpr size_t AR_SIZE = AR_END0 > AR_END1 ? (AR_END0 > AR_END2 ? AR_END0 : AR_END2) : (AR_END1 > AR_END2 ? AR_END1 : AR_END2);
constexpr size_t WS_END = WS_ARENA + AR_SIZE;

constexpr int CW_BAR = 4096;
constexpr int CW_CNT = 16384;
constexpr int CW_KMAX = 20480;
constexpr int CW_Q18 = 24576;
constexpr int CW_AMAX15 = 32768;
constexpr int CW_AMAX0 = 40960;
constexpr int CW_NEFF = 65536;
constexpr int CW_AMAXW = 131072;
static_assert((CW_AMAXW + 9 * 14336) * 4 <= (int)CTL_BYTES, "CTL map");

constexpr int RING_BYTES = 131072;
constexpr int MISC_OFF = RING_BYTES + 320;
constexpr int LDS_BYTES = 147456;
constexpr int NWAVES = 8;
#ifndef WGM_GU
#define WGM_GU 4
#endif
#ifndef WGM_K2048
#define WGM_K2048 4
#endif
#ifndef WGM_DOWN
#define WGM_DOWN 8
#endif

#define LDS_WAIT() asm volatile("s_waitcnt lgkmcnt(0)" ::: "memory")
#define VM_WAIT() asm volatile("s_waitcnt vmcnt(0)" ::: "memory")
#define RLX_AGENT __ATOMIC_RELAXED, __HIP_MEMORY_SCOPE_AGENT
__device__ __forceinline__ unsigned cvt_pk_bf16(float lo, float hi) { unsigned r; asm volatile("v_cvt_pk_bf16_f32 %0, %1, %2" : "=v"(r) : "v"(lo), "v"(hi)); return r; }
typedef _Float16 h16x2 __attribute__((ext_vector_type(2)));
typedef _Float16 h16x8 __attribute__((ext_vector_type(8)));
__device__ __forceinline__ unsigned pk_f16(float lo, float hi) { const h16x2 v = {(_Float16)lo, (_Float16)hi}; return __builtin_bit_cast(unsigned, v); }
__device__ __forceinline__ f32x2 unpk_f16(unsigned u) { const h16x2 v = __builtin_bit_cast(h16x2, u); return (f32x2){(float)v.x, (float)v.y}; }
__device__ __forceinline__ f32x4 unpk_f16x4(u32x2 u) { const f32x2 a = unpk_f16(u.x), b = unpk_f16(u.y); return (f32x4){a.x, a.y, b.x, b.y}; }
__device__ __forceinline__ u32x2 pack8_fp8(f32x4 a, f32x4 b) {
    int lo = 0, hi = 0;
    lo = __builtin_amdgcn_cvt_pk_fp8_f32(a[0], a[1], lo, false); lo = __builtin_amdgcn_cvt_pk_fp8_f32(a[2], a[3], lo, true);
    hi = __builtin_amdgcn_cvt_pk_fp8_f32(b[0], b[1], hi, false); hi = __builtin_amdgcn_cvt_pk_fp8_f32(b[2], b[3], hi, true);
    return (u32x2){(unsigned)lo, (unsigned)hi};
}
__device__ __forceinline__ float bf2f(unsigned short b) { return __uint_as_float((unsigned)b << 16); }
__device__ __forceinline__ float wave_sum(float v) {
#pragma unroll
    for (int o = 1; o < 64; o <<= 1) v += __shfl_xor(v, o);
    return v;
}

#define XB_TMO      128
#define XB_XCNT(j)  (256  + 64 * (j))
#define XB_XSUB(j)  (1280 + 64 * (j))
#define XB_XGEN(j)  (2304 + 64 * (j))
#define XB_TOP      3328
#define XB_TOPGEN   3392
#define XCD_BAR_WORDS 3456
#define XB_SPIN_CAP (1u << 18)
__device__ __forceinline__ unsigned xb_ld(unsigned* p)              { return __hip_atomic_load(p, __ATOMIC_RELAXED, __HIP_MEMORY_SCOPE_AGENT); }
__device__ __forceinline__ unsigned xb_add(unsigned* p, unsigned v) { return __hip_atomic_fetch_add(p, v, __ATOMIC_RELAXED, __HIP_MEMORY_SCOPE_AGENT); }
__device__ __forceinline__ unsigned xb_xcc_id() { return (unsigned)__builtin_amdgcn_s_getreg((3 << 11) | 20) & 0xFu; }
#define XB_SPIN(cond, bar) do { unsigned _sp = 0; while (cond) { __builtin_amdgcn_s_sleep(1); \
    if ((++_sp & 255u) == 0u) { if (xb_ld(&(bar)[XB_TMO])) break; if (_sp > XB_SPIN_CAP) { atomicAdd(&(bar)[XB_TMO], 1u); break; } } } } while (0)
struct XcdBarrier { unsigned* bar; unsigned x; volatile LAS unsigned* st; };
__device__ __forceinline__ XcdBarrier xcd_barrier_post(unsigned* bar, volatile LAS unsigned* st) {
    XcdBarrier b; b.bar = bar; b.x = xb_xcc_id(); b.st = st;
    if (threadIdx.x == 0) (void)xb_add(&bar[XB_XCNT(b.x)], 1u);
    return b;
}
__device__ __forceinline__ void xcd_barrier_complete(unsigned* bar, unsigned x, unsigned& nloc, unsigned& nx) {
    const unsigned G = gridDim.x * gridDim.y * gridDim.z;
    unsigned sum, cnt, mine, sp = 0u;
    for (;;) {
        sum = 0u; cnt = 0u; mine = 0u;
#pragma unroll
        for (unsigned j = 0; j < 16; ++j) { const unsigned c = xb_ld(&bar[XB_XCNT(j)]); sum += c; cnt += (c > 0u) ? 1u : 0u; mine = (j == x) ? c : mine; }
        if (sum == G) break;
        __builtin_amdgcn_s_sleep(1);
        if ((++sp & 255u) == 0u) { if (xb_ld(&bar[XB_TMO])) break; if (sp > XB_SPIN_CAP) { atomicAdd(&bar[XB_TMO], 1u); break; } }
    }
    nloc = mine > 0u ? mine : 1u; nx = cnt > 0u ? cnt : 1u;
}
__device__ __forceinline__ void xcd_barrier(const XcdBarrier& b) {
    asm volatile("s_waitcnt vmcnt(0)" ::: "memory");
    __syncthreads();
    if (threadIdx.x == 0) {
        unsigned* bar = b.bar;
        __builtin_amdgcn_s_waitcnt(0);
        unsigned nloc = b.st[0], nx = b.st[1];
        if (nloc == 0u) { xcd_barrier_complete(bar, b.x, nloc, nx); b.st[0] = nloc; b.st[1] = nx; }
        const unsigned old = xb_add(&bar[XB_XSUB(b.x)], 1u);
        const unsigned gen = old / nloc;
        if (old + 1u == (gen + 1u) * nloc) {
            __builtin_amdgcn_fence(__ATOMIC_RELEASE, "agent");
            asm volatile("s_waitcnt vmcnt(0)" ::: "memory");
            const unsigned og = xb_add(&bar[XB_TOP], 1u);
            const unsigned tg = og / nx;
            if (og + 1u == (tg + 1u) * nx) xb_add(&bar[XB_TOPGEN], 1u);
            else XB_SPIN(xb_ld(&bar[XB_TOPGEN]) == tg, bar);
            __builtin_amdgcn_fence(__ATOMIC_ACQUIRE, "agent");
            xb_add(&bar[XB_XGEN(b.x)], 1u);
            asm volatile("s_waitcnt vmcnt(0)" ::: "memory");
        } else {
            XB_SPIN(xb_ld(&bar[XB_XGEN(b.x)]) == gen, bar);
            __builtin_amdgcn_fence(__ATOMIC_ACQUIRE, "agent");
            asm volatile("s_waitcnt vmcnt(0)" ::: "memory");
        }
    }
    __syncthreads();
}

namespace pg8 {
constexpr int BM = 256, BK = 64, HALF = 128, HTB = HALF * BK * 2, STAGE_BYTES = 8 * HTB, NXCD = 8, WGM = 8;
__host__ __device__ __forceinline__ int lds_byte(int r, int c) { const int st = (r >> 4) * 2 + (c >> 5), rr = r & 15, cc = c & 31, ob = rr * 64 + cc * 2; return st * 1024 + (ob ^ (((ob >> 9) & 1) << 5)); }
__host__ __device__ __forceinline__ void stage_rc(int b, int& R, int& C) { const int st = b / 1024, sb = b % 1024, swz = sb ^ (((sb >> 9) & 1) << 5); R = (st >> 1) * 16 + swz / 64; C = (st & 1) * 32 + (swz % 64) / 2; }
__host__ __device__ __forceinline__ int perm32(int rho) { const int n = rho >> 4, i = rho & 15; return 8 * (i >> 2) + 4 * n + (i & 3); }
struct Unit { int pm, pn; };
struct StaticOrder {
    int nM, nN, nwg, G, c, pm0, nd, qd, wgm;
    __device__ __forceinline__ void init(int nM_, int nN_, int G_, int c_, int pm0_, int wgm_ = WGM) { nM = nM_; nN = nN_; nwg = nM * nN; G = G_; c = c_; pm0 = pm0_; nd = 0; qd = 0; wgm = wgm_; }
    __device__ __forceinline__ void quota(int nd_) { nd = nd_ < G ? nd_ : 0; if (nd_ >= G) return; const int q = (nwg + 5 * nd + G - 1) / G; qd = q > 5 ? q - 5 : 0; }
    __device__ __forceinline__ bool next(int i, Unit& u) const {
        long L;
        if (nd == 0) L = (long)i * G + c;
        else if (c < nd) { if (i >= qd) return false; L = (long)i * G + c; }
        else L = i < qd ? (long)i * G + c : (long)qd * G + (long)(i - qd) * (G - nd) + (c - nd);
        if (L >= nwg) return false;
        int wgid = (int)L; { const int q = nwg / NXCD, r = nwg % NXCD, xcd = wgid % NXCD, off = wgid / NXCD; wgid = (xcd < r ? xcd * (q + 1) : r * (q + 1) + (xcd - r) * q) + off; }
        const int nig = wgm * nN, gid = wgid / nig, fm = gid * wgm, gsz = (nM - fm) < wgm ? (nM - fm) : wgm;
        u.pm = pm0 + fm + ((wgid % nig) % gsz); u.pn = (wgid % nig) / gsz; return true;
    }
};
struct PolPlain {
    const char* A; unsigned lda2; const char* B; unsigned ldb2; int K;
    __device__ __forceinline__ size_t kstepA() const { return 128; }
    __device__ __forceinline__ size_t kstepB() const { return 128; }
    __device__ __forceinline__ unsigned a_off(const Unit& u, int h, int R, int C) const { return (unsigned)(u.pm * BM + h * HALF + R) * lda2 + (unsigned)C * 2u; }
    __device__ __forceinline__ const char* b_ptr(const Unit& u) const { return B + (size_t)u.pn * BM * ldb2; }
};
struct PolMoeUp {
    const char* A; unsigned lda2; const char* B; unsigned ldb2; int K; const int* rowidx; const LAS int* tile_e; size_t estride;
    __device__ __forceinline__ size_t kstepA() const { return 128; }
    __device__ __forceinline__ size_t kstepB() const { return 128; }
    __device__ __forceinline__ unsigned a_off(const Unit& u, int h, int R, int C) const { return (unsigned)rowidx[u.pm * BM + h * HALF + R] * lda2 + (unsigned)C * 2u; }
    __device__ __forceinline__ const char* b_ptr(const Unit& u) const { return B + (size_t)tile_e[u.pm] * estride + (size_t)u.pn * BM * ldb2; }
};
struct PolMoeDown {
    const char* A; unsigned lda2; const char* B; unsigned ldb2; int K; int pmc0; const LAS int* tile_e; size_t estride;
    __device__ __forceinline__ size_t kstepA() const { return (size_t)MCH_ROWS * 128; }
    __device__ __forceinline__ size_t kstepB() const { return (size_t)DM * 128; }
    __device__ __forceinline__ unsigned a_off(const Unit& u, int h, int R, int C) const { return (unsigned)((u.pm - pmc0) * BM + h * HALF + R) * 128u + (unsigned)C * 2u; }
    __device__ __forceinline__ const char* b_ptr(const Unit& u) const { return B + (size_t)tile_e[u.pm] * estride + (size_t)u.pn * BM * 128; }
};
struct PolChunkA {
    const char* A; unsigned lda2; const char* B; unsigned ldb2; int K; int pmc0;
    __device__ __forceinline__ size_t kstepA() const { return (size_t)CHUNK_ROWS * 128; }
    __device__ __forceinline__ size_t kstepB() const { return (size_t)DM * 128; }
    __device__ __forceinline__ unsigned a_off(const Unit& u, int h, int R, int C) const { return (unsigned)((u.pm - pmc0) * BM + h * HALF + R) * 128u + (unsigned)C * 2u; }
    __device__ __forceinline__ const char* b_ptr(const Unit& u) const { return B + (size_t)u.pn * BM * 128; }
};

template <int I8> struct AccT { typedef f32x4 type; };
template <> struct AccT<1> { typedef i32x4 type; };
template <class Epi, class Pol, int I8 = 0>
__device__ __forceinline__ void gemm_phase(LAS unsigned char* lds, const Pol& P, const StaticOrder& S, const Epi& E) {
    typedef typename AccT<I8>::type acc_t;
    int tid_ = threadIdx.x; asm volatile("" : "+v"(tid_));
    const int tid = tid_, wid = __builtin_amdgcn_readfirstlane(tid >> 6), lane = tid & 63, wr = wid >> 2, wc = wid & 3, fr = lane & 15, fq = lane >> 4;
    const int K = P.K, nt = K / BK;
    int sR[2], sC[2]; unsigned voffB[2];
#pragma unroll
    for (int i = 0; i < 2; ++i) { int R, C; stage_rc(tid * 16 + i * 8192, R, C); sR[i] = R; sC[i] = C; const int Rb = (R & ~31) + perm32(R & 31); voffB[i] = (unsigned)Rb * P.ldb2 + (unsigned)C * 2u; }
    const size_t kstepA = P.kstepA(), kstepB = P.kstepB();
    const size_t hstepB = (size_t)HALF * P.ldb2;
    const unsigned ldsw = (unsigned)wid * 1024u;
    const int aoff = lds_byte(wr * 64 + fr, fq * 8), boff = lds_byte(wc * 32 + fr, fq * 8);
#define PG8_SA(b, h) (((b) * 2 + (h)) * HTB)
#define PG8_SB(b, h) ((4 + (b) * 2 + (h)) * HTB)
#define PG8_STAGE(bufoff, gbase, voff) do { _Pragma("unroll") for (int _i = 0; _i < 2; ++_i) \
        __builtin_amdgcn_global_load_lds((const unsigned*)((const char*)(gbase) + (voff)[_i]), (LAS unsigned*)(lds + (bufoff) + ldsw + _i * 8192), 16, 0, 0); } while (0)
#define PG8_LDA(dst, b, h) do { _Pragma("unroll") for (int m = 0; m < 4; ++m) _Pragma("unroll") for (int k = 0; k < 2; ++k) dst[m][k] = *(const LAS bf16x8*)(lds + PG8_SA(b, h) + aoff + m * 2048 + k * 1024); } while (0)
#define PG8_LDB(dst, b, h) do { _Pragma("unroll") for (int n = 0; n < 2; ++n) _Pragma("unroll") for (int k = 0; k < 2; ++k) dst[n][k] = *(const LAS bf16x8*)(lds + PG8_SB(b, h) + boff + n * 2048 + k * 1024); } while (0)
#define PG8_MMA(ai, bj, At, Bt) do { __builtin_amdgcn_s_setprio(1); _Pragma("unroll") for (int m = 0; m < 4; ++m) _Pragma("unroll") for (int n = 0; n < 2; ++n) _Pragma("unroll") for (int k = 0; k < 2; ++k) \
        { if constexpr (I8 == 1) acc[ai][bj][m][n] = __builtin_amdgcn_mfma_i32_16x16x64_i8(__builtin_bit_cast(i32x4, Bt[n][k]), __builtin_bit_cast(i32x4, At[m][k]), acc[ai][bj][m][n], 0, 0, 0); \
          else if constexpr (I8 == 4) { const i64x2 b_ = __builtin_bit_cast(i64x2, Bt[n][k]), a_ = __builtin_bit_cast(i64x2, At[m][k]); \
              acc[ai][bj][m][n] = __builtin_amdgcn_mfma_f32_16x16x32_fp8_fp8(b_[0], a_[0], acc[ai][bj][m][n], 0, 0, 0); acc[ai][bj][m][n] = __builtin_amdgcn_mfma_f32_16x16x32_fp8_fp8(b_[1], a_[1], acc[ai][bj][m][n], 0, 0, 0); } \
          else if constexpr (I8 == 3) acc[ai][bj][m][n] = __builtin_amdgcn_mfma_f32_16x16x32_f16(__builtin_bit_cast(h16x8, Bt[n][k]), __builtin_bit_cast(h16x8, At[m][k]), acc[ai][bj][m][n], 0, 0, 0); \
          else acc[ai][bj][m][n] = __builtin_amdgcn_mfma_f32_16x16x32_bf16(Bt[n][k], At[m][k], acc[ai][bj][m][n], 0, 0, 0); } __builtin_amdgcn_s_setprio(0); } while (0)
#define PG8_WAIT_V(n) asm volatile("s_waitcnt vmcnt(" #n ")" ::: "memory")
#define PG8_WAIT_L(n) asm volatile("s_waitcnt lgkmcnt(" #n ")" ::: "memory")
#define PG8_BAR __builtin_amdgcn_s_barrier()
#define PG8_SCHED __builtin_amdgcn_sched_barrier(0)
    Unit cur, nxt; int ui = 0;
    if (!S.next(0, cur)) return;
    LAS unsigned char* sl_ = lds + RING_BYTES + 4096;
#define PG8_SCALES(u_, slot) do { if constexpr (Epi::LDS_SCALES) { \
        if (wid == 0) __builtin_amdgcn_global_load_lds((const unsigned*)(E.row_src(u_)) + lane * 4, (LAS unsigned*)(sl_ + (slot) * 2048), 16, 0, 0); \
        else if (wid == 1) __builtin_amdgcn_global_load_lds((const unsigned*)(E.col_src(u_)) + lane * 4, (LAS unsigned*)(sl_ + (slot) * 2048 + 1024), 16, 0, 0); } } while (0)
    PG8_SCALES(cur, 0);
    acc_t acc[2][2][4][2];
#pragma unroll
    for (int a = 0; a < 2; ++a)
#pragma unroll
        for (int b = 0; b < 2; ++b)
#pragma unroll
            for (int m = 0; m < 4; ++m)
#pragma unroll
                for (int n = 0; n < 2; ++n) acc[a][b][m][n] = acc_t{};
    bf16x8 At[4][2], B0[2][2], B1[2][2];
    unsigned vC0[2], vC1[2], vN0[2], vN1[2];
#pragma unroll
    for (int i = 0; i < 2; ++i) { vC0[i] = P.a_off(cur, 0, sR[i], sC[i]); vC1[i] = P.a_off(cur, 1, sR[i], sC[i]); }
    const char* Ab = P.A; const char* cB = P.b_ptr(cur);
    PG8_STAGE(PG8_SB(0, 0), cB, voffB); PG8_STAGE(PG8_SB(0, 1), cB + hstepB, voffB); PG8_STAGE(PG8_SA(0, 0), Ab, vC0); PG8_STAGE(PG8_SA(0, 1), Ab, vC1);
    if (wr == 1) PG8_BAR;
    PG8_WAIT_V(2); PG8_BAR;
    PG8_STAGE(PG8_SB(1, 0), cB + kstepB, voffB); PG8_STAGE(PG8_SA(1, 0), Ab + kstepA, vC0); PG8_STAGE(PG8_SB(1, 1), cB + hstepB + kstepB, voffB);
    PG8_WAIT_V(6); PG8_BAR;
    for (;;) {
        const bool has_next = S.next(ui + 1, nxt);
        const char* nB = cB;
#pragma unroll
        for (int i = 0; i < 2; ++i) { vN0[i] = vC0[i]; vN1[i] = vC1[i]; }
        if (has_next) { nB = P.b_ptr(nxt);
#pragma unroll
            for (int i = 0; i < 2; ++i) { vN0[i] = P.a_off(nxt, 0, sR[i], sC[i]); vN1[i] = P.a_off(nxt, 1, sR[i], sC[i]); } }
        int tsc_ = 4; asm volatile("" : "+s"(tsc_));
#pragma unroll 1
        for (int t = 0; t < nt; t += 2) {
            const bool last = (t == nt - 2);
            if (t == tsc_ && has_next) PG8_SCALES(nxt, (ui + 1) & 1);
            const char* a1 = Ab + (size_t)(t + 1) * kstepA;
            const char* a2 = last ? Ab : Ab + (size_t)(t + 2) * kstepA; const char* b2 = last ? nB : cB + (size_t)(t + 2) * kstepB;
            const char* a3 = a2 + kstepA; const char* b3 = b2 + kstepB;
            unsigned v20[2], v21[2];
#pragma unroll
            for (int i = 0; i < 2; ++i) { v20[i] = last ? vN0[i] : vC0[i]; v21[i] = last ? vN1[i] : vC1[i]; }
            PG8_LDB(B0, 0, 0); PG8_LDB(B1, 0, 1); PG8_SCHED; PG8_LDA(At, 0, 0); PG8_STAGE(PG8_SA(1, 1), a1, vC1);
            PG8_WAIT_V(8); PG8_WAIT_L(0); PG8_BAR; PG8_MMA(0, 0, At, B0); PG8_MMA(0, 1, At, B1); PG8_BAR; PG8_SCHED;
            PG8_LDA(At, 0, 1); PG8_STAGE(PG8_SB(0, 0), b2, voffB); PG8_STAGE(PG8_SB(0, 1), b2 + hstepB, voffB); PG8_STAGE(PG8_SA(0, 0), a2, v20);
            PG8_WAIT_V(8); PG8_WAIT_L(0); PG8_BAR; PG8_MMA(1, 0, At, B0); PG8_MMA(1, 1, At, B1); PG8_BAR; PG8_SCHED;
            PG8_LDB(B0, 1, 0); PG8_LDB(B1, 1, 1); PG8_SCHED; PG8_LDA(At, 1, 0); PG8_STAGE(PG8_SA(0, 1), a2, v21);
            PG8_WAIT_V(8); PG8_WAIT_L(0); PG8_BAR; PG8_MMA(0, 0, At, B0); PG8_MMA(0, 1, At, B1); PG8_BAR; PG8_SCHED;
            PG8_LDA(At, 1, 1); PG8_STAGE(PG8_SB(1, 0), b3, voffB); PG8_STAGE(PG8_SB(1, 1), b3 + hstepB, voffB); PG8_STAGE(PG8_SA(1, 0), a3, v20);
            PG8_WAIT_V(8); PG8_WAIT_L(0); PG8_BAR; PG8_MMA(1, 0, At, B0); PG8_MMA(1, 1, At, B1); PG8_BAR; PG8_SCHED;
        }
        if (wr == 0) PG8_BAR;
        E(acc, cur, wr, wc, fr, fq, (const LAS unsigned char*)(sl_ + (ui & 1) * 2048));
        if (!has_next) break;
#pragma unroll
        for (int a = 0; a < 2; ++a)
#pragma unroll
            for (int b = 0; b < 2; ++b)
#pragma unroll
                for (int m = 0; m < 4; ++m)
#pragma unroll
                    for (int n = 0; n < 2; ++n) acc[a][b][m][n] = acc_t{};
        cur = nxt; cB = nB; ++ui;
#pragma unroll
        for (int i = 0; i < 2; ++i) { vC0[i] = vN0[i]; vC1[i] = vN1[i]; }
        if (wr == 1) PG8_BAR;
    }
    PG8_WAIT_V(0);
    PG8_BAR;
#undef PG8_SA
#undef PG8_SB
#undef PG8_STAGE
#undef PG8_SCALES
#undef PG8_LDA
#undef PG8_LDB
#undef PG8_MMA
#undef PG8_WAIT_V
#undef PG8_WAIT_L
#undef PG8_BAR
#undef PG8_SCHED
}

__device__ __forceinline__ float row_rstd(const float* ssq, int row, int nparts, float inv_n) {
    const f32x4* p = (const f32x4*)(ssq + (size_t)row * nparts); f32x4 s = p[0];
    for (int i = 1; i < nparts / 4; ++i) s += p[i];
    return __builtin_amdgcn_rsqf(((s[0] + s[1]) + (s[2] + s[3])) * inv_n + EPS);
}
template <int NP>
__device__ __forceinline__ void wave_row_rstd(const float* ssq, float inv_n, int rowbase, int wr, int wid, int fr, LAS float* xl, float (&rs)[8]) {
    const int lane = threadIdx.x & 63; LAS float* wl = xl + wid * 128;
    f32x4 sa = (f32x4){0.f, 0.f, 0.f, 0.f}, sb = sa;
    const f32x4* pa = (const f32x4*)(ssq + (size_t)(rowbase + wr * 64 + lane) * NP); const f32x4* pb = (const f32x4*)(ssq + (size_t)(rowbase + HALF + wr * 64 + lane) * NP);
#pragma unroll
    for (int i = 0; i < NP / 4; ++i) { sa += pa[i]; sb += pb[i]; }
    wl[lane] = __builtin_amdgcn_rsqf(((sa[0] + sa[1]) + (sa[2] + sa[3])) * inv_n + EPS);
    wl[64 + lane] = __builtin_amdgcn_rsqf(((sb[0] + sb[1]) + (sb[2] + sb[3])) * inv_n + EPS);
    asm volatile("s_waitcnt lgkmcnt(0)" ::: "memory");
#pragma unroll
    for (int ai = 0; ai < 2; ++ai)
#pragma unroll
        for (int m = 0; m < 4; ++m) rs[ai * 4 + m] = wl[ai * 64 + 16 * m + fr];
    asm volatile("s_waitcnt lgkmcnt(0)" ::: "memory");
}
__device__ __forceinline__ void rope8(f32x4& v0, f32x4& v1, const float* tab  ) {
    const f32x4 t0 = *(const f32x4*)tab, t1 = *(const f32x4*)(tab + 4);
    f32x4 a = v0, b = v1;
    v0[0] = a[0] * t0[0] - a[1] * t0[1]; v0[1] = a[1] * t0[0] + a[0] * t0[1]; v0[2] = a[2] * t0[2] - a[3] * t0[3]; v0[3] = a[3] * t0[2] + a[2] * t0[3];
    v1[0] = b[0] * t1[0] - b[1] * t1[1]; v1[1] = b[1] * t1[0] + b[0] * t1[1]; v1[2] = b[2] * t1[2] - b[3] * t1[3]; v1[3] = b[3] * t1[2] + b[2] * t1[3];
}
__device__ __forceinline__ u32x4 pack8(f32x4 v0, f32x4 v1) { u32x4 w; w.x = cvt_pk_bf16(v0[0], v0[1]); w.y = cvt_pk_bf16(v0[2], v0[3]); w.z = cvt_pk_bf16(v1[0], v1[1]); w.w = cvt_pk_bf16(v1[2], v1[3]); return w; }
__device__ __forceinline__ float sq8(f32x4 v0, f32x4 v1) { return (v0[0] * v0[0] + v0[1] * v0[1]) + (v0[2] * v0[2] + v0[3] * v0[3]) + (v1[0] * v1[0] + v1[1] * v1[1]) + (v1[2] * v1[2] + v1[3] * v1[3]); }

__device__ __forceinline__ f32x4 acc_f(const f32x4& a) { return a; }
__device__ __forceinline__ f32x4 acc_f(const i32x4& a) { return __builtin_convertvector(a, f32x4); }
template <int MODE, int NP> struct EpiStore {
    bf16_t* O; int ldc; const float* ssq; LAS float* xl; float inv_n;
    const float* rope; float* ssq_q; float* ssq_kv;
    bf16_t* O2; const bf16_t* Zsrc; float* Flog;
    const float* rowf; const unsigned* cmax;
    static constexpr bool LDS_SCALES = (MODE == 1 || MODE == 4);
    __device__ __forceinline__ const float* row_src(const Unit& u) const { return rowf + u.pm * BM; }
    __device__ __forceinline__ const unsigned* col_src(const Unit& u) const { return cmax + u.pn * BM; }
    template <class ACC>
    __device__ __forceinline__ void operator()(const ACC (&acc)[2][2][4][2], const Unit& u, int wr, int wc, int fr, int fq, const LAS unsigned char* lsc) const {
        const int row0 = u.pm * BM + wr * 64 + fr;
        float rs8[8];
        const LAS unsigned* cp = (const LAS unsigned*)(lsc + 1024) + wc * 32 + 8 * fq; const LAS float* rp = (const LAS float*)lsc + wr * 64 + fr;
        if (!LDS_SCALES) wave_row_rstd<NP>(ssq, inv_n, u.pm * BM, wr, wr * 4 + wc, fr, xl, rs8);
#pragma unroll
        for (int ai = 0; ai < 2; ++ai)
#pragma unroll
            for (int m = 0; m < 4; ++m) {
                const int row = row0 + ai * HALF + m * 16;
                const float rs = LDS_SCALES ? rp[ai * HALF + m * 16] * (1.f / 127.f) : rs8[ai * 4 + m];
                float sq = 0.f;
#pragma unroll
                for (int bj = 0; bj < 2; ++bj) {
                    const int col = u.pn * BM + bj * HALF + wc * 32 + 8 * fq;
                    f32x4 v0 = acc_f(acc[ai][bj][m][0]) * rs, v1 = acc_f(acc[ai][bj][m][1]) * rs;
                    if (LDS_SCALES) { const u32x4 c0 = *(const LAS u32x4*)(cp + bj * HALF), c1 = *(const LAS u32x4*)(cp + bj * HALF + 4);
                        v0 *= (f32x4){__uint_as_float(c0.x), __uint_as_float(c0.y), __uint_as_float(c0.z), __uint_as_float(c0.w)};
                        v1 *= (f32x4){__uint_as_float(c1.x), __uint_as_float(c1.y), __uint_as_float(c1.z), __uint_as_float(c1.w)}; }
                    if (MODE == 1) { if (col >= 1280 && col < 1344) rope8(v0, v1, rope + (size_t)row * 64 + (col - 1280)); sq += sq8(v0, v1); }
                    if (MODE == 2) { const int w = col % 192; if (w >= 128) rope8(v0, v1, rope + (size_t)row * 64 + (w - 128)); }
                    if (MODE == 3) {
                        if (bj == 0) *(u32x4*)(O + (size_t)row * KM_LD + u.pn * 192 + wc * 32 + 8 * fq) = pack8(v0, v1);
                        else *(u32x4*)(O2 + (size_t)row * VM_LD + u.pn * 128 + wc * 32 + 8 * fq) = pack8(v0, v1);
                    } else if (MODE == 4) {
                        if (u.pn < 24) *(u32x4*)(O + (size_t)row * ldc + col) = pack8(v0, v1);
                        else if (bj == 0 && wc == 0 && fq < 2) { *(f32x4*)(Flog + (size_t)row * 16 + 8 * fq) = v0; *(f32x4*)(Flog + (size_t)row * 16 + 8 * fq + 4) = v1; }
                    } else *(u32x4*)(O + (size_t)row * ldc + col) = pack8(v0, v1);
                }
                if (MODE == 1 && u.pn < 5) {
                    sq += __shfl_xor(sq, 16); sq += __shfl_xor(sq, 32);
                    if (fq == 0) { if (u.pn < 3) ssq_q[(size_t)row * 12 + u.pn * 4 + wc] = sq; else ssq_kv[(size_t)row * 8 + (u.pn - 3) * 4 + wc] = sq; }
                }
                asm volatile("" ::: "memory");
            }
        if (MODE == 3) {
            const int tid = (wr * 4 + wc) * 64 + fq * 16 + fr;
#pragma unroll
            for (int i = 0; i < 4; ++i) { const int idx = tid + 512 * i, r = idx >> 3, c = idx & 7; const size_t row = (size_t)u.pm * BM + r;
                *(u32x4*)(O + row * KM_LD + u.pn * 192 + 128 + c * 8) = *(const u32x4*)(Zsrc + row * Z0_LD + 1280 + c * 8); }
        }
    }
};
template <bool BF32> struct EpiRes {
    const void* base; unsigned short* out; float* ssq; float sc = 1.f;
    static constexpr bool LDS_SCALES = false;
    __device__ __forceinline__ void operator()(const f32x4 (&acc)[2][2][4][2], const Unit& u, int wr, int wc, int fr, int fq, const LAS unsigned char*) const {
        const int row0 = u.pm * BM + wr * 64 + fr; const int colb = u.pn * BM + wc * 32 + 8 * fq;
        f32x4 bA[2][2], bB[2][2];
#define ER_LOAD(dst, i) do { const size_t off_ = (size_t)(row0 + ((i) >> 2) * HALF + ((i) & 3) * 16) * DM + colb; \
        _Pragma("unroll") for (int bj = 0; bj < 2; ++bj) { \
            if constexpr (BF32) { dst[bj][0] = *(const f32x4*)((const float*)base + off_ + bj * HALF); dst[bj][1] = *(const f32x4*)((const float*)base + off_ + bj * HALF + 4); } \
            else { const u32x4 h_ = *(const u32x4*)((const unsigned short*)base + off_ + bj * HALF); dst[bj][0] = unpk_f16x4((u32x2){h_.x, h_.y}); dst[bj][1] = unpk_f16x4((u32x2){h_.z, h_.w}); } } } while (0)
#define ER_DO(src, i) do { const int ai = (i) >> 2, m = (i) & 3; const int row = row0 + ai * HALF + m * 16; float sq = 0.f; \
        _Pragma("unroll") for (int bj = 0; bj < 2; ++bj) { const size_t off = (size_t)row * DM + colb + bj * HALF; \
            const f32x4 v0 = acc[ai][bj][m][0] * sc + src[bj][0], v1 = acc[ai][bj][m][1] * sc + src[bj][1]; \
            u32x4 w_; w_.x = pk_f16(v0[0], v0[1]); w_.y = pk_f16(v0[2], v0[3]); w_.z = pk_f16(v1[0], v1[1]); w_.w = pk_f16(v1[2], v1[3]); \
            *(u32x4*)(out + off) = w_; sq += sq8(v0, v1); } \
        if (ssq) { sq += __shfl_xor(sq, 16); sq += __shfl_xor(sq, 32); if (fq == 0) ssq[(size_t)row * 32 + u.pn * 4 + wc] = sq; } } while (0)
        ER_LOAD(bA, 0); asm volatile("" ::: "memory");
#pragma unroll
        for (int i = 0; i < 8; i += 2) {
            ER_LOAD(bB, i + 1); asm volatile("" ::: "memory");
            ER_DO(bA, i); asm volatile("" ::: "memory");
            if (i + 2 < 8) { ER_LOAD(bA, i + 2); asm volatile("" ::: "memory"); }
            ER_DO(bB, i + 1); asm volatile("" ::: "memory");
        }
#undef ER_LOAD
#undef ER_DO
    }
};
template <int RS> struct EpiSwiGLU {
    bf16_t* H; int row_base; const float* ssq; const float* rsp; const unsigned* cmax; const LAS int* tile_e; int f8 = 0;
    static constexpr bool LDS_SCALES = (RS == 2);
    __device__ __forceinline__ const float* row_src(const Unit& u) const { return rsp + u.pm * BM; }
    __device__ __forceinline__ const unsigned* col_src(const Unit& u) const { return cmax + (size_t)(tile_e ? tile_e[u.pm] : 0) * (2 * DFF) + u.pn * BM; }
    template <class ACC>
    __device__ __forceinline__ void operator()(const ACC (&acc)[2][2][4][2], const Unit& u, int wr, int wc, int fr, int fq, const LAS unsigned char* lsc) const {
        const int row0 = u.pm * BM + wr * 64 + fr;
        f32x4 sg[2], su[2];
        if (RS == 2) { const LAS unsigned* cp = (const LAS unsigned*)(lsc + 1024) + wc * 32 + 8 * fq;
#pragma unroll
            for (int n = 0; n < 2; ++n) { const u32x4 a = *(const LAS u32x4*)(cp + 4 * n), b = *(const LAS u32x4*)(cp + HALF + 4 * n);
#pragma unroll
                for (int j = 0; j < 4; ++j) { sg[n][j] = __uint_as_float(a[j]) * (1.f / 127.f); su[n][j] = __uint_as_float(b[j]) * (1.f / 127.f); } } }
        float rs8[8];
#pragma unroll
        for (int i = 0; i < 8; ++i) { const int row = row0 + (i >> 2) * HALF + (i & 3) * 16;
            if (RS == 2) rs8[i] = ((const LAS float*)lsc)[wr * 64 + fr + (i >> 2) * HALF + (i & 3) * 16]; else rs8[i] = RS == 0 ? row_rstd(ssq, row, 32, 1.f / DM) : rsp[row]; }
#pragma unroll
        for (int ai = 0; ai < 2; ++ai)
#pragma unroll
            for (int m = 0; m < 4; ++m) {
                const int row = row0 + ai * HALF + m * 16;
                const float rs = rs8[ai * 4 + m];
                f32x4 o[2];
#pragma unroll
                for (int n = 0; n < 2; ++n) { f32x4 g = acc_f(acc[ai][0][m][n]) * rs, up = acc_f(acc[ai][1][m][n]) * rs;
                    if (RS == 2) { g *= sg[n]; up *= su[n]; }
#pragma unroll
                    for (int j = 0; j < 4; ++j) o[n][j] = g[j] * __builtin_amdgcn_rcpf(1.f + __builtin_amdgcn_exp2f(-LOG2E * g[j])) * up[j]; }
                if (RS == 2 && f8) {
                    _Pragma("unroll") for (int n = 0; n < 2; ++n) _Pragma("unroll") for (int j = 0; j < 4; ++j) o[n][j] = __builtin_amdgcn_fmed3f(o[n][j], -448.f, 448.f);
                    *(u32x2*)((unsigned char*)H + ((size_t)u.pn * MCH_ROWS + (row - row_base)) * 128 + wc * 32 + 8 * fq) = pack8_fp8(o[0], o[1]);
                } else
                *(u32x4*)(H + ((size_t)(u.pn * 2 + (wc >> 1)) * CHUNK_ROWS + (row - row_base)) * 64 + (wc & 1) * 32 + 8 * fq) = pack8(o[0], o[1]);
                asm volatile("" ::: "memory");
            }
    }
};
struct EpiMoeDown {
    bf16_t* Y; const float* gate;
    static constexpr bool LDS_SCALES = false;
    __device__ __forceinline__ void operator()(const f32x4 (&acc)[2][2][4][2], const Unit& u, int wr, int wc, int fr, int fq, const LAS unsigned char*) const {
        const int row0 = u.pm * BM + wr * 64 + fr;
        float g8[8];
#pragma unroll
        for (int i = 0; i < 8; ++i) g8[i] = gate[row0 + (i >> 2) * HALF + (i & 3) * 16] * (1.f / 64.f);
#pragma unroll
        for (int ai = 0; ai < 2; ++ai)
#pragma unroll
            for (int m = 0; m < 4; ++m) {
                const int row = row0 + ai * HALF + m * 16; const float g = g8[ai * 4 + m];
#pragma unroll
                for (int bj = 0; bj < 2; ++bj) *(u32x4*)(Y + (size_t)row * DM + u.pn * BM + bj * HALF + wc * 32 + 8 * fq) = pack8(acc[ai][bj][m][0] * g, acc[ai][bj][m][1] * g);
                asm volatile("" ::: "memory");
            }
    }
};
}

namespace fa {
#define SBAR() __builtin_amdgcn_sched_barrier(0)
template <int NDV> __device__ __forceinline__ int v_st(int k, int c) { const int kk = (k & ~0xC) | ((k & 4) << 1) | ((k & 8) >> 1); return ((kk >> 3) * NDV + (c >> 5)) * 512 + ((kk & 7) * 32 + (c & 31)) * 2; }
__device__ __forceinline__ int v_rd_base(int lane) { return ((lane & 3) << 3) | (((lane >> 2) & 3) << 6) | (((lane >> 4) & 1) << 5) | (((lane >> 5) & 1) << 8); }
__device__ __forceinline__ int crow(int r, int hi) { return (r & 3) + 8 * (r >> 2) + 4 * hi; }
__device__ __forceinline__ void mask_tile(f32x16& p0, f32x16& p1, int dq, unsigned W) {
    const float NEG = -__builtin_inff();
#pragma unroll
    for (int r = 0; r < 16; ++r) {
        const int c = (r & 3) + 8 * (r >> 2);
        if ((unsigned)(dq - c) >= W) p0[r] = NEG;
        if ((unsigned)(dq - c - 32) >= W) p1[r] = NEG;
    }
}
struct AttnArgs {
    const bf16_t* Q; int ldq; const bf16_t* K; int ldk; const bf16_t* V; int ldv; bf16_t* O; int ldo;
    int q0, j_lo, j_hi, W;
    const float* dec;
    float sinkl; const float* biasT;
    const float* sinks;
    float kmax;
    const float* neff;
};
template <int DK, int DV, int MODE>
__device__ __forceinline__ void attn_unit(const AttnArgs& a, LAS char* lds) {
    constexpr int KROWB = DK * 2 + 16  , SHM_K = 64 * KROWB, SHM_V = 64 * DV * 2, NDK = DK / 16, NDV = DV / 32, KCH = DK / 8, VCH = DV / 8, KPT = KCH * 64 / 512, VPT = VCH * 64 / 512;
    constexpr int RB = NDV * 512;
    constexpr float THR = 8.f;
    int tid_ = threadIdx.x; asm volatile("" : "+v"(tid_));
    const int tid = tid_, wid = __builtin_amdgcn_readfirstlane(tid >> 6), lane = tid & 63, r32 = lane & 31, hi = lane >> 5;
    LAS char* V_lds = lds; LAS char* K_lds = lds + 2 * SHM_V;
    LAS float* dec_l = (LAS float*)(K_lds + 2 * SHM_K);
    LAS float* ws = dec_l + 128 + wid * 64;
    LAS float* bias_l = dec_l + 128 + 512 + ((MODE == 2) ? wid * 128 : 0);
    const int NT = a.j_hi - a.j_lo;
    const int qlo = (MODE == 2) ? a.q0 : a.q0 + wid * 32, qpos = qlo + r32;
    const int hoff = (MODE == 2) ? wid * 64 : 0;
    static_assert(KPT == KCH / 8 && VPT == VCH / 8, "staging map");
    const int srow_ = tid >> 3, scg_ = tid & 7;
    const int kws0 = srow_ * KROWB + scg_ * 16, vws0 = v_st<NDV>(srow_, scg_ * 8);
    const unsigned ksrc0 = (unsigned)(srow_ * a.ldk + scg_ * 8) * 2u, vsrc0 = (unsigned)(srow_ * a.ldv + scg_ * 8) * 2u;
    bf16x8 qr[NDK];
#pragma unroll
    for (int d0 = 0; d0 < NDK; ++d0) qr[d0] = *(const bf16x8*)(a.Q + (size_t)qpos * a.ldq + hoff + d0 * 16 + hi * 8);
    __builtin_amdgcn_s_waitcnt(0x0F70);
    float m_reg = -1e30f, l_reg = 0.f, skm = 0.f;
    if (MODE == 2) { m_reg = a.sinks[wid] * LOG2E; l_reg = 1.f; }
    f32x16 o[NDV];
#pragma unroll
    for (int d = 0; d < NDV; ++d) o[d] = f32x16{};
    float clq = 0.f; if (MODE == 1) clq = a.dec[(size_t)qpos * 16];
    if (MODE == 2) { (dec_l + 128 + 512)[tid] = a.biasT[tid]; (dec_l + 128 + 512)[tid + 512] = a.biasT[tid + 512]; }
    const int vb0 = (int)(uintptr_t)V_lds + v_rd_base(lane);
    const int kq = r32 * KROWB;
    bf16x8 sk[2][KPT], sv[2][VPT]; float sdec[2] = {0.f, 0.f};
    if (wid >= 4) __builtin_amdgcn_s_setprio(1);
#define FA_LOADT(j, S_) do { const size_t kb_ = (size_t)(j) * 64; const char* kt_ = (const char*)(a.K + kb_ * a.ldk); const char* vt_ = (const char*)(a.V + kb_ * a.ldv); \
        _Pragma("unroll") for (int i = 0; i < KPT; ++i) sk[S_][i] = *(const bf16x8*)(kt_ + ksrc0 + i * 128); \
        _Pragma("unroll") for (int i = 0; i < VPT; ++i) sv[S_][i] = *(const bf16x8*)(vt_ + vsrc0 + i * 128); \
        if (MODE == 1) { if (tid < 64) sdec[S_] = a.dec[(kb_ + tid) * 16]; else if (tid == 64) sdec[S_] = a.neff[(j)]; } } while (0)
#define FA_WRITET(bf, S_) do { \
        _Pragma("unroll") for (int i = 0; i < KPT; ++i) *(LAS bf16x8*)(K_lds + (bf) * SHM_K + kws0 + i * 128) = sk[S_][i]; \
        _Pragma("unroll") for (int i = 0; i < VPT; ++i) *(LAS bf16x8*)(V_lds + (bf) * SHM_V + vws0 + i * 1024) = sv[S_][i]; \
        if (MODE == 1) { if (tid < 64) dec_l[(bf) * 64 + tid] = sdec[S_]; else if (tid == 64) dec_l[800 + (bf)] = sdec[S_]; } } while (0)
#define FA_TR(dst, off) asm volatile("ds_read_b64_tr_b16 %0, %1 offset:%2" : "=&v"(dst) : "v"(vb0), "i"(off) : "memory")
#define FA_VRD(S, BUF, d0) do { constexpr int b_ = (BUF) * SHM_V + (d0) * 512; \
        FA_TR(S##l[0], b_); FA_TR(S##h[0], b_ + RB); FA_TR(S##l[1], b_ + 2 * RB); FA_TR(S##h[1], b_ + 3 * RB); FA_TR(S##l[2], b_ + 4 * RB); FA_TR(S##h[2], b_ + 5 * RB); FA_TR(S##l[3], b_ + 6 * RB); FA_TR(S##h[3], b_ + 7 * RB); } while (0)
#define FA_VMM(S, d0) do { \
        o[d0] = __builtin_amdgcn_mfma_f32_32x32x16_bf16(pa0, (bf16x8){S##l[0][0], S##l[0][1], S##l[0][2], S##l[0][3], S##h[0][0], S##h[0][1], S##h[0][2], S##h[0][3]}, o[d0], 0, 0, 0); \
        o[d0] = __builtin_amdgcn_mfma_f32_32x32x16_bf16(pa1, (bf16x8){S##l[1][0], S##l[1][1], S##l[1][2], S##l[1][3], S##h[1][0], S##h[1][1], S##h[1][2], S##h[1][3]}, o[d0], 0, 0, 0); \
        o[d0] = __builtin_amdgcn_mfma_f32_32x32x16_bf16(pa2, (bf16x8){S##l[2][0], S##l[2][1], S##l[2][2], S##l[2][3], S##h[2][0], S##h[2][1], S##h[2][2], S##h[2][3]}, o[d0], 0, 0, 0); \
        o[d0] = __builtin_amdgcn_mfma_f32_32x32x16_bf16(pa3, (bf16x8){S##l[3][0], S##l[3][1], S##l[3][2], S##l[3][3], S##h[3][0], S##h[3][1], S##h[3][2], S##h[3][3]}, o[d0], 0, 0, 0); } while (0)
#define FA_LW(n) do { asm volatile("s_waitcnt lgkmcnt(" #n ")" ::: "memory"); SBAR(); } while (0)
#define FA_PVALL(BUF) do { s16x4 Al[4], Ah[4], Bl[4], Bh[4]; \
        FA_VRD(A, BUF, 0); FA_VRD(B, BUF, 1); FA_LW(8); FA_VMM(A, 0); \
        if constexpr (NDV == 4) { FA_VRD(A, BUF, 2); FA_LW(8); FA_VMM(B, 1); FA_VRD(B, BUF, 3); FA_LW(8); FA_VMM(A, 2); FA_LW(0); FA_VMM(B, 3); } \
        else { FA_LW(0); FA_VMM(B, 1); } } while (0)
#define FA_PK4(P, B_, OUT) do { unsigned a0 = cvt_pk_bf16(P[B_ + 0], P[B_ + 1]), a1 = cvt_pk_bf16(P[B_ + 2], P[B_ + 3]); \
        unsigned b0 = cvt_pk_bf16(P[B_ + 4], P[B_ + 5]), b1 = cvt_pk_bf16(P[B_ + 6], P[B_ + 7]); \
        auto r0 = __builtin_amdgcn_permlane32_swap(a0, b0, false, false); auto r1 = __builtin_amdgcn_permlane32_swap(a1, b1, false, false); \
        u32x4 w = {r0[0], r1[0], r0[1], r1[1]}; OUT = *reinterpret_cast<bf16x8*>(&w); } while (0)
#define FA_COMPUTE(BUF, kb) do { \
            f32x16 p0, p1; \
            if (MODE == 1) { _Pragma("unroll") for (int r = 0; r < 16; ++r) { p0[r] = clq - dec_l[(BUF) * 64 + crow(r, hi)]; p1[r] = clq - dec_l[(BUF) * 64 + 32 + crow(r, hi)]; } } \
            else { p0 = f32x16{}; p1 = f32x16{}; } \
            { const LAS char* kbp[4];     \
              kbp[0] = K_lds + (BUF) * SHM_K + kq + hi * 16; \
              bf16x8 ka0 = *(const LAS bf16x8*)kbp[0], ka1 = *(const LAS bf16x8*)(kbp[0] + 32 * KROWB), kb0, kb1; SBAR(); \
              _Pragma("unroll") for (int d0 = 0; d0 < NDK; d0 += 2) { \
                  { const LAS char* ap = kbp[0] + (d0 + 1) * 32; kb0 = *(const LAS bf16x8*)ap; kb1 = *(const LAS bf16x8*)(ap + 32 * KROWB); } SBAR(); \
                  p0 = __builtin_amdgcn_mfma_f32_32x32x16_bf16(ka0, qr[d0], p0, 0, 0, 0); p1 = __builtin_amdgcn_mfma_f32_32x32x16_bf16(ka1, qr[d0], p1, 0, 0, 0); SBAR(); \
                  if (d0 + 2 < NDK) { const LAS char* ap = kbp[0] + (d0 + 2) * 32; ka0 = *(const LAS bf16x8*)ap; ka1 = *(const LAS bf16x8*)(ap + 32 * KROWB); } SBAR(); \
                  p0 = __builtin_amdgcn_mfma_f32_32x32x16_bf16(kb0, qr[d0 + 1], p0, 0, 0, 0); p1 = __builtin_amdgcn_mfma_f32_32x32x16_bf16(kb1, qr[d0 + 1], p1, 0, 0, 0); SBAR(); } } \
            if (MODE == 2) { const int dq0 = qpos - (kb) - 4 * hi; \
                _Pragma("unroll") for (int r = 0; r < 16; ++r) { const int c = (r & 3) + 8 * (r >> 2); int i0 = dq0 - c, i1 = dq0 - c - 32; \
                    i0 = i0 < 0 ? 0 : (i0 > 127 ? 127 : i0); i1 = i1 < 0 ? 0 : (i1 > 127 ? 127 : i1); p0[r] += bias_l[i0]; p1[r] += bias_l[i1]; } } \
            if (MODE != 3) { if ((kb) + 63 > qlo || (kb) <= qlo + 31 - a.W) mask_tile(p0, p1, qpos - (kb) - 4 * hi, (unsigned)a.W); } \
            float pmax = p0[0]; \
            _Pragma("unroll") for (int r = 1; r < 16; ++r) pmax = fmaxf(pmax, p0[r]); \
            _Pragma("unroll") for (int r = 0; r < 16; ++r) pmax = fmaxf(pmax, p1[r]); \
            { auto rr = __builtin_amdgcn_permlane32_swap(__float_as_uint(pmax), __float_as_uint(pmax), false, false); pmax = fmaxf(__uint_as_float(rr[0]), __uint_as_float(rr[1])); } \
              \
            const float skc_ = skm + 64.f * __builtin_amdgcn_exp2f(pmax - m_reg);        \
            const bool skip_ = MODE == 1 && __all(skc_ < 6.1035e-5f); \
            if (skip_) skm = skc_; \
            if (!skip_) { \
            float mn, alpha; \
            if (__builtin_expect(__all((pmax - m_reg) <= THR), 1)) { mn = m_reg; alpha = 1.f; } \
            else { mn = fmaxf(m_reg, pmax); alpha = __builtin_amdgcn_exp2f(m_reg - mn); m_reg = mn; } \
            _Pragma("unroll") for (int r = 0; r < 16; ++r) { p0[r] = __builtin_amdgcn_exp2f(p0[r] - mn); p1[r] = __builtin_amdgcn_exp2f(p1[r] - mn); } \
            float ps = 0.f; \
            _Pragma("unroll") for (int r = 0; r < 16; ++r) ps += p0[r]; \
            _Pragma("unroll") for (int r = 0; r < 16; ++r) ps += p1[r]; \
            { auto rr = __builtin_amdgcn_permlane32_swap(__float_as_uint(ps), __float_as_uint(ps), false, false); ps = __uint_as_float(rr[0]) + __uint_as_float(rr[1]); } \
            l_reg = l_reg * alpha + ps; \
            if (__any(alpha < 1.f)) { if (hi == 0) ws[32 + r32] = alpha; asm volatile("s_waitcnt lgkmcnt(0)" ::: "memory"); \
                _Pragma("unroll") for (int d_ = 0; d_ < NDV; ++d_) _Pragma("unroll") for (int r = 0; r < 16; ++r) o[d_][r] *= ws[32 + crow(r, hi)]; } \
            bf16x8 pa0, pa1, pa2, pa3; \
            FA_PK4(p0, 0, pa0); FA_PK4(p0, 8, pa1); FA_PK4(p1, 0, pa2); FA_PK4(p1, 8, pa3); SBAR(); \
            FA_PVALL(BUF); } \
        } while (0)
    if constexpr (MODE != 1) {
#define FA_TILE(t, BUF) do { \
        const int kb = (a.j_lo + (t)) * 64; \
        bool act = true; if (MODE != 3) act = (kb <= qlo + 31) && (kb + 63 >= qlo - a.W + 1); \
        if ((t) + 2 < NT) FA_LOADT(a.j_lo + (t) + 2, BUF);              \
        if (act) FA_COMPUTE(BUF, kb); \
        if ((t) + 1 < NT) FA_WRITET((BUF) ^ 1, (BUF) ^ 1);              \
        __syncthreads(); } while (0)
        FA_LOADT(a.j_lo, 0); FA_WRITET(0, 0); if (NT > 1) FA_LOADT(a.j_lo + 1, 1); __syncthreads();
        for (int t = 0; t < NT; t += 2) {
            FA_TILE(t, 0);
            if (t + 1 < NT) FA_TILE(t + 1, 1);
        }
#undef FA_TILE
    } else {
        constexpr float TEXIT = 14.f;
        float qn2 = 0.f;
#pragma unroll
        for (int d0 = 0; d0 < NDK; ++d0)
#pragma unroll
            for (int e = 0; e < 8; ++e) { const float f = bf2f((unsigned short)qr[d0][e]); qn2 += f * f; }
        { auto rr = __builtin_amdgcn_permlane32_swap(__float_as_uint(qn2), __float_as_uint(qn2), false, false); qn2 = __uint_as_float(rr[0]) + __uint_as_float(rr[1]); }
        const float ubase = sqrtf(qn2) * a.kmax * 1.0001f + clq;
        LAS int* flags = (LAS int*)(dec_l + 128 + 512 + 128);
        bool wdone = false, stop = false;
#define FA_TILE_R(t, BUF) do { \
        const int kb = (a.j_lo + (t)) * 64; const bool more = (t) > 0; \
        const bool act = !wdone && (kb <= qlo + 31); \
        if ((t) > 1) FA_LOADT(a.j_lo + (t) - 2, BUF); \
        if (act) { FA_COMPUTE(BUF, kb); \
            wdone = __all((ubase - dec_l[(BUF) * 64] + dec_l[800 + (BUF)]) < (m_reg - TEXIT)) != 0; } \
        if (more) FA_WRITET((BUF) ^ 1, (BUF) ^ 1); \
        if (lane == 0) flags[(BUF) * 8 + wid] = wdone ? 1 : 0; \
        __syncthreads(); \
        { int all_ = 1; _Pragma("unroll") for (int w_ = 0; w_ < 8; ++w_) all_ &= flags[(BUF) * 8 + w_]; stop = !more || (all_ != 0); } } while (0)
        FA_LOADT(a.j_lo + NT - 1, 0); FA_WRITET(0, 0); if (NT > 1) FA_LOADT(a.j_lo + NT - 2, 1); __syncthreads();
        for (int t = NT - 1;;) {
            FA_TILE_R(t, 0); if (stop) break; --t;
            FA_TILE_R(t, 1); if (stop) break; --t;
        }
#undef FA_TILE_R
    }
    __builtin_amdgcn_s_setprio(0);
    if (hi == 0) ws[r32] = l_reg; asm volatile("s_waitcnt lgkmcnt(0)" ::: "memory");
    float rli[16];
#pragma unroll
    for (int r = 0; r < 16; ++r) rli[r] = __builtin_amdgcn_rcpf(ws[crow(r, hi)]);
    bf16_t* Ow = a.O + (size_t)qlo * a.ldo + hoff;
#pragma unroll
    for (int r = 0; r < 16; ++r) { const int orow = crow(r, hi);
#pragma unroll
        for (int d0 = 0; d0 < NDV; ++d0) { const float v = o[d0][r] * rli[r]; const float vn = __shfl_xor(v, 1);
            if ((r32 & 1) == 0) *(unsigned*)(Ow + (size_t)orow * a.ldo + d0 * 32 + r32) = cvt_pk_bf16(v, vn); } }
    __syncthreads();
#undef FA_LOADT
#undef FA_WRITET
#undef FA_TR
#undef FA_VRD
#undef FA_VMM
#undef FA_LW
#undef FA_PVALL
#undef FA_PK4
#undef FA_COMPUTE
}
#undef SBAR
}

struct Args { const void* in[N_IN]; float* out; unsigned char* ws; int ph_lo, ph_hi; };

__device__ const float ROPE_INV[32] = {
    1.000000000e+00f, 7.498942614e-01f, 5.623413324e-01f, 4.216965139e-01f, 3.162277639e-01f, 2.371373773e-01f, 1.778279394e-01f, 1.333521307e-01f,
    1.000000015e-01f, 7.498941571e-02f, 5.623413250e-02f, 4.216965288e-02f, 3.162277490e-02f, 2.371373773e-02f, 1.778279431e-02f, 1.333521493e-02f,
    9.999999776e-03f, 7.498941850e-03f, 5.623413250e-03f, 4.216964822e-03f, 3.162277630e-03f, 2.371373586e-03f, 1.778279431e-03f, 1.333521446e-03f,
    1.000000047e-03f, 7.498942432e-04f, 5.623413017e-04f, 4.216965172e-04f, 3.162277571e-04f, 2.371373703e-04f, 1.778279402e-04f, 1.333521504e-04f };
__device__ const unsigned char T5_BUCKET[128] = {
    0, 1, 2, 3, 4, 5, 6, 7, 8, 9, 10, 11, 12, 13, 14, 15, 16, 16, 16, 17, 17, 18, 18, 18, 19, 19, 19, 20, 20, 20, 20, 21, 21, 21, 21, 22, 22, 22, 22, 22, 23, 23, 23, 23, 23, 23, 24, 24, 24, 24, 24, 24,
    25, 25, 25, 25, 25, 25, 25, 26, 26, 26, 26, 26, 26, 26, 26, 27, 27, 27, 27, 27, 27, 27, 27, 27, 27, 28, 28, 28, 28, 28, 28, 28, 28, 28, 28, 29, 29, 29, 29, 29, 29, 29, 29, 29, 29, 29, 29,
    30, 30, 30, 30, 30, 30, 30, 30, 30, 30, 30, 30, 30, 30, 31, 31, 31, 31, 31, 31, 31, 31, 31, 31, 31, 31, 31, 31, 31 };

struct CvtJob { const float* src; int K, Nsrc, Npad; const float* gain; bf16_t* dst; int ldd; int mode; int row_off; int kblk;   unsigned* amax;   int f8;   int f16;   };
__device__ __forceinline__ int cvt_row(int mode, int n) {
    if (mode == 1) { if (n >= 1280 && n < 1344) { const int j = n - 1280; return 1280 + 2 * (j & 31) + (j >> 5); } return n; }
    if (mode == 2) { const int h = n / 192, w = n - h * 192; if (w >= 128) { const int j = w - 128; return h * 192 + 128 + 2 * (j & 31) + (j >> 5); } return n; }
    if (mode == 4) return (n >> 7) * 256 + (n & 127);
    if (mode == 5) return (n >> 7) * 256 + 128 + (n & 127);
    return n;
}
__device__ __forceinline__ float cvt_cs(int mode, int n) {
    if (mode == 1) return (n >= 1344 && n < 2368) ? C2_SWA : 1.f;
    if (mode == 2) return C2_MLA;
    if (mode == 3) return C2_128;
    if (mode == 6) return n < 2048 ? C2_128 : 1.f;
    return 1.f;
}
constexpr int N_CVT_JOBS = 17 + 24;
__device__ __forceinline__ CvtJob get_job(const Args& a, int j) {
    unsigned char* ws = a.ws; CvtJob jb; jb.gain = nullptr; jb.mode = 0; jb.row_off = 0; jb.amax = nullptr; jb.kblk = 0; jb.f16 = 0; jb.f8 = 0;
    const float* nmix = (const float*)a.in[I_NMIX]; const float* ncross = (const float*)a.in[I_NCROSS]; const float* nmem = (const float*)a.in[I_NMEM]; const float* nffn = (const float*)a.in[I_NFFN];
    if (j >= 17) { const int t = (j - 17) >> 3, e = (j - 17) & 7;
        if (t == 0) { jb.src = (const float*)a.in[I_MG] + (size_t)e * DM * DFF; jb.K = DM; jb.Nsrc = jb.Npad = DFF; jb.gain = nffn + DM; jb.dst = (bf16_t*)(ws + WS_WGU1 + (size_t)e * E_GU); jb.ldd = DM; jb.mode = 4; jb.amax = (unsigned*)(ws + WS_CTL) + CW_AMAXW + e * 2 * DFF; }
        else if (t == 1) { jb.src = (const float*)a.in[I_MU] + (size_t)e * DM * DFF; jb.K = DM; jb.Nsrc = jb.Npad = DFF; jb.gain = nffn + DM; jb.dst = (bf16_t*)(ws + WS_WGU1 + (size_t)e * E_GU); jb.ldd = DM; jb.mode = 5; jb.amax = (unsigned*)(ws + WS_CTL) + CW_AMAXW + e * 2 * DFF; }
        else { jb.src = (const float*)a.in[I_MD] + (size_t)e * DFF * DM; jb.K = DFF; jb.Nsrc = jb.Npad = DM; jb.dst = (bf16_t*)(ws + WS_WD1 + (size_t)e * E_D)  ; jb.ldd = DFF; jb.kblk = 1; jb.f8 = 1; }
        return jb; }
    switch (j) {
    case 0: jb.src = (const float*)a.in[I_EVWIN]; jb.K = DM; jb.Nsrc = EVEN_IN; jb.Npad = Z0_LD; jb.gain = nmix; jb.dst = (bf16_t*)(ws + WS_WIN0)  ; jb.ldd = DM; jb.mode = 1; jb.amax = (unsigned*)(ws + WS_CTL) + CW_AMAX0; break;
    case 1: jb.src = (const float*)a.in[I_WUQ]; jb.K = 768; jb.Nsrc = jb.Npad = 1536; jb.gain = (const float*)a.in[I_QNORM]; jb.dst = (bf16_t*)(ws + WS_WUQ); jb.ldd = 768; jb.mode = 2; break;
    case 2: jb.src = (const float*)a.in[I_WUKV]; jb.K = 512; jb.Nsrc = jb.Npad = 2048; jb.gain = (const float*)a.in[I_KVNORM]; jb.dst = (bf16_t*)(ws + WS_WUKV); jb.ldd = 512; break;
    case 3: jb.src = (const float*)a.in[I_EVWO]; jb.K = DM; jb.Nsrc = jb.Npad = DM; jb.dst = (bf16_t*)(ws + WS_WO0); jb.ldd = DM; break;
    case 4: case 5: { const int l = j - 4; jb.src = (const float*)a.in[I_XWQ] + (size_t)l * DM * 512; jb.K = DM; jb.Nsrc = jb.Npad = 512; jb.gain = ncross + l * DM; jb.dst = (bf16_t*)(ws + WS_WXQ) + (size_t)l * E_XQ; jb.ldd = DM; jb.mode = 3; jb.f16 = 1; break; }
    case 6: case 7: { const int l = j - 6; jb.src = (const float*)a.in[I_XWK] + (size_t)l * DM * 512; jb.K = DM; jb.Nsrc = jb.Npad = 512; jb.gain = nmem + l * DM; jb.dst = (bf16_t*)(ws + WS_WXKV); jb.ldd = DM; jb.row_off = l * 1024; break; }
    case 8: case 9: { const int l = j - 8; jb.src = (const float*)a.in[I_XWV] + (size_t)l * DM * 512; jb.K = DM; jb.Nsrc = jb.Npad = 512; jb.gain = nmem + l * DM; jb.dst = (bf16_t*)(ws + WS_WXKV); jb.ldd = DM; jb.row_off = l * 1024 + 512; break; }
    case 10: case 11: { const int l = j - 10; jb.src = (const float*)a.in[I_XWO] + (size_t)l * 512 * DM; jb.K = 512; jb.Nsrc = jb.Npad = DM; jb.dst = (bf16_t*)(ws + WS_WXO) + (size_t)l * E_XO; jb.ldd = 512; break; }
    case 12: jb.src = (const float*)a.in[I_FG]; jb.K = DM; jb.Nsrc = jb.Npad = DFF; jb.gain = nffn; jb.dst = (bf16_t*)(ws + WS_WGU0); jb.ldd = DM; jb.mode = 4; jb.amax = (unsigned*)(ws + WS_CTL) + CW_AMAXW + 8 * 2 * DFF; break;
    case 13: jb.src = (const float*)a.in[I_FU]; jb.K = DM; jb.Nsrc = jb.Npad = DFF; jb.gain = nffn; jb.dst = (bf16_t*)(ws + WS_WGU0); jb.ldd = DM; jb.mode = 5; jb.amax = (unsigned*)(ws + WS_CTL) + CW_AMAXW + 8 * 2 * DFF; break;
    case 14: jb.src = (const float*)a.in[I_FD]; jb.K = DFF; jb.Nsrc = jb.Npad = DM; jb.dst = (bf16_t*)(ws + WS_WD0); jb.ldd = DFF; jb.kblk = 1; break;
    case 15: jb.src = (const float*)a.in[I_ODWIN]; jb.K = DM; jb.Nsrc = ODD_IN; jb.Npad = IN1_PAD; jb.gain = nmix + DM; jb.dst = (bf16_t*)(ws + WS_WIN1)  ; jb.ldd = DM; jb.mode = 6; jb.amax = (unsigned*)(ws + WS_CTL) + CW_AMAX15; break;
    default: jb.src = (const float*)a.in[I_ODWO]; jb.K = DM; jb.Nsrc = jb.Npad = DM; jb.dst = (bf16_t*)(ws + WS_WO1); jb.ldd = DM; break;
    }
    return jb;
}
__device__ __forceinline__ int cvt_find(const LAS int* cum, int it, int& j) { while (it >= cum[j + 1]) ++j; return it - cum[j]; }
__device__ __forceinline__ void cvt_load(const CvtJob& jb, int item, int lane, float (&v)[32]) {
    const int nblk = jb.Npad / 32, kb = item / nblk, nb = item % nblk, k0 = 64 * kb, n0 = 32 * nb;
    const int nn = n0 + (lane & 31); const bool ok = nn < jb.Nsrc;
    const float* p = jb.src + (size_t)(k0 + (lane >> 5)) * jb.Nsrc + nn; const size_t st = (size_t)2 * jb.Nsrc;
#pragma unroll
    for (int i = 0; i < 32; ++i) v[i] = ok ? __builtin_nontemporal_load(p + i * st) : 0.f;
}
__device__ __forceinline__ void cvt_store(const CvtJob& jb, LAS float* scr, int item, int lane, const float (&v)[32]) {
    const int nblk = jb.Npad / 32, kb = item / nblk, nb = item % nblk, k0 = 64 * kb, n0 = 32 * nb;
    const float cs = cvt_cs(jb.mode, n0 + (lane & 31));
    const int c = lane & 7;
    f32x4 g0 = (f32x4){1.f, 1.f, 1.f, 1.f}, g1 = g0;
    if (jb.gain) { g0 = *(const f32x4*)(jb.gain + k0 + 8 * c); g1 = *(const f32x4*)(jb.gain + k0 + 8 * c + 4); }
#pragma unroll
    for (int i = 0; i < 32; ++i) scr[(2 * i + (lane >> 5)) * 33 + (lane & 31)] = v[i] * cs;
    LDS_WAIT(); asm volatile("" ::: "memory");
#pragma unroll
    for (int j = 0; j < 4; ++j) { const int n = (lane >> 3) + 8 * j; const LAS float* s = scr + (8 * c) * 33 + n;
        u32x4 o;
        if (jb.f16) { o.x = pk_f16(s[0 * 33] * g0[0], s[1 * 33] * g0[1]); o.y = pk_f16(s[2 * 33] * g0[2], s[3 * 33] * g0[3]); o.z = pk_f16(s[4 * 33] * g1[0], s[5 * 33] * g1[1]); o.w = pk_f16(s[6 * 33] * g1[2], s[7 * 33] * g1[3]); }
        else { o.x = cvt_pk_bf16(s[0 * 33] * g0[0], s[1 * 33] * g0[1]); o.y = cvt_pk_bf16(s[2 * 33] * g0[2], s[3 * 33] * g0[3]); o.z = cvt_pk_bf16(s[4 * 33] * g1[0], s[5 * 33] * g1[1]); o.w = cvt_pk_bf16(s[6 * 33] * g1[2], s[7 * 33] * g1[3]); }
        const int drow = jb.row_off + cvt_row(jb.mode, n0 + n);
        if (jb.f8) {
            const f32x4 a_ = (f32x4){s[0 * 33] * g0[0], s[1 * 33] * g0[1], s[2 * 33] * g0[2], s[3 * 33] * g0[3]} * 64.f, b_ = (f32x4){s[4 * 33] * g1[0], s[5 * 33] * g1[1], s[6 * 33] * g1[2], s[7 * 33] * g1[3]} * 64.f;
            *(u32x2*)((unsigned char*)jb.dst + ((size_t)(k0 >> 7) * jb.Npad + drow) * 128 + (k0 & 64) + 8 * c) = pack8_fp8(a_, b_);
        } else { bf16_t* dp = jb.kblk ? jb.dst + ((size_t)(k0 >> 6) * jb.Npad + drow) * 64 + 8 * c : jb.dst + (size_t)drow * jb.ldd + k0 + 8 * c; *(u32x4*)dp = o; } }
    LDS_WAIT(); asm volatile("" ::: "memory");
}
__device__ __forceinline__ void cvt_amax(const CvtJob& jb, int item, int lane, const float (&v)[32]) {
    const int nblk = jb.Npad / 32, kb = item / nblk, nb = item % nblk, k0 = 64 * kb, n0 = 32 * nb;
    const int nn = n0 + (lane & 31); float mx = 0.f;
#pragma unroll
    for (int i = 0; i < 32; ++i) mx = fmaxf(mx, fabsf(v[i] * jb.gain[k0 + 2 * i + (lane >> 5)]));
    mx = fmaxf(mx, __shfl_xor(mx, 32)) * cvt_cs(jb.mode, nn);
    if (lane < 32 && nn < jb.Nsrc) atomicMax(jb.amax + jb.row_off + cvt_row(jb.mode, nn), __float_as_uint(mx));
}
__device__ __forceinline__ float cvt_amax_item(const CvtJob& jb, int item, int lane, const float (&v)[32]) {
    const int nblk = jb.Npad / 32, kb = item / nblk, nb = item % nblk, k0 = 64 * kb, n0 = 32 * nb;
    float mx = 0.f;
#pragma unroll
    for (int i = 0; i < 32; ++i) mx = fmaxf(mx, fabsf(v[i] * jb.gain[k0 + 2 * i + (lane >> 5)]));
    return fmaxf(mx, __shfl_xor(mx, 32)) * cvt_cs(jb.mode, n0 + (lane & 31));
}
__device__ __forceinline__ void cvt_store_q8(const CvtJob& jb, LAS float* scr, int item, int lane, const float (&v)[32], const LAS float* cam = nullptr) {
    const int nblk = jb.Npad / 32, kb = item / nblk, nb = item % nblk, k0 = 64 * kb, n0 = 32 * nb;
    const int c = lane & 7;
    const f32x4 g0 = *(const f32x4*)(jb.gain + k0 + 8 * c), g1 = *(const f32x4*)(jb.gain + k0 + 8 * c + 4);
#pragma unroll
    for (int i = 0; i < 32; ++i) scr[(2 * i + (lane >> 5)) * 33 + (lane & 31)] = v[i];
    LDS_WAIT(); asm volatile("" ::: "memory");
#pragma unroll
    for (int j = 0; j < 4; ++j) { const int n = (lane >> 3) + 8 * j; const LAS float* s = scr + (8 * c) * 33 + n;
        const int row = jb.row_off + cvt_row(jb.mode, n0 + n);
        const float am = cam ? cam[n] : __uint_as_float(__hip_atomic_load(jb.amax + row, RLX_AGENT)); const float inv = am > 0.f ? cvt_cs(jb.mode, n0 + n) * 127.f / am : 0.f;
        int q[8];
#pragma unroll
        for (int i = 0; i < 4; ++i) { q[i] = (int)__builtin_rintf(s[i * 33] * g0[i] * inv); q[4 + i] = (int)__builtin_rintf(s[(4 + i) * 33] * g1[i] * inv); }
#pragma unroll
        for (int i = 0; i < 8; ++i) q[i] = q[i] > 127 ? 127 : (q[i] < -127 ? -127 : q[i]);
        u32x2 o; o.x = (unsigned)(q[0] & 255) | ((unsigned)(q[1] & 255) << 8) | ((unsigned)(q[2] & 255) << 16) | ((unsigned)(q[3] & 255) << 24);
        o.y = (unsigned)(q[4] & 255) | ((unsigned)(q[5] & 255) << 8) | ((unsigned)(q[6] & 255) << 16) | ((unsigned)(q[7] & 255) << 24);
        *(u32x2*)((unsigned char*)jb.dst + (size_t)row * jb.ldd + k0 + 8 * c) = o; }
    LDS_WAIT(); asm volatile("" ::: "memory");
}
__device__ __forceinline__ void row_to_bf16_ssq(const float* xrow, bf16_t* orow, float* ssqrow, int lane) {
    const f32x4* xr = (const f32x4*)xrow + lane; f32x4 v[8]; float s = 0.f;
#pragma unroll
    for (int j = 0; j < 8; ++j) { v[j] = xr[64 * j]; s += (v[j][0] * v[j][0] + v[j][1] * v[j][1]) + (v[j][2] * v[j][2] + v[j][3] * v[j][3]); }
    s = wave_sum(s);
    u32x2* o8 = (u32x2*)orow + lane;
#pragma unroll
    for (int j = 0; j < 8; ++j) { u32x2 w; w.x = cvt_pk_bf16(v[j][0], v[j][1]); w.y = cvt_pk_bf16(v[j][2], v[j][3]); o8[64 * j] = w; }
    if (lane < 32) ssqrow[lane] = lane == 0 ? s : 0.f;
}

__global__ void __launch_bounds__(NWAVES * 64, 2) trunk_fwd(Args args) {
    extern __shared__ __attribute__((aligned(16))) unsigned char lds_raw[];
    LAS unsigned char* lds = (LAS unsigned char*)lds_raw;
    volatile LAS unsigned* MISC = (volatile LAS unsigned*)(lds + MISC_OFF);
    const int tid = threadIdx.x, lane = tid & 63, wave = __builtin_amdgcn_readfirstlane(tid >> 6);
    const int G = gridDim.x; const int bx = blockIdx.x; const int vcu = (G % 8 == 0) ? (bx % 8) * (G / 8) + bx / 8 : bx;
    const int gw = vcu * NWAVES + wave, NGW = G * NWAVES;
    unsigned* ctl = (unsigned*)(args.ws + WS_CTL);
    const int lo = args.ph_lo, hi = args.ph_hi;
    const bool fused = (hi - lo) > 1;
    for (int u = tid; u < (LDS_BYTES - RING_BYTES) / 4; u += NWAVES * 64) ((LAS unsigned*)(lds + RING_BYTES))[u] = 0u;
    __syncthreads();
    XcdBarrier bar; bar.bar = ctl + CW_BAR; bar.x = 0; bar.st = nullptr;
    if (fused) bar = xcd_barrier_post(ctl + CW_BAR, MISC + 8);
#ifndef PH_MASK
#define PH_MASK 0xFFFFFFFFFFFFFFFFull
#endif
#define IN(k) ((((unsigned long long)PH_MASK >> (k)) & 1ull) && lo <= (k) && (k) < hi)
#define GRID_BAR(k) do { if (fused && IN((k) + 1)) xcd_barrier(bar); } while (0)
#ifndef DUP_MASK
#define DUP_MASK 0ull
#endif
#ifndef DUP_SUB
#define DUP_SUB 0
#endif
#define NREP(k) ((((unsigned long long)DUP_MASK >> (k)) & 1ull) ? 2 : 1)
#define PHASE(k) for (int rep_ = 0; rep_ < NREP(k) && IN(k); ++rep_)

#define WSL() GAS unsigned char* wsg_ = (GAS unsigned char*)args.ws; asm volatile("" : "+s"(wsg_)); unsigned char* ws = (unsigned char*)wsg_
#define XB ((bf16_t*)(ws + WS_XB))
#define SSQ ((float*)(ws + WS_SSQ))
#define ROPE ((float*)(ws + WS_ROPE))
#define MEMN ((bf16_t*)(ws + WS_MEMN))
#define SSQM ((float*)(ws + WS_SSQM))
#define MEMKV ((bf16_t*)(ws + WS_MEMKV))
#define SSQQ ((float*)(ws + WS_SSQQ))
#define SSQKV ((float*)(ws + WS_SSQKV))
#define QX ((bf16_t*)(ws + WS_QX))
#define OX ((bf16_t*)(ws + WS_OX))
#define FL ((float*)(ws + WS_FL))
#define DEC ((float*)(ws + WS_DEC))
#define TOPE ((int*)(ws + WS_TOPE))
#define TOPS ((int*)(ws + WS_TOPS))
#define TOPG ((float*)(ws + WS_TOPG))
#define RSTDF ((float*)(ws + WS_RSTDF))
#define TOKPOS ((int*)(ws + WS_TOKPOS))
#define ROWIDX ((int*)(ws + WS_ROWIDX))
#define GATEP ((float*)(ws + WS_GATEP))
#define RSTDP ((float*)(ws + WS_RSTDP))
#define BIAST ((float*)(ws + WS_BIAST))
#define Z0 ((bf16_t*)(ws + WS_ARENA + AR_Z0))
#define QM ((bf16_t*)(ws + WS_ARENA + AR_QM))
#define KM ((bf16_t*)(ws + WS_ARENA + AR_KM))
#define VM ((bf16_t*)(ws + WS_ARENA + AR_VM))
#define O0 ((bf16_t*)(ws + WS_ARENA + AR_O0))
#define HIDB(i) ((bf16_t*)(ws + WS_ARENA + AR_HID + (size_t)((i) & 1) * HID_BYTES))
#define YB ((bf16_t*)(ws + WS_ARENA + AR_Y))
#define Z1 ((bf16_t*)(ws + WS_ARENA + AR_Z1))
#define O1 ((bf16_t*)(ws + WS_ARENA + AR_O1))
#define XQ ((unsigned char*)(ws + WS_QX))
#define XH ((unsigned short*)(ws + WS_XB))
#define XIN ((const float*)args.in[I_X])

    PHASE(0) {
        WSL();
        LAS float* scr = (LAS float*)(lds + wave * 16384);
        LAS int* cum = (LAS int*)(lds + RING_BYTES + 4096);
        if (tid < N_CVT_JOBS) { const CvtJob jb = get_job(args, tid); cum[64 + tid] = jb.amax ? 0   : (jb.K / 64) * (jb.Npad / 32); }
        __syncthreads();
        if (tid == 0) { int run = 0; for (int j = 0; j < N_CVT_JOBS; ++j) { cum[j] = run; run += cum[64 + j]; } cum[N_CVT_JOBS] = run; cum[N_CVT_JOBS + 1] = 0x7fffffff; }
        __syncthreads();
        {
            const int total = cum[N_CVT_JOBS];
            float va[32], vb[32]; int jL = 0, jP = 0;
            if (gw < total) { const int li = cvt_find(cum, gw, jL); cvt_load(get_job(args, jL), li, lane, va); }
#pragma unroll 1
            for (int it = gw; it < total; it += 2 * NGW) {
                const int it2 = it + NGW, it3 = it + 2 * NGW;
                if (it2 < total) { const int li = cvt_find(cum, it2, jL); cvt_load(get_job(args, jL), li, lane, vb); }
                { const int li = cvt_find(cum, it, jP); const CvtJob jb = get_job(args, jP); cvt_store(jb, scr, li, lane, va); }
                if (it2 < total) {
                    if (it3 < total) { const int li = cvt_find(cum, it3, jL); cvt_load(get_job(args, jL), li, lane, va); }
                    const int li = cvt_find(cum, it2, jP); const CvtJob jb = get_job(args, jP); cvt_store(jb, scr, li, lane, vb);
                }
            }
        }
        for (int m = gw; m < M; m += NGW) {
            const f32x4* xr = (const f32x4*)(XIN + (size_t)m * DM) + lane; f32x4 v[8]; float ss = 0.f, amx = 0.f;
#pragma unroll
            for (int j = 0; j < 8; ++j) { v[j] = xr[64 * j]; ss += (v[j][0] * v[j][0] + v[j][1] * v[j][1]) + (v[j][2] * v[j][2] + v[j][3] * v[j][3]);
                amx = fmaxf(amx, fmaxf(fmaxf(fabsf(v[j][0]), fabsf(v[j][1])), fmaxf(fabsf(v[j][2]), fabsf(v[j][3])))); }
            ss = wave_sum(ss);
#pragma unroll
            for (int o_ = 1; o_ < 64; o_ <<= 1) amx = fmaxf(amx, __shfl_xor(amx, o_));
            const float inv = amx > 0.f ? 127.f / amx : 0.f; unsigned* xq = (unsigned*)((unsigned char*)XB + (size_t)m * DM) + lane;
#pragma unroll
            for (int j = 0; j < 8; ++j) { const int q0 = (int)__builtin_rintf(v[j][0] * inv), q1 = (int)__builtin_rintf(v[j][1] * inv), q2 = (int)__builtin_rintf(v[j][2] * inv), q3 = (int)__builtin_rintf(v[j][3] * inv);
                xq[64 * j] = (unsigned)(q0 & 255) | ((unsigned)(q1 & 255) << 8) | ((unsigned)(q2 & 255) << 16) | ((unsigned)(q3 & 255) << 24); }
            if (lane == 0) RSTDF[m] = __builtin_amdgcn_rsqf(ss * (1.f / DM) + EPS) * amx * (1.f / 127.f);
        }
        for (int m = gw; m < MROWS; m += NGW) row_to_bf16_ssq((const float*)args.in[I_MEM] + (size_t)m * DM, MEMN + (size_t)m * DM, SSQM + (size_t)m * 32, lane);
        const int* pos = (const int*)args.in[I_POS];
        int gt0_ = tid; asm volatile("" : "+v"(gt0_)); gt0_ += bx * 512;
        for (int e = gt0_; e < M * 32; e += G * 512) {
            const int row = e >> 5, i = e & 31;
            const float ang = (float)pos[row] * ROPE_INV[i];
            const double rev = (double)ang * 0.15915494309189535; const float fr = (float)(rev - __builtin_rint(rev));
            ROPE[(size_t)e * 2] = __builtin_amdgcn_cosf(fr); ROPE[(size_t)e * 2 + 1] = __builtin_amdgcn_sinf(fr);
        }
        const float* relb = (const float*)args.in[I_RELB];
        for (int e = gt0_; e < 16 * 128; e += G * 512) { const int h = e >> 7, d = e & 127; BIAST[e] = relb[(int)T5_BUCKET[d] * 16 + h] * LOG2E; }
        if (fused && IN(1) && !IN(44)) xcd_barrier(bar);
        __syncthreads();
    }

    PHASE(44) {
        LAS float* scr = (LAS float*)(lds + wave * 16384);
        LAS float* cam = (LAS float*)(lds + RING_BYTES + 4096);
        constexpr int NBJ = DFF / 32, NB15 = IN1_PAD / 32, NB0 = Z0_LD / 32, NB = 18 * NBJ + NB15 + NB0;
#define Q8DEC(cb_, j_, nb_) const int j_ = (cb_) >= 18 * NBJ + NB15 ? 0 : ((cb_) >= 18 * NBJ ? 15 : ((cb_) / NBJ < 2 ? 12 + (cb_) / NBJ : 15 + (cb_) / NBJ)); \
        const int nb_ = (cb_) >= 18 * NBJ + NB15 ? (cb_) - 18 * NBJ - NB15 : ((cb_) >= 18 * NBJ ? (cb_) - 18 * NBJ : (cb_) % NBJ)
        float v0[32], v1[32], v2[32], v3[32];
        if (bx < NB) { Q8DEC(bx, j, nb); const CvtJob jb = get_job(args, j); const int nblk = jb.Npad / 32;
            cvt_load(jb, (4 * wave + 0) * nblk + nb, lane, v0); cvt_load(jb, (4 * wave + 1) * nblk + nb, lane, v1);
            cvt_load(jb, (4 * wave + 2) * nblk + nb, lane, v2); cvt_load(jb, (4 * wave + 3) * nblk + nb, lane, v3); }
#pragma unroll 1
        for (int cb = bx; cb < NB; cb += G) {
            Q8DEC(cb, j, nb); const CvtJob jb = get_job(args, j); const int nblk = jb.Npad / 32;
            const int cn = cb + G; const bool more = cn < NB; Q8DEC(more ? cn : cb, jn, nbn); const CvtJob jbn = get_job(args, jn); const int nblkn = jbn.Npad / 32;
            float mx = fmaxf(fmaxf(cvt_amax_item(jb, (4 * wave + 0) * nblk + nb, lane, v0), cvt_amax_item(jb, (4 * wave + 1) * nblk + nb, lane, v1)),
                             fmaxf(cvt_amax_item(jb, (4 * wave + 2) * nblk + nb, lane, v2), cvt_amax_item(jb, (4 * wave + 3) * nblk + nb, lane, v3)));
            __syncthreads();
            if (lane < 32) cam[wave * 32 + lane] = mx;
            __syncthreads();
            if (lane < 32) { float m = cam[lane];
#pragma unroll
                for (int w = 1; w < 8; ++w) m = fmaxf(m, cam[w * 32 + lane]);
                cam[256 + wave * 32 + lane] = m;
                const int nn = 32 * nb + lane; if (wave == 0 && nn < jb.Nsrc) jb.amax[jb.row_off + cvt_row(jb.mode, nn)] = __float_as_uint(m); }
            LDS_WAIT(); asm volatile("" ::: "memory");
            const LAS float* camw = cam + 256 + wave * 32;
            cvt_store_q8(jb, scr, (4 * wave + 0) * nblk + nb, lane, v0, camw); if (more) cvt_load(jbn, (4 * wave + 0) * nblkn + nbn, lane, v0);
            cvt_store_q8(jb, scr, (4 * wave + 1) * nblk + nb, lane, v1, camw); if (more) cvt_load(jbn, (4 * wave + 1) * nblkn + nbn, lane, v1);
            cvt_store_q8(jb, scr, (4 * wave + 2) * nblk + nb, lane, v2, camw); if (more) cvt_load(jbn, (4 * wave + 2) * nblkn + nbn, lane, v2);
            cvt_store_q8(jb, scr, (4 * wave + 3) * nblk + nb, lane, v3, camw); if (more) cvt_load(jbn, (4 * wave + 3) * nblkn + nbn, lane, v3);
        }
#undef Q8DEC
        GRID_BAR(0);
    }

    PHASE(1) {
        WSL();
        { pg8::PolPlain P{(const char*)XB  , DM, (const char*)(ws + WS_WIN0)  , DM, DM / 2};
          pg8::StaticOrder S; S.init(M / 256, Z0_LD / 256, G, bx, 0, WGM_K2048);
          pg8::EpiStore<1, 32> E{Z0, Z0_LD, nullptr, (LAS float*)(lds + RING_BYTES + 12288), 1.f / DM, ROPE, SSQQ, SSQKV, nullptr, nullptr, nullptr, RSTDF, ctl + CW_AMAX0};
          pg8::gemm_phase<pg8::EpiStore<1, 32>, pg8::PolPlain, 1>(lds, P, S, E); }
        { pg8::PolPlain P{(const char*)MEMN, DM * 2, (const char*)(ws + WS_WXKV), DM * 2, DM};
          pg8::StaticOrder S; S.init(MROWS / 256, 2048 / 256, G, (G - 1) - bx, 0);
          pg8::EpiStore<0, 32> E{MEMKV, 2048, SSQM, (LAS float*)(lds + RING_BYTES + 12288), 1.f / DM, nullptr, nullptr, nullptr, nullptr, nullptr, nullptr};
          pg8::gemm_phase(lds, P, S, E); }
        GRID_BAR(1);
    }
    PHASE(2) {
        WSL();
        { pg8::PolPlain P{(const char*)Z0, Z0_LD * 2, (const char*)(ws + WS_WUQ), 768 * 2, 768};
          pg8::StaticOrder S; S.init(M / 256, 1536 / 256, G, bx, 0);
          pg8::EpiStore<2, 12> E{QM, QM_LD, SSQQ, (LAS float*)(lds + RING_BYTES + 12288), 1.f / 768.f, ROPE, nullptr, nullptr, nullptr, nullptr, nullptr};
          pg8::gemm_phase(lds, P, S, E); }
        { pg8::PolPlain P{(const char*)(Z0 + 768), Z0_LD * 2, (const char*)(ws + WS_WUKV), 512 * 2, 512};
          pg8::StaticOrder S; S.init(M / 256, 2048 / 256, G, bx, 0);
          pg8::EpiStore<3, 8> E{KM, KM_LD, SSQKV, (LAS float*)(lds + RING_BYTES + 12288), 1.f / 512.f, nullptr, nullptr, nullptr, VM, Z0, nullptr};
          pg8::gemm_phase(lds, P, S, E); }
        GRID_BAR(2);
    }
    PHASE(3) {
        WSL();
#pragma unroll 1
        for (int r3_ = 0; r3_ < (DUP_SUB == 1 ? 2 : 1); ++r3_)
#pragma unroll 1
        for (int it = vcu; it < BATCH * 8 * 32; it += G) {
            const int bh = it >> 5, x = it & 31, b = bh >> 3, h = bh & 7;
#pragma unroll 1
            for (int pass = 0; pass < 2; ++pass) { const int qb = pass ? x : 63 - x;
                fa::AttnArgs a; a.Q = QM + (size_t)b * SEQ * QM_LD + h * 192; a.ldq = QM_LD; a.K = KM + (size_t)b * SEQ * KM_LD + h * 192; a.ldk = KM_LD;
                a.V = VM + (size_t)b * SEQ * VM_LD + h * 128; a.ldv = VM_LD; a.O = O0 + (size_t)b * SEQ * DM + h * 128; a.ldo = DM;
                a.q0 = qb * 256; a.j_lo = 0; a.j_hi = qb * 4 + 4; a.W = 0x3fffffff; a.dec = nullptr; a.sinkl = 0.f; a.sinks = nullptr; a.biasT = nullptr; a.kmax = 0.f;
                fa::attn_unit<192, 128, 0>(a, (LAS char*)lds); } }
        const float* sinks = (const float*)args.in[I_SINKS];
#pragma unroll 1
        for (int r3_ = 0; r3_ < (DUP_SUB == 2 ? 2 : 1); ++r3_)
#pragma unroll 1
        for (int it = vcu; it < BATCH * 2 * (SEQ / 32); it += G) {
            const int bk = it >> 9, qb = it & 511, b = bk >> 1, kvh = bk & 1, q0 = qb * 32;
            fa::AttnArgs a; const bf16_t* zb = Z0 + (size_t)b * SEQ * Z0_LD;
            a.Q = zb + 1344 + kvh * 512; a.ldq = Z0_LD; a.K = zb + 2368 + kvh * 64; a.ldk = Z0_LD; a.V = zb + 2496 + kvh * 64; a.ldv = Z0_LD;
            a.O = O0 + (size_t)b * SEQ * DM + 1024 + kvh * 512; a.ldo = DM;
            a.q0 = q0; a.j_lo = q0 - 127 < 0 ? 0 : (q0 - 127) >> 6; a.j_hi = ((q0 + 31) >> 6) + 1; a.W = 128; a.dec = nullptr; a.sinkl = 0.f; a.sinks = sinks + kvh * 8;
            a.biasT = BIAST + kvh * 8 * 128; a.kmax = 0.f;
            fa::attn_unit<64, 64, 2>(a, (LAS char*)lds); }
        GRID_BAR(3);
    }
    PHASE(4) {
        WSL();
        pg8::PolPlain P{(const char*)O0, DM * 2, (const char*)(ws + WS_WO0), DM * 2, DM};
        pg8::StaticOrder S; S.init(M / 256, DM / 256, G, bx, 0, WGM_K2048);
        pg8::EpiRes<true> E{XIN, XH, SSQ};
        pg8::gemm_phase(lds, P, S, E);
        GRID_BAR(4);
    }
#define CROSS_PHASES(l, s0) \
    PHASE(s0) { WSL(); \
        pg8::PolPlain P{(const char*)XH  , DM * 2, (const char*)(ws + WS_WXQ + (size_t)(l) * E_XQ * 2)  , DM * 2, DM}; \
        pg8::StaticOrder S; S.init(M / 256, 512 / 256, G, bx, 0, WGM_K2048); \
        pg8::EpiStore<0, 32> E{QX, 512, SSQ, (LAS float*)(lds + RING_BYTES + 12288), 1.f / DM, nullptr, nullptr, nullptr, nullptr, nullptr, nullptr}; \
        pg8::gemm_phase<pg8::EpiStore<0, 32>, pg8::PolPlain, 3>(lds, P, S, E); \
        GRID_BAR(s0); } \
    PHASE((s0) + 1) { WSL(); \
        _Pragma("unroll 1") for (int it = vcu; it < BATCH * 4 * 64; it += G) { \
            const int bh = it >> 6, qb = it & 63, b = bh >> 2, h = bh & 3; \
            fa::AttnArgs a; a.Q = QX + (size_t)b * SEQ * 512 + h * 128; a.ldq = 512; a.K = MEMKV + (size_t)b * MEMLEN * 2048 + (l) * 1024 + h * 128; a.ldk = 2048; \
            a.V = a.K + 512; a.ldv = 2048; a.O = OX + (size_t)b * SEQ * 512 + h * 128; a.ldo = 512; \
            a.q0 = qb * 256; a.j_lo = 0; a.j_hi = 4; a.W = 0x3fffffff; a.dec = nullptr; a.sinkl = 0.f; a.sinks = nullptr; a.biasT = nullptr; a.kmax = 0.f; \
            fa::attn_unit<128, 128, 3>(a, (LAS char*)lds); } \
        GRID_BAR((s0) + 1); } \
    PHASE((s0) + 2) { WSL(); \
        pg8::PolPlain P{(const char*)OX, 512 * 2, (const char*)(ws + WS_WXO + (size_t)(l) * E_XO * 2), 512 * 2, 512}; \
        pg8::StaticOrder S; S.init(M / 256, DM / 256, G, bx, 0); \
        pg8::EpiRes<false> E{XH, XH, nullptr};           \
        pg8::gemm_phase(lds, P, S, E); \
        GRID_BAR((s0) + 2); }
    CROSS_PHASES(0, 5)
    PHASE(45) {
        WSL();
#pragma unroll 1
        for (int m = gw; m < M; m += NGW) {
            const u32x2* xr = (const u32x2*)(XH + (size_t)m * DM) + lane; f32x4 v[8]; float ss = 0.f, amx = 0.f;
#pragma unroll
            for (int j = 0; j < 8; ++j) { v[j] = unpk_f16x4(xr[64 * j]); ss += (v[j][0] * v[j][0] + v[j][1] * v[j][1]) + (v[j][2] * v[j][2] + v[j][3] * v[j][3]);
                amx = fmaxf(amx, fmaxf(fmaxf(fabsf(v[j][0]), fabsf(v[j][1])), fmaxf(fabsf(v[j][2]), fabsf(v[j][3])))); }
            ss = wave_sum(ss);
#pragma unroll
            for (int o_ = 1; o_ < 64; o_ <<= 1) amx = fmaxf(amx, __shfl_xor(amx, o_));
            const float inv = amx > 0.f ? 127.f / amx : 0.f; unsigned* xq = (unsigned*)(XQ + (size_t)m * DM) + lane;
#pragma unroll
            for (int j = 0; j < 8; ++j) { const int q0 = (int)__builtin_rintf(v[j][0] * inv), q1 = (int)__builtin_rintf(v[j][1] * inv), q2 = (int)__builtin_rintf(v[j][2] * inv), q3 = (int)__builtin_rintf(v[j][3] * inv);
                xq[64 * j] = (unsigned)(q0 & 255) | ((unsigned)(q1 & 255) << 8) | ((unsigned)(q2 & 255) << 16) | ((unsigned)(q3 & 255) << 24); }
            if (lane == 0) RSTDF[m] = __builtin_amdgcn_rsqf(ss * (1.f / DM) + EPS) * amx * (1.f / 127.f);
        }
        GRID_BAR(7);
    }
#pragma unroll 1
    for (int p = 0; p < 5; ++p) {
        PHASE(8 + p) {
            if (p >= 1) {
                WSL();
                const int c = p - 1;
                pg8::PolChunkA P{(const char*)HIDB(c), 128, (const char*)(ws + WS_WD0), 128, DFF, c * CHUNK_TILES};
                pg8::StaticOrder S; S.init(CHUNK_TILES, DM / 256, G, bx, c * CHUNK_TILES, WGM_DOWN);
                pg8::EpiRes<false> E{XH, XH, SSQ};
                pg8::gemm_phase(lds, P, S, E);
            }
            int pg = p; asm volatile("" : "+s"(pg));
            if (pg <= 3) {
                WSL();
                pg8::PolPlain P{(const char*)XQ, DM, (const char*)(ws + WS_WGU0)  , DM, DM / 2};
                pg8::StaticOrder S; S.init(CHUNK_TILES, 2 * DFF / 256, G, bx, pg * CHUNK_TILES, WGM_GU);
                pg8::EpiSwiGLU<2> E{HIDB(pg), pg * CHUNK_ROWS, nullptr, RSTDF, ctl + CW_AMAXW + 8 * 2 * DFF, nullptr};
                pg8::gemm_phase<pg8::EpiSwiGLU<2>, pg8::PolPlain, 1>(lds, P, S, E);
            }
            GRID_BAR(8 + p);
        }
    }
    PHASE(46) {
        WSL();
#pragma unroll 1
        for (int m = gw; m < M; m += NGW) {
            const u32x2* xr = (const u32x2*)(XH + (size_t)m * DM) + lane; f32x4 v[8]; float ss = 0.f, amx = 0.f;
#pragma unroll
            for (int j = 0; j < 8; ++j) { v[j] = unpk_f16x4(xr[64 * j]); ss += (v[j][0] * v[j][0] + v[j][1] * v[j][1]) + (v[j][2] * v[j][2] + v[j][3] * v[j][3]);
                amx = fmaxf(amx, fmaxf(fmaxf(fabsf(v[j][0]), fabsf(v[j][1])), fmaxf(fabsf(v[j][2]), fabsf(v[j][3])))); }
            ss = wave_sum(ss);
#pragma unroll
            for (int o_ = 1; o_ < 64; o_ <<= 1) amx = fmaxf(amx, __shfl_xor(amx, o_));
            const float inv = amx > 0.f ? 127.f / amx : 0.f; unsigned* xq = (unsigned*)(XQ + (size_t)m * DM) + lane;
#pragma unroll
            for (int j = 0; j < 8; ++j) { const int q0 = (int)__builtin_rintf(v[j][0] * inv), q1 = (int)__builtin_rintf(v[j][1] * inv), q2 = (int)__builtin_rintf(v[j][2] * inv), q3 = (int)__builtin_rintf(v[j][3] * inv);
                xq[64 * j] = (unsigned)(q0 & 255) | ((unsigned)(q1 & 255) << 8) | ((unsigned)(q2 & 255) << 16) | ((unsigned)(q3 & 255) << 24); }
            if (lane == 0) RSTDF[m] = __builtin_amdgcn_rsqf(ss * (1.f / DM) + EPS) * amx * (1.f / 127.f);
        }
        GRID_BAR(15);
    }
    PHASE(16) {
        WSL();
        pg8::PolPlain P{(const char*)XQ  , DM, (const char*)(ws + WS_WIN1)  , DM, DM / 2};
        pg8::StaticOrder S; S.init(M / 256, IN1_PAD / 256, G, bx, 0, WGM_K2048);
        pg8::EpiStore<4, 32> E{Z1, Z1_LD, nullptr, (LAS float*)(lds + RING_BYTES + 12288), 1.f / DM, nullptr, nullptr, nullptr, nullptr, nullptr, FL, RSTDF, ctl + CW_AMAX15};
        pg8::gemm_phase<pg8::EpiStore<4, 32>, pg8::PolPlain, 1>(lds, P, S, E);
        GRID_BAR(16);
    }
    PHASE(17) {
        WSL();
#pragma unroll 1
        for (int b = 0; b < BATCH; ++b) {
            float kmx = 0.f;
#pragma unroll 1
            for (int r = gw; r < SEQ; r += NGW) {
                const u32x4* kp = (const u32x4*)(Z1 + ((size_t)b * SEQ + r) * Z1_LD + 2048 + lane * 32); float ss = 0.f;
#pragma unroll
                for (int q = 0; q < 4; ++q) { const u32x4 w = kp[q];
#pragma unroll
                    for (int e = 0; e < 4; ++e) { const float lo_ = __uint_as_float(w[e] << 16), hi_ = __uint_as_float(w[e] & 0xffff0000u); ss += lo_ * lo_ + hi_ * hi_; } }
                ss += __shfl_xor(ss, 1); ss += __shfl_xor(ss, 2);
                kmx = fmaxf(kmx, ss);
            }
            if ((lane & 3) == 0) atomicMax(ctl + CW_KMAX + 64 * (b * 16 + (lane >> 2)), __float_as_uint(kmx));
        }
        const float* bfv = (const float*)args.in[I_BF];
        LAS double* wtot = (LAS double*)lds;
#pragma unroll 1
        for (int bh = bx; bh < BATCH * 16; bh += G) {
            const int b = bh >> 4, h = bh & 15; const float bias = bfv[h];
            const size_t base = ((size_t)b * SEQ + (size_t)tid * 32) * 16 + h;
            float lf[32]; double run = 0.0;
#pragma unroll
            for (int i = 0; i < 32; ++i) { const float xv = FL[base + (size_t)i * 16] + bias; lf[i] = fminf(xv, 0.f) - log1pf(expf(-fabsf(xv))); }
#pragma unroll
            for (int i = 0; i < 32; ++i) run += (double)lf[i];
            double incl = run;
#pragma unroll
            for (int o = 1; o < 64; o <<= 1) { const double t = __shfl_up(incl, o); if (lane >= o) incl += t; }
            float Aa = 1.f, Bb = 0.f;
#pragma unroll
            for (int i = 0; i < 32; ++i) { const float a_ = __expf(lf[i]); Bb = a_ * Bb + 1.f; Aa *= a_; }
            float Ai = Aa, Bi = Bb;
#pragma unroll
            for (int o = 1; o < 64; o <<= 1) { const float Ap = __shfl_up(Ai, o), Bp = __shfl_up(Bi, o); if (lane >= o) { Bi = Ai * Bp + Bi; Ai = Ai * Ap; } }
            LAS float* wAB = (LAS float*)(lds + 256);
            if (lane == 63) { wtot[wave] = incl; wAB[wave] = Ai; wAB[8 + wave] = Bi; }
            __syncthreads();
            { float Ss = 0.f; for (int w = 0; w < wave; ++w) Ss = wAB[w] * Ss + wAB[8 + w];
              float Ae = __shfl_up(Ai, 1), Be = __shfl_up(Bi, 1); if (lane == 0) { Ae = 1.f; Be = 0.f; }
              const float nk = __expf(lf[0]) * (Ae * Ss + Be);
              if ((tid & 1) == 0) ((float*)ctl)[CW_NEFF + bh * 256 + (tid >> 1)] = nk > 0.f ? log2f(nk) + 0.01f : -100.f; }
            double off = incl - run;
            for (int w = 0; w < wave; ++w) off += wtot[w];
            double cacc = off;
#pragma unroll
            for (int i = 0; i < 32; ++i) { cacc += (double)lf[i]; DEC[base + (size_t)i * 16] = (float)(cacc * 1.4426950408889634); }
            __syncthreads();
        }
        GRID_BAR(17);
    }
    PHASE(18) {
        WSL();
        LAS int* qslot = (LAS int*)(lds + RING_BYTES + 8192);
#pragma unroll 1
        for (;;) {
            if (tid == 0) qslot[0] = (int)__hip_atomic_fetch_add(ctl + CW_Q18, 1u, RLX_AGENT);
            __syncthreads();
            const int u = qslot[0];
            __syncthreads();
            if (u >= BATCH * 16 * 64) break;
            const int qb = 63 - (u >> 5), bh = u & 31, b = bh >> 4, h = bh & 15;
            fa::AttnArgs a; const bf16_t* zb = Z1 + (size_t)b * SEQ * Z1_LD;
            a.Q = zb + h * 128; a.ldq = Z1_LD; a.K = zb + 2048 + h * 128; a.ldk = Z1_LD; a.V = zb + 4096 + h * 128; a.ldv = Z1_LD;
            a.O = O1 + (size_t)b * SEQ * DM + h * 128; a.ldo = DM;
            a.q0 = qb * 256; a.j_lo = 0; a.j_hi = qb * 4 + 4; a.W = 0x3fffffff; a.dec = DEC + (size_t)b * SEQ * 16 + h; a.sinkl = 0.f; a.sinks = nullptr; a.biasT = nullptr;
            a.kmax = sqrtf(__uint_as_float(__hip_atomic_load(ctl + CW_KMAX + 64 * bh, RLX_AGENT))); a.neff = (const float*)ctl + CW_NEFF + bh * 256;
            fa::attn_unit<128, 128, 1>(a, (LAS char*)lds);
        }
        GRID_BAR(18);
    }
    PHASE(19) {
        WSL();
        pg8::PolPlain P{(const char*)O1, DM * 2, (const char*)(ws + WS_WO1), DM * 2, DM};
        pg8::StaticOrder S; S.init(M / 256, DM / 256, G, bx, 0, WGM_K2048);
        pg8::EpiRes<false> E{XH, XH, SSQ};
        pg8::gemm_phase(lds, P, S, E);
        GRID_BAR(19);
    }
    CROSS_PHASES(1, 20)
    PHASE(23) {
        WSL();
        LAS float* WrT = (LAS float*)lds;
        const float* rw = (const float*)args.in[I_RW]; const float* gn = (const float*)args.in[I_NFFN] + DM; const float* rb = (const float*)args.in[I_RB];
        for (int i = tid; i < 8 * DM; i += 512) { const int e = i >> 11, k = i & 2047; WrT[i] = rw[k * 8 + e] * gn[k]; }
        __syncthreads();
#pragma unroll 1
        for (int g16 = gw; g16 < M / 16; g16 += NGW) {
            int e1 = 0, e2 = 0; float g1 = 0.f, g2 = 0.f, rstd = 0.f;
#pragma unroll 1
            for (int i = 0; i < 16; ++i) {
                const int row = g16 * 16 + i;
                const u32x2* xr = (const u32x2*)(XH + (size_t)row * DM) + lane;
                float pe[8], ss = 0.f, amx = 0.f;
#pragma unroll
                for (int e = 0; e < 8; ++e) pe[e] = 0.f;
#pragma unroll 2
                for (int j = 0; j < 8; ++j) { const f32x4 v = unpk_f16x4(xr[64 * j]); ss += (v[0] * v[0] + v[1] * v[1]) + (v[2] * v[2] + v[3] * v[3]);
                    amx = fmaxf(amx, fmaxf(fmaxf(fabsf(v[0]), fabsf(v[1])), fmaxf(fabsf(v[2]), fabsf(v[3]))));
#pragma unroll
                    for (int e = 0; e < 8; ++e) { const f32x4 w = *(const LAS f32x4*)(WrT + e * DM + 256 * j + lane * 4); pe[e] += (v[0] * w[0] + v[1] * w[1]) + (v[2] * w[2] + v[3] * w[3]); } }
                ss = wave_sum(ss);
#pragma unroll
                for (int e = 0; e < 8; ++e) pe[e] = wave_sum(pe[e]);
                const float rs = __builtin_amdgcn_rsqf(ss * (1.f / DM) + EPS);
#pragma unroll
                for (int o_ = 1; o_ < 64; o_ <<= 1) amx = fmaxf(amx, __shfl_xor(amx, o_));
                { const float inv = amx > 0.f ? 127.f / amx : 0.f; unsigned* xq = (unsigned*)(XQ + (size_t)row * DM) + lane;
#pragma unroll 2
                  for (int j = 0; j < 8; ++j) { const f32x4 v = unpk_f16x4(xr[64 * j]);
                      const int q0 = (int)__builtin_rintf(v[0] * inv), q1 = (int)__builtin_rintf(v[1] * inv), q2 = (int)__builtin_rintf(v[2] * inv), q3 = (int)__builtin_rintf(v[3] * inv);
                      xq[64 * j] = (unsigned)(q0 & 255) | ((unsigned)(q1 & 255) << 8) | ((unsigned)(q2 & 255) << 16) | ((unsigned)(q3 & 255) << 24); } }
                const float rowf = rs * amx * (1.f / 127.f);
                float lg[8];
#pragma unroll
                for (int e = 0; e < 8; ++e) lg[e] = pe[e] * rs + rb[e];
                int b1 = 0; float v1 = lg[0];
#pragma unroll
                for (int e = 1; e < 8; ++e) if (lg[e] > v1) { v1 = lg[e]; b1 = e; }
                int b2 = -1; float v2 = -__builtin_inff();
#pragma unroll
                for (int e = 0; e < 8; ++e) if (e != b1 && lg[e] > v2) { v2 = lg[e]; b2 = e; }
                const float ex = __expf(v2 - v1); const float gg2 = ex / (1.f + ex), gg1 = 1.f / (1.f + ex);
                if (lane == i) { e1 = b1; e2 = b2; g1 = gg1; g2 = gg2; rstd = rowf; }
            }
            int s1 = 0, s2 = 0;
#pragma unroll
            for (int e = 0; e < 8; ++e) {
                const unsigned long long m1 = __ballot(lane < 16 && e1 == e), m2 = __ballot(lane < 16 && e2 == e);
                const int c1 = __popcll(m1), c2 = __popcll(m2);
                int basev = 0;
                if (lane == 0 && c1 + c2 > 0) basev = (int)__hip_atomic_fetch_add(ctl + CW_CNT + 64 * e, (unsigned)(c1 + c2), RLX_AGENT);
                basev = __shfl(basev, 0);
                const unsigned long long lt = (1ull << lane) - 1ull;
                if (lane < 16 && e1 == e) s1 = basev + __popcll(m1 & lt);
                if (lane < 16 && e2 == e) s2 = basev + c1 + __popcll(m2 & lt);
            }
            if (lane < 16) { const int row = g16 * 16 + lane; TOPE[row * 2] = e1; TOPE[row * 2 + 1] = e2; TOPS[row * 2] = s1; TOPS[row * 2 + 1] = s2;
                TOPG[row * 2] = g1; TOPG[row * 2 + 1] = g2; RSTDF[row] = rstd; }
        }
        GRID_BAR(23);
    }
    if (hi > 24) {
#define EOFF() int eoff[9]; eoff[0] = 0; _Pragma("unroll") for (int e = 0; e < 8; ++e) { const int c_ = (int)__hip_atomic_load(ctl + CW_CNT + 64 * e, RLX_AGENT); eoff[e + 1] = eoff[e] + ((c_ + 255) & ~255); }
        PHASE(24) {
            WSL();
            EOFF();
            int ecnt[8];
#pragma unroll
            for (int e = 0; e < 8; ++e) ecnt[e] = (int)__hip_atomic_load(ctl + CW_CNT + 64 * e, RLX_AGENT);
            int gt1_ = tid; asm volatile("" : "+v"(gt1_)); gt1_ += bx * 512;
            for (int i = gt1_; i < M * 2; i += G * 512) {
                const int e = TOPE[i], sl = TOPS[i]; int off = 0;
#pragma unroll
                for (int q = 0; q < 8; ++q) if (q == e) off = eoff[q];
                const int pos = off + sl; ROWIDX[pos] = i >> 1; GATEP[pos] = TOPG[i]; RSTDP[pos] = RSTDF[i >> 1]; TOKPOS[i] = pos;
            }
            for (int i = gt1_; i < 8 * 256; i += G * 512) {
                const int e = i >> 8, j = i & 255; int off = 0, cnt = 0, nxt = 0;
#pragma unroll
                for (int q = 0; q < 8; ++q) if (q == e) { off = eoff[q]; cnt = ecnt[q]; nxt = eoff[q + 1]; }
                const int pos = off + cnt + j;
                if (pos < nxt) { ROWIDX[pos] = 0; GATEP[pos] = 0.f; RSTDP[pos] = 0.f; }
            }
            GRID_BAR(24);
        }
        LAS int* TILE_E = (LAS int*)(lds + RING_BYTES + 1024);
        if (hi > 25) {
            EOFF();
            for (int t = tid; t < MOE_MAX_TILES; t += 512) { int e = 0;
#pragma unroll
                for (int q = 1; q < 8; ++q) if (t * 256 >= eoff[q]) e = q;
                TILE_E[t] = e; }
            if (tid == 0) TILE_E[MOE_MAX_TILES] = eoff[8] >> 8;
            __syncthreads();
        }
#pragma unroll 1
        for (int p = 0; p <= MOE_CHUNKS; ++p) {
            PHASE(25 + p) {
                int ndown = 0;
                { WSL();
                const int ntiles = TILE_E[MOE_MAX_TILES], nch = (ntiles + MCH_TILES - 1) / MCH_TILES, t0 = ntiles - MCH_TILES * (nch - 1);
                if (p >= 1 && p - 1 < nch) {
                    const int c = p - 1, ft = c == 0 ? 0 : t0 + (c - 1) * MCH_TILES, nt_ = c == 0 ? t0 : MCH_TILES;
                    pg8::PolMoeDown P{(const char*)HIDB(c)  , 128, (const char*)(ws + WS_WD1)  , 128, DFF / 2, ft, TILE_E, E_D};
                    pg8::StaticOrder S; S.init(nt_, DM / 256, G, bx, ft, WGM_DOWN);
                    pg8::EpiMoeDown E{YB, GATEP};
                    pg8::gemm_phase<pg8::EpiMoeDown, pg8::PolMoeDown, 4>(lds, P, S, E);
                    ndown = nt_ * (DM / 256);
                } }
                int pg = p; asm volatile("" : "+s"(pg), "+s"(ndown));
                { WSL();
                const int ntiles = TILE_E[MOE_MAX_TILES], nch = (ntiles + MCH_TILES - 1) / MCH_TILES, t0 = ntiles - MCH_TILES * (nch - 1);
                if (pg < nch) {
                    const int ft = pg == 0 ? 0 : t0 + (pg - 1) * MCH_TILES, nt_ = pg == 0 ? t0 : MCH_TILES;
                    pg8::PolMoeUp P{(const char*)XQ  , DM, (const char*)(ws + WS_WGU1)  , DM, DM / 2, ROWIDX, TILE_E, E_GU};
                    pg8::StaticOrder S; S.init(nt_, 2 * DFF / 256, G, bx, ft, WGM_GU); S.quota(ndown);
                    pg8::EpiSwiGLU<2> E{HIDB(pg), ft * 256, nullptr, RSTDP, ctl + CW_AMAXW, TILE_E, 1};
                    pg8::gemm_phase<pg8::EpiSwiGLU<2>, pg8::PolMoeUp, 1>(lds, P, S, E);
                } }
                GRID_BAR(25 + p);
            }
        }
    }
    PHASE(43) {
        WSL();
        const float* fn = (const float*)args.in[I_FNORM];
#pragma unroll 1
        for (int m = gw; m < M; m += NGW) {
            const int p0 = TOKPOS[m * 2], p1 = TOKPOS[m * 2 + 1];
            const u32x2* xr = (const u32x2*)(XH + (size_t)m * DM) + lane; f32x4* orow = (f32x4*)(args.out + (size_t)m * DM) + lane;
            const u32x2* y0 = (const u32x2*)(YB + (size_t)p0 * DM) + lane; const u32x2* y1 = (const u32x2*)(YB + (size_t)p1 * DM) + lane;
            f32x4 v[8]; float s = 0.f;
#pragma unroll
            for (int j = 0; j < 8; ++j) { v[j] = unpk_f16x4(xr[64 * j]); const u32x2 a0 = y0[64 * j], a1 = y1[64 * j];
                v[j][0] += __uint_as_float(a0.x << 16) + __uint_as_float(a1.x << 16); v[j][1] += __uint_as_float(a0.x & 0xffff0000u) + __uint_as_float(a1.x & 0xffff0000u);
                v[j][2] += __uint_as_float(a0.y << 16) + __uint_as_float(a1.y << 16); v[j][3] += __uint_as_float(a0.y & 0xffff0000u) + __uint_as_float(a1.y & 0xffff0000u);
                s += (v[j][0] * v[j][0] + v[j][1] * v[j][1]) + (v[j][2] * v[j][2] + v[j][3] * v[j][3]); }
            s = wave_sum(s); const float rs = __builtin_amdgcn_rsqf(s * (1.f / DM) + EPS);
#pragma unroll
            for (int j = 0; j < 8; ++j) { const f32x4 g = *((const f32x4*)fn + lane + 64 * j); orow[64 * j] = v[j] * rs * g; }
        }
    }
#undef IN
#undef GRID_BAR
}

constexpr int N_STEPS = 47;
extern "C" void kernel_launch(void* const* d_in, const int* in_sizes, int n_in, void* d_out, int out_size, void* d_ws, size_t ws_size, hipStream_t stream) {
    static int grid = 0;
    if (grid == 0) {
        if (n_in != N_IN || in_sizes[0] != M * DM || out_size != M * DM || ws_size < WS_END) {
            fprintf(stderr, "kernel_launch: shape / workspace mismatch (n_in %d, in0 %d, out %d, ws %zu, need %zu); nothing launched\n", n_in, n_in > 0 ? in_sizes[0] : -1, out_size, ws_size, (size_t)WS_END); grid = -1; return; }
        int dev = 0, cus = 0, per_cu = 0;
        if (hipGetDevice(&dev) != hipSuccess || hipDeviceGetAttribute(&cus, hipDeviceAttributeMultiprocessorCount, dev) != hipSuccess) { grid = -1; return; }
        if (hipFuncSetAttribute((const void*)trunk_fwd, hipFuncAttributeMaxDynamicSharedMemorySize, LDS_BYTES) != hipSuccess) { fprintf(stderr, "kernel_launch: hipFuncSetAttribute failed\n"); grid = -1; return; }
        if (hipOccupancyMaxActiveBlocksPerMultiprocessor(&per_cu, (const void*)trunk_fwd, NWAVES * 64, LDS_BYTES) != hipSuccess || per_cu < 1)
            fprintf(stderr, "kernel_launch: note: occupancy query reports %d workgroups per CU\n", per_cu);
        (void)hipGetLastError();
        grid = cus;
    }
    if (grid < 0) return;
    if (hipMemsetAsync((char*)d_ws + WS_CTL, 0, CTL_BYTES, stream) != hipSuccess) return;
    Args a{};
    for (int i = 0; i < N_IN; ++i) a.in[i] = d_in[i];
    a.out = (float*)d_out; a.ws = (unsigned char*)d_ws;
#if MK_ONE_LAUNCH
    a.ph_lo = 0; a.ph_hi = N_STEPS;
    hipLaunchKernelGGL(trunk_fwd, dim3(grid), dim3(NWAVES * 64), LDS_BYTES, stream, a);
#else
    for (int i = 0; i < N_STEPS; ++i) { const int s = i == 0 ? 0 : (i == 1 ? 44 : (i <= 8 ? i - 1 : (i == 9 ? 45 : (i <= 14 ? i - 2 : (i == 15 ? 46 : i - 3))))); a.ph_lo = s; a.ph_hi = s + 1; hipLaunchKernelGGL(trunk_fwd, dim3(grid), dim3(NWAVES * 64), LDS_BYTES, stream, a); }
#endif
}
```

```cpp
#include <hip/hip_runtime.h>
#include <hip/hip_bf16.h>
#include <cstdio>
#include <cstdint>
#include <cmath>

#ifndef MK_ONE_LAUNCH
#define MK_ONE_LAUNCH 1
#endif

#define GAS __attribute__((address_space(1)))
#define LAS __attribute__((address_space(3)))
typedef unsigned short bf16_t;
typedef short bf16x8 __attribute__((ext_vector_type(8)));
typedef short s16x4 __attribute__((ext_vector_type(4)));
typedef float f32x2 __attribute__((ext_vector_type(2)));
typedef float f32x4 __attribute__((ext_vector_type(4)));
typedef float f32x16 __attribute__((ext_vector_type(16)));
typedef unsigned u32x2 __attribute__((ext_vector_type(2)));
typedef unsigned u32x4 __attribute__((ext_vector_type(4)));
typedef int i32x4 __attribute__((ext_vector_type(4)));
typedef long i64x2 __attribute__((ext_vector_type(2)));

constexpr int BATCH = 2, SEQ = 16384, DM = 2048, M = BATCH * SEQ, MEMLEN = 256, MROWS = BATCH * MEMLEN;
constexpr int EVEN_IN = 2624, Z0_LD = 2816, ODD_IN = 6160, Z1_LD = 6144, IN1_PAD = 6400;
constexpr int DFF = 7168, NEXP = 8;
constexpr int HLD = DFF + 64;
constexpr int QM_LD = 1536, KM_LD = 1536, VM_LD = 1024;
constexpr float LOG2E = 1.4426950408889634f;
constexpr float C2_MLA = LOG2E * 0.07216878364870323f;
constexpr float C2_SWA = LOG2E * 0.125f;
constexpr float C2_128 = LOG2E * 0.08838834764831845f;
constexpr float EPS = 1e-6f;
constexpr int CHUNK_ROWS = 8192, CHUNK_TILES = 32, MOE_MAX_TILES = 264, MOE_MAX_ROWS = MOE_MAX_TILES * 256;
constexpr int MCH_TILES = 64, MCH_ROWS = MCH_TILES * 256, MOE_CHUNKS = (MOE_MAX_TILES + MCH_TILES - 1) / MCH_TILES;

enum { I_X = 0, I_MEM, I_POS, I_RELB, I_NMIX, I_NCROSS, I_NMEM, I_NFFN, I_XWQ, I_XWK, I_XWV, I_XWO, I_EVWIN, I_QNORM, I_WUQ, I_KVNORM, I_WUKV, I_SINKS, I_EVWO,
       I_FG, I_FU, I_FD, I_ODWIN, I_BF, I_ODWO, I_RW, I_RB, I_MG, I_MU, I_MD, I_FNORM, N_IN };

constexpr size_t al256(size_t x) { return (x + 255) & ~(size_t)255; }
constexpr size_t WS_CTL = 0, CTL_BYTES = 1u << 20;
constexpr size_t E_IN0 = (size_t)Z0_LD * DM, E_UQ = (size_t)1536 * 768, E_UKV = (size_t)2048 * 512, E_SQ = (size_t)DM * DM, E_XQ = (size_t)512 * DM, E_XKV = (size_t)2048 * DM,
                 E_XO = (size_t)DM * 512, E_GU = (size_t)2 * DFF * DM, E_D = (size_t)DM * DFF, E_IN1 = (size_t)IN1_PAD * DM;
constexpr size_t WS_WIN0 = WS_CTL + CTL_BYTES;
constexpr size_t WS_WUQ = WS_WIN0 + 2 * E_IN0;
constexpr size_t WS_WUKV = WS_WUQ + 2 * E_UQ;
constexpr size_t WS_WO0 = WS_WUKV + 2 * E_UKV;
constexpr size_t WS_WXQ = WS_WO0 + 2 * E_SQ;
constexpr size_t WS_WXKV = WS_WXQ + 2 * 2 * E_XQ;
constexpr size_t WS_WXO = WS_WXKV + 2 * E_XKV;
constexpr size_t WS_WGU0 = WS_WXO + 2 * 2 * E_XO;
constexpr size_t WS_WD0 = WS_WGU0 + 2 * E_GU;
constexpr size_t WS_WIN1 = WS_WD0 + 2 * E_D;
constexpr size_t WS_WO1 = WS_WIN1 + 2 * E_IN1;
constexpr size_t WS_WGU1 = WS_WO1 + 2 * E_SQ;
constexpr size_t WS_WD1 = WS_WGU1 + 2 * 8 * E_GU;
constexpr size_t WS_XB = WS_WD1 + 2 * 8 * E_D;
constexpr size_t WS_SSQ = WS_XB + (size_t)M * DM * 2;
constexpr size_t WS_ROPE = WS_SSQ + (size_t)M * 32 * 4;
constexpr size_t WS_MEMN = WS_ROPE + (size_t)M * 64 * 4;
constexpr size_t WS_SSQM = WS_MEMN + (size_t)MROWS * DM * 2;
constexpr size_t WS_MEMKV = WS_SSQM + (size_t)MROWS * 32 * 4;
constexpr size_t WS_SSQQ = WS_MEMKV + (size_t)MROWS * 2048 * 2;
constexpr size_t WS_SSQKV = WS_SSQQ + (size_t)M * 12 * 4;
constexpr size_t WS_QX = WS_SSQKV + (size_t)M * 8 * 4;
constexpr size_t WS_OX = WS_QX + (size_t)M * 512 * 2;
constexpr size_t WS_FL = WS_OX + (size_t)M * 512 * 2;
constexpr size_t WS_DEC = WS_FL + (size_t)M * 16 * 4;
constexpr size_t WS_TOPE = WS_DEC + (size_t)M * 16 * 4;
constexpr size_t WS_TOPS = WS_TOPE + (size_t)M * 2 * 4;
constexpr size_t WS_TOPG = WS_TOPS + (size_t)M * 2 * 4;
constexpr size_t WS_RSTDF = WS_TOPG + (size_t)M * 2 * 4;
constexpr size_t WS_TOKPOS = WS_RSTDF + (size_t)M * 4;
constexpr size_t WS_ROWIDX = WS_TOKPOS + (size_t)M * 2 * 4;
constexpr size_t WS_GATEP = WS_ROWIDX + (size_t)MOE_MAX_ROWS * 4;
constexpr size_t WS_RSTDP = WS_GATEP + (size_t)MOE_MAX_ROWS * 4;
constexpr size_t WS_BIAST = WS_RSTDP + (size_t)MOE_MAX_ROWS * 4;
constexpr size_t WS_ARENA = al256(WS_BIAST + 16 * 128 * 4);
constexpr size_t AR_Z0 = 0;
constexpr size_t AR_QM = AR_Z0 + (size_t)M * Z0_LD * 2;
constexpr size_t AR_KM = AR_QM + (size_t)M * QM_LD * 2;
constexpr size_t AR_VM = AR_KM + (size_t)M * KM_LD * 2;
constexpr size_t AR_O0 = AR_VM + (size_t)M * VM_LD * 2;
constexpr size_t AR_END0 = AR_O0 + (size_t)M * DM * 2;
constexpr size_t AR_HID = 0;
constexpr size_t HID_BYTES = (size_t)CHUNK_ROWS * DFF * 2;
constexpr size_t AR_Y = AR_HID + 2 * HID_BYTES;
constexpr size_t AR_END2 = AR_Y + (size_t)MOE_MAX_ROWS * DM * 2;
constexpr size_t AR_Z1 = 0;
constexpr size_t AR_O1 = AR_Z1 + (size_t)M * Z1_LD * 2;
constexpr size_t AR_END1 = AR_O1 + (size_t)M * DM * 2;
constexpr size_t AR_SIZE = AR_END0 > AR_END1 ? (AR_END0 > AR_END2 ? AR_END0 : AR_END2) : (AR_END1 > AR_END2 ? AR_END1 : AR_END2);
constexpr size_t WS_END = WS_ARENA + AR_SIZE;

constexpr int CW_BAR = 4096;
constexpr int CW_CNT = 16384;
constexpr int CW_KMAX = 20480;
constexpr int CW_Q18 = 24576;
constexpr int CW_AMAX15 = 32768;
constexpr int CW_AMAX0 = 40960;
constexpr int CW_NEFF = 65536;
constexpr int CW_AMAXW = 131072;
static_assert((CW_AMAXW + 9 * 14336) * 4 <= (int)CTL_BYTES, "CTL map");

constexpr int RING_BYTES = 131072;
constexpr int MISC_OFF = RING_BYTES + 320;
constexpr int LDS_BYTES = 147456;
constexpr int NWAVES = 8;
#ifndef WGM_GU
#define WGM_GU 4
#endif
#ifndef WGM_K2048
#define WGM_K2048 4
#endif
#ifndef WGM_DOWN
#define WGM_DOWN 8
#endif

#define LDS_WAIT() asm volatile("s_waitcnt lgkmcnt(0)" ::: "memory")
#define VM_WAIT() asm volatile("s_waitcnt vmcnt(0)" ::: "memory")
#define RLX_AGENT __ATOMIC_RELAXED, __HIP_MEMORY_SCOPE_AGENT
__device__ __forceinline__ unsigned cvt_pk_bf16(float lo, float hi) { unsigned r; asm volatile("v_cvt_pk_bf16_f32 %0, %1, %2" : "=v"(r) : "v"(lo), "v"(hi)); return r; }
typedef _Float16 h16x2 __attribute__((ext_vector_type(2)));
typedef _Float16 h16x8 __attribute__((ext_vector_type(8)));
__device__ __forceinline__ unsigned pk_f16(float lo, float hi) { const h16x2 v = {(_Float16)lo, (_Float16)hi}; return __builtin_bit_cast(unsigned, v); }
__device__ __forceinline__ f32x2 unpk_f16(unsigned u) { const h16x2 v = __builtin_bit_cast(h16x2, u); return (f32x2){(float)v.x, (float)v.y}; }
__device__ __forceinline__ f32x4 unpk_f16x4(u32x2 u) { const f32x2 a = unpk_f16(u.x), b = unpk_f16(u.y); return (f32x4){a.x, a.y, b.x, b.y}; }
__device__ __forceinline__ u32x2 pack8_fp8(f32x4 a, f32x4 b) {
    int lo = 0, hi = 0;
    lo = __builtin_amdgcn_cvt_pk_fp8_f32(a[0], a[1], lo, false); lo = __builtin_amdgcn_cvt_pk_fp8_f32(a[2], a[3], lo, true);
    hi = __builtin_amdgcn_cvt_pk_fp8_f32(b[0], b[1], hi, false); hi = __builtin_amdgcn_cvt_pk_fp8_f32(b[2], b[3], hi, true);
    return (u32x2){(unsigned)lo, (unsigned)hi};
}
__device__ __forceinline__ float bf2f(unsigned short b) { return __uint_as_float((unsigned)b << 16); }
__device__ __forceinline__ float wave_sum(float v) {
#pragma unroll
    for (int o = 1; o < 64; o <<= 1) v += __shfl_xor(v, o);
    return v;
}

#define XB_TMO      128
#define XB_XCNT(j)  (256  + 64 * (j))
#define XB_XSUB(j)  (1280 + 64 * (j))
#define XB_XGEN(j)  (2304 + 64 * (j))
#define XB_TOP      3328
#define XB_TOPGEN   3392
#define XCD_BAR_WORDS 3456
#define XB_SPIN_CAP (1u << 18)
__device__ __forceinline__ unsigned xb_ld(unsigned* p)              { return __hip_atomic_load(p, __ATOMIC_RELAXED, __HIP_MEMORY_SCOPE_AGENT); }
__device__ __forceinline__ unsigned xb_add(unsigned* p, unsigned v) { return __hip_atomic_fetch_add(p, v, __ATOMIC_RELAXED, __HIP_MEMORY_SCOPE_AGENT); }
__device__ __forceinline__ unsigned xb_xcc_id() { return (unsigned)__builtin_amdgcn_s_getreg((3 << 11) | 20) & 0xFu; }
#define XB_SPIN(cond, bar) do { unsigned _sp = 0; while (cond) { __builtin_amdgcn_s_sleep(1); \
    if ((++_sp & 255u) == 0u) { if (xb_ld(&(bar)[XB_TMO])) break; if (_sp > XB_SPIN_CAP) { atomicAdd(&(bar)[XB_TMO], 1u); break; } } } } while (0)
struct XcdBarrier { unsigned* bar; unsigned x; volatile LAS unsigned* st; };
__device__ __forceinline__ XcdBarrier xcd_barrier_post(unsigned* bar, volatile LAS unsigned* st) {
    XcdBarrier b; b.bar = bar; b.x = xb_xcc_id(); b.st = st;
    if (threadIdx.x == 0) (void)xb_add(&bar[XB_XCNT(b.x)], 1u);
    return b;
}
__device__ __forceinline__ void xcd_barrier_complete(unsigned* bar, unsigned x, unsigned& nloc, unsigned& nx) {
    const unsigned G = gridDim.x * gridDim.y * gridDim.z;
    unsigned sum, cnt, mine, sp = 0u;
    for (;;) {
        sum = 0u; cnt = 0u; mine = 0u;
#pragma unroll
        for (unsigned j = 0; j < 16; ++j) { const unsigned c = xb_ld(&bar[XB_XCNT(j)]); sum += c; cnt += (c > 0u) ? 1u : 0u; mine = (j == x) ? c : mine; }
        if (sum == G) break;
        __builtin_amdgcn_s_sleep(1);
        if ((++sp & 255u) == 0u) { if (xb_ld(&bar[XB_TMO])) break; if (sp > XB_SPIN_CAP) { atomicAdd(&bar[XB_TMO], 1u); break; } }
    }
    nloc = mine > 0u ? mine : 1u; nx = cnt > 0u ? cnt : 1u;
}
__device__ __forceinline__ void xcd_barrier(const XcdBarrier& b) {
    asm volatile("s_waitcnt vmcnt(0)" ::: "memory");
    __syncthreads();
    if (threadIdx.x == 0) {
        unsigned* bar = b.bar;
        __builtin_amdgcn_s_waitcnt(0);
        unsigned nloc = b.st[0], nx = b.st[1];
        if (nloc == 0u) { xcd_barrier_complete(bar, b.x, nloc, nx); b.st[0] = nloc; b.st[1] = nx; }
        const unsigned old = xb_add(&bar[XB_XSUB(b.x)], 1u);
        const unsigned gen = old / nloc;
        if (old + 1u == (gen + 1u) * nloc) {
            __builtin_amdgcn_fence(__ATOMIC_RELEASE, "agent");
            asm volatile("s_waitcnt vmcnt(0)" ::: "memory");
            const unsigned og = xb_add(&bar[XB_TOP], 1u);
            const unsigned tg = og / nx;
            if (og + 1u == (tg + 1u) * nx) xb_add(&bar[XB_TOPGEN], 1u);
            else XB_SPIN(xb_ld(&bar[XB_TOPGEN]) == tg, bar);
            __builtin_amdgcn_fence(__ATOMIC_ACQUIRE, "agent");
            xb_add(&bar[XB_XGEN(b.x)], 1u);
            asm volatile("s_waitcnt vmcnt(0)" ::: "memory");
        } else {
            XB_SPIN(xb_ld(&bar[XB_XGEN(b.x)]) == gen, bar);
            __builtin_amdgcn_fence(__ATOMIC_ACQUIRE, "agent");
            asm volatile("s_waitcnt vmcnt(0)" ::: "memory");
        }
    }
    __syncthreads();
}

namespace pg8 {
constexpr int BM = 256, BK = 64, HALF = 128, HTB = HALF * BK * 2, STAGE_BYTES = 8 * HTB, NXCD = 8, WGM = 8;
__host__ __device__ __forceinline__ int lds_byte(int r, int c) { const int st = (r >> 4) * 2 + (c >> 5), rr = r & 15, cc = c & 31, ob = rr * 64 + cc * 2; return st * 1024 + (ob ^ (((ob >> 9) & 1) << 5)); }
__host__ __device__ __forceinline__ void stage_rc(int b, int& R, int& C) { const int st = b / 1024, sb = b % 1024, swz = sb ^ (((sb >> 9) & 1) << 5); R = (st >> 1) * 16 + swz / 64; C = (st & 1) * 32 + (swz % 64) / 2; }
__host__ __device__ __forceinline__ int perm32(int rho) { const int n = rho >> 4, i = rho & 15; return 8 * (i >> 2) + 4 * n + (i & 3); }
struct Unit { int pm, pn; };
struct StaticOrder {
    int nM, nN, nwg, G, c, pm0, nd, qd, wgm;
    __device__ __forceinline__ void init(int nM_, int nN_, int G_, int c_, int pm0_, int wgm_ = WGM) { nM = nM_; nN = nN_; nwg = nM * nN; G = G_; c = c_; pm0 = pm0_; nd = 0; qd = 0; wgm = wgm_; }
    __device__ __forceinline__ void quota(int nd_) { nd = nd_ < G ? nd_ : 0; if (nd_ >= G) return; const int q = (nwg + 5 * nd + G - 1) / G; qd = q > 5 ? q - 5 : 0; }
    __device__ __forceinline__ bool next(int i, Unit& u) const {
        long L;
        if (nd == 0) L = (long)i * G + c;
        else if (c < nd) { if (i >= qd) return false; L = (long)i * G + c; }
        else L = i < qd ? (long)i * G + c : (long)qd * G + (long)(i - qd) * (G - nd) + (c - nd);
        if (L >= nwg) return false;
        int wgid = (int)L; { const int q = nwg / NXCD, r = nwg % NXCD, xcd = wgid % NXCD, off = wgid / NXCD; wgid = (xcd < r ? xcd * (q + 1) : r * (q + 1) + (xcd - r) * q) + off; }
        const int nig = wgm * nN, gid = wgid / nig, fm = gid * wgm, gsz = (nM - fm) < wgm ? (nM - fm) : wgm;
        u.pm = pm0 + fm + ((wgid % nig) % gsz); u.pn = (wgid % nig) / gsz; return true;
    }
};
struct PolPlain {
    const char* A; unsigned lda2; const char* B; unsigned ldb2; int K;
    __device__ __forceinline__ size_t kstepA() const { return 128; }
    __device__ __forceinline__ size_t kstepB() const { return 128; }
    __device__ __forceinline__ unsigned a_off(const Unit& u, int h, int R, int C) const { return (unsigned)(u.pm * BM + h * HALF + R) * lda2 + (unsigned)C * 2u; }
    __device__ __forceinline__ const char* b_ptr(const Unit& u) const { return B + (size_t)u.pn * BM * ldb2; }
};
struct PolMoeUp {
    const char* A; unsigned lda2; const char* B; unsigned ldb2; int K; const int* rowidx; const LAS int* tile_e; size_t estride;
    __device__ __forceinline__ size_t kstepA() const { return 128; }
    __device__ __forceinline__ size_t kstepB() const { return 128; }
    __device__ __forceinline__ unsigned a_off(const Unit& u, int h, int R, int C) const { return (unsigned)rowidx[u.pm * BM + h * HALF + R] * lda2 + (unsigned)C * 2u; }
    __device__ __forceinline__ const char* b_ptr(const Unit& u) const { return B + (size_t)tile_e[u.pm] * estride + (size_t)u.pn * BM * ldb2; }
};
struct PolMoeDown {
    const char* A; unsigned lda2; const char* B; unsigned ldb2; int K; int pmc0; const LAS int* tile_e; size_t estride;
    __device__ __forceinline__ size_t kstepA() const { return (size_t)MCH_ROWS * 128; }
    __device__ __forceinline__ size_t kstepB() const { return (size_t)DM * 128; }
    __device__ __forceinline__ unsigned a_off(const Unit& u, int h, int R, int C) const { return (unsigned)((u.pm - pmc0) * BM + h * HALF + R) * 128u + (unsigned)C * 2u; }
    __device__ __forceinline__ const char* b_ptr(const Unit& u) const { return B + (size_t)tile_e[u.pm] * estride + (size_t)u.pn * BM * 128; }
};
struct PolChunkA {
    const char* A; unsigned lda2; const char* B; unsigned ldb2; int K; int pmc0;
    __device__ __forceinline__ size_t kstepA() const { return (size_t)CHUNK_ROWS * 128; }
    __device__ __forceinline__ size_t kstepB() const { return (size_t)DM * 128; }
    __device__ __forceinline__ unsigned a_off(const Unit& u, int h, int R, int C) const { return (unsigned)((u.pm - pmc0) * BM + h * HALF + R) * 128u + (unsigned)C * 2u; }
    __device__ __forceinline__ const char* b_ptr(const Unit& u) const { return B + (size_t)u.pn * BM * 128; }
};

template <int I8> struct AccT { typedef f32x4 type; };
template <> struct AccT<1> { typedef i32x4 type; };
template <class Epi, class Pol, int I8 = 0>
__device__ __forceinline__ void gemm_phase(LAS unsigned char* lds, const Pol& P, const StaticOrder& S, const Epi& E) {
    typedef typename AccT<I8>::type acc_t;
    int tid_ = threadIdx.x; asm volatile("" : "+v"(tid_));
    const int tid = tid_, wid = __builtin_amdgcn_readfirstlane(tid >> 6), lane = tid & 63, wr = wid >> 2, wc = wid & 3, fr = lane & 15, fq = lane >> 4;
    const int K = P.K, nt = K / BK;
    int sR[2], sC[2]; unsigned voffB[2];
#pragma unroll
    for (int i = 0; i < 2; ++i) { int R, C; stage_rc(tid * 16 + i * 8192, R, C); sR[i] = R; sC[i] = C; const int Rb = (R & ~31) + perm32(R & 31); voffB[i] = (unsigned)Rb * P.ldb2 + (unsigned)C * 2u; }
    const size_t kstepA = P.kstepA(), kstepB = P.kstepB();
    const size_t hstepB = (size_t)HALF * P.ldb2;
    const unsigned ldsw = (unsigned)wid * 1024u;
    const int aoff = lds_byte(wr * 64 + fr, fq * 8), boff = lds_byte(wc * 32 + fr, fq * 8);
#define PG8_SA(b, h) (((b) * 2 + (h)) * HTB)
#define PG8_SB(b, h) ((4 + (b) * 2 + (h)) * HTB)
#define PG8_STAGE(bufoff, gbase, voff) do { _Pragma("unroll") for (int _i = 0; _i < 2; ++_i) \
        __builtin_amdgcn_global_load_lds((const unsigned*)((const char*)(gbase) + (voff)[_i]), (LAS unsigned*)(lds + (bufoff) + ldsw + _i * 8192), 16, 0, 0); } while (0)
#define PG8_LDA(dst, b, h) do { _Pragma("unroll") for (int m = 0; m < 4; ++m) _Pragma("unroll") for (int k = 0; k < 2; ++k) dst[m][k] = *(const LAS bf16x8*)(lds + PG8_SA(b, h) + aoff + m * 2048 + k * 1024); } while (0)
#define PG8_LDB(dst, b, h) do { _Pragma("unroll") for (int n = 0; n < 2; ++n) _Pragma("unroll") for (int k = 0; k < 2; ++k) dst[n][k] = *(const LAS bf16x8*)(lds + PG8_SB(b, h) + boff + n * 2048 + k * 1024); } while (0)
#define PG8_MMA(ai, bj, At, Bt) do { __builtin_amdgcn_s_setprio(1); _Pragma("unroll") for (int m = 0; m < 4; ++m) _Pragma("unroll") for (int n = 0; n < 2; ++n) _Pragma("unroll") for (int k = 0; k < 2; ++k) \
        { if constexpr (I8 == 1) acc[ai][bj][m][n] = __builtin_amdgcn_mfma_i32_16x16x64_i8(__builtin_bit_cast(i32x4, Bt[n][k]), __builtin_bit_cast(i32x4, At[m][k]), acc[ai][bj][m][n], 0, 0, 0); \
          else if constexpr (I8 == 4) { const i64x2 b_ = __builtin_bit_cast(i64x2, Bt[n][k]), a_ = __builtin_bit_cast(i64x2, At[m][k]); \
              acc[ai][bj][m][n] = __builtin_amdgcn_mfma_f32_16x16x32_fp8_fp8(b_[0], a_[0], acc[ai][bj][m][n], 0, 0, 0); acc[ai][bj][m][n] = __builtin_amdgcn_mfma_f32_16x16x32_fp8_fp8(b_[1], a_[1], acc[ai][bj][m][n], 0, 0, 0); } \
          else if constexpr (I8 == 3) acc[ai][bj][m][n] = __builtin_amdgcn_mfma_f32_16x16x32_f16(__builtin_bit_cast(h16x8, Bt[n][k]), __builtin_bit_cast(h16x8, At[m][k]), acc[ai][bj][m][n], 0, 0, 0); \
          else acc[ai][bj][m][n] = __builtin_amdgcn_mfma_f32_16x16x32_bf16(Bt[n][k], At[m][k], acc[ai][bj][m][n], 0, 0, 0); } __builtin_amdgcn_s_setprio(0); } while (0)
#define PG8_WAIT_V(n) asm volatile("s_waitcnt vmcnt(" #n ")" ::: "memory")
#define PG8_WAIT_L(n) asm volatile("s_waitcnt lgkmcnt(" #n ")" ::: "memory")
#define PG8_BAR __builtin_amdgcn_s_barrier()
#define PG8_SCHED __builtin_amdgcn_sched_barrier(0)
    Unit cur, nxt; int ui = 0;
    if (!S.next(0, cur)) return;
    LAS unsigned char* sl_ = lds + RING_BYTES + 4096;
#define PG8_SCALES(u_, slot) do { if constexpr (Epi::LDS_SCALES) { \
        if (wid == 0) __builtin_amdgcn_global_load_lds((const unsigned*)(E.row_src(u_)) + lane * 4, (LAS unsigned*)(sl_ + (slot) * 2048), 16, 0, 0); \
        else if (wid == 1) __builtin_amdgcn_global_load_lds((const unsigned*)(E.col_src(u_)) + lane * 4, (LAS unsigned*)(sl_ + (slot) * 2048 + 1024), 16, 0, 0); } } while (0)
    PG8_SCALES(cur, 0);
    acc_t acc[2][2][4][2];
#pragma unroll
    for (int a = 0; a < 2; ++a)
#pragma unroll
        for (int b = 0; b < 2; ++b)
#pragma unroll
            for (int m = 0; m < 4; ++m)
#pragma unroll
                for (int n = 0; n < 2; ++n) acc[a][b][m][n] = acc_t{};
    bf16x8 At[4][2], B0[2][2], B1[2][2];
    unsigned vC0[2], vC1[2], vN0[2], vN1[2];
#pragma unroll
    for (int i = 0; i < 2; ++i) { vC0[i] = P.a_off(cur, 0, sR[i], sC[i]); vC1[i] = P.a_off(cur, 1, sR[i], sC[i]); }
    const char* Ab = P.A; const char* cB = P.b_ptr(cur);
    PG8_STAGE(PG8_SB(0, 0), cB, voffB); PG8_STAGE(PG8_SB(0, 1), cB + hstepB, voffB); PG8_STAGE(PG8_SA(0, 0), Ab, vC0); PG8_STAGE(PG8_SA(0, 1), Ab, vC1);
    if (wr == 1) PG8_BAR;
    PG8_WAIT_V(2); PG8_BAR;
    PG8_STAGE(PG8_SB(1, 0), cB + kstepB, voffB); PG8_STAGE(PG8_SA(1, 0), Ab + kstepA, vC0); PG8_STAGE(PG8_SB(1, 1), cB + hstepB + kstepB, voffB);
    PG8_WAIT_V(6); PG8_BAR;
    for (;;) {
        const bool has_next = S.next(ui + 1, nxt);
        const char* nB = cB;
#pragma unroll
        for (int i = 0; i < 2; ++i) { vN0[i] = vC0[i]; vN1[i] = vC1[i]; }
        if (has_next) { nB = P.b_ptr(nxt);
#pragma unroll
            for (int i = 0; i < 2; ++i) { vN0[i] = P.a_off(nxt, 0, sR[i], sC[i]); vN1[i] = P.a_off(nxt, 1, sR[i], sC[i]); } }
        int tsc_ = 4; asm volatile("" : "+s"(tsc_));
#pragma unroll 1
        for (int t = 0; t < nt; t += 2) {
            const bool last = (t == nt - 2);
            if (t == tsc_ && has_next) PG8_SCALES(nxt, (ui + 1) & 1);
            const char* a1 = Ab + (size_t)(t + 1) * kstepA;
            const char* a2 = last ? Ab : Ab + (size_t)(t + 2) * kstepA; const char* b2 = last ? nB : cB + (size_t)(t + 2) * kstepB;
            const char* a3 = a2 + kstepA; const char* b3 = b2 + kstepB;
            unsigned v20[2], v21[2];
#pragma unroll
            for (int i = 0; i < 2; ++i) { v20[i] = last ? vN0[i] : vC0[i]; v21[i] = last ? vN1[i] : vC1[i]; }
            PG8_LDB(B0, 0, 0); PG8_LDB(B1, 0, 1); PG8_SCHED; PG8_LDA(At, 0, 0); PG8_STAGE(PG8_SA(1, 1), a1, vC1);
            PG8_WAIT_V(8); PG8_WAIT_L(0); PG8_BAR; PG8_MMA(0, 0, At, B0); PG8_MMA(0, 1, At, B1); PG8_BAR; PG8_SCHED;
            PG8_LDA(At, 0, 1); PG8_STAGE(PG8_SB(0, 0), b2, voffB); PG8_STAGE(PG8_SB(0, 1), b2 + hstepB, voffB); PG8_STAGE(PG8_SA(0, 0), a2, v20);
            PG8_WAIT_V(8); PG8_WAIT_L(0); PG8_BAR; PG8_MMA(1, 0, At, B0); PG8_MMA(1, 1, At, B1); PG8_BAR; PG8_SCHED;
            PG8_LDB(B0, 1, 0); PG8_LDB(B1, 1, 1); PG8_SCHED; PG8_LDA(At, 1, 0); PG8_STAGE(PG8_SA(0, 1), a2, v21);
            PG8_WAIT_V(8); PG8_WAIT_L(0); PG8_BAR; PG8_MMA(0, 0, At, B0); PG8_MMA(0, 1, At, B1); PG8_BAR; PG8_SCHED;
            PG8_LDA(At, 1, 1); PG8_STAGE(PG8_SB(1, 0), b3, voffB); PG8_STAGE(PG8_SB(1, 1), b3 + hstepB, voffB); PG8_STAGE(PG8_SA(1, 0), a3, v20);
            PG8_WAIT_V(8); PG8_WAIT_L(0); PG8_BAR; PG8_MMA(1, 0, At, B0); PG8_MMA(1, 1, At, B1); PG8_BAR; PG8_SCHED;
        }
        if (wr == 0) PG8_BAR;
        E(acc, cur, wr, wc, fr, fq, (const LAS unsigned char*)(sl_ + (ui & 1) * 2048));
        if (!has_next) break;
#pragma unroll
        for (int a = 0; a < 2; ++a)
#pragma unroll
            for (int b = 0; b < 2; ++b)
#pragma unroll
                for (int m = 0; m < 4; ++m)
#pragma unroll
                    for (int n = 0; n < 2; ++n) acc[a][b][m][n] = acc_t{};
        cur = nxt; cB = nB; ++ui;
#pragma unroll
        for (int i = 0; i < 2; ++i) { vC0[i] = vN0[i]; vC1[i] = vN1[i]; }
        if (wr == 1) PG8_BAR;
    }
    PG8_WAIT_V(0);
    PG8_BAR;
#undef PG8_SA
#undef PG8_SB
#undef PG8_STAGE
#undef PG8_SCALES
#undef PG8_LDA
#undef PG8_LDB
#undef PG8_MMA
#undef PG8_WAIT_V
#undef PG8_WAIT_L
#undef PG8_BAR
#undef PG8_SCHED
}

__device__ __forceinline__ float row_rstd(const float* ssq, int row, int nparts, float inv_n) {
    const f32x4* p = (const f32x4*)(ssq + (size_t)row * nparts); f32x4 s = p[0];
    for (int i = 1; i < nparts / 4; ++i) s += p[i];
    return __builtin_amdgcn_rsqf(((s[0] + s[1]) + (s[2] + s[3])) * inv_n + EPS);
}
template <int NP>
__device__ __forceinline__ void wave_row_rstd(const float* ssq, float inv_n, int rowbase, int wr, int wid, int fr, LAS float* xl, float (&rs)[8]) {
    const int lane = threadIdx.x & 63; LAS float* wl = xl + wid * 128;
    f32x4 sa = (f32x4){0.f, 0.f, 0.f, 0.f}, sb = sa;
    const f32x4* pa = (const f32x4*)(ssq + (size_t)(rowbase + wr * 64 + lane) * NP); const f32x4* pb = (const f32x4*)(ssq + (size_t)(rowbase + HALF + wr * 64 + lane) * NP);
#pragma unroll
    for (int i = 0; i < NP / 4; ++i) { sa += pa[i]; sb += pb[i]; }
    wl[lane] = __builtin_amdgcn_rsqf(((sa[0] + sa[1]) + (sa[2] + sa[3])) * inv_n + EPS);
    wl[64 + lane] = __builtin_amdgcn_rsqf(((sb[0] + sb[1]) + (sb[2] + sb[3])) * inv_n + EPS);
    asm volatile("s_waitcnt lgkmcnt(0)" ::: "memory");
#pragma unroll
    for (int ai = 0; ai < 2; ++ai)
#pragma unroll
        for (int m = 0; m < 4; ++m) rs[ai * 4 + m] = wl[ai * 64 + 16 * m + fr];
    asm volatile("s_waitcnt lgkmcnt(0)" ::: "memory");
}
__device__ __forceinline__ void rope8(f32x4& v0, f32x4& v1, const float* tab  ) {
    const f32x4 t0 = *(const f32x4*)tab, t1 = *(const f32x4*)(tab + 4);
    f32x4 a = v0, b = v1;
    v0[0] = a[0] * t0[0] - a[1] * t0[1]; v0[1] = a[1] * t0[0] + a[0] * t0[1]; v0[2] = a[2] * t0[2] - a[3] * t0[3]; v0[3] = a[3] * t0[2] + a[2] * t0[3];
    v1[0] = b[0] * t1[0] - b[1] * t1[1]; v1[1] = b[1] * t1[0] + b[0] * t1[1]; v1[2] = b[2] * t1[2] - b[3] * t1[3]; v1[3] = b[3] * t1[2] + b[2] * t1[3];
}
__device__ __forceinline__ u32x4 pack8(f32x4 v0, f32x4 v1) { u32x4 w; w.x = cvt_pk_bf16(v0[0], v0[1]); w.y = cvt_pk_bf16(v0[2], v0[3]); w.z = cvt_pk_bf16(v1[0], v1[1]); w.w = cvt_pk_bf16(v1[2], v1[3]); return w; }
__device__ __forceinline__ float sq8(f32x4 v0, f32x4 v1) { return (v0[0] * v0[0] + v0[1] * v0[1]) + (v0[2] * v0[2] + v0[3] * v0[3]) + (v1[0] * v1[0] + v1[1] * v1[1]) + (v1[2] * v1[2] + v1[3] * v1[3]); }

__device__ __forceinline__ f32x4 acc_f(const f32x4& a) { return a; }
__device__ __forceinline__ f32x4 acc_f(const i32x4& a) { return __builtin_convertvector(a, f32x4); }
template <int MODE, int NP> struct EpiStore {
    bf16_t* O; int ldc; const float* ssq; LAS float* xl; float inv_n;
    const float* rope; float* ssq_q; float* ssq_kv;
    bf16_t* O2; const bf16_t* Zsrc; float* Flog;
    const float* rowf; const unsigned* cmax;
    static constexpr bool LDS_SCALES = (MODE == 1 || MODE == 4);
    __device__ __forceinline__ const float* row_src(const Unit& u) const { return rowf + u.pm * BM; }
    __device__ __forceinline__ const unsigned* col_src(const Unit& u) const { return cmax + u.pn * BM; }
    template <class ACC>
    __device__ __forceinline__ void operator()(const ACC (&acc)[2][2][4][2], const Unit& u, int wr, int wc, int fr, int fq, const LAS unsigned char* lsc) const {
        const int row0 = u.pm * BM + wr * 64 + fr;
        float rs8[8];
        const LAS unsigned* cp = (const LAS unsigned*)(lsc + 1024) + wc * 32 + 8 * fq; const LAS float* rp = (const LAS float*)lsc + wr * 64 + fr;
        if (!LDS_SCALES) wave_row_rstd<NP>(ssq, inv_n, u.pm * BM, wr, wr * 4 + wc, fr, xl, rs8);
#pragma unroll
        for (int ai = 0; ai < 2; ++ai)
#pragma unroll
            for (int m = 0; m < 4; ++m) {
                const int row = row0 + ai * HALF + m * 16;
                const float rs = LDS_SCALES ? rp[ai * HALF + m * 16] * (1.f / 127.f) : rs8[ai * 4 + m];
                float sq = 0.f;
#pragma unroll
                for (int bj = 0; bj < 2; ++bj) {
                    const int col = u.pn * BM + bj * HALF + wc * 32 + 8 * fq;
                    f32x4 v0 = acc_f(acc[ai][bj][m][0]) * rs, v1 = acc_f(acc[ai][bj][m][1]) * rs;
                    if (LDS_SCALES) { const u32x4 c0 = *(const LAS u32x4*)(cp + bj * HALF), c1 = *(const LAS u32x4*)(cp + bj * HALF + 4);
                        v0 *= (f32x4){__uint_as_float(c0.x), __uint_as_float(c0.y), __uint_as_float(c0.z), __uint_as_float(c0.w)};
                        v1 *= (f32x4){__uint_as_float(c1.x), __uint_as_float(c1.y), __uint_as_float(c1.z), __uint_as_float(c1.w)}; }
                    if (MODE == 1) { if (col >= 1280 && col < 1344) rope8(v0, v1, rope + (size_t)row * 64 + (col - 1280)); sq += sq8(v0, v1); }
                    if (MODE == 2) { const int w = col % 192; if (w >= 128) rope8(v0, v1, rope + (size_t)row * 64 + (w - 128)); }
                    if (MODE == 3) {
                        if (bj == 0) *(u32x4*)(O + (size_t)row * KM_LD + u.pn * 192 + wc * 32 + 8 * fq) = pack8(v0, v1);
                        else *(u32x4*)(O2 + (size_t)row * VM_LD + u.pn * 128 + wc * 32 + 8 * fq) = pack8(v0, v1);
                    } else if (MODE == 4) {
                        if (u.pn < 24) *(u32x4*)(O + (size_t)row * ldc + col) = pack8(v0, v1);
                        else if (bj == 0 && wc == 0 && fq < 2) { *(f32x4*)(Flog + (size_t)row * 16 + 8 * fq) = v0; *(f32x4*)(Flog + (size_t)row * 16 + 8 * fq + 4) = v1; }
                    } else *(u32x4*)(O + (size_t)row * ldc + col) = pack8(v0, v1);
                }
                if (MODE == 1 && u.pn < 5) {
                    sq += __shfl_xor(sq, 16); sq += __shfl_xor(sq, 32);
                    if (fq == 0) { if (u.pn < 3) ssq_q[(size_t)row * 12 + u.pn * 4 + wc] = sq; else ssq_kv[(size_t)row * 8 + (u.pn - 3) * 4 + wc] = sq; }
                }
                asm volatile("" ::: "memory");
            }
        if (MODE == 3) {
            const int tid = (wr * 4 + wc) * 64 + fq * 16 + fr;
#pragma unroll
            for (int i = 0; i < 4; ++i) { const int idx = tid + 512 * i, r = idx >> 3, c = idx & 7; const size_t row = (size_t)u.pm * BM + r;
                *(u32x4*)(O + row * KM_LD + u.pn * 192 + 128 + c * 8) = *(const u32x4*)(Zsrc + row * Z0_LD + 1280 + c * 8); }
        }
    }
};
template <bool BF32> struct EpiRes {
    const void* base; unsigned short* out; float* ssq; float sc = 1.f;
    static constexpr bool LDS_SCALES = false;
    __device__ __forceinline__ void operator()(const f32x4 (&acc)[2][2][4][2], const Unit& u, int wr, int wc, int fr, int fq, const LAS unsigned char*) const {
        const int row0 = u.pm * BM + wr * 64 + fr; const int colb = u.pn * BM + wc * 32 + 8 * fq;
        f32x4 bA[2][2], bB[2][2];
#define ER_LOAD(dst, i) do { const size_t off_ = (size_t)(row0 + ((i) >> 2) * HALF + ((i) & 3) * 16) * DM + colb; \
        _Pragma("unroll") for (int bj = 0; bj < 2; ++bj) { \
            if constexpr (BF32) { dst[bj][0] = *(const f32x4*)((const float*)base + off_ + bj * HALF); dst[bj][1] = *(const f32x4*)((const float*)base + off_ + bj * HALF + 4); } \
            else { const u32x4 h_ = *(const u32x4*)((const unsigned short*)base + off_ + bj * HALF); dst[bj][0] = unpk_f16x4((u32x2){h_.x, h_.y}); dst[bj][1] = unpk_f16x4((u32x2){h_.z, h_.w}); } } } while (0)
#define ER_DO(src, i) do { const int ai = (i) >> 2, m = (i) & 3; const int row = row0 + ai * HALF + m * 16; float sq = 0.f; \
        _Pragma("unroll") for (int bj = 0; bj < 2; ++bj) { const size_t off = (size_t)row * DM + colb + bj * HALF; \
            const f32x4 v0 = acc[ai][bj][m][0] * sc + src[bj][0], v1 = acc[ai][bj][m][1] * sc + src[bj][1]; \
            u32x4 w_; w_.x = pk_f16(v0[0], v0[1]); w_.y = pk_f16(v0[2], v0[3]); w_.z = pk_f16(v1[0], v1[1]); w_.w = pk_f16(v1[2], v1[3]); \
            *(u32x4*)(out + off) = w_; sq += sq8(v0, v1); } \
        if (ssq) { sq += __shfl_xor(sq, 16); sq += __shfl_xor(sq, 32); if (fq == 0) ssq[(size_t)row * 32 + u.pn * 4 + wc] = sq; } } while (0)
        ER_LOAD(bA, 0); asm volatile("" ::: "memory");
#pragma unroll
        for (int i = 0; i < 8; i += 2) {
            ER_LOAD(bB, i + 1); asm volatile("" ::: "memory");
            ER_DO(bA, i); asm volatile("" ::: "memory");
            if (i + 2 < 8) { ER_LOAD(bA, i + 2); asm volatile("" ::: "memory"); }
            ER_DO(bB, i + 1); asm volatile("" ::: "memory");
        }
#undef ER_LOAD
#undef ER_DO
    }
};
template <int RS> struct EpiSwiGLU {
    bf16_t* H; int row_base; const float* ssq; const float* rsp; const unsigned* cmax; const LAS int* tile_e; int f8 = 0;
    static constexpr bool LDS_SCALES = (RS == 2);
    __device__ __forceinline__ const float* row_src(const Unit& u) const { return rsp + u.pm * BM; }
    __device__ __forceinline__ const unsigned* col_src(const Unit& u) const { return cmax + (size_t)(tile_e ? tile_e[u.pm] : 0) * (2 * DFF) + u.pn * BM; }
    template <class ACC>
    __device__ __forceinline__ void operator()(const ACC (&acc)[2][2][4][2], const Unit& u, int wr, int wc, int fr, int fq, const LAS unsigned char* lsc) const {
        const int row0 = u.pm * BM + wr * 64 + fr;
        f32x4 sg[2], su[2];
        if (RS == 2) { const LAS unsigned* cp = (const LAS unsigned*)(lsc + 1024) + wc * 32 + 8 * fq;
#pragma unroll
            for (int n = 0; n < 2; ++n) { const u32x4 a = *(const LAS u32x4*)(cp + 4 * n), b = *(const LAS u32x4*)(cp + HALF + 4 * n);
#pragma unroll
                for (int j = 0; j < 4; ++j) { sg[n][j] = __uint_as_float(a[j]) * (1.f / 127.f); su[n][j] = __uint_as_float(b[j]) * (1.f / 127.f); } } }
        float rs8[8];
#pragma unroll
        for (int i = 0; i < 8; ++i) { const int row = row0 + (i >> 2) * HALF + (i & 3) * 16;
            if (RS == 2) rs8[i] = ((const LAS float*)lsc)[wr * 64 + fr + (i >> 2) * HALF + (i & 3) * 16]; else rs8[i] = RS == 0 ? row_rstd(ssq, row, 32, 1.f / DM) : rsp[row]; }
#pragma unroll
        for (int ai = 0; ai < 2; ++ai)
#pragma unroll
            for (int m = 0; m < 4; ++m) {
                const int row = row0 + ai * HALF + m * 16;
                const float rs = rs8[ai * 4 + m];
                f32x4 o[2];
#pragma unroll
                for (int n = 0; n < 2; ++n) { f32x4 g = acc_f(acc[ai][0][m][n]) * rs, up = acc_f(acc[ai][1][m][n]) * rs;
                    if (RS == 2) { g *= sg[n]; up *= su[n]; }
#pragma unroll
                    for (int j = 0; j < 4; ++j) o[n][j] = g[j] * __builtin_amdgcn_rcpf(1.f + __builtin_amdgcn_exp2f(-LOG2E * g[j])) * up[j]; }
                if (RS == 2 && f8) {
                    _Pragma("unroll") for (int n = 0; n < 2; ++n) _Pragma("unroll") for (int j = 0; j < 4; ++j) o[n][j] = __builtin_amdgcn_fmed3f(o[n][j], -448.f, 448.f);
                    *(u32x2*)((unsigned char*)H + ((size_t)u.pn * MCH_ROWS + (row - row_base)) * 128 + wc * 32 + 8 * fq) = pack8_fp8(o[0], o[1]);
                } else
                *(u32x4*)(H + ((size_t)(u.pn * 2 + (wc >> 1)) * CHUNK_ROWS + (row - row_base)) * 64 + (wc & 1) * 32 + 8 * fq) = pack8(o[0], o[1]);
                asm volatile("" ::: "memory");
            }
    }
};
struct EpiMoeDown {
    bf16_t* Y; const float* gate;
    static constexpr bool LDS_SCALES = false;
    __device__ __forceinline__ void operator()(const f32x4 (&acc)[2][2][4][2], const Unit& u, int wr, int wc, int fr, int fq, const LAS unsigned char*) const {
        const int row0 = u.pm * BM + wr * 64 + fr;
        float g8[8];
#pragma unroll
        for (int i = 0; i < 8; ++i) g8[i] = gate[row0 + (i >> 2) * HALF + (i & 3) * 16] * (1.f / 64.f);
#pragma unroll
        for (int ai = 0; ai < 2; ++ai)
#pragma unroll
            for (int m = 0; m < 4; ++m) {
                const int row = row0 + ai * HALF + m * 16; const float g = g8[ai * 4 + m];
#pragma unroll
                for (int bj = 0; bj < 2; ++bj) *(u32x2*)((unsigned char*)Y + (size_t)row * DM + u.pn * BM + bj * HALF + wc * 32 + 8 * fq) = pack8_fp8(acc[ai][bj][m][0] * g, acc[ai][bj][m][1] * g);
                asm volatile("" ::: "memory");
            }
    }
};
}

namespace fa {
#define SBAR() __builtin_amdgcn_sched_barrier(0)
template <int NDV> __device__ __forceinline__ int v_st(int k, int c) { const int kk = (k & ~0xC) | ((k & 4) << 1) | ((k & 8) >> 1); return ((kk >> 3) * NDV + (c >> 5)) * 512 + ((kk & 7) * 32 + (c & 31)) * 2; }
__device__ __forceinline__ int v_rd_base(int lane) { return ((lane & 3) << 3) | (((lane >> 2) & 3) << 6) | (((lane >> 4) & 1) << 5) | (((lane >> 5) & 1) << 8); }
__device__ __forceinline__ int crow(int r, int hi) { return (r & 3) + 8 * (r >> 2) + 4 * hi; }
__device__ __forceinline__ void mask_tile(f32x16& p0, f32x16& p1, int dq, unsigned W) {
    const float NEG = -__builtin_inff();
#pragma unroll
    for (int r = 0; r < 16; ++r) {
        const int c = (r & 3) + 8 * (r >> 2);
        if ((unsigned)(dq - c) >= W) p0[r] = NEG;
        if ((unsigned)(dq - c - 32) >= W) p1[r] = NEG;
    }
}
struct AttnArgs {
    const bf16_t* Q; int ldq; const bf16_t* K; int ldk; const bf16_t* V; int ldv; bf16_t* O; int ldo;
    int q0, j_lo, j_hi, W;
    const float* dec;
    float sinkl; const float* biasT;
    const float* sinks;
    float kmax;
    const float* neff;
};
template <int DK, int DV, int MODE>
__device__ __forceinline__ void attn_unit(const AttnArgs& a, LAS char* lds) {
    constexpr int KROWB = DK * 2 + 16  , SHM_K = 64 * KROWB, SHM_V = 64 * DV * 2, NDK = DK / 16, NDV = DV / 32, KCH = DK / 8, VCH = DV / 8, KPT = KCH * 64 / 512, VPT = VCH * 64 / 512;
    constexpr int RB = NDV * 512;
    constexpr float THR = 8.f;
    int tid_ = threadIdx.x; asm volatile("" : "+v"(tid_));
    const int tid = tid_, wid = __builtin_amdgcn_readfirstlane(tid >> 6), lane = tid & 63, r32 = lane & 31, hi = lane >> 5;
    LAS char* V_lds = lds; LAS char* K_lds = lds + 2 * SHM_V;
    LAS float* dec_l = (LAS float*)(K_lds + 2 * SHM_K);
    LAS float* ws = dec_l + 128 + wid * 64;
    LAS float* bias_l = dec_l + 128 + 512 + ((MODE == 2) ? wid * 128 : 0);
    const int NT = a.j_hi - a.j_lo;
    const int qlo = (MODE == 2) ? a.q0 : a.q0 + wid * 32, qpos = qlo + r32;
    const int hoff = (MODE == 2) ? wid * 64 : 0;
    static_assert(KPT == KCH / 8 && VPT == VCH / 8, "staging map");
    const int srow_ = tid >> 3, scg_ = tid & 7;
    const int kws0 = srow_ * KROWB + scg_ * 16, vws0 = v_st<NDV>(srow_, scg_ * 8);
    const unsigned ksrc0 = (unsigned)(srow_ * a.ldk + scg_ * 8) * 2u, vsrc0 = (unsigned)(srow_ * a.ldv + scg_ * 8) * 2u;
    bf16x8 qr[NDK];
#pragma unroll
    for (int d0 = 0; d0 < NDK; ++d0) qr[d0] = *(const bf16x8*)(a.Q + (size_t)qpos * a.ldq + hoff + d0 * 16 + hi * 8);
    __builtin_amdgcn_s_waitcnt(0x0F70);
    float m_reg = -1e30f, l_reg = 0.f, skm = 0.f;
    if (MODE == 2) { m_reg = a.sinks[wid] * LOG2E; l_reg = 1.f; }
    f32x16 o[NDV];
#pragma unroll
    for (int d = 0; d < NDV; ++d) o[d] = f32x16{};
    float clq = 0.f; if (MODE == 1) clq = a.dec[(size_t)qpos * 16];
    if (MODE == 2) { (dec_l + 128 + 512)[tid] = a.biasT[tid]; (dec_l + 128 + 512)[tid + 512] = a.biasT[tid + 512]; }
    const int vb0 = (int)(uintptr_t)V_lds + v_rd_base(lane);
    const int kq = r32 * KROWB;
    bf16x8 sk[2][KPT], sv[2][VPT]; float sdec[2] = {0.f, 0.f};
    if (wid >= 4) __builtin_amdgcn_s_setprio(1);
#define FA_LOADT(j, S_) do { const size_t kb_ = (size_t)(j) * 64; const char* kt_ = (const char*)(a.K + kb_ * a.ldk); const char* vt_ = (const char*)(a.V + kb_ * a.ldv); \
        _Pragma("unroll") for (int i = 0; i < KPT; ++i) sk[S_][i] = *(const bf16x8*)(kt_ + ksrc0 + i * 128); \
        _Pragma("unroll") for (int i = 0; i < VPT; ++i) sv[S_][i] = *(const bf16x8*)(vt_ + vsrc0 + i * 128); \
        if (MODE == 1) { if (tid < 64) sdec[S_] = a.dec[(kb_ + tid) * 16]; else if (tid == 64) sdec[S_] = a.neff[(j)]; } } while (0)
#define FA_WRITET(bf, S_) do { \
        _Pragma("unroll") for (int i = 0; i < KPT; ++i) *(LAS bf16x8*)(K_lds + (bf) * SHM_K + kws0 + i * 128) = sk[S_][i]; \
        _Pragma("unroll") for (int i = 0; i < VPT; ++i) *(LAS bf16x8*)(V_lds + (bf) * SHM_V + vws0 + i * 1024) = sv[S_][i]; \
        if (MODE == 1) { if (tid < 64) dec_l[(bf) * 64 + tid] = sdec[S_]; else if (tid == 64) dec_l[800 + (bf)] = sdec[S_]; } } while (0)
#define FA_TR(dst, off) asm volatile("ds_read_b64_tr_b16 %0, %1 offset:%2" : "=&v"(dst) : "v"(vb0), "i"(off) : "memory")
#define FA_VRD(S, BUF, d0) do { constexpr int b_ = (BUF) * SHM_V + (d0) * 512; \
        FA_TR(S##l[0], b_); FA_TR(S##h[0], b_ + RB); FA_TR(S##l[1], b_ + 2 * RB); FA_TR(S##h[1], b_ + 3 * RB); FA_TR(S##l[2], b_ + 4 * RB); FA_TR(S##h[2], b_ + 5 * RB); FA_TR(S##l[3], b_ + 6 * RB); FA_TR(S##h[3], b_ + 7 * RB); } while (0)
#define FA_VMM(S, d0) do { \
        o[d0] = __builtin_amdgcn_mfma_f32_32x32x16_bf16(pa0, (bf16x8){S##l[0][0], S##l[0][1], S##l[0][2], S##l[0][3], S##h[0][0], S##h[0][1], S##h[0][2], S##h[0][3]}, o[d0], 0, 0, 0); \
        o[d0] = __builtin_amdgcn_mfma_f32_32x32x16_bf16(pa1, (bf16x8){S##l[1][0], S##l[1][1], S##l[1][2], S##l[1][3], S##h[1][0], S##h[1][1], S##h[1][2], S##h[1][3]}, o[d0], 0, 0, 0); \
        o[d0] = __builtin_amdgcn_mfma_f32_32x32x16_bf16(pa2, (bf16x8){S##l[2][0], S##l[2][1], S##l[2][2], S##l[2][3], S##h[2][0], S##h[2][1], S##h[2][2], S##h[2][3]}, o[d0], 0, 0, 0); \
        o[d0] = __builtin_amdgcn_mfma_f32_32x32x16_bf16(pa3, (bf16x8){S##l[3][0], S##l[3][1], S##l[3][2], S##l[3][3], S##h[3][0], S##h[3][1], S##h[3][2], S##h[3][3]}, o[d0], 0, 0, 0); } while (0)
#define FA_LW(n) do { asm volatile("s_waitcnt lgkmcnt(" #n ")" ::: "memory"); SBAR(); } while (0)
#define FA_PVALL(BUF) do { s16x4 Al[4], Ah[4], Bl[4], Bh[4]; \
        FA_VRD(A, BUF, 0); FA_VRD(B, BUF, 1); FA_LW(8); FA_VMM(A, 0); \
        if constexpr (NDV == 4) { FA_VRD(A, BUF, 2); FA_LW(8); FA_VMM(B, 1); FA_VRD(B, BUF, 3); FA_LW(8); FA_VMM(A, 2); FA_LW(0); FA_VMM(B, 3); } \
        else { FA_LW(0); FA_VMM(B, 1); } } while (0)
#define FA_PK4(P, B_, OUT) do { unsigned a0 = cvt_pk_bf16(P[B_ + 0], P[B_ + 1]), a1 = cvt_pk_bf16(P[B_ + 2], P[B_ + 3]); \
        unsigned b0 = cvt_pk_bf16(P[B_ + 4], P[B_ + 5]), b1 = cvt_pk_bf16(P[B_ + 6], P[B_ + 7]); \
        auto r0 = __builtin_amdgcn_permlane32_swap(a0, b0, false, false); auto r1 = __builtin_amdgcn_permlane32_swap(a1, b1, false, false); \
        u32x4 w = {r0[0], r1[0], r0[1], r1[1]}; OUT = *reinterpret_cast<bf16x8*>(&w); } while (0)
#define FA_COMPUTE(BUF, kb) do { \
            f32x16 p0, p1; \
            if (MODE == 1) { _Pragma("unroll") for (int r = 0; r < 16; ++r) { p0[r] = clq - dec_l[(BUF) * 64 + crow(r, hi)]; p1[r] = clq - dec_l[(BUF) * 64 + 32 + crow(r, hi)]; } } \
            else { p0 = f32x16{}; p1 = f32x16{}; } \
            { const LAS char* kbp[4];     \
              kbp[0] = K_lds + (BUF) * SHM_K + kq + hi * 16; \
              bf16x8 ka0 = *(const LAS bf16x8*)kbp[0], ka1 = *(const LAS bf16x8*)(kbp[0] + 32 * KROWB), kb0, kb1; SBAR(); \
              _Pragma("unroll") for (int d0 = 0; d0 < NDK; d0 += 2) { \
                  { const LAS char* ap = kbp[0] + (d0 + 1) * 32; kb0 = *(const LAS bf16x8*)ap; kb1 = *(const LAS bf16x8*)(ap + 32 * KROWB); } SBAR(); \
                  p0 = __builtin_amdgcn_mfma_f32_32x32x16_bf16(ka0, qr[d0], p0, 0, 0, 0); p1 = __builtin_amdgcn_mfma_f32_32x32x16_bf16(ka1, qr[d0], p1, 0, 0, 0); SBAR(); \
                  if (d0 + 2 < NDK) { const LAS char* ap = kbp[0] + (d0 + 2) * 32; ka0 = *(const LAS bf16x8*)ap; ka1 = *(const LAS bf16x8*)(ap + 32 * KROWB); } SBAR(); \
                  p0 = __builtin_amdgcn_mfma_f32_32x32x16_bf16(kb0, qr[d0 + 1], p0, 0, 0, 0); p1 = __builtin_amdgcn_mfma_f32_32x32x16_bf16(kb1, qr[d0 + 1], p1, 0, 0, 0); SBAR(); } } \
            if (MODE == 2) { const int dq0 = qpos - (kb) - 4 * hi; \
                _Pragma("unroll") for (int r = 0; r < 16; ++r) { const int c = (r & 3) + 8 * (r >> 2); int i0 = dq0 - c, i1 = dq0 - c - 32; \
                    i0 = i0 < 0 ? 0 : (i0 > 127 ? 127 : i0); i1 = i1 < 0 ? 0 : (i1 > 127 ? 127 : i1); p0[r] += bias_l[i0]; p1[r] += bias_l[i1]; } } \
            if (MODE != 3) { if ((kb) + 63 > qlo || (kb) <= qlo + 31 - a.W) mask_tile(p0, p1, qpos - (kb) - 4 * hi, (unsigned)a.W); } \
            float pmax = p0[0]; \
            _Pragma("unroll") for (int r = 1; r < 16; ++r) pmax = fmaxf(pmax, p0[r]); \
            _Pragma("unroll") for (int r = 0; r < 16; ++r) pmax = fmaxf(pmax, p1[r]); \
            { auto rr = __builtin_amdgcn_permlane32_swap(__float_as_uint(pmax), __float_as_uint(pmax), false, false); pmax = fmaxf(__uint_as_float(rr[0]), __uint_as_float(rr[1])); } \
              \
            const float skc_ = skm + 64.f * __builtin_amdgcn_exp2f(pmax - m_reg);        \
            const bool skip_ = MODE == 1 && __all(skc_ < 6.1035e-5f); \
            if (skip_) skm = skc_; \
            if (!skip_) { \
            float mn, alpha; \
            if (__builtin_expect(__all((pmax - m_reg) <= THR), 1)) { mn = m_reg; alpha = 1.f; } \
            else { mn = fmaxf(m_reg, pmax); alpha = __builtin_amdgcn_exp2f(m_reg - mn); m_reg = mn; } \
            _Pragma("unroll") for (int r = 0; r < 16; ++r) { p0[r] = __builtin_amdgcn_exp2f(p0[r] - mn); p1[r] = __builtin_amdgcn_exp2f(p1[r] - mn); } \
            float ps = 0.f; \
            _Pragma("unroll") for (int r = 0; r < 16; ++r) ps += p0[r]; \
            _Pragma("unroll") for (int r = 0; r < 16; ++r) ps += p1[r]; \
            { auto rr = __builtin_amdgcn_permlane32_swap(__float_as_uint(ps), __float_as_uint(ps), false, false); ps = __uint_as_float(rr[0]) + __uint_as_float(rr[1]); } \
            l_reg = l_reg * alpha + ps; \
            if (__any(alpha < 1.f)) { if (hi == 0) ws[32 + r32] = alpha; asm volatile("s_waitcnt lgkmcnt(0)" ::: "memory"); \
                _Pragma("unroll") for (int d_ = 0; d_ < NDV; ++d_) _Pragma("unroll") for (int r = 0; r < 16; ++r) o[d_][r] *= ws[32 + crow(r, hi)]; } \
            bf16x8 pa0, pa1, pa2, pa3; \
            FA_PK4(p0, 0, pa0); FA_PK4(p0, 8, pa1); FA_PK4(p1, 0, pa2); FA_PK4(p1, 8, pa3); SBAR(); \
            FA_PVALL(BUF); } \
        } while (0)
    if constexpr (MODE != 1) {
#define FA_TILE(t, BUF) do { \
        const int kb = (a.j_lo + (t)) * 64; \
        bool act = true; if (MODE != 3) act = (kb <= qlo + 31) && (kb + 63 >= qlo - a.W + 1); \
        if ((t) + 2 < NT) FA_LOADT(a.j_lo + (t) + 2, BUF);              \
        if (act) FA_COMPUTE(BUF, kb); \
        if ((t) + 1 < NT) FA_WRITET((BUF) ^ 1, (BUF) ^ 1);              \
        __syncthreads(); } while (0)
        FA_LOADT(a.j_lo, 0); FA_WRITET(0, 0); if (NT > 1) FA_LOADT(a.j_lo + 1, 1); __syncthreads();
        for (int t = 0; t < NT; t += 2) {
            FA_TILE(t, 0);
            if (t + 1 < NT) FA_TILE(t + 1, 1);
        }
#undef FA_TILE
    } else {
        constexpr float TEXIT = 14.f;
        float qn2 = 0.f;
#pragma unroll
        for (int d0 = 0; d0 < NDK; ++d0)
#pragma unroll
            for (int e = 0; e < 8; ++e) { const float f = bf2f((unsigned short)qr[d0][e]); qn2 += f * f; }
        { auto rr = __builtin_amdgcn_permlane32_swap(__float_as_uint(qn2), __float_as_uint(qn2), false, false); qn2 = __uint_as_float(rr[0]) + __uint_as_float(rr[1]); }
        const float ubase = sqrtf(qn2) * a.kmax * 1.0001f + clq;
        LAS int* flags = (LAS int*)(dec_l + 128 + 512 + 128);
        bool wdone = false, stop = false;
#define FA_TILE_R(t, BUF) do { \
        const int kb = (a.j_lo + (t)) * 64; const bool more = (t) > 0; \
        const bool act = !wdone && (kb <= qlo + 31); \
        if ((t) > 1) FA_LOADT(a.j_lo + (t) - 2, BUF); \
        if (act) { FA_COMPUTE(BUF, kb); \
            wdone = __all((ubase - dec_l[(BUF) * 64] + dec_l[800 + (BUF)]) < (m_reg - TEXIT)) != 0; } \
        if (more) FA_WRITET((BUF) ^ 1, (BUF) ^ 1); \
        if (lane == 0) flags[(BUF) * 8 + wid] = wdone ? 1 : 0; \
        __syncthreads(); \
        { int all_ = 1; _Pragma("unroll") for (int w_ = 0; w_ < 8; ++w_) all_ &= flags[(BUF) * 8 + w_]; stop = !more || (all_ != 0); } } while (0)
        FA_LOADT(a.j_lo + NT - 1, 0); FA_WRITET(0, 0); if (NT > 1) FA_LOADT(a.j_lo + NT - 2, 1); __syncthreads();
        for (int t = NT - 1;;) {
            FA_TILE_R(t, 0); if (stop) break; --t;
            FA_TILE_R(t, 1); if (stop) break; --t;
        }
#undef FA_TILE_R
    }
    __builtin_amdgcn_s_setprio(0);
    if (hi == 0) ws[r32] = l_reg; asm volatile("s_waitcnt lgkmcnt(0)" ::: "memory");
    float rli[16];
#pragma unroll
    for (int r = 0; r < 16; ++r) rli[r] = __builtin_amdgcn_rcpf(ws[crow(r, hi)]);
    bf16_t* Ow = a.O + (size_t)qlo * a.ldo + hoff;
#pragma unroll
    for (int r = 0; r < 16; ++r) { const int orow = crow(r, hi);
#pragma unroll
        for (int d0 = 0; d0 < NDV; ++d0) { const float v = o[d0][r] * rli[r]; const float vn = __shfl_xor(v, 1);
            if ((r32 & 1) == 0) *(unsigned*)(Ow + (size_t)orow * a.ldo + d0 * 32 + r32) = cvt_pk_bf16(v, vn); } }
    __syncthreads();
#undef FA_LOADT
#undef FA_WRITET
#undef FA_TR
#undef FA_VRD
#undef FA_VMM
#undef FA_LW
#undef FA_PVALL
#undef FA_PK4
#undef FA_COMPUTE
}
#undef SBAR
}

struct Args { const void* in[N_IN]; float* out; unsigned char* ws; int ph_lo, ph_hi; };

__device__ const float ROPE_INV[32] = {
    1.000000000e+00f, 7.498942614e-01f, 5.623413324e-01f, 4.216965139e-01f, 3.162277639e-01f, 2.371373773e-01f, 1.778279394e-01f, 1.333521307e-01f,
    1.000000015e-01f, 7.498941571e-02f, 5.623413250e-02f, 4.216965288e-02f, 3.162277490e-02f, 2.371373773e-02f, 1.778279431e-02f, 1.333521493e-02f,
    9.999999776e-03f, 7.498941850e-03f, 5.623413250e-03f, 4.216964822e-03f, 3.162277630e-03f, 2.371373586e-03f, 1.778279431e-03f, 1.333521446e-03f,
    1.000000047e-03f, 7.498942432e-04f, 5.623413017e-04f, 4.216965172e-04f, 3.162277571e-04f, 2.371373703e-04f, 1.778279402e-04f, 1.333521504e-04f };
__device__ const unsigned char T5_BUCKET[128] = {
    0, 1, 2, 3, 4, 5, 6, 7, 8, 9, 10, 11, 12, 13, 14, 15, 16, 16, 16, 17, 17, 18, 18, 18, 19, 19, 19, 20, 20, 20, 20, 21, 21, 21, 21, 22, 22, 22, 22, 22, 23, 23, 23, 23, 23, 23, 24, 24, 24, 24, 24, 24,
    25, 25, 25, 25, 25, 25, 25, 26, 26, 26, 26, 26, 26, 26, 26, 27, 27, 27, 27, 27, 27, 27, 27, 27, 27, 28, 28, 28, 28, 28, 28, 28, 28, 28, 28, 29, 29, 29, 29, 29, 29, 29, 29, 29, 29, 29, 29,
    30, 30, 30, 30, 30, 30, 30, 30, 30, 30, 30, 30, 30, 30, 31, 31, 31, 31, 31, 31, 31, 31, 31, 31, 31, 31, 31, 31, 31 };

struct CvtJob { const float* src; int K, Nsrc, Npad; const float* gain; bf16_t* dst; int ldd; int mode; int row_off; int kblk;   unsigned* amax;   int f8;   int f16;   };
__device__ __forceinline__ int cvt_row(int mode, int n) {
    if (mode == 1) { if (n >= 1280 && n < 1344) { const int j = n - 1280; return 1280 + 2 * (j & 31) + (j >> 5); } return n; }
    if (mode == 2) { const int h = n / 192, w = n - h * 192; if (w >= 128) { const int j = w - 128; return h * 192 + 128 + 2 * (j & 31) + (j >> 5); } return n; }
    if (mode == 4) return (n >> 7) * 256 + (n & 127);
    if (mode == 5) return (n >> 7) * 256 + 128 + (n & 127);
    return n;
}
__device__ __forceinline__ float cvt_cs(int mode, int n) {
    if (mode == 1) return (n >= 1344 && n < 2368) ? C2_SWA : 1.f;
    if (mode == 2) return C2_MLA;
    if (mode == 3) return C2_128;
    if (mode == 6) return n < 2048 ? C2_128 : 1.f;
    return 1.f;
}
constexpr int N_CVT_JOBS = 17 + 24;
__device__ __forceinline__ CvtJob get_job(const Args& a, int j) {
    unsigned char* ws = a.ws; CvtJob jb; jb.gain = nullptr; jb.mode = 0; jb.row_off = 0; jb.amax = nullptr; jb.kblk = 0; jb.f16 = 0; jb.f8 = 0;
    const float* nmix = (const float*)a.in[I_NMIX]; const float* ncross = (const float*)a.in[I_NCROSS]; const float* nmem = (const float*)a.in[I_NMEM]; const float* nffn = (const float*)a.in[I_NFFN];
    if (j >= 17) { const int t = (j - 17) >> 3, e = (j - 17) & 7;
        if (t == 0) { jb.src = (const float*)a.in[I_MG] + (size_t)e * DM * DFF; jb.K = DM; jb.Nsrc = jb.Npad = DFF; jb.gain = nffn + DM; jb.dst = (bf16_t*)(ws + WS_WGU1 + (size_t)e * E_GU); jb.ldd = DM; jb.mode = 4; jb.amax = (unsigned*)(ws + WS_CTL) + CW_AMAXW + e * 2 * DFF; }
        else if (t == 1) { jb.src = (const float*)a.in[I_MU] + (size_t)e * DM * DFF; jb.K = DM; jb.Nsrc = jb.Npad = DFF; jb.gain = nffn + DM; jb.dst = (bf16_t*)(ws + WS_WGU1 + (size_t)e * E_GU); jb.ldd = DM; jb.mode = 5; jb.amax = (unsigned*)(ws + WS_CTL) + CW_AMAXW + e * 2 * DFF; }
        else { jb.src = (const float*)a.in[I_MD] + (size_t)e * DFF * DM; jb.K = DFF; jb.Nsrc = jb.Npad = DM; jb.dst = (bf16_t*)(ws + WS_WD1 + (size_t)e * E_D)  ; jb.ldd = DFF; jb.kblk = 1; jb.f8 = 1; }
        return jb; }
    switch (j) {
    case 0: jb.src = (const float*)a.in[I_EVWIN]; jb.K = DM; jb.Nsrc = EVEN_IN; jb.Npad = Z0_LD; jb.gain = nmix; jb.dst = (bf16_t*)(ws + WS_WIN0)  ; jb.ldd = DM; jb.mode = 1; jb.amax = (unsigned*)(ws + WS_CTL) + CW_AMAX0; break;
    case 1: jb.src = (const float*)a.in[I_WUQ]; jb.K = 768; jb.Nsrc = jb.Npad = 1536; jb.gain = (const float*)a.in[I_QNORM]; jb.dst = (bf16_t*)(ws + WS_WUQ); jb.ldd = 768; jb.mode = 2; break;
    case 2: jb.src = (const float*)a.in[I_WUKV]; jb.K = 512; jb.Nsrc = jb.Npad = 2048; jb.gain = (const float*)a.in[I_KVNORM]; jb.dst = (bf16_t*)(ws + WS_WUKV); jb.ldd = 512; break;
    case 3: jb.src = (const float*)a.in[I_EVWO]; jb.K = DM; jb.Nsrc = jb.Npad = DM; jb.dst = (bf16_t*)(ws + WS_WO0); jb.ldd = DM; break;
    case 4: case 5: { const int l = j - 4; jb.src = (const float*)a.in[I_XWQ] + (size_t)l * DM * 512; jb.K = DM; jb.Nsrc = jb.Npad = 512; jb.gain = ncross + l * DM; jb.dst = (bf16_t*)(ws + WS_WXQ) + (size_t)l * E_XQ; jb.ldd = DM; jb.mode = 3; jb.f16 = 1; break; }
    case 6: case 7: { const int l = j - 6; jb.src = (const float*)a.in[I_XWK] + (size_t)l * DM * 512; jb.K = DM; jb.Nsrc = jb.Npad = 512; jb.gain = nmem + l * DM; jb.dst = (bf16_t*)(ws + WS_WXKV); jb.ldd = DM; jb.row_off = l * 1024; break; }
    case 8: case 9: { const int l = j - 8; jb.src = (const float*)a.in[I_XWV] + (size_t)l * DM * 512; jb.K = DM; jb.Nsrc = jb.Npad = 512; jb.gain = nmem + l * DM; jb.dst = (bf16_t*)(ws + WS_WXKV); jb.ldd = DM; jb.row_off = l * 1024 + 512; break; }
    case 10: case 11: { const int l = j - 10; jb.src = (const float*)a.in[I_XWO] + (size_t)l * 512 * DM; jb.K = 512; jb.Nsrc = jb.Npad = DM; jb.dst = (bf16_t*)(ws + WS_WXO) + (size_t)l * E_XO; jb.ldd = 512; break; }
    case 12: jb.src = (const float*)a.in[I_FG]; jb.K = DM; jb.Nsrc = jb.Npad = DFF; jb.gain = nffn; jb.dst = (bf16_t*)(ws + WS_WGU0); jb.ldd = DM; jb.mode = 4; jb.amax = (unsigned*)(ws + WS_CTL) + CW_AMAXW + 8 * 2 * DFF; break;
    case 13: jb.src = (const float*)a.in[I_FU]; jb.K = DM; jb.Nsrc = jb.Npad = DFF; jb.gain = nffn; jb.dst = (bf16_t*)(ws + WS_WGU0); jb.ldd = DM; jb.mode = 5; jb.amax = (unsigned*)(ws + WS_CTL) + CW_AMAXW + 8 * 2 * DFF; break;
    case 14: jb.src = (const float*)a.in[I_FD]; jb.K = DFF; jb.Nsrc = jb.Npad = DM; jb.dst = (bf16_t*)(ws + WS_WD0); jb.ldd = DFF; jb.kblk = 1; break;
    case 15: jb.src = (const float*)a.in[I_ODWIN]; jb.K = DM; jb.Nsrc = ODD_IN; jb.Npad = IN1_PAD; jb.gain = nmix + DM; jb.dst = (bf16_t*)(ws + WS_WIN1)  ; jb.ldd = DM; jb.mode = 6; jb.amax = (unsigned*)(ws + WS_CTL) + CW_AMAX15; break;
    default: jb.src = (const float*)a.in[I_ODWO]; jb.K = DM; jb.Nsrc = jb.Npad = DM; jb.dst = (bf16_t*)(ws + WS_WO1); jb.ldd = DM; break;
    }
    return jb;
}
__device__ __forceinline__ int cvt_find(const LAS int* cum, int it, int& j) { while (it >= cum[j + 1]) ++j; return it - cum[j]; }
__device__ __forceinline__ void cvt_load(const CvtJob& jb, int item, int lane, float (&v)[32]) {
    const int nblk = jb.Npad / 32, kb = item / nblk, nb = item % nblk, k0 = 64 * kb, n0 = 32 * nb;
    const int nn = n0 + (lane & 31); const bool ok = nn < jb.Nsrc;
    const float* p = jb.src + (size_t)(k0 + (lane >> 5)) * jb.Nsrc + nn; const size_t st = (size_t)2 * jb.Nsrc;
#pragma unroll
    for (int i = 0; i < 32; ++i) v[i] = ok ? __builtin_nontemporal_load(p + i * st) : 0.f;
}
__device__ __forceinline__ void cvt_store(const CvtJob& jb, LAS float* scr, int item, int lane, const float (&v)[32]) {
    const int nblk = jb.Npad / 32, kb = item / nblk, nb = item % nblk, k0 = 64 * kb, n0 = 32 * nb;
    const float cs = cvt_cs(jb.mode, n0 + (lane & 31));
    const int c = lane & 7;
    f32x4 g0 = (f32x4){1.f, 1.f, 1.f, 1.f}, g1 = g0;
    if (jb.gain) { g0 = *(const f32x4*)(jb.gain + k0 + 8 * c); g1 = *(const f32x4*)(jb.gain + k0 + 8 * c + 4); }
#pragma unroll
    for (int i = 0; i < 32; ++i) scr[(2 * i + (lane >> 5)) * 33 + (lane & 31)] = v[i] * cs;
    LDS_WAIT(); asm volatile("" ::: "memory");
#pragma unroll
    for (int j = 0; j < 4; ++j) { const int n = (lane >> 3) + 8 * j; const LAS float* s = scr + (8 * c) * 33 + n;
        u32x4 o;
        if (jb.f16) { o.x = pk_f16(s[0 * 33] * g0[0], s[1 * 33] * g0[1]); o.y = pk_f16(s[2 * 33] * g0[2], s[3 * 33] * g0[3]); o.z = pk_f16(s[4 * 33] * g1[0], s[5 * 33] * g1[1]); o.w = pk_f16(s[6 * 33] * g1[2], s[7 * 33] * g1[3]); }
        else { o.x = cvt_pk_bf16(s[0 * 33] * g0[0], s[1 * 33] * g0[1]); o.y = cvt_pk_bf16(s[2 * 33] * g0[2], s[3 * 33] * g0[3]); o.z = cvt_pk_bf16(s[4 * 33] * g1[0], s[5 * 33] * g1[1]); o.w = cvt_pk_bf16(s[6 * 33] * g1[2], s[7 * 33] * g1[3]); }
        const int drow = jb.row_off + cvt_row(jb.mode, n0 + n);
        if (jb.f8) {
            const f32x4 a_ = (f32x4){s[0 * 33] * g0[0], s[1 * 33] * g0[1], s[2 * 33] * g0[2], s[3 * 33] * g0[3]} * 64.f, b_ = (f32x4){s[4 * 33] * g1[0], s[5 * 33] * g1[1], s[6 * 33] * g1[2], s[7 * 33] * g1[3]} * 64.f;
            *(u32x2*)((unsigned char*)jb.dst + ((size_t)(k0 >> 7) * jb.Npad + drow) * 128 + (k0 & 64) + 8 * c) = pack8_fp8(a_, b_);
        } else { bf16_t* dp = jb.kblk ? jb.dst + ((size_t)(k0 >> 6) * jb.Npad + drow) * 64 + 8 * c : jb.dst + (size_t)drow * jb.ldd + k0 + 8 * c; *(u32x4*)dp = o; } }
    LDS_WAIT(); asm volatile("" ::: "memory");
}
__device__ __forceinline__ void cvt_amax(const CvtJob& jb, int item, int lane, const float (&v)[32]) {
    const int nblk = jb.Npad / 32, kb = item / nblk, nb = item % nblk, k0 = 64 * kb, n0 = 32 * nb;
    const int nn = n0 + (lane & 31); float mx = 0.f;
#pragma unroll
    for (int i = 0; i < 32; ++i) mx = fmaxf(mx, fabsf(v[i] * jb.gain[k0 + 2 * i + (lane >> 5)]));
    mx = fmaxf(mx, __shfl_xor(mx, 32)) * cvt_cs(jb.mode, nn);
    if (lane < 32 && nn < jb.Nsrc) atomicMax(jb.amax + jb.row_off + cvt_row(jb.mode, nn), __float_as_uint(mx));
}
__device__ __forceinline__ float cvt_amax_item(const CvtJob& jb, int item, int lane, const float (&v)[32]) {
    const int nblk = jb.Npad / 32, kb = item / nblk, nb = item % nblk, k0 = 64 * kb, n0 = 32 * nb;
    float mx = 0.f;
#pragma unroll
    for (int i = 0; i < 32; ++i) mx = fmaxf(mx, fabsf(v[i] * jb.gain[k0 + 2 * i + (lane >> 5)]));
    return fmaxf(mx, __shfl_xor(mx, 32)) * cvt_cs(jb.mode, n0 + (lane & 31));
}
__device__ __forceinline__ void cvt_store_q8(const CvtJob& jb, LAS float* scr, int item, int lane, const float (&v)[32], const LAS float* cam = nullptr) {
    const int nblk = jb.Npad / 32, kb = item / nblk, nb = item % nblk, k0 = 64 * kb, n0 = 32 * nb;
    const int c = lane & 7;
    const f32x4 g0 = *(const f32x4*)(jb.gain + k0 + 8 * c), g1 = *(const f32x4*)(jb.gain + k0 + 8 * c + 4);
#pragma unroll
    for (int i = 0; i < 32; ++i) scr[(2 * i + (lane >> 5)) * 33 + (lane & 31)] = v[i];
    LDS_WAIT(); asm volatile("" ::: "memory");
#pragma unroll
    for (int j = 0; j < 4; ++j) { const int n = (lane >> 3) + 8 * j; const LAS float* s = scr + (8 * c) * 33 + n;
        const int row = jb.row_off + cvt_row(jb.mode, n0 + n);
        const float am = cam ? cam[n] : __uint_as_float(__hip_atomic_load(jb.amax + row, RLX_AGENT)); const float inv = am > 0.f ? cvt_cs(jb.mode, n0 + n) * 127.f / am : 0.f;
        int q[8];
#pragma unroll
        for (int i = 0; i < 4; ++i) { q[i] = (int)__builtin_rintf(s[i * 33] * g0[i] * inv); q[4 + i] = (int)__builtin_rintf(s[(4 + i) * 33] * g1[i] * inv); }
#pragma unroll
        for (int i = 0; i < 8; ++i) q[i] = q[i] > 127 ? 127 : (q[i] < -127 ? -127 : q[i]);
        u32x2 o; o.x = (unsigned)(q[0] & 255) | ((unsigned)(q[1] & 255) << 8) | ((unsigned)(q[2] & 255) << 16) | ((unsigned)(q[3] & 255) << 24);
        o.y = (unsigned)(q[4] & 255) | ((unsigned)(q[5] & 255) << 8) | ((unsigned)(q[6] & 255) << 16) | ((unsigned)(q[7] & 255) << 24);
        *(u32x2*)((unsigned char*)jb.dst + (size_t)row * jb.ldd + k0 + 8 * c) = o; }
    LDS_WAIT(); asm volatile("" ::: "memory");
}
__device__ __forceinline__ void row_to_bf16_ssq(const float* xrow, bf16_t* orow, float* ssqrow, int lane) {
    const f32x4* xr = (const f32x4*)xrow + lane; f32x4 v[8]; float s = 0.f;
#pragma unroll
    for (int j = 0; j < 8; ++j) { v[j] = xr[64 * j]; s += (v[j][0] * v[j][0] + v[j][1] * v[j][1]) + (v[j][2] * v[j][2] + v[j][3] * v[j][3]); }
    s = wave_sum(s);
    u32x2* o8 = (u32x2*)orow + lane;
#pragma unroll
    for (int j = 0; j < 8; ++j) { u32x2 w; w.x = cvt_pk_bf16(v[j][0], v[j][1]); w.y = cvt_pk_bf16(v[j][2], v[j][3]); o8[64 * j] = w; }
    if (lane < 32) ssqrow[lane] = lane == 0 ? s : 0.f;
}

__global__ void __launch_bounds__(NWAVES * 64, 2) trunk_fwd(Args args) {
    extern __shared__ __attribute__((aligned(16))) unsigned char lds_raw[];
    LAS unsigned char* lds = (LAS unsigned char*)lds_raw;
    volatile LAS unsigned* MISC = (volatile LAS unsigned*)(lds + MISC_OFF);
    const int tid = threadIdx.x, lane = tid & 63, wave = __builtin_amdgcn_readfirstlane(tid >> 6);
    const int G = gridDim.x; const int bx = blockIdx.x; const int vcu = (G % 8 == 0) ? (bx % 8) * (G / 8) + bx / 8 : bx;
    const int gw = vcu * NWAVES + wave, NGW = G * NWAVES;
    unsigned* ctl = (unsigned*)(args.ws + WS_CTL);
    const int lo = args.ph_lo, hi = args.ph_hi;
    const bool fused = (hi - lo) > 1;
    for (int u = tid; u < (LDS_BYTES - RING_BYTES) / 4; u += NWAVES * 64) ((LAS unsigned*)(lds + RING_BYTES))[u] = 0u;
    __syncthreads();
    XcdBarrier bar; bar.bar = ctl + CW_BAR; bar.x = 0; bar.st = nullptr;
    if (fused) bar = xcd_barrier_post(ctl + CW_BAR, MISC + 8);
#ifndef PH_MASK
#define PH_MASK 0xFFFFFFFFFFFFFFFFull
#endif
#define IN(k) ((((unsigned long long)PH_MASK >> (k)) & 1ull) && lo <= (k) && (k) < hi)
#define GRID_BAR(k) do { if (fused && IN((k) + 1)) xcd_barrier(bar); } while (0)
#ifndef DUP_MASK
#define DUP_MASK 0ull
#endif
#ifndef DUP_SUB
#define DUP_SUB 0
#endif
#define NREP(k) ((((unsigned long long)DUP_MASK >> (k)) & 1ull) ? 2 : 1)
#define PHASE(k) for (int rep_ = 0; rep_ < NREP(k) && IN(k); ++rep_)

#define WSL() GAS unsigned char* wsg_ = (GAS unsigned char*)args.ws; asm volatile("" : "+s"(wsg_)); unsigned char* ws = (unsigned char*)wsg_
#define XB ((bf16_t*)(ws + WS_XB))
#define SSQ ((float*)(ws + WS_SSQ))
#define ROPE ((float*)(ws + WS_ROPE))
#define MEMN ((bf16_t*)(ws + WS_MEMN))
#define SSQM ((float*)(ws + WS_SSQM))
#define MEMKV ((bf16_t*)(ws + WS_MEMKV))
#define SSQQ ((float*)(ws + WS_SSQQ))
#define SSQKV ((float*)(ws + WS_SSQKV))
#define QX ((bf16_t*)(ws + WS_QX))
#define OX ((bf16_t*)(ws + WS_OX))
#define FL ((float*)(ws + WS_FL))
#define DEC ((float*)(ws + WS_DEC))
#define TOPE ((int*)(ws + WS_TOPE))
#define TOPS ((int*)(ws + WS_TOPS))
#define TOPG ((float*)(ws + WS_TOPG))
#define RSTDF ((float*)(ws + WS_RSTDF))
#define TOKPOS ((int*)(ws + WS_TOKPOS))
#define ROWIDX ((int*)(ws + WS_ROWIDX))
#define GATEP ((float*)(ws + WS_GATEP))
#define RSTDP ((float*)(ws + WS_RSTDP))
#define BIAST ((float*)(ws + WS_BIAST))
#define Z0 ((bf16_t*)(ws + WS_ARENA + AR_Z0))
#define QM ((bf16_t*)(ws + WS_ARENA + AR_QM))
#define KM ((bf16_t*)(ws + WS_ARENA + AR_KM))
#define VM ((bf16_t*)(ws + WS_ARENA + AR_VM))
#define O0 ((bf16_t*)(ws + WS_ARENA + AR_O0))
#define HIDB(i) ((bf16_t*)(ws + WS_ARENA + AR_HID + (size_t)((i) & 1) * HID_BYTES))
#define YB ((bf16_t*)(ws + WS_ARENA + AR_Y))
#define Z1 ((bf16_t*)(ws + WS_ARENA + AR_Z1))
#define O1 ((bf16_t*)(ws + WS_ARENA + AR_O1))
#define XQ ((unsigned char*)(ws + WS_QX))
#define XH ((unsigned short*)(ws + WS_XB))
#define XIN ((const float*)args.in[I_X])

    PHASE(0) {
        WSL();
        LAS float* scr = (LAS float*)(lds + wave * 16384);
        LAS int* cum = (LAS int*)(lds + RING_BYTES + 4096);
        if (tid < N_CVT_JOBS) { const CvtJob jb = get_job(args, tid); cum[64 + tid] = jb.amax ? 0   : (jb.K / 64) * (jb.Npad / 32); }
        __syncthreads();
        if (tid == 0) { int run = 0; for (int j = 0; j < N_CVT_JOBS; ++j) { cum[j] = run; run += cum[64 + j]; } cum[N_CVT_JOBS] = run; cum[N_CVT_JOBS + 1] = 0x7fffffff; }
        __syncthreads();
        {
            const int total = cum[N_CVT_JOBS];
            float va[32], vb[32]; int jL = 0, jP = 0;
            if (gw < total) { const int li = cvt_find(cum, gw, jL); cvt_load(get_job(args, jL), li, lane, va); }
#pragma unroll 1
            for (int it = gw; it < total; it += 2 * NGW) {
                const int it2 = it + NGW, it3 = it + 2 * NGW;
                if (it2 < total) { const int li = cvt_find(cum, it2, jL); cvt_load(get_job(args, jL), li, lane, vb); }
                { const int li = cvt_find(cum, it, jP); const CvtJob jb = get_job(args, jP); cvt_store(jb, scr, li, lane, va); }
                if (it2 < total) {
                    if (it3 < total) { const int li = cvt_find(cum, it3, jL); cvt_load(get_job(args, jL), li, lane, va); }
                    const int li = cvt_find(cum, it2, jP); const CvtJob jb = get_job(args, jP); cvt_store(jb, scr, li, lane, vb);
                }
            }
        }
        for (int m = gw; m < M; m += NGW) {
            const f32x4* xr = (const f32x4*)(XIN + (size_t)m * DM) + lane; f32x4 v[8]; float ss = 0.f, amx = 0.f;
#pragma unroll
            for (int j = 0; j < 8; ++j) { v[j] = xr[64 * j]; ss += (v[j][0] * v[j][0] + v[j][1] * v[j][1]) + (v[j][2] * v[j][2] + v[j][3] * v[j][3]);
                amx = fmaxf(amx, fmaxf(fmaxf(fabsf(v[j][0]), fabsf(v[j][1])), fmaxf(fabsf(v[j][2]), fabsf(v[j][3])))); }
            ss = wave_sum(ss);
#pragma unroll
            for (int o_ = 1; o_ < 64; o_ <<= 1) amx = fmaxf(amx, __shfl_xor(amx, o_));
            const float inv = amx > 0.f ? 127.f / amx : 0.f; unsigned* xq = (unsigned*)((unsigned char*)XB + (size_t)m * DM) + lane;
#pragma unroll
            for (int j = 0; j < 8; ++j) { const int q0 = (int)__builtin_rintf(v[j][0] * inv), q1 = (int)__builtin_rintf(v[j][1] * inv), q2 = (int)__builtin_rintf(v[j][2] * inv), q3 = (int)__builtin_rintf(v[j][3] * inv);
                xq[64 * j] = (unsigned)(q0 & 255) | ((unsigned)(q1 & 255) << 8) | ((unsigned)(q2 & 255) << 16) | ((unsigned)(q3 & 255) << 24); }
            if (lane == 0) RSTDF[m] = __builtin_amdgcn_rsqf(ss * (1.f / DM) + EPS) * amx * (1.f / 127.f);
        }
        for (int m = gw; m < MROWS; m += NGW) row_to_bf16_ssq((const float*)args.in[I_MEM] + (size_t)m * DM, MEMN + (size_t)m * DM, SSQM + (size_t)m * 32, lane);
        const int* pos = (const int*)args.in[I_POS];
        int gt0_ = tid; asm volatile("" : "+v"(gt0_)); gt0_ += bx * 512;
        for (int e = gt0_; e < M * 32; e += G * 512) {
            const int row = e >> 5, i = e & 31;
            const float ang = (float)pos[row] * ROPE_INV[i];
            const double rev = (double)ang * 0.15915494309189535; const float fr = (float)(rev - __builtin_rint(rev));
            ROPE[(size_t)e * 2] = __builtin_amdgcn_cosf(fr); ROPE[(size_t)e * 2 + 1] = __builtin_amdgcn_sinf(fr);
        }
        const float* relb = (const float*)args.in[I_RELB];
        for (int e = gt0_; e < 16 * 128; e += G * 512) { const int h = e >> 7, d = e & 127; BIAST[e] = relb[(int)T5_BUCKET[d] * 16 + h] * LOG2E; }
        if (fused && IN(1) && !IN(44)) xcd_barrier(bar);
        __syncthreads();
    }

    PHASE(44) {
        LAS float* scr = (LAS float*)(lds + wave * 16384);
        LAS float* cam = (LAS float*)(lds + RING_BYTES + 4096);
        constexpr int NBJ = DFF / 32, NB15 = IN1_PAD / 32, NB0 = Z0_LD / 32, NB = 18 * NBJ + NB15 + NB0;
#define Q8DEC(cb_, j_, nb_) const int j_ = (cb_) >= 18 * NBJ + NB15 ? 0 : ((cb_) >= 18 * NBJ ? 15 : ((cb_) / NBJ < 2 ? 12 + (cb_) / NBJ : 15 + (cb_) / NBJ)); \
        const int nb_ = (cb_) >= 18 * NBJ + NB15 ? (cb_) - 18 * NBJ - NB15 : ((cb_) >= 18 * NBJ ? (cb_) - 18 * NBJ : (cb_) % NBJ)
        float v0[32], v1[32], v2[32], v3[32];
        if (bx < NB) { Q8DEC(bx, j, nb); const CvtJob jb = get_job(args, j); const int nblk = jb.Npad / 32;
            cvt_load(jb, (4 * wave + 0) * nblk + nb, lane, v0); cvt_load(jb, (4 * wave + 1) * nblk + nb, lane, v1);
            cvt_load(jb, (4 * wave + 2) * nblk + nb, lane, v2); cvt_load(jb, (4 * wave + 3) * nblk + nb, lane, v3); }
#pragma unroll 1
        for (int cb = bx; cb < NB; cb += G) {
            Q8DEC(cb, j, nb); const CvtJob jb = get_job(args, j); const int nblk = jb.Npad / 32;
            const int cn = cb + G; const bool more = cn < NB; Q8DEC(more ? cn : cb, jn, nbn); const CvtJob jbn = get_job(args, jn); const int nblkn = jbn.Npad / 32;
            float mx = fmaxf(fmaxf(cvt_amax_item(jb, (4 * wave + 0) * nblk + nb, lane, v0), cvt_amax_item(jb, (4 * wave + 1) * nblk + nb, lane, v1)),
                             fmaxf(cvt_amax_item(jb, (4 * wave + 2) * nblk + nb, lane, v2), cvt_amax_item(jb, (4 * wave + 3) * nblk + nb, lane, v3)));
            __syncthreads();
            if (lane < 32) cam[wave * 32 + lane] = mx;
            __syncthreads();
            if (lane < 32) { float m = cam[lane];
#pragma unroll
                for (int w = 1; w < 8; ++w) m = fmaxf(m, cam[w * 32 + lane]);
                cam[256 + wave * 32 + lane] = m;
                const int nn = 32 * nb + lane; if (wave == 0 && nn < jb.Nsrc) jb.amax[jb.row_off + cvt_row(jb.mode, nn)] = __float_as_uint(m); }
            LDS_WAIT(); asm volatile("" ::: "memory");
            const LAS float* camw = cam + 256 + wave * 32;
            cvt_store_q8(jb, scr, (4 * wave + 0) * nblk + nb, lane, v0, camw); if (more) cvt_load(jbn, (4 * wave + 0) * nblkn + nbn, lane, v0);
            cvt_store_q8(jb, scr, (4 * wave + 1) * nblk + nb, lane, v1, camw); if (more) cvt_load(jbn, (4 * wave + 1) * nblkn + nbn, lane, v1);
            cvt_store_q8(jb, scr, (4 * wave + 2) * nblk + nb, lane, v2, camw); if (more) cvt_load(jbn, (4 * wave + 2) * nblkn + nbn, lane, v2);
            cvt_store_q8(jb, scr, (4 * wave + 3) * nblk + nb, lane, v3, camw); if (more) cvt_load(jbn, (4 * wave + 3) * nblkn + nbn, lane, v3);
        }
#undef Q8DEC
        GRID_BAR(0);
    }

    PHASE(1) {
        WSL();
        { pg8::PolPlain P{(const char*)XB  , DM, (const char*)(ws + WS_WIN0)  , DM, DM / 2};
          pg8::StaticOrder S; S.init(M / 256, Z0_LD / 256, G, bx, 0, WGM_K2048);
          pg8::EpiStore<1, 32> E{Z0, Z0_LD, nullptr, (LAS float*)(lds + RING_BYTES + 12288), 1.f / DM, ROPE, SSQQ, SSQKV, nullptr, nullptr, nullptr, RSTDF, ctl + CW_AMAX0};
          pg8::gemm_phase<pg8::EpiStore<1, 32>, pg8::PolPlain, 1>(lds, P, S, E); }
        { pg8::PolPlain P{(const char*)MEMN, DM * 2, (const char*)(ws + WS_WXKV), DM * 2, DM};
          pg8::StaticOrder S; S.init(MROWS / 256, 2048 / 256, G, (G - 1) - bx, 0);
          pg8::EpiStore<0, 32> E{MEMKV, 2048, SSQM, (LAS float*)(lds + RING_BYTES + 12288), 1.f / DM, nullptr, nullptr, nullptr, nullptr, nullptr, nullptr};
          pg8::gemm_phase(lds, P, S, E); }
        GRID_BAR(1);
    }
    PHASE(2) {
        WSL();
        { pg8::PolPlain P{(const char*)Z0, Z0_LD * 2, (const char*)(ws + WS_WUQ), 768 * 2, 768};
          pg8::StaticOrder S; S.init(M / 256, 1536 / 256, G, bx, 0);
          pg8::EpiStore<2, 12> E{QM, QM_LD, SSQQ, (LAS float*)(lds + RING_BYTES + 12288), 1.f / 768.f, ROPE, nullptr, nullptr, nullptr, nullptr, nullptr};
          pg8::gemm_phase(lds, P, S, E); }
        { pg8::PolPlain P{(const char*)(Z0 + 768), Z0_LD * 2, (const char*)(ws + WS_WUKV), 512 * 2, 512};
          pg8::StaticOrder S; S.init(M / 256, 2048 / 256, G, bx, 0);
          pg8::EpiStore<3, 8> E{KM, KM_LD, SSQKV, (LAS float*)(lds + RING_BYTES + 12288), 1.f / 512.f, nullptr, nullptr, nullptr, VM, Z0, nullptr};
          pg8::gemm_phase(lds, P, S, E); }
        GRID_BAR(2);
    }
    PHASE(3) {
        WSL();
#pragma unroll 1
        for (int r3_ = 0; r3_ < (DUP_SUB == 1 ? 2 : 1); ++r3_)
#pragma unroll 1
        for (int it = vcu; it < BATCH * 8 * 32; it += G) {
            const int bh = it >> 5, x = it & 31, b = bh >> 3, h = bh & 7;
#pragma unroll 1
            for (int pass = 0; pass < 2; ++pass) { const int qb = pass ? x : 63 - x;
                fa::AttnArgs a; a.Q = QM + (size_t)b * SEQ * QM_LD + h * 192; a.ldq = QM_LD; a.K = KM + (size_t)b * SEQ * KM_LD + h * 192; a.ldk = KM_LD;
                a.V = VM + (size_t)b * SEQ * VM_LD + h * 128; a.ldv = VM_LD; a.O = O0 + (size_t)b * SEQ * DM + h * 128; a.ldo = DM;
                a.q0 = qb * 256; a.j_lo = 0; a.j_hi = qb * 4 + 4; a.W = 0x3fffffff; a.dec = nullptr; a.sinkl = 0.f; a.sinks = nullptr; a.biasT = nullptr; a.kmax = 0.f;
                fa::attn_unit<192, 128, 0>(a, (LAS char*)lds); } }
        const float* sinks = (const float*)args.in[I_SINKS];
#pragma unroll 1
        for (int r3_ = 0; r3_ < (DUP_SUB == 2 ? 2 : 1); ++r3_)
#pragma unroll 1
        for (int it = vcu; it < BATCH * 2 * (SEQ / 32); it += G) {
            const int bk = it >> 9, qb = it & 511, b = bk >> 1, kvh = bk & 1, q0 = qb * 32;
            fa::AttnArgs a; const bf16_t* zb = Z0 + (size_t)b * SEQ * Z0_LD;
            a.Q = zb + 1344 + kvh * 512; a.ldq = Z0_LD; a.K = zb + 2368 + kvh * 64; a.ldk = Z0_LD; a.V = zb + 2496 + kvh * 64; a.ldv = Z0_LD;
            a.O = O0 + (size_t)b * SEQ * DM + 1024 + kvh * 512; a.ldo = DM;
            a.q0 = q0; a.j_lo = q0 - 127 < 0 ? 0 : (q0 - 127) >> 6; a.j_hi = ((q0 + 31) >> 6) + 1; a.W = 128; a.dec = nullptr; a.sinkl = 0.f; a.sinks = sinks + kvh * 8;
            a.biasT = BIAST + kvh * 8 * 128; a.kmax = 0.f;
            fa::attn_unit<64, 64, 2>(a, (LAS char*)lds); }
        GRID_BAR(3);
    }
    PHASE(4) {
        WSL();
        pg8::PolPlain P{(const char*)O0, DM * 2, (const char*)(ws + WS_WO0), DM * 2, DM};
        pg8::StaticOrder S; S.init(M / 256, DM / 256, G, bx, 0, WGM_K2048);
        pg8::EpiRes<true> E{XIN, XH, SSQ};
        pg8::gemm_phase(lds, P, S, E);
        GRID_BAR(4);
    }
#define CROSS_PHASES(l, s0) \
    PHASE(s0) { WSL(); \
        pg8::PolPlain P{(const char*)XH  , DM * 2, (const char*)(ws + WS_WXQ + (size_t)(l) * E_XQ * 2)  , DM * 2, DM}; \
        pg8::StaticOrder S; S.init(M / 256, 512 / 256, G, bx, 0, WGM_K2048); \
        pg8::EpiStore<0, 32> E{QX, 512, SSQ, (LAS float*)(lds + RING_BYTES + 12288), 1.f / DM, nullptr, nullptr, nullptr, nullptr, nullptr, nullptr}; \
        pg8::gemm_phase<pg8::EpiStore<0, 32>, pg8::PolPlain, 3>(lds, P, S, E); \
        GRID_BAR(s0); } \
    PHASE((s0) + 1) { WSL(); \
        _Pragma("unroll 1") for (int it = vcu; it < BATCH * 4 * 64; it += G) { \
            const int bh = it >> 6, qb = it & 63, b = bh >> 2, h = bh & 3; \
            fa::AttnArgs a; a.Q = QX + (size_t)b * SEQ * 512 + h * 128; a.ldq = 512; a.K = MEMKV + (size_t)b * MEMLEN * 2048 + (l) * 1024 + h * 128; a.ldk = 2048; \
            a.V = a.K + 512; a.ldv = 2048; a.O = OX + (size_t)b * SEQ * 512 + h * 128; a.ldo = 512; \
            a.q0 = qb * 256; a.j_lo = 0; a.j_hi = 4; a.W = 0x3fffffff; a.dec = nullptr; a.sinkl = 0.f; a.sinks = nullptr; a.biasT = nullptr; a.kmax = 0.f; \
            fa::attn_unit<128, 128, 3>(a, (LAS char*)lds); } \
        GRID_BAR((s0) + 1); } \
    PHASE((s0) + 2) { WSL(); \
        pg8::PolPlain P{(const char*)OX, 512 * 2, (const char*)(ws + WS_WXO + (size_t)(l) * E_XO * 2), 512 * 2, 512}; \
        pg8::StaticOrder S; S.init(M / 256, DM / 256, G, bx, 0); \
        pg8::EpiRes<false> E{XH, XH, nullptr};           \
        pg8::gemm_phase(lds, P, S, E); \
        GRID_BAR((s0) + 2); }
    CROSS_PHASES(0, 5)
    PHASE(45) {
        WSL();
#pragma unroll 1
        for (int m = gw; m < M; m += NGW) {
            const u32x2* xr = (const u32x2*)(XH + (size_t)m * DM) + lane; f32x4 v[8]; float ss = 0.f, amx = 0.f;
#pragma unroll
            for (int j = 0; j < 8; ++j) { v[j] = unpk_f16x4(xr[64 * j]); ss += (v[j][0] * v[j][0] + v[j][1] * v[j][1]) + (v[j][2] * v[j][2] + v[j][3] * v[j][3]);
                amx = fmaxf(amx, fmaxf(fmaxf(fabsf(v[j][0]), fabsf(v[j][1])), fmaxf(fabsf(v[j][2]), fabsf(v[j][3])))); }
            ss = wave_sum(ss);
#pragma unroll
            for (int o_ = 1; o_ < 64; o_ <<= 1) amx = fmaxf(amx, __shfl_xor(amx, o_));
            const float inv = amx > 0.f ? 127.f / amx : 0.f; unsigned* xq = (unsigned*)(XQ + (size_t)m * DM) + lane;
#pragma unroll
            for (int j = 0; j < 8; ++j) { const int q0 = (int)__builtin_rintf(v[j][0] * inv), q1 = (int)__builtin_rintf(v[j][1] * inv), q2 = (int)__builtin_rintf(v[j][2] * inv), q3 = (int)__builtin_rintf(v[j][3] * inv);
                xq[64 * j] = (unsigned)(q0 & 255) | ((unsigned)(q1 & 255) << 8) | ((unsigned)(q2 & 255) << 16) | ((unsigned)(q3 & 255) << 24); }
            if (lane == 0) RSTDF[m] = __builtin_amdgcn_rsqf(ss * (1.f / DM) + EPS) * amx * (1.f / 127.f);
        }
        GRID_BAR(7);
    }
#pragma unroll 1
    for (int p = 0; p < 5; ++p) {
        PHASE(8 + p) {
            if (p >= 1) {
                WSL();
                const int c = p - 1;
                pg8::PolChunkA P{(const char*)HIDB(c), 128, (const char*)(ws + WS_WD0), 128, DFF, c * CHUNK_TILES};
                pg8::StaticOrder S; S.init(CHUNK_TILES, DM / 256, G, bx, c * CHUNK_TILES, WGM_DOWN);
                pg8::EpiRes<false> E{XH, XH, SSQ};
                pg8::gemm_phase(lds, P, S, E);
            }
            int pg = p; asm volatile("" : "+s"(pg));
            if (pg <= 3) {
                WSL();
                pg8::PolPlain P{(const char*)XQ, DM, (const char*)(ws + WS_WGU0)  , DM, DM / 2};
                pg8::StaticOrder S; S.init(CHUNK_TILES, 2 * DFF / 256, G, bx, pg * CHUNK_TILES, WGM_GU);
                pg8::EpiSwiGLU<2> E{HIDB(pg), pg * CHUNK_ROWS, nullptr, RSTDF, ctl + CW_AMAXW + 8 * 2 * DFF, nullptr};
                pg8::gemm_phase<pg8::EpiSwiGLU<2>, pg8::PolPlain, 1>(lds, P, S, E);
            }
            GRID_BAR(8 + p);
        }
    }
    PHASE(46) {
        WSL();
#pragma unroll 1
        for (int m = gw; m < M; m += NGW) {
            const u32x2* xr = (const u32x2*)(XH + (size_t)m * DM) + lane; f32x4 v[8]; float ss = 0.f, amx = 0.f;
#pragma unroll
            for (int j = 0; j < 8; ++j) { v[j] = unpk_f16x4(xr[64 * j]); ss += (v[j][0] * v[j][0] + v[j][1] * v[j][1]) + (v[j][2] * v[j][2] + v[j][3] * v[j][3]);
                amx = fmaxf(amx, fmaxf(fmaxf(fabsf(v[j][0]), fabsf(v[j][1])), fmaxf(fabsf(v[j][2]), fabsf(v[j][3])))); }
            ss = wave_sum(ss);
#pragma unroll
            for (int o_ = 1; o_ < 64; o_ <<= 1) amx = fmaxf(amx, __shfl_xor(amx, o_));
            const float inv = amx > 0.f ? 127.f / amx : 0.f; unsigned* xq = (unsigned*)(XQ + (size_t)m * DM) + lane;
#pragma unroll
            for (int j = 0; j < 8; ++j) { const int q0 = (int)__builtin_rintf(v[j][0] * inv), q1 = (int)__builtin_rintf(v[j][1] * inv), q2 = (int)__builtin_rintf(v[j][2] * inv), q3 = (int)__builtin_rintf(v[j][3] * inv);
                xq[64 * j] = (unsigned)(q0 & 255) | ((unsigned)(q1 & 255) << 8) | ((unsigned)(q2 & 255) << 16) | ((unsigned)(q3 & 255) << 24); }
            if (lane == 0) RSTDF[m] = __builtin_amdgcn_rsqf(ss * (1.f / DM) + EPS) * amx * (1.f / 127.f);
        }
        GRID_BAR(15);
    }
    PHASE(16) {
        WSL();
        pg8::PolPlain P{(const char*)XQ  , DM, (const char*)(ws + WS_WIN1)  , DM, DM / 2};
        pg8::StaticOrder S; S.init(M / 256, IN1_PAD / 256, G, bx, 0, WGM_K2048);
        pg8::EpiStore<4, 32> E{Z1, Z1_LD, nullptr, (LAS float*)(lds + RING_BYTES + 12288), 1.f / DM, nullptr, nullptr, nullptr, nullptr, nullptr, FL, RSTDF, ctl + CW_AMAX15};
        pg8::gemm_phase<pg8::EpiStore<4, 32>, pg8::PolPlain, 1>(lds, P, S, E);
        GRID_BAR(16);
    }
    PHASE(17) {
        WSL();
#pragma unroll 1
        for (int b = 0; b < BATCH; ++b) {
            float kmx = 0.f;
#pragma unroll 1
            for (int r = gw; r < SEQ; r += NGW) {
                const u32x4* kp = (const u32x4*)(Z1 + ((size_t)b * SEQ + r) * Z1_LD + 2048 + lane * 32); float ss = 0.f;
#pragma unroll
                for (int q = 0; q < 4; ++q) { const u32x4 w = kp[q];
#pragma unroll
                    for (int e = 0; e < 4; ++e) { const float lo_ = __uint_as_float(w[e] << 16), hi_ = __uint_as_float(w[e] & 0xffff0000u); ss += lo_ * lo_ + hi_ * hi_; } }
                ss += __shfl_xor(ss, 1); ss += __shfl_xor(ss, 2);
                kmx = fmaxf(kmx, ss);
            }
            if ((lane & 3) == 0) atomicMax(ctl + CW_KMAX + 64 * (b * 16 + (lane >> 2)), __float_as_uint(kmx));
        }
        const float* bfv = (const float*)args.in[I_BF];
        LAS double* wtot = (LAS double*)lds;
#pragma unroll 1
        for (int bh = bx; bh < BATCH * 16; bh += G) {
            const int b = bh >> 4, h = bh & 15; const float bias = bfv[h];
            const size_t base = ((size_t)b * SEQ + (size_t)tid * 32) * 16 + h;
            float lf[32]; double run = 0.0;
#pragma unroll
            for (int i = 0; i < 32; ++i) { const float xv = FL[base + (size_t)i * 16] + bias; lf[i] = fminf(xv, 0.f) - log1pf(expf(-fabsf(xv))); }
#pragma unroll
            for (int i = 0; i < 32; ++i) run += (double)lf[i];
            double incl = run;
#pragma unroll
            for (int o = 1; o < 64; o <<= 1) { const double t = __shfl_up(incl, o); if (lane >= o) incl += t; }
            float Aa = 1.f, Bb = 0.f;
#pragma unroll
            for (int i = 0; i < 32; ++i) { const float a_ = __expf(lf[i]); Bb = a_ * Bb + 1.f; Aa *= a_; }
            float Ai = Aa, Bi = Bb;
#pragma unroll
            for (int o = 1; o < 64; o <<= 1) { const float Ap = __shfl_up(Ai, o), Bp = __shfl_up(Bi, o); if (lane >= o) { Bi = Ai * Bp + Bi; Ai = Ai * Ap; } }
            LAS float* wAB = (LAS float*)(lds + 256);
            if (lane == 63) { wtot[wave] = incl; wAB[wave] = Ai; wAB[8 + wave] = Bi; }
            __syncthreads();
            { float Ss = 0.f; for (int w = 0; w < wave; ++w) Ss = wAB[w] * Ss + wAB[8 + w];
              float Ae = __shfl_up(Ai, 1), Be = __shfl_up(Bi, 1); if (lane == 0) { Ae = 1.f; Be = 0.f; }
              const float nk = __expf(lf[0]) * (Ae * Ss + Be);
              if ((tid & 1) == 0) ((float*)ctl)[CW_NEFF + bh * 256 + (tid >> 1)] = nk > 0.f ? log2f(nk) + 0.01f : -100.f; }
            double off = incl - run;
            for (int w = 0; w < wave; ++w) off += wtot[w];
            double cacc = off;
#pragma unroll
            for (int i = 0; i < 32; ++i) { cacc += (double)lf[i]; DEC[base + (size_t)i * 16] = (float)(cacc * 1.4426950408889634); }
            __syncthreads();
        }
        GRID_BAR(17);
    }
    PHASE(18) {
        WSL();
        LAS int* qslot = (LAS int*)(lds + RING_BYTES + 8192);
#pragma unroll 1
        for (;;) {
            if (tid == 0) qslot[0] = (int)__hip_atomic_fetch_add(ctl + CW_Q18, 1u, RLX_AGENT);
            __syncthreads();
            const int u = qslot[0];
            __syncthreads();
            if (u >= BATCH * 16 * 64) break;
            const int qb = 63 - (u >> 5), bh = u & 31, b = bh >> 4, h = bh & 15;
            fa::AttnArgs a; const bf16_t* zb = Z1 + (size_t)b * SEQ * Z1_LD;
            a.Q = zb + h * 128; a.ldq = Z1_LD; a.K = zb + 2048 + h * 128; a.ldk = Z1_LD; a.V = zb + 4096 + h * 128; a.ldv = Z1_LD;
            a.O = O1 + (size_t)b * SEQ * DM + h * 128; a.ldo = DM;
            a.q0 = qb * 256; a.j_lo = 0; a.j_hi = qb * 4 + 4; a.W = 0x3fffffff; a.dec = DEC + (size_t)b * SEQ * 16 + h; a.sinkl = 0.f; a.sinks = nullptr; a.biasT = nullptr;
            a.kmax = sqrtf(__uint_as_float(__hip_atomic_load(ctl + CW_KMAX + 64 * bh, RLX_AGENT))); a.neff = (const float*)ctl + CW_NEFF + bh * 256;
            fa::attn_unit<128, 128, 1>(a, (LAS char*)lds);
        }
        GRID_BAR(18);
    }
    PHASE(19) {
        WSL();
        pg8::PolPlain P{(const char*)O1, DM * 2, (const char*)(ws + WS_WO1), DM * 2, DM};
        pg8::StaticOrder S; S.init(M / 256, DM / 256, G, bx, 0, WGM_K2048);
        pg8::EpiRes<false> E{XH, XH, SSQ};
        pg8::gemm_phase(lds, P, S, E);
        GRID_BAR(19);
    }
    CROSS_PHASES(1, 20)
    PHASE(23) {
        WSL();
        LAS float* WrT = (LAS float*)lds;
        const float* rw = (const float*)args.in[I_RW]; const float* gn = (const float*)args.in[I_NFFN] + DM; const float* rb = (const float*)args.in[I_RB];
        for (int i = tid; i < 8 * DM; i += 512) { const int e = i >> 11, k = i & 2047; WrT[i] = rw[k * 8 + e] * gn[k]; }
        __syncthreads();
#pragma unroll 1
        for (int g16 = gw; g16 < M / 16; g16 += NGW) {
            int e1 = 0, e2 = 0; float g1 = 0.f, g2 = 0.f, rstd = 0.f;
#pragma unroll 1
            for (int i = 0; i < 16; ++i) {
                const int row = g16 * 16 + i;
                const u32x2* xr = (const u32x2*)(XH + (size_t)row * DM) + lane;
                float pe[8], ss = 0.f, amx = 0.f;
#pragma unroll
                for (int e = 0; e < 8; ++e) pe[e] = 0.f;
#pragma unroll 2
                for (int j = 0; j < 8; ++j) { const f32x4 v = unpk_f16x4(xr[64 * j]); ss += (v[0] * v[0] + v[1] * v[1]) + (v[2] * v[2] + v[3] * v[3]);
                    amx = fmaxf(amx, fmaxf(fmaxf(fabsf(v[0]), fabsf(v[1])), fmaxf(fabsf(v[2]), fabsf(v[3]))));
#pragma unroll
                    for (int e = 0; e < 8; ++e) { const f32x4 w = *(const LAS f32x4*)(WrT + e * DM + 256 * j + lane * 4); pe[e] += (v[0] * w[0] + v[1] * w[1]) + (v[2] * w[2] + v[3] * w[3]); } }
                ss = wave_sum(ss);
#pragma unroll
                for (int e = 0; e < 8; ++e) pe[e] = wave_sum(pe[e]);
                const float rs = __builtin_amdgcn_rsqf(ss * (1.f / DM) + EPS);
#pragma unroll
                for (int o_ = 1; o_ < 64; o_ <<= 1) amx = fmaxf(amx, __shfl_xor(amx, o_));
                { const float inv = amx > 0.f ? 127.f / amx : 0.f; unsigned* xq = (unsigned*)(XQ + (size_t)row * DM) + lane;
#pragma unroll 2
                  for (int j = 0; j < 8; ++j) { const f32x4 v = unpk_f16x4(xr[64 * j]);
                      const int q0 = (int)__builtin_rintf(v[0] * inv), q1 = (int)__builtin_rintf(v[1] * inv), q2 = (int)__builtin_rintf(v[2] * inv), q3 = (int)__builtin_rintf(v[3] * inv);
                      xq[64 * j] = (unsigned)(q0 & 255) | ((unsigned)(q1 & 255) << 8) | ((unsigned)(q2 & 255) << 16) | ((unsigned)(q3 & 255) << 24); } }
                const float rowf = rs * amx * (1.f / 127.f);
                float lg[8];
#pragma unroll
                for (int e = 0; e < 8; ++e) lg[e] = pe[e] * rs + rb[e];
                int b1 = 0; float v1 = lg[0];
#pragma unroll
                for (int e = 1; e < 8; ++e) if (lg[e] > v1) { v1 = lg[e]; b1 = e; }
                int b2 = -1; float v2 = -__builtin_inff();
#pragma unroll
                for (int e = 0; e < 8; ++e) if (e != b1 && lg[e] > v2) { v2 = lg[e]; b2 = e; }
                const float ex = __expf(v2 - v1); const float gg2 = ex / (1.f + ex), gg1 = 1.f / (1.f + ex);
                if (lane == i) { e1 = b1; e2 = b2; g1 = gg1; g2 = gg2; rstd = rowf; }
            }
            int s1 = 0, s2 = 0;
#pragma unroll
            for (int e = 0; e < 8; ++e) {
                const unsigned long long m1 = __ballot(lane < 16 && e1 == e), m2 = __ballot(lane < 16 && e2 == e);
                const int c1 = __popcll(m1), c2 = __popcll(m2);
                int basev = 0;
                if (lane == 0 && c1 + c2 > 0) basev = (int)__hip_atomic_fetch_add(ctl + CW_CNT + 64 * e, (unsigned)(c1 + c2), RLX_AGENT);
                basev = __shfl(basev, 0);
                const unsigned long long lt = (1ull << lane) - 1ull;
                if (lane < 16 && e1 == e) s1 = basev + __popcll(m1 & lt);
                if (lane < 16 && e2 == e) s2 = basev + c1 + __popcll(m2 & lt);
            }
            if (lane < 16) { const int row = g16 * 16 + lane; TOPE[row * 2] = e1; TOPE[row * 2 + 1] = e2; TOPS[row * 2] = s1; TOPS[row * 2 + 1] = s2;
                TOPG[row * 2] = g1; TOPG[row * 2 + 1] = g2; RSTDF[row] = rstd; }
        }
        GRID_BAR(23);
    }
    if (hi > 24) {
#define EOFF() int eoff[9]; eoff[0] = 0; _Pragma("unroll") for (int e = 0; e < 8; ++e) { const int c_ = (int)__hip_atomic_load(ctl + CW_CNT + 64 * e, RLX_AGENT); eoff[e + 1] = eoff[e] + ((c_ + 255) & ~255); }
        PHASE(24) {
            WSL();
            EOFF();
            int ecnt[8];
#pragma unroll
            for (int e = 0; e < 8; ++e) ecnt[e] = (int)__hip_atomic_load(ctl + CW_CNT + 64 * e, RLX_AGENT);
            int gt1_ = tid; asm volatile("" : "+v"(gt1_)); gt1_ += bx * 512;
            for (int i = gt1_; i < M * 2; i += G * 512) {
                const int e = TOPE[i], sl = TOPS[i]; int off = 0;
#pragma unroll
                for (int q = 0; q < 8; ++q) if (q == e) off = eoff[q];
                const int pos = off + sl; ROWIDX[pos] = i >> 1; GATEP[pos] = TOPG[i]; RSTDP[pos] = RSTDF[i >> 1]; TOKPOS[i] = pos;
            }
            for (int i = gt1_; i < 8 * 256; i += G * 512) {
                const int e = i >> 8, j = i & 255; int off = 0, cnt = 0, nxt = 0;
#pragma unroll
                for (int q = 0; q < 8; ++q) if (q == e) { off = eoff[q]; cnt = ecnt[q]; nxt = eoff[q + 1]; }
                const int pos = off + cnt + j;
                if (pos < nxt) { ROWIDX[pos] = 0; GATEP[pos] = 0.f; RSTDP[pos] = 0.f; }
            }
            GRID_BAR(24);
        }
        LAS int* TILE_E = (LAS int*)(lds + RING_BYTES + 1024);
        if (hi > 25) {
            EOFF();
            for (int t = tid; t < MOE_MAX_TILES; t += 512) { int e = 0;
#pragma unroll
                for (int q = 1; q < 8; ++q) if (t * 256 >= eoff[q]) e = q;
                TILE_E[t] = e; }
            if (tid == 0) TILE_E[MOE_MAX_TILES] = eoff[8] >> 8;
            __syncthreads();
        }
#pragma unroll 1
        for (int p = 0; p <= MOE_CHUNKS; ++p) {
            PHASE(25 + p) {
                int ndown = 0;
                { WSL();
                const int ntiles = TILE_E[MOE_MAX_TILES], nch = (ntiles + MCH_TILES - 1) / MCH_TILES, t0 = ntiles - MCH_TILES * (nch - 1);
                if (p >= 1 && p - 1 < nch) {
                    const int c = p - 1, ft = c == 0 ? 0 : t0 + (c - 1) * MCH_TILES, nt_ = c == 0 ? t0 : MCH_TILES;
                    pg8::PolMoeDown P{(const char*)HIDB(c)  , 128, (const char*)(ws + WS_WD1)  , 128, DFF / 2, ft, TILE_E, E_D};
                    pg8::StaticOrder S; S.init(nt_, DM / 256, G, bx, ft, WGM_DOWN);
                    pg8::EpiMoeDown E{YB, GATEP};
                    pg8::gemm_phase<pg8::EpiMoeDown, pg8::PolMoeDown, 4>(lds, P, S, E);
                    ndown = nt_ * (DM / 256);
                } }
                int pg = p; asm volatile("" : "+s"(pg), "+s"(ndown));
                { WSL();
                const int ntiles = TILE_E[MOE_MAX_TILES], nch = (ntiles + MCH_TILES - 1) / MCH_TILES, t0 = ntiles - MCH_TILES * (nch - 1);
                if (pg < nch) {
                    const int ft = pg == 0 ? 0 : t0 + (pg - 1) * MCH_TILES, nt_ = pg == 0 ? t0 : MCH_TILES;
                    pg8::PolMoeUp P{(const char*)XQ  , DM, (const char*)(ws + WS_WGU1)  , DM, DM / 2, ROWIDX, TILE_E, E_GU};
                    pg8::StaticOrder S; S.init(nt_, 2 * DFF / 256, G, bx, ft, WGM_GU); S.quota(ndown);
                    pg8::EpiSwiGLU<2> E{HIDB(pg), ft * 256, nullptr, RSTDP, ctl + CW_AMAXW, TILE_E, 1};
                    pg8::gemm_phase<pg8::EpiSwiGLU<2>, pg8::PolMoeUp, 1>(lds, P, S, E);
                } }
                GRID_BAR(25 + p);
            }
        }
    }
    PHASE(43) {
        WSL();
        const float* fn = (const float*)args.in[I_FNORM];
#pragma unroll 1
        for (int m = gw; m < M; m += NGW) {
            const int p0 = TOKPOS[m * 2], p1 = TOKPOS[m * 2 + 1];
            const u32x2* xr = (const u32x2*)(XH + (size_t)m * DM) + lane; f32x4* orow = (f32x4*)(args.out + (size_t)m * DM) + lane;
            const unsigned* y0 = (const unsigned*)((const unsigned char*)YB + (size_t)p0 * DM) + lane; const unsigned* y1 = (const unsigned*)((const unsigned char*)YB + (size_t)p1 * DM) + lane;
            f32x4 v[8]; float s = 0.f;
#pragma unroll
            for (int j = 0; j < 8; ++j) { v[j] = unpk_f16x4(xr[64 * j]); const int a0 = (int)y0[64 * j], a1 = (int)y1[64 * j];
                v[j][0] += __builtin_amdgcn_cvt_f32_fp8(a0, 0) + __builtin_amdgcn_cvt_f32_fp8(a1, 0); v[j][1] += __builtin_amdgcn_cvt_f32_fp8(a0, 1) + __builtin_amdgcn_cvt_f32_fp8(a1, 1);
                v[j][2] += __builtin_amdgcn_cvt_f32_fp8(a0, 2) + __builtin_amdgcn_cvt_f32_fp8(a1, 2); v[j][3] += __builtin_amdgcn_cvt_f32_fp8(a0, 3) + __builtin_amdgcn_cvt_f32_fp8(a1, 3);
                s += (v[j][0] * v[j][0] + v[j][1] * v[j][1]) + (v[j][2] * v[j][2] + v[j][3] * v[j][3]); }
            s = wave_sum(s); const float rs = __builtin_amdgcn_rsqf(s * (1.f / DM) + EPS);
#pragma unroll
            for (int j = 0; j < 8; ++j) { const f32x4 g = *((const f32x4*)fn + lane + 64 * j); orow[64 * j] = v[j] * rs * g; }
        }
    }
#undef IN
#undef GRID_BAR
}

constexpr int N_STEPS = 47;
extern "C" void kernel_launch(void* const* d_in, const int* in_sizes, int n_in, void* d_out, int out_size, void* d_ws, size_t ws_size, hipStream_t stream) {
    static int grid = 0;
    if (grid == 0) {
        if (n_in != N_IN || in_sizes[0] != M * DM || out_size != M * DM || ws_size < WS_END) {
            fprintf(stderr, "kernel_launch: shape / workspace mismatch (n_in %d, in0 %d, out %d, ws %zu, need %zu); nothing launched\n", n_in, n_in > 0 ? in_sizes[0] : -1, out_size, ws_size, (size_t)WS_END); grid = -1; return; }
        int dev = 0, cus = 0, per_cu = 0;
        if (hipGetDevice(&dev) != hipSuccess || hipDeviceGetAttribute(&cus, hipDeviceAttributeMultiprocessorCount, dev) != hipSuccess) { grid = -1; return; }
        if (hipFuncSetAttribute((const void*)trunk_fwd, hipFuncAttributeMaxDynamicSharedMemorySize, LDS_BYTES) != hipSuccess) { fprintf(stderr, "kernel_launch: hipFuncSetAttribute failed\n"); grid = -1; return; }
        if (hipOccupancyMaxActiveBlocksPerMultiprocessor(&per_cu, (const void*)trunk_fwd, NWAVES * 64, LDS_BYTES) != hipSuccess || per_cu < 1)
            fprintf(stderr, "kernel_launch: note: occupancy query reports %d workgroups per CU\n", per_cu);
        (void)hipGetLastError();
        grid = cus;
    }
    if (grid < 0) return;
    if (hipMemsetAsync((char*)d_ws + WS_CTL, 0, CTL_BYTES, stream) != hipSuccess) return;
    Args a{};
    for (int i = 0; i < N_IN; ++i) a.in[i] = d_in[i];
    a.out = (float*)d_out; a.ws = (unsigned char*)d_ws;
#if MK_ONE_LAUNCH
    a.ph_lo = 0; a.ph_hi = N_STEPS;
    hipLaunchKernelGGL(trunk_fwd, dim3(grid), dim3(NWAVES * 64), LDS_BYTES, stream, a);
#else
    for (int i = 0; i < N_STEPS; ++i) { const int s = i == 0 ? 0 : (i == 1 ? 44 : (i <= 8 ? i - 1 : (i == 9 ? 45 : (i <= 14 ? i - 2 : (i == 15 ? 46 : i - 3))))); a.ph_lo = s; a.ph_hi = s + 1; hipLaunchKernelGGL(trunk_fwd, dim3(grid), dim3(NWAVES * 64), LDS_BYTES, stream, a); }
#endif
}
```
